# Optimizing an MI355X kernel written in HIP

```python
import math
import jax
import jax.numpy as jnp
from jax import lax
import numpy as np

D_MODEL = 1024
BATCH = 32
SEQ = 2048
DEPTH = 4

GRID_W = 64
CTX_LEN = 256
N_MOD = 6
EPS = 1e-6
W_A = 256
W_B = 256
W_C = 256
W_D = 256
D_MIX = W_A + W_B + W_C + W_D
LRU_HEADS = 4
LRU_HEAD_DIM = W_A // LRU_HEADS
LRU_CONV = 4
RG_C = 8.0
DIFF_HEADS = 4
DIFF_DV = W_B // DIFF_HEADS
DIFF_DK = DIFF_DV // 2
ROPE_BASE = 10000.0
ROPE_FREQS = DIFF_DK // 4
Q_BLOCK = 128
CONF_K = 31
HYENA_ORDER = 2
HYENA_SHORT = 3
HYENA_EMB = 33
HYENA_BANDS = (HYENA_EMB - 1) // 2
HYENA_FFN = 64
HYENA_MIN_DECAY = -math.log(1e-2) / 1.5
HYENA_MAX_DECAY = -math.log(1e-2) / 0.3
N_GROUPS = 4
EXPERTS_PER_GROUP = 8
N_EXPERTS = N_GROUPS * EXPERTS_PER_GROUP
TOP_K = 2
D_EXPERT = 512
MOE_BLOCK = 128
IN_A = 2 * W_A
IN_B = 3 * W_B
IN_C = 2 * W_C
IN_D = (HYENA_ORDER + 1) * W_D
OFF_B = IN_A
OFF_C = OFF_B + IN_B
OFF_D = OFF_C + IN_C
D_IN = OFF_D + IN_D

kernel_name = 'hybrid_parallel_groups_dit_block'


def rms_norm(x, g, eps=EPS):
    xf = x.astype(jnp.float32)
    y = xf * lax.rsqrt(jnp.mean(xf * xf, -1, keepdims=True) + eps)
    return (y * g).astype(x.dtype)


def layer_norm(x, g, b, eps=1e-5):
    xf = x.astype(jnp.float32)
    mu = jnp.mean(xf, -1, keepdims=True)
    var = jnp.mean(jnp.square(xf - mu), -1, keepdims=True)
    return ((xf - mu) * lax.rsqrt(var + eps) * g + b).astype(x.dtype)


def modulate(x, shift, scale):
    return x * (1.0 + scale) + shift


def dwconv(x, w, b, pad):
    y = lax.conv_general_dilated(
        x, w.astype(x.dtype)[:, None, :], window_strides=(1,), padding=[pad],
        dimension_numbers=('NWC', 'WIO', 'NWC'), feature_group_count=x.shape[-1])
    return y + b


def linear_scan(a, b, h0, reverse):
    edge = -1 if reverse else 0
    b = b.at[:, edge].add(a[:, edge] * h0)

    def combine(left, right):
        a1, b1 = left
        a2, b2 = right
        return a1 * a2, a2 * b1 + b2

    _, h = lax.associative_scan(combine, (a, b), reverse=reverse, axis=1)
    return h


def rglru_direction(x, conv_w, conv_b, w_r, b_r, w_i, b_i, lam, pad, reverse, h0):
    u = dwconv(x, conv_w, conv_b, pad)
    B_, L, _ = u.shape
    uh = u.reshape(B_, L, LRU_HEADS, LRU_HEAD_DIM)
    r = jax.nn.sigmoid((jnp.einsum('blhi,hij->blhj', uh, w_r).reshape(B_, L, W_A) + b_r).astype(jnp.float32))
    i = jax.nn.sigmoid((jnp.einsum('blhi,hij->blhj', uh, w_i).reshape(B_, L, W_A) + b_i).astype(jnp.float32))
    log_a = -RG_C * r * jax.nn.softplus(-lam.astype(jnp.float32))
    a = jnp.exp(log_a)
    b = jnp.sqrt(-jnp.expm1(2.0 * log_a)) * (i * u.astype(jnp.float32))
    return linear_scan(a, b, h0, reverse)


def rglru_mixer(pa, pa_c, conv_w, conv_b, w_r, b_r, w_i, b_i, lam, ctx_out):
    xr, xg = pa[..., :W_A], pa[..., W_A:]
    xr_c, xg_c = pa_c[..., :W_A], pa_c[..., W_A:]
    h_lat, h_ctx = [], []
    for d, reverse in enumerate((False, True)):
        pad = (0, LRU_CONV - 1) if reverse else (LRU_CONV - 1, 0)
        prm = (conv_w[d], conv_b[d], w_r[d], b_r[d], w_i[d], b_i[d], lam[d], pad, reverse)
        hc = rglru_direction(xr_c, *prm, jnp.zeros((xr_c.shape[0], W_A), jnp.float32))
        h_final = hc[:, 0] if reverse else hc[:, -1]
        h_lat.append(rglru_direction(xr, *prm, h_final))
        h_ctx.append(hc)
    y = (h_lat[0] + h_lat[1]) * jax.nn.gelu(xg)
    y_c = (h_ctx[0] + h_ctx[1]) * jax.nn.gelu(xg_c) if ctx_out else None
    return y, y_c


def axial_rope_tables(L):
    rows = L // GRID_W
    row = jnp.repeat(jnp.arange(rows, dtype=jnp.float32), GRID_W)
    col = jnp.tile(jnp.arange(GRID_W, dtype=jnp.float32), rows)
    inv = ROPE_BASE ** (-jnp.arange(ROPE_FREQS, dtype=jnp.float32) / ROPE_FREQS)
    ang = jnp.concatenate([row[:, None] * inv, col[:, None] * inv], -1)
    return jnp.cos(ang), jnp.sin(ang)


def apply_rope(x, cos, sin):
    half = x.shape[-1] // 2
    cs = cos[None, :, None, None, :]
    sn = sin[None, :, None, None, :]
    x1, x2 = x[..., :half], x[..., half:]
    return jnp.concatenate([x1 * cs - x2 * sn, x1 * sn + x2 * cs], -1).astype(x.dtype)


def diff_softmax(q, k, v, lam):
    s = jnp.einsum('bqhcd,bkhcd->bhcqk', q, k).astype(jnp.float32) * (DIFF_DK ** -0.5)
    p = jax.nn.softmax(s, -1)
    w = p[:, :, 0] - lam * p[:, :, 1]
    return jnp.einsum('bhqk,bkhd->bqhd', w, v)


def diff_attn_mixer(pb, pb_c, rope_cos, rope_sin, lq1, lk1, lq2, lk2, sub_g, lam_init, ctx_out):
    B_, L, _ = pb.shape
    Lc = pb_c.shape[1]
    lam = (jnp.exp(jnp.sum(lq1.astype(jnp.float32) * lk1)) -
           jnp.exp(jnp.sum(lq2.astype(jnp.float32) * lk2)) + lam_init)

    def split_qkv(pp, n):
        q, k, v = jnp.split(pp, 3, -1)
        return (q.reshape(B_, n, DIFF_HEADS, 2, DIFF_DK), k.reshape(B_, n, DIFF_HEADS, 2, DIFF_DK),
                v.reshape(B_, n, DIFF_HEADS, DIFF_DV))

    q, k, v = split_qkv(pb, L)
    q = apply_rope(q, rope_cos, rope_sin)
    k = apply_rope(k, rope_cos, rope_sin)
    q_c, k_c, v_c = split_qkv(pb_c, Lc)
    keys = jnp.concatenate([k, k_c], 1)
    vals = jnp.concatenate([v, v_c], 1)
    n_blk = L // Q_BLOCK
    qb = jnp.moveaxis(q.reshape(B_, n_blk, Q_BLOCK, DIFF_HEADS, 2, DIFF_DK), 1, 0)
    o = lax.map(lambda qq: diff_softmax(qq, keys, vals, lam), qb)
    o = jnp.moveaxis(o, 0, 1).reshape(B_, L, DIFF_HEADS, DIFF_DV)

    def head_out(oo):
        return (rms_norm(oo, sub_g) * (1.0 - lam_init)).reshape(oo.shape[0], oo.shape[1], W_B)

    y = head_out(o)
    y_c = head_out(diff_softmax(q_c, k_c, v_c, lam)) if ctx_out else None
    return y, y_c


def conformer_conv(pc, conv_w, conv_b, ln_g, ln_b, w_pw, b_pw):
    u = pc[..., :W_C] * jax.nn.sigmoid(pc[..., W_C:])
    u = dwconv(u, conv_w, conv_b, (CONF_K // 2, CONF_K // 2))
    u = layer_norm(u, ln_g, ln_b)
    return jax.nn.silu(u) @ w_pw + b_pw


def hyena_filters(L, w_f1, b_f1, freq, w_f2, b_f2, w_f3, decay):
    t = jnp.arange(L, dtype=jnp.float32)
    t_unit = t / max(L - 1, 1)
    bands = jnp.linspace(1e-4, HYENA_BANDS - 1, HYENA_BANDS, dtype=jnp.float32)
    ang = (2.0 * math.pi / L) * t[:, None] * bands[None, :]
    feats = jnp.concatenate([t_unit[:, None], jnp.cos(ang), -jnp.sin(ang)], -1)
    f = jnp.sin(freq * (feats @ w_f1 + b_f1))
    f = jnp.sin(freq * (f @ w_f2 + b_f2))
    h = (f @ w_f3) * jnp.exp(-t_unit[:, None] * jnp.abs(decay))
    h = h.astype(jnp.float32).reshape(L, HYENA_ORDER, 2, W_D)
    energy = jnp.sum(jnp.square(h[:, :, 0]), 0) + jnp.sum(jnp.square(h[1:, :, 1]), 0)
    return h * lax.rsqrt(energy + EPS)[None, :, None, :]


def long_conv_bidir(z, h_fwd, h_bwd, bias):
    B_, L, C = z.shape
    n = 2 * L
    taps = jnp.concatenate([h_fwd, jnp.zeros((1, C), jnp.float32), h_bwd[:0:-1]], 0)
    zf = z.astype(jnp.float32)
    y = jnp.fft.irfft(jnp.fft.rfft(zf, n=n, axis=1) * jnp.fft.rfft(taps, n=n, axis=0)[None], n=n, axis=1)
    return y[:, :L] + zf * bias


def hyena_mixer(pd, filt, conv_w, conv_b, h_bias):
    u = dwconv(pd, conv_w, conv_b, (HYENA_SHORT // 2, HYENA_SHORT // 2))
    v, x1, x2 = jnp.split(u, HYENA_ORDER + 1, -1)
    z = v
    for o, gate in enumerate((x1, x2)):
        z = gate * long_conv_bidir(z, filt[:, o, 0], filt[:, o, 1], h_bias[o])
    return z


def hier_moe(h, w_rg, b_rg, w_re, b_re, w_gate, w_up, w_down):
    T, D = h.shape
    hf = h.astype(jnp.float32)
    p_grp, g_idx = lax.top_k(jax.nn.softmax(hf @ w_rg.astype(jnp.float32) + b_rg, -1), 1)
    le = (hf @ w_re.astype(jnp.float32) + b_re).reshape(T, N_GROUPS, EXPERTS_PER_GROUP)
    le = jnp.take_along_axis(le, g_idx[:, :, None], axis=1)[:, 0]
    p_in, e_in = lax.top_k(jax.nn.softmax(le, -1), TOP_K)
    p_in = p_in / jnp.sum(p_in, -1, keepdims=True)
    gate = (p_grp * p_in).reshape(-1)
    expert = (g_idx * EXPERTS_PER_GROUP + e_in).reshape(-1)
    token = jnp.repeat(jnp.arange(T, dtype=jnp.int32), TOP_K)
    n_assign = T * TOP_K
    order = jnp.argsort(expert)
    e_sorted = expert[order]
    counts = jnp.bincount(expert, length=N_EXPERTS)
    padded = (counts + MOE_BLOCK - 1) // MOE_BLOCK * MOE_BLOCK
    start = jnp.cumsum(counts) - counts
    p_end = jnp.cumsum(padded)
    p_start = p_end - padded
    dest = p_start[e_sorted] + jnp.arange(n_assign, dtype=jnp.int32) - start[e_sorted]
    n_slots = -(-n_assign // MOE_BLOCK) * MOE_BLOCK + N_EXPERTS * MOE_BLOCK
    n_blk = n_slots // MOE_BLOCK
    slot_tok = jnp.full((n_slots,), T, jnp.int32).at[dest].set(token[order])
    slot_gate = jnp.zeros((n_slots,), jnp.float32).at[dest].set(gate[order])
    blk_expert = jnp.minimum(
        jnp.searchsorted(p_end, jnp.arange(n_blk, dtype=jnp.int32) * MOE_BLOCK, side='right'), N_EXPERTS - 1)
    h_pad = jnp.concatenate([h, jnp.zeros((1, D), h.dtype)], 0)

    def expert_block(args):
        toks, gw, e = args
        xb = h_pad[toks]
        hid = jax.nn.silu(xb @ w_gate[e]) * (xb @ w_up[e])
        return (hid @ w_down[e]) * gw[:, None]

    y = lax.map(expert_block, (slot_tok.reshape(n_blk, MOE_BLOCK),
                               slot_gate.reshape(n_blk, MOE_BLOCK), blk_expert))
    y = jax.ops.segment_sum(y.reshape(n_slots, D), slot_tok, num_segments=T + 1)
    return y[:T]


def setup_inputs(seed: int = 0) -> dict:
    key = jax.random.key(seed)
    ks = iter(jax.random.split(key, 64))

    def nrm(shape, scale):
        return scale * jax.random.normal(next(ks), shape, jnp.float32)

    def gain(shape):
        return 1.0 + nrm(shape, 0.05)

    x = nrm((BATCH, SEQ, D_MODEL), 1.0)
    c = nrm((BATCH, D_MODEL), 1.0)
    ctx = nrm((BATCH, CTX_LEN, D_MODEL), 1.0)
    c_ctx = nrm((D_MODEL,), 1.0)
    w_ada = nrm((DEPTH, D_MODEL, N_MOD * D_MODEL), 0.5 * D_MODEL ** -0.5)
    b_ada = nrm((DEPTH, N_MOD * D_MODEL), 0.02)
    g_mix = gain((DEPTH, D_MODEL))
    g_ffn = gain((DEPTH, D_MODEL))
    w_in = nrm((DEPTH, D_MODEL, D_IN), D_MODEL ** -0.5)
    w_out = nrm((DEPTH, D_MIX, D_MODEL), D_MIX ** -0.5)
    a_conv_w = nrm((DEPTH, 2, LRU_CONV, W_A), LRU_CONV ** -0.5)
    a_conv_b = nrm((DEPTH, 2, W_A), 0.02)
    a_w_r = nrm((DEPTH, 2, LRU_HEADS, LRU_HEAD_DIM, LRU_HEAD_DIM), LRU_HEAD_DIM ** -0.5)
    a_b_r = nrm((DEPTH, 2, W_A), 0.02)
    a_w_i = nrm((DEPTH, 2, LRU_HEADS, LRU_HEAD_DIM, LRU_HEAD_DIM), LRU_HEAD_DIM ** -0.5)
    a_b_i = nrm((DEPTH, 2, W_A), 0.02)
    a_pow = jax.random.uniform(next(ks), (DEPTH, 2, W_A), jnp.float32, 0.9, 0.999)
    a_base = a_pow ** (1.0 / RG_C)
    a_lam = jnp.log(a_base) - jnp.log1p(-a_base)
    b_lq1 = nrm((DEPTH, DIFF_DK), 0.1)
    b_lk1 = nrm((DEPTH, DIFF_DK), 0.1)
    b_lq2 = nrm((DEPTH, DIFF_DK), 0.1)
    b_lk2 = nrm((DEPTH, DIFF_DK), 0.1)
    b_sub_g = gain((DEPTH, DIFF_DV))
    c_conv_w = nrm((DEPTH, CONF_K, W_C), CONF_K ** -0.5)
    c_conv_b = nrm((DEPTH, W_C), 0.02)
    c_ln_g = gain((DEPTH, W_C))
    c_ln_b = nrm((DEPTH, W_C), 0.02)
    c_w_pw = nrm((DEPTH, W_C, W_C), W_C ** -0.5)
    c_b_pw = nrm((DEPTH, W_C), 0.02)
    d_conv_w = nrm((DEPTH, HYENA_SHORT, IN_D), HYENA_SHORT ** -0.5)
    d_conv_b = nrm((DEPTH, IN_D), 0.02)
    d_w_f1 = nrm((DEPTH, HYENA_EMB, HYENA_FFN), HYENA_EMB ** -0.5)
    d_b_f1 = nrm((DEPTH, HYENA_FFN), 0.1)
    d_freq = gain((DEPTH, HYENA_FFN))
    d_w_f2 = nrm((DEPTH, HYENA_FFN, HYENA_FFN), HYENA_FFN ** -0.5)
    d_b_f2 = nrm((DEPTH, HYENA_FFN), 0.1)
    d_w_f3 = nrm((DEPTH, HYENA_FFN, 2 * HYENA_ORDER * W_D), HYENA_FFN ** -0.5)
    decay0 = jnp.tile(jnp.linspace(HYENA_MIN_DECAY, HYENA_MAX_DECAY, W_D, dtype=jnp.float32), 2 * HYENA_ORDER)
    d_decay = decay0[None, :] + nrm((DEPTH, 2 * HYENA_ORDER * W_D), 0.1)
    d_bias = nrm((DEPTH, HYENA_ORDER, W_D), 1.0)
    moe_w_rg = nrm((DEPTH, D_MODEL, N_GROUPS), D_MODEL ** -0.5)
    moe_b_rg = nrm((DEPTH, N_GROUPS), 0.01)
    moe_w_re = nrm((DEPTH, D_MODEL, N_EXPERTS), D_MODEL ** -0.5)
    moe_b_re = nrm((DEPTH, N_EXPERTS), 0.01)
    moe_w_gate = nrm((DEPTH, N_EXPERTS, D_MODEL, D_EXPERT), D_MODEL ** -0.5)
    moe_w_up = nrm((DEPTH, N_EXPERTS, D_MODEL, D_EXPERT), D_MODEL ** -0.5)
    moe_w_down = nrm((DEPTH, N_EXPERTS, D_EXPERT, D_MODEL), D_EXPERT ** -0.5)
    g_final = gain((D_MODEL,))
    return {
        'x': x, 'c': c, 'ctx': ctx, 'c_ctx': c_ctx,
        'w_ada': w_ada, 'b_ada': b_ada, 'g_mix': g_mix, 'g_ffn': g_ffn, 'w_in': w_in, 'w_out': w_out,
        'a_conv_w': a_conv_w, 'a_conv_b': a_conv_b, 'a_w_r': a_w_r, 'a_b_r': a_b_r,
        'a_w_i': a_w_i, 'a_b_i': a_b_i, 'a_lam': a_lam,
        'b_lq1': b_lq1, 'b_lk1': b_lk1, 'b_lq2': b_lq2, 'b_lk2': b_lk2, 'b_sub_g': b_sub_g,
        'c_conv_w': c_conv_w, 'c_conv_b': c_conv_b, 'c_ln_g': c_ln_g, 'c_ln_b': c_ln_b,
        'c_w_pw': c_w_pw, 'c_b_pw': c_b_pw,
        'd_conv_w': d_conv_w, 'd_conv_b': d_conv_b, 'd_w_f1': d_w_f1, 'd_b_f1': d_b_f1, 'd_freq': d_freq,
        'd_w_f2': d_w_f2, 'd_b_f2': d_b_f2, 'd_w_f3': d_w_f3, 'd_decay': d_decay, 'd_bias': d_bias,
        'moe_w_rg': moe_w_rg, 'moe_b_rg': moe_b_rg, 'moe_w_re': moe_w_re, 'moe_b_re': moe_b_re,
        'moe_w_gate': moe_w_gate, 'moe_w_up': moe_w_up, 'moe_w_down': moe_w_down,
        'g_final': g_final,
    }


def reference(x, c, ctx, c_ctx, w_ada, b_ada, g_mix, g_ffn, w_in, w_out,
              a_conv_w, a_conv_b, a_w_r, a_b_r, a_w_i, a_b_i, a_lam,
              b_lq1, b_lk1, b_lq2, b_lk2, b_sub_g,
              c_conv_w, c_conv_b, c_ln_g, c_ln_b, c_w_pw, c_b_pw,
              d_conv_w, d_conv_b, d_w_f1, d_b_f1, d_freq, d_w_f2, d_b_f2, d_w_f3, d_decay, d_bias,
              moe_w_rg, moe_b_rg, moe_w_re, moe_b_re, moe_w_gate, moe_w_up, moe_w_down,
              g_final):
    out_dtype = x.dtype
    B_, L, D = x.shape
    Lc = ctx.shape[1]
    n_lat = B_ * L
    rope_cos, rope_sin = axial_rope_tables(L)
    s_lat = jax.nn.silu(c.astype(jnp.float32))
    s_ctx = jax.nn.silu(c_ctx.astype(jnp.float32))
    xc = ctx
    for l in range(DEPTH):
        last = l == DEPTH - 1
        mod = jnp.split((s_lat @ w_ada[l] + b_ada[l])[:, None, :], N_MOD, -1)
        mod_c = jnp.split(s_ctx @ w_ada[l] + b_ada[l], N_MOD, -1)
        lam_init = 0.8 - 0.6 * math.exp(-0.3 * l)
        conf = (c_conv_w[l], c_conv_b[l], c_ln_g[l], c_ln_b[l], c_w_pw[l], c_b_pw[l])
        hy = (d_w_f1[l], d_b_f1[l], d_freq[l], d_w_f2[l], d_b_f2[l], d_w_f3[l], d_decay[l])
        h = modulate(rms_norm(x, g_mix[l]), mod[0], mod[1])
        hc = modulate(rms_norm(xc, g_mix[l]), mod_c[0], mod_c[1])
        p = h @ w_in[l]
        p_c = hc @ w_in[l][:, :(OFF_C if last else D_IN)]
        y_a, yc_a = rglru_mixer(p[..., :OFF_B], p_c[..., :OFF_B], a_conv_w[l], a_conv_b[l],
                                a_w_r[l], a_b_r[l], a_w_i[l], a_b_i[l], a_lam[l], not last)
        y_b, yc_b = diff_attn_mixer(p[..., OFF_B:OFF_C], p_c[..., OFF_B:OFF_C], rope_cos, rope_sin,
                                    b_lq1[l], b_lk1[l], b_lq2[l], b_lk2[l], b_sub_g[l], lam_init, not last)
        y_c = conformer_conv(p[..., OFF_C:OFF_D], *conf)
        y_d = hyena_mixer(p[..., OFF_D:], hyena_filters(L, *hy), d_conv_w[l], d_conv_b[l], d_bias[l])
        x = x + mod[2] * (jnp.concatenate([y_a, y_b, y_c, y_d], -1) @ w_out[l])
        if not last:
            yc_c = conformer_conv(p_c[..., OFF_C:OFF_D], *conf)
            yc_d = hyena_mixer(p_c[..., OFF_D:], hyena_filters(Lc, *hy), d_conv_w[l], d_conv_b[l], d_bias[l])
            xc = xc + mod_c[2] * (jnp.concatenate([yc_a, yc_b, yc_c, yc_d], -1) @ w_out[l])
        moe = (moe_w_rg[l], moe_b_rg[l], moe_w_re[l], moe_b_re[l], moe_w_gate[l], moe_w_up[l], moe_w_down[l])
        h = modulate(rms_norm(x, g_ffn[l]), mod[3], mod[4]).reshape(n_lat, D)
        if last:
            x = x + mod[5] * hier_moe(h, *moe).reshape(B_, L, D)
        else:
            hc = modulate(rms_norm(xc, g_ffn[l]), mod_c[3], mod_c[4]).reshape(B_ * Lc, D)
            f = hier_moe(jnp.concatenate([h, hc], 0), *moe)
            x = x + mod[5] * f[:n_lat].reshape(B_, L, D)
            xc = xc + mod_c[5] * f[n_lat:].reshape(B_, Lc, D)
    return rms_norm(x, g_final).astype(out_dtype)
```

```cpp
#include <hip/hip_runtime.h>
#include <cstdio>
#include <cstdint>
#include <cstring>

#ifndef PH_MASK
#define PH_MASK 0xffffffffu
#endif
#define PH(k) ((PH_MASK >> (k)) & 1u)
#ifndef STOP_AFTER
#define STOP_AFTER 9999
#endif

#define LAS __attribute__((address_space(3)))
typedef unsigned short bf16_t;
typedef short bf16x8 __attribute__((ext_vector_type(8)));
typedef float f32x4 __attribute__((ext_vector_type(4)));
typedef float f32x16 __attribute__((ext_vector_type(16)));
typedef unsigned u32x4 __attribute__((ext_vector_type(4)));
typedef unsigned u32x2 __attribute__((ext_vector_type(2)));
typedef int i32x4 __attribute__((ext_vector_type(4)));
typedef int i32x2 __attribute__((ext_vector_type(2)));

constexpr int D = 1024, NB = 32, SEQ = 2048, LC = 256, DEPTH = 4;
constexpr int TL = NB * SEQ, TC = NB * LC, TT = TL + TC;
constexpr int DIN = 2560, NMOD = 6;
constexpr int OFF_B = 512, OFF_C = 1280, OFF_D = 1792;
constexpr int NEXP = 32, DEXP = 512;
constexpr int MAXSLOT = 155648;
constexpr float EPS = 1e-6f;
constexpr int NTHREADS = 512;
constexpr int LDS_BYTES = 163840;
constexpr int LDS_BARW = LDS_BYTES - 16;

constexpr size_t MBy = 1ull << 20;
constexpr size_t WS_CTL   = 0;
constexpr size_t CTL_BYTES = 65536;
constexpr size_t WS_MOD   = WS_CTL + CTL_BYTES;
constexpr size_t WS_ROPE  = WS_MOD + 4 * MBy;
constexpr size_t WS_WINT  = WS_ROPE + 1 * MBy;
constexpr size_t WS_WOUTT = WS_WINT + 20 * MBy;
constexpr size_t WS_CPW   = WS_WOUTT + 8 * MBy;
constexpr size_t WS_LRUW  = WS_CPW + 1 * MBy;
constexpr size_t WS_FRAW  = WS_LRUW + 1 * MBy;
constexpr size_t WS_FEN   = WS_FRAW + 36 * MBy;
constexpr size_t WS_GR    = WS_FEN + 1 * MBy;
constexpr size_t WS_GRC   = WS_GR + 16 * MBy;
constexpr size_t WS_XC    = WS_GRC + 2 * MBy;
constexpr size_t WS_H     = WS_XC + 32 * MBy;
constexpr size_t WS_Y     = WS_H + 144 * MBy;
constexpr size_t WS_MOEGU = WS_Y + 144 * MBy;
constexpr size_t WS_MOEDN = WS_MOEGU + 64 * MBy;
constexpr size_t WS_TOKOF = WS_MOEDN + 32 * MBy;
constexpr size_t WS_GATEOF= WS_TOKOF + 9 * MBy;
constexpr size_t WS_TOKINF= WS_GATEOF + 9 * MBy;
constexpr size_t WS_LRUS  = WS_TOKINF + 2 * MBy;
constexpr size_t WS_LRUC  = WS_LRUS + 3 * MBy;
constexpr size_t WS_BIG   = WS_LRUC + 2 * MBy;
constexpr size_t WS_P     = WS_BIG;
constexpr size_t WS_UF    = WS_P + 360 * MBy;
constexpr size_t WS_Z1F   = WS_UF + 108 * MBy;
constexpr size_t WS_HID   = WS_BIG;
constexpr size_t WS_O     = WS_HID + 152 * MBy;
constexpr size_t WS_END   = WS_Z1F + 36 * MBy;
static_assert(WS_O + 304 * MBy <= WS_END, "overlay");
static_assert(WS_END <= 1200 * MBy, "workspace budget");

constexpr int CW_BAR = 0;
constexpr int CW_CNT = 4096;
constexpr int CW_Q   = 4096 + 256;

struct Params {
    const float* in[46];
    float* out;
    unsigned char* ws;
};

typedef float f32x2 __attribute__((ext_vector_type(2)));
typedef __bf16 bf16x2v __attribute__((ext_vector_type(2)));
__device__ __forceinline__ unsigned pk_bf16(float lo, float hi) { const f32x2 v = {lo, hi}; const bf16x2v r = __builtin_convertvector(v, bf16x2v); return __builtin_bit_cast(unsigned, r); }
__device__ __forceinline__ bf16x8 pk8(const float (&v)[8]) { u32x4 w; w.x = pk_bf16(v[0], v[1]); w.y = pk_bf16(v[2], v[3]); w.z = pk_bf16(v[4], v[5]); w.w = pk_bf16(v[6], v[7]); return __builtin_bit_cast(bf16x8, w); }
#define MFMA32(a, b, c) __builtin_amdgcn_mfma_f32_32x32x16_bf16((a), (b), (c), 0, 0, 0)
#define MFMA16(a, b, c) __builtin_amdgcn_mfma_f32_16x16x32_bf16((a), (b), (c), 0, 0, 0)
__device__ __forceinline__ float bf2f(bf16_t v) { return __uint_as_float(((unsigned)v) << 16); }
__device__ __forceinline__ float bflo(unsigned w) { return __uint_as_float(w << 16); }
__device__ __forceinline__ float bfhi(unsigned w) { return __uint_as_float(w & 0xffff0000u); }
__device__ __forceinline__ float silu_f(float v) { return v / (1.0f + __expf(-v)); }
__device__ __forceinline__ float sigmoid_f(float v) { return 1.0f / (1.0f + __expf(-v)); }
__device__ __forceinline__ float gelu_tanh_f(float v) { const float u = 0.7978845608028654f * (v + 0.044715f * v * v * v); const float t = 1.0f - 2.0f / (1.0f + __expf(2.0f * u)); return 0.5f * v * (1.0f + t); }
__device__ __forceinline__ float wave_sum(float v) {
#pragma unroll
    for (int o = 32; o > 0; o >>= 1) v += __shfl_xor(v, o);
    return v;
}

#define XB_TMO      128
#define XB_XCNT(j)  (256  + 64 * (j))
#define XB_XSUB(j)  (1280 + 64 * (j))
#define XB_XGEN(j)  (2304 + 64 * (j))
#define XB_TOP      3328
#define XB_TOPGEN   3392
#define XCD_BAR_WORDS 3456
#define XB_SPIN_CAP (1u << 18)
__device__ __forceinline__ unsigned xb_ld(unsigned* p)              { return __hip_atomic_load(p, __ATOMIC_RELAXED, __HIP_MEMORY_SCOPE_AGENT); }
__device__ __forceinline__ unsigned xb_add(unsigned* p, unsigned v) { return __hip_atomic_fetch_add(p, v, __ATOMIC_RELAXED, __HIP_MEMORY_SCOPE_AGENT); }
__device__ __forceinline__ unsigned xb_xcc_id() { return (unsigned)__builtin_amdgcn_s_getreg((3 << 11) | 20) & 0xFu; }
#define XB_SPIN(cond, bar) do { unsigned _sp = 0; while (cond) { __builtin_amdgcn_s_sleep(1); \
    if ((++_sp & 255u) == 0u) { if (xb_ld(&(bar)[XB_TMO])) break; if (_sp > XB_SPIN_CAP) { atomicAdd(&(bar)[XB_TMO], 1u); break; } } } } while (0)
struct XcdBarrier { unsigned* bar; unsigned x; volatile LAS unsigned* st; };
__device__ __forceinline__ XcdBarrier xcd_barrier_post(unsigned* bar, volatile LAS unsigned* st) {
    XcdBarrier b; b.bar = bar; b.x = xb_xcc_id(); b.st = st;
    if (threadIdx.x == 0) (void)xb_add(&bar[XB_XCNT(b.x)], 1u);
    return b;
}
__device__ __forceinline__ void xcd_barrier_complete(unsigned* bar, unsigned x, unsigned& nloc, unsigned& nx) {
    const unsigned G = gridDim.x * gridDim.y * gridDim.z;
    unsigned sum, cnt, mine, sp = 0u;
    for (;;) {
        sum = 0u; cnt = 0u; mine = 0u;
#pragma unroll
        for (unsigned j = 0; j < 16; ++j) { const unsigned c = xb_ld(&bar[XB_XCNT(j)]); sum += c; cnt += (c > 0u) ? 1u : 0u; mine = (j == x) ? c : mine; }
        if (sum == G) break;
        __builtin_amdgcn_s_sleep(1);
        if ((++sp & 255u) == 0u) { if (xb_ld(&bar[XB_TMO])) break; if (sp > XB_SPIN_CAP) { atomicAdd(&bar[XB_TMO], 1u); break; } }
    }
    nloc = mine > 0u ? mine : 1u; nx = cnt > 0u ? cnt : 1u;
}
__device__ __forceinline__ void xcd_barrier(const XcdBarrier& b) {
    asm volatile("s_waitcnt vmcnt(0)" ::: "memory");
    __syncthreads();
    if (threadIdx.x == 0) {
        unsigned* bar = b.bar;
        __builtin_amdgcn_s_waitcnt(0);
        unsigned nloc = b.st[0], nx = b.st[1];
        if (nloc == 0u) { xcd_barrier_complete(bar, b.x, nloc, nx); b.st[0] = nloc; b.st[1] = nx; }
        const unsigned old = xb_add(&bar[XB_XSUB(b.x)], 1u);
        const unsigned gen = old / nloc;
        if (old + 1u == (gen + 1u) * nloc) {
            __builtin_amdgcn_fence(__ATOMIC_RELEASE, "agent");
            asm volatile("s_waitcnt vmcnt(0)" ::: "memory");
            const unsigned og = xb_add(&bar[XB_TOP], 1u);
            const unsigned tg = og / nx;
            if (og + 1u == (tg + 1u) * nx) xb_add(&bar[XB_TOPGEN], 1u);
            else XB_SPIN(xb_ld(&bar[XB_TOPGEN]) == tg, bar);
            __builtin_amdgcn_fence(__ATOMIC_ACQUIRE, "agent");
            xb_add(&bar[XB_XGEN(b.x)], 1u);
            asm volatile("s_waitcnt vmcnt(0)" ::: "memory");
        } else {
            XB_SPIN(xb_ld(&bar[XB_XGEN(b.x)]) == gen, bar);
            __builtin_amdgcn_fence(__ATOMIC_ACQUIRE, "agent");
            asm volatile("s_waitcnt vmcnt(0)" ::: "memory");
        }
    }
    __syncthreads();
}

namespace pg8 {
constexpr int BM = 256, BK = 64, HALF = 128, HTB = HALF * BK * 2, STAGE_BYTES = 8 * HTB, NXCD = 8, WGM = 8;
__host__ __device__ __forceinline__ int lds_byte(int r, int c) { const int st = (r >> 4) * 2 + (c >> 5), rr = r & 15, cc = c & 31, ob = rr * 64 + cc * 2; return st * 1024 + (ob ^ (((ob >> 9) & 1) << 5)); }
__host__ __device__ __forceinline__ void stage_rc(int b, int& R, int& C) { const int st = b / 1024, sb = b % 1024, swz = sb ^ (((sb >> 9) & 1) << 5); R = (st >> 1) * 16 + swz / 64; C = (st & 1) * 32 + (swz % 64) / 2; }
__host__ __device__ __forceinline__ int perm32(int rho) { const int n = rho >> 4, i = rho & 15; return 8 * (i >> 2) + 4 * n + (i & 3); }

struct Unit { int pm, pn, e; };
struct Gemm { const bf16_t* A; const bf16_t* Bt; int K; size_t bstride; };

struct StaticOrder {
    int nM, nN, nwg, G, c;
    __device__ void init(int M, int N, int G_, int c_) { nM = M / BM; nN = N / BM; nwg = nM * nN; G = G_; c = c_; }
    __device__ __forceinline__ bool next(int i, Unit& u) const {
        const long L = (long)i * G + c; if (L >= nwg) return false;
        int wgid = (int)L; { const int q = nwg / NXCD, r = nwg % NXCD, xcd = wgid % NXCD, off = wgid / NXCD; wgid = (xcd < r ? xcd * (q + 1) : r * (q + 1) + (xcd - r) * q) + off; }
        const int nig = WGM * nN, gid = wgid / nig, fm = gid * WGM, gsz = (nM - fm) < WGM ? (nM - fm) : WGM;
        u.pm = fm + ((wgid % nig) % gsz); u.pn = (wgid % nig) / gsz; u.e = 0; return true;
    }
    __device__ __forceinline__ unsigned arow(const Unit& u, int r) const { return (unsigned)(u.pm * BM + r); }
};

template <class Epi, class Sched>
__device__ __forceinline__ void gemm_phase(LAS unsigned char* lds, const Gemm g, const Sched& S, const Epi& E, const int tid_in) {
    const int tid = tid_in, wid = __builtin_amdgcn_readfirstlane(tid >> 6), lane = tid & 63, wr = wid >> 2, wc = wid & 3, fr = lane & 15, fq = lane >> 4;
    const int K = g.K, nt = K / BK;
    unsigned voffB[2];
#pragma unroll
    for (int i = 0; i < 2; ++i) { int R, C; stage_rc(tid * 16 + i * 8192, R, C); const int Rb = Epi::PERM ? ((R & ~31) + perm32(R & 31)) : R;
        voffB[i] = (unsigned)(Rb * K + C) * 2u; }
    const size_t kstep = (size_t)(BK * 2);
    const size_t hstep = (size_t)HALF * K * 2;
    const size_t tstep = 2 * hstep;
    const unsigned rowb = (unsigned)K * 2u;
    const unsigned ldsw = (unsigned)wid * 1024u;
    const int aoff = lds_byte(wr * 64 + fr, fq * 8), boff = lds_byte(wc * 32 + fr, fq * 8);
#define PG8_SA(b, h) (((b) * 2 + (h)) * HTB)
#define PG8_SB(b, h) ((4 + (b) * 2 + (h)) * HTB)
#define PG8_STAGE(bufoff, gbase, voff) do { _Pragma("unroll") for (int _i = 0; _i < 2; ++_i) \
        __builtin_amdgcn_global_load_lds((const unsigned*)((const char*)(gbase) + (voff)[_i]), (LAS unsigned*)(lds + (bufoff) + ldsw + _i * 8192), 16, 0, 0); } while (0)
#define PG8_LDA(dst, b, h) do { _Pragma("unroll") for (int m = 0; m < 4; ++m) _Pragma("unroll") for (int k = 0; k < 2; ++k) dst[m][k] = *(const LAS bf16x8*)(lds + PG8_SA(b, h) + aoff + m * 2048 + k * 1024); } while (0)
#define PG8_LDB(dst, b, h) do { _Pragma("unroll") for (int n = 0; n < 2; ++n) _Pragma("unroll") for (int k = 0; k < 2; ++k) dst[n][k] = *(const LAS bf16x8*)(lds + PG8_SB(b, h) + boff + n * 2048 + k * 1024); } while (0)
#define PG8_MMA(ai, bj, At, Bt) do { __builtin_amdgcn_s_setprio(1); _Pragma("unroll") for (int m = 0; m < 4; ++m) _Pragma("unroll") for (int n = 0; n < 2; ++n) _Pragma("unroll") for (int k = 0; k < 2; ++k) \
        acc[ai][bj][m][n] = __builtin_amdgcn_mfma_f32_16x16x32_bf16(Bt[n][k], At[m][k], acc[ai][bj][m][n], 0, 0, 0); __builtin_amdgcn_s_setprio(0); } while (0)
#define PG8_WAIT_V(n) asm volatile("s_waitcnt vmcnt(" #n ")" ::: "memory")
#define PG8_WAIT_L(n) asm volatile("s_waitcnt lgkmcnt(" #n ")" ::: "memory")
#define PG8_BAR __builtin_amdgcn_s_barrier()
#define PG8_SCHED __builtin_amdgcn_sched_barrier(0)
    Unit cur, nxt; int ui = 0;
    if (!S.next(0, cur)) return;
    f32x4 acc[2][2][4][2];
#pragma unroll
    for (int a = 0; a < 2; ++a)
#pragma unroll
        for (int b = 0; b < 2; ++b)
#pragma unroll
            for (int m = 0; m < 4; ++m)
#pragma unroll
                for (int n = 0; n < 2; ++n) acc[a][b][m][n] = (f32x4){0.f, 0.f, 0.f, 0.f};
    bf16x8 At[4][2], B0[2][2], B1[2][2];
    unsigned ca0[2], ca1[2];
#define PG8_AROWS(u, o0, o1) do { int _tz = tid_in; asm volatile("" : "+v"(_tz)); _Pragma("unroll") for (int _i = 0; _i < 2; ++_i) { int _R, _C; stage_rc(_tz * 16 + _i * 8192, _R, _C); \
        o0[_i] = S.arow(u, _R) * rowb + (unsigned)_C * 2u; o1[_i] = S.arow(u, HALF + _R) * rowb + (unsigned)_C * 2u; } } while (0)
    PG8_AROWS(cur, ca0, ca1);
    const char* Ab = (const char*)g.A;
    const char* cB = (const char*)g.Bt + (size_t)cur.e * g.bstride + (size_t)cur.pn * tstep;
    PG8_STAGE(PG8_SB(0, 0), cB, voffB); PG8_STAGE(PG8_SA(0, 0), Ab, ca0); PG8_STAGE(PG8_SB(0, 1), cB + hstep, voffB); PG8_STAGE(PG8_SA(0, 1), Ab, ca1);
    if (wr == 1) PG8_BAR;
    PG8_WAIT_V(4); PG8_BAR;
    PG8_STAGE(PG8_SB(1, 0), cB + kstep, voffB); PG8_STAGE(PG8_SA(1, 0), Ab + kstep, ca0); PG8_STAGE(PG8_SB(1, 1), cB + hstep + kstep, voffB);
    PG8_WAIT_V(6); PG8_BAR;
    for (;;) {
        const bool has_next = S.next(ui + 1, nxt);
        const char* nB = has_next ? (const char*)g.Bt + (size_t)nxt.e * g.bstride + (size_t)nxt.pn * tstep : cB;
        for (int t = 0; t < nt; t += 2) {
            const bool last = (t == nt - 2);
            const char* a1 = Ab + (size_t)(t + 1) * kstep;
            const char* a2 = last ? Ab : Ab + (size_t)(t + 2) * kstep; const char* b2 = last ? nB : cB + (size_t)(t + 2) * kstep;
            const char* a3 = a2 + kstep; const char* b3 = b2 + kstep;
            PG8_LDB(B0, 0, 0); PG8_SCHED; PG8_LDA(At, 0, 0); PG8_STAGE(PG8_SA(1, 1), a1, ca1);
            if (last && has_next) PG8_AROWS(nxt, ca0, ca1);
            PG8_WAIT_L(8); PG8_BAR; PG8_WAIT_L(0); PG8_MMA(0, 0, At, B0); PG8_BAR; PG8_SCHED;
            PG8_LDB(B1, 0, 1); PG8_STAGE(PG8_SB(0, 0), b2, voffB);
            PG8_BAR; PG8_WAIT_L(0); PG8_MMA(0, 1, At, B1); PG8_BAR;
            PG8_LDA(At, 0, 1); PG8_STAGE(PG8_SA(0, 0), a2, ca0);
            PG8_BAR; PG8_WAIT_L(0); PG8_MMA(1, 0, At, B0); PG8_BAR; PG8_SCHED;
            PG8_STAGE(PG8_SB(0, 1), b2 + hstep, voffB);
            PG8_WAIT_V(6); PG8_BAR; PG8_MMA(1, 1, At, B1); PG8_BAR;
            PG8_LDB(B0, 1, 0); PG8_SCHED; PG8_LDA(At, 1, 0); PG8_STAGE(PG8_SA(0, 1), a2, ca1);
            PG8_WAIT_L(8); PG8_BAR; PG8_WAIT_L(0); PG8_MMA(0, 0, At, B0); PG8_BAR; PG8_SCHED;
            PG8_LDB(B1, 1, 1); PG8_STAGE(PG8_SB(1, 0), b3, voffB);
            PG8_BAR; PG8_WAIT_L(0); PG8_MMA(0, 1, At, B1); PG8_BAR;
            PG8_LDA(At, 1, 1); PG8_STAGE(PG8_SA(1, 0), a3, ca0);
            PG8_BAR; PG8_WAIT_L(0); PG8_MMA(1, 0, At, B0); PG8_BAR; PG8_SCHED;
            PG8_STAGE(PG8_SB(1, 1), b3 + hstep, voffB);
            PG8_WAIT_V(6); PG8_BAR; PG8_MMA(1, 1, At, B1); PG8_BAR;
        }
        E(acc, cur, wr, wc, fr, fq);
        if (!has_next) break;
#pragma unroll
        for (int a = 0; a < 2; ++a)
#pragma unroll
            for (int b = 0; b < 2; ++b)
#pragma unroll
                for (int m = 0; m < 4; ++m)
#pragma unroll
                    for (int n = 0; n < 2; ++n) acc[a][b][m][n] = (f32x4){0.f, 0.f, 0.f, 0.f};
        cur = nxt; cB = nB; ++ui;
    }
    PG8_WAIT_V(0);
    if (wr == 0) PG8_BAR;
    PG8_BAR;
#undef PG8_AROWS
#undef PG8_SA
#undef PG8_SB
#undef PG8_STAGE
#undef PG8_LDA
#undef PG8_LDB
#undef PG8_MMA
#undef PG8_WAIT_V
#undef PG8_WAIT_L
#undef PG8_BAR
#undef PG8_SCHED
}

struct EpiBf16 {
    static constexpr bool PERM = true;
    bf16_t* O; int ldc;
    __device__ __forceinline__ void operator()(const f32x4 (&acc)[2][2][4][2], const Unit& u, int wr, int wc, int fr, int fq) const {
        const int row0 = u.pm * BM + wr * 64 + fr, col0 = u.pn * BM + wc * 32 + 8 * fq;
#pragma unroll
        for (int ai = 0; ai < 2; ++ai)
#pragma unroll
            for (int m = 0; m < 4; ++m) { bf16_t* rowp = O + (size_t)(row0 + ai * HALF + m * 16) * ldc + col0;
#pragma unroll
                for (int bj = 0; bj < 2; ++bj) { const f32x4 v0 = acc[ai][bj][m][0], v1 = acc[ai][bj][m][1];
                    u32x4 w; w.x = pk_bf16(v0[0], v0[1]); w.y = pk_bf16(v0[2], v0[3]); w.z = pk_bf16(v1[0], v1[1]); w.w = pk_bf16(v1[2], v1[3]);
                    *(u32x4*)(rowp + bj * HALF) = w; } }
    }
};
struct EpiResid {
    static constexpr bool PERM = false;
    const float* xl_in; float* xl_out; float* xc; const float* mod2;
    __device__ __forceinline__ void operator()(const f32x4 (&acc)[2][2][4][2], const Unit& u, int wr, int wc, int fr, int fq) const {
        const int rowt = u.pm * BM; const bool isc = rowt >= TL;
        const float* xi = isc ? xc + (size_t)(rowt - TL) * D : xl_in + (size_t)rowt * D;
        float* xo = isc ? xc + (size_t)(rowt - TL) * D : xl_out + (size_t)rowt * D;
        const float* gv = mod2 + (size_t)(isc ? 32 : (rowt >> 11)) * (NMOD * D);
        const int r0 = wr * 64 + fr, col0 = u.pn * BM + wc * 32 + 4 * fq;
        f32x4 g4[2][2];
#pragma unroll
        for (int bj = 0; bj < 2; ++bj)
#pragma unroll
            for (int n = 0; n < 2; ++n) g4[bj][n] = *(const f32x4*)(gv + col0 + bj * HALF + n * 16);
#pragma unroll
        for (int ai = 0; ai < 2; ++ai)
#pragma unroll
            for (int m = 0; m < 4; ++m) { const size_t ro = (size_t)(r0 + ai * HALF + m * 16) * D + col0;
#pragma unroll
                for (int bj = 0; bj < 2; ++bj)
#pragma unroll
                    for (int n = 0; n < 2; ++n) { const f32x4 xv = *(const f32x4*)(xi + ro + bj * HALF + n * 16);
                        *(f32x4*)(xo + ro + bj * HALF + n * 16) = xv + g4[bj][n] * acc[ai][bj][m][n]; } }
    }
};
}

typedef const Params __attribute__((address_space(4)))* KParams;
struct Frame {
    KParams P; LAS unsigned char* lds; unsigned char* ws; int tid, lane, wave, G, bid;
    unsigned* ctl;
};

__device__ __forceinline__ void tr_tile(const Frame& F, const float* src, int ld, int k0, int n0, bf16_t* dst, int ldd, int drow0) {
    LAS float* tile = (LAS float*)F.lds;
    const int r = F.tid >> 4, c4 = F.tid & 15;
#pragma unroll
    for (int i = 0; i < 2; ++i) { const f32x4 v = *(const f32x4*)(src + (size_t)(k0 + r + 32 * i) * ld + n0 + 4 * c4);
#pragma unroll
        for (int e = 0; e < 4; ++e) tile[(r + 32 * i) * 65 + 4 * c4 + e] = v[e]; }
    __syncthreads();
    const int n = F.tid >> 3, kq = F.tid & 7;
    float v[8];
#pragma unroll
    for (int j = 0; j < 8; ++j) v[j] = tile[(8 * kq + j) * 65 + n];
    u32x4 w; w.x = pk_bf16(v[0], v[1]); w.y = pk_bf16(v[2], v[3]); w.z = pk_bf16(v[4], v[5]); w.w = pk_bf16(v[6], v[7]);
    *(u32x4*)(dst + (size_t)(drow0 + n) * ldd + k0 + 8 * kq) = w;
    __syncthreads();
}

enum { I_X = 0, I_C, I_CTX, I_CCTX, I_WADA, I_BADA, I_GMIX, I_GFFN, I_WIN, I_WOUT, I_ACW, I_ACB, I_AWR, I_ABR, I_AWI, I_ABI, I_ALAM,
       I_LQ1, I_LK1, I_LQ2, I_LK2, I_SUBG, I_CCW, I_CCB, I_CLG, I_CLB, I_CWPW, I_CBPW, I_DCW, I_DCB, I_DWF1, I_DBF1, I_DFREQ, I_DWF2, I_DBF2, I_DWF3,
       I_DDECAY, I_DBIAS, I_WRG, I_BRG, I_WRE, I_BRE, I_WGATE, I_WUP, I_WDOWN, I_GFINAL };

__device__ __forceinline__ void p0_mods(const Frame& F) {
    LAS float* sS = (LAS float*)F.lds;
    LAS float* red = sS + 33 * 512;
    static_assert((33 * 512 + 8 * 33 * 64) * 4 <= LDS_BARW, "p0_mods LDS");
    const float* c = F.P->in[I_C]; const float* cc = F.P->in[I_CCTX];
    for (int it = F.bid; it < 384; it += F.G) {
        const int l = it / 96, col0 = (it % 96) * 64;
        const float* W = F.P->in[I_WADA] + (size_t)l * D * (NMOD * D);
        const int cq = F.tid & 31, ks = F.tid >> 5;
        float acc[33][2];
#pragma unroll
        for (int b = 0; b < 33; ++b) { acc[b][0] = 0.f; acc[b][1] = 0.f; }
        for (int kh = 0; kh < 2; ++kh) {
            __syncthreads();
            for (int i = F.tid; i < 33 * 512; i += NTHREADS) { const int b = i >> 9, k = kh * 512 + (i & 511); const float v = (b < 32) ? c[b * 1024 + k] : cc[k]; sS[i] = silu_f(v); }
            __syncthreads();
            for (int kk = 0; kk < 32; ++kk) {
                const int kl = ks * 32 + kk, k = kh * 512 + kl;
                const float w0 = W[(size_t)k * (NMOD * D) + col0 + 2 * cq], w1 = W[(size_t)k * (NMOD * D) + col0 + 2 * cq + 1];
#pragma unroll
                for (int b = 0; b < 33; ++b) { const float s = sS[b * 512 + kl]; acc[b][0] += s * w0; acc[b][1] += s * w1; }
            }
        }
#pragma unroll
        for (int b = 0; b < 33; ++b) { acc[b][0] += __shfl_xor(acc[b][0], 32); acc[b][1] += __shfl_xor(acc[b][1], 32); }
        if (F.lane < 32) {
#pragma unroll
            for (int b = 0; b < 33; ++b) { red[(F.wave * 33 + b) * 64 + 2 * cq] = acc[b][0]; red[(F.wave * 33 + b) * 64 + 2 * cq + 1] = acc[b][1]; }
        }
        __syncthreads();
        float* mod = (float*)(F.ws + WS_MOD) + (size_t)l * 33 * (NMOD * D);
        const float* bada = F.P->in[I_BADA] + (size_t)l * (NMOD * D);
        for (int o = F.tid; o < 33 * 64; o += NTHREADS) { const int b = o >> 6, cl = o & 63; float s = 0.f;
#pragma unroll
            for (int w = 0; w < 8; ++w) s += red[(w * 33 + b) * 64 + cl];
            mod[(size_t)b * (NMOD * D) + col0 + cl] = s + bada[col0 + cl]; }
        __syncthreads();
    }
}

__device__ __forceinline__ void p0_rope(const Frame& F) {
    float* ct = (float*)(F.ws + WS_ROPE); float* st = ct + 2048 * 16;
    for (int i = F.bid * NTHREADS + F.tid; i < 2048 * 16; i += F.G * NTHREADS) {
        const int t = i >> 4, f = i & 15; const float inv = powf(10000.0f, -(float)(f & 7) / 8.0f);
        const float pos = (f < 8) ? (float)(t >> 6) : (float)(t & 63); const float a = pos * inv;
        ct[i] = cosf(a); st[i] = sinf(a);
    }
}

__device__ __forceinline__ void p0_transposes(const Frame& F) {
    constexpr int N1 = 2560, N2 = N1 + 1024, N3 = N2 + 64, N4 = N3 + 128;
    for (int it = F.bid; it < N4; it += F.G) {
        if (it < N1) { const int l = it / 640, r = it % 640, kt = r / 40, nt = r % 40;
            tr_tile(F, F.P->in[I_WIN] + (size_t)l * D * DIN, DIN, kt * 64, nt * 64, (bf16_t*)(F.ws + WS_WINT) + (size_t)l * DIN * D, D, nt * 64); }
        else if (it < N2) { const int j = it - N1, l = j / 256, r = j % 256, kt = r / 16, nt = r % 16;
            tr_tile(F, F.P->in[I_WOUT] + (size_t)l * D * D, D, kt * 64, nt * 64, (bf16_t*)(F.ws + WS_WOUTT) + (size_t)l * D * D, D, nt * 64); }
        else if (it < N3) { const int j = it - N2, l = j / 16, r = j % 16, kt = r / 4, nt = r % 4;
            tr_tile(F, F.P->in[I_CWPW] + (size_t)l * 256 * 256, 256, kt * 64, nt * 64, (bf16_t*)(F.ws + WS_CPW) + (size_t)l * 256 * 256, 256, nt * 64); }
        else { const int j = it - N3, gate = j / 64, m = j % 64;
            const int l = m / 8, dir = (m / 4) & 1, hd = m & 3;
            const float* src = F.P->in[gate ? I_AWI : I_AWR] + (size_t)m * 4096;
            bf16_t* dst = (bf16_t*)(F.ws + WS_LRUW) + ((size_t)((l * 2 + dir) * 2 + gate) * 4 + hd) * 4096;
            tr_tile(F, src, 64, 0, 0, dst, 64, 0); }
    }
}

__device__ __forceinline__ void p0_filters(const Frame& F) {
    LAS float* feats = (LAS float*)F.lds;
    LAS float* f1 = feats + 64 * 33;
    LAS float* f2 = f1 + 64 * 64;
    LAS float* tun = f2 + 64 * 64;
    for (int it = F.bid; it < 4 * 36; it += F.G) {
        const int l = it / 36, ch = it % 36; const bool isc = ch >= 32; const int Lf = isc ? LC : SEQ; const int t0 = isc ? (ch - 32) * 64 : ch * 64;
        const float* wf1 = F.P->in[I_DWF1] + (size_t)l * 33 * 64; const float* bf1 = F.P->in[I_DBF1] + l * 64; const float* frq = F.P->in[I_DFREQ] + l * 64;
        const float* wf2 = F.P->in[I_DWF2] + (size_t)l * 64 * 64; const float* bf2 = F.P->in[I_DBF2] + l * 64;
        const float* wf3 = F.P->in[I_DWF3] + (size_t)l * 64 * 1024; const float* dec = F.P->in[I_DDECAY] + l * 1024;
        for (int i = F.tid; i < 64 * 33; i += NTHREADS) { const int p = i / 33, f = i % 33; const float t = (float)(t0 + p);
            float v;
            if (f == 0) v = t / (float)(Lf - 1);
            else { const int bi = (f - 1) & 15; const float band = 1e-4f + (float)bi * ((15.0f - 1e-4f) / 15.0f);
                   const float ang = (6.283185307179586f / (float)Lf) * t * band; v = (f <= 16) ? cosf(ang) : -sinf(ang); }
            feats[i] = v; if (f == 0) tun[p] = v; }
        __syncthreads();
        for (int i = F.tid; i < 64 * 64; i += NTHREADS) { const int p = i >> 6, j = i & 63; float s = bf1[j];
            for (int f = 0; f < 33; ++f) s += feats[p * 33 + f] * wf1[f * 64 + j];
            f1[i] = sinf(frq[j] * s); }
        __syncthreads();
        for (int i = F.tid; i < 64 * 64; i += NTHREADS) { const int p = i >> 6, j = i & 63; float s = bf2[j];
            for (int f = 0; f < 64; ++f) s += f1[p * 64 + f] * wf2[f * 64 + j];
            f2[i] = sinf(frq[j] * s); }
        __syncthreads();
        {   const int c4 = (F.tid & 255) * 4, pg = F.tid >> 8;
            const f32x4 dc = *(const f32x4*)(dec + c4);
            float* raw = (float*)(F.ws + WS_FRAW) + ((size_t)l * 2304 + (isc ? 2048 : 0) + t0) * 1024;
            const bool bwd = ((c4 >> 8) & 1) != 0;
            float es[4] = {0.f, 0.f, 0.f, 0.f};
#pragma unroll 1
            for (int ps = 0; ps < 2; ++ps) {
                float acc[16][4];
#pragma unroll
                for (int p = 0; p < 16; ++p) { acc[p][0] = 0.f; acc[p][1] = 0.f; acc[p][2] = 0.f; acc[p][3] = 0.f; }
#pragma unroll 2
                for (int k = 0; k < 64; ++k) { const f32x4 w = *(const f32x4*)(wf3 + (size_t)k * 1024 + c4);
#pragma unroll
                    for (int p = 0; p < 16; ++p) { const float a = f2[(pg * 32 + ps * 16 + p) * 64 + k]; acc[p][0] += a * w[0]; acc[p][1] += a * w[1]; acc[p][2] += a * w[2]; acc[p][3] += a * w[3]; } }
#pragma unroll
                for (int p = 0; p < 16; ++p) { const int pp = pg * 32 + ps * 16 + p; const float tu = tun[pp]; f32x4 h;
#pragma unroll
                    for (int e = 0; e < 4; ++e) { h[e] = acc[p][e] * expf(-tu * fabsf(dc[e])); if (!(bwd && (t0 + pp) == 0)) es[e] += h[e] * h[e]; }
                    *(f32x4*)(raw + (size_t)pp * 1024 + c4) = h; }
            }
            __syncthreads();
            LAS float* er = (LAS float*)F.lds;
#pragma unroll
            for (int e = 0; e < 4; ++e) er[pg * 1024 + c4 + e] = es[e];
            __syncthreads();
            float* fen = (float*)(F.ws + WS_FEN) + ((size_t)l * 36 + ch) * 1024;
            for (int i = F.tid; i < 1024; i += NTHREADS) fen[i] = er[i] + er[1024 + i];
            __syncthreads();
        }
    }
}

__device__ __forceinline__ void p0_xc(const Frame& F) {
    const f32x4* s = (const f32x4*)F.P->in[I_CTX]; f32x4* d = (f32x4*)(F.ws + WS_XC);
    for (size_t i = (size_t)F.bid * NTHREADS + F.tid; i < (size_t)TC * D / 4; i += (size_t)F.G * NTHREADS) d[i] = s[i];
}

__device__ __forceinline__ void p0_gr(const Frame& F) {
    LAS float* tile = (LAS float*)F.lds;
    for (int it = F.bid; it < 4 * 2 * 2 * 4 * 36; it += F.G) {
        int r = it; const int ch = r % 36; r /= 36; const int cg = r % 4; r /= 4; const int d = r % 2; r /= 2; const int o = r % 2; r /= 2; const int l = r;
        const bool isc = ch >= 32; const int Lf = isc ? LC : SEQ; const int t0 = isc ? (ch - 32) * 64 : ch * 64;
        const int colb = (o * 2 + d) * 256 + cg * 64;
        const float* raw = (const float*)(F.ws + WS_FRAW) + ((size_t)l * 2304 + (isc ? 2048 : 0) + t0) * 1024 + colb;
        {   const int rr = F.tid >> 4, c4 = F.tid & 15;
#pragma unroll
            for (int i = 0; i < 2; ++i) { const f32x4 v = *(const f32x4*)(raw + (size_t)(rr + 32 * i) * 1024 + 4 * c4);
#pragma unroll
                for (int e = 0; e < 4; ++e) tile[(rr + 32 * i) * 65 + 4 * c4 + e] = v[e]; } }
        __syncthreads();
        const int cl = F.tid >> 3, pq = F.tid & 7; const int c = cg * 64 + cl;
        float en = 0.f;
        {   const float* fen = (const float*)(F.ws + WS_FEN) + (size_t)l * 36 * 1024;
            const int c0 = isc ? 32 : 0, c1 = isc ? 36 : 32;
            for (int q = c0; q < c1; ++q) en += fen[q * 1024 + (o * 2) * 256 + c] + fen[q * 1024 + (o * 2 + 1) * 256 + c]; }
        const float sc = rsqrtf(en + EPS);
        const float bias = F.P->in[I_DBIAS][(size_t)l * 512 + o * 256 + c];
        bf16_t* G = isc ? (bf16_t*)(F.ws + WS_GRC) + ((size_t)(l * 2 + o) * 256 + c) * 512 : (bf16_t*)(F.ws + WS_GR) + ((size_t)(l * 2 + o) * 256 + c) * 4096;
#pragma unroll
        for (int j = 0; j < 8; ++j) { const int p = pq * 8 + j, pos = t0 + p; float v = tile[p * 65 + cl] * sc;
            if (d == 0) { if (pos == 0) v += bias; G[Lf - pos] = (bf16_t)(pk_bf16(v, 0.f) & 0xffffu); }
            else if (pos > 0) G[Lf + pos] = (bf16_t)(pk_bf16(v, 0.f) & 0xffffu); }
        if (d == 0 && t0 == 0 && F.tid < 64) {   }
        __syncthreads();
    }
}

template <int MODE>
__device__ __forceinline__ void row_norm_phase(const Frame& F, int l, int lprev, bool from_input) {
    const bool addmoe = (lprev >= 0);
    const float* modp = (const float*)(F.ws + WS_MOD) + (size_t)l * 33 * (NMOD * D);
    const float* modm = (const float*)(F.ws + WS_MOD) + (size_t)(lprev >= 0 ? lprev : 0) * 33 * (NMOD * D) + 5 * D;
    const float* gn = (MODE == 2) ? F.P->in[I_GFINAL] : F.P->in[I_GMIX] + (size_t)l * D;
    LAS int* rb = (LAS int*)(F.lds + 131072);
    if (addmoe) {
        if (F.tid == 0) { const unsigned* cnt = F.ctl + CW_CNT + lprev * 32; int acc = 0; for (int e = 0; e < 32; ++e) { rb[e] = acc; acc += ((int)cnt[e] + 255) / 256 * 256; } }
        __syncthreads();
    }
    const int nrows = (MODE == 2) ? TL : TT;
    const bf16_t* O = (const bf16_t*)(F.ws + WS_O);
    const i32x4* tokinf = (const i32x4*)(F.ws + WS_TOKINF);
    for (int row = F.bid * 8 + F.wave; row < nrows; row += F.G * 8) {
        const bool isc = row >= TL; const int b = isc ? 32 : (row >> 11);
        float* xr = isc ? (float*)(F.ws + WS_XC) + (size_t)(row - TL) * D : F.P->out + (size_t)row * D;
        const float* xin = (from_input && !isc) ? F.P->in[I_X] + (size_t)row * D : xr;
        f32x4 v[4];
#pragma unroll
        for (int i = 0; i < 4; ++i) v[i] = *(const f32x4*)(xin + i * 256 + 4 * F.lane);
        if (addmoe) {
            const i32x4 ti = tokinf[row]; const size_t r0 = (size_t)(rb[ti.x] + ti.y), r1 = (size_t)(rb[ti.z] + ti.w);
            const float* gm = modm + (size_t)b * (NMOD * D);
#pragma unroll
            for (int i = 0; i < 4; ++i) { const u32x2 a = *(const u32x2*)(O + r0 * D + i * 256 + 4 * F.lane), c = *(const u32x2*)(O + r1 * D + i * 256 + 4 * F.lane);
                const f32x4 g = *(const f32x4*)(gm + i * 256 + 4 * F.lane);
                v[i][0] += g[0] * (bflo(a.x) + bflo(c.x)); v[i][1] += g[1] * (bfhi(a.x) + bfhi(c.x)); v[i][2] += g[2] * (bflo(a.y) + bflo(c.y)); v[i][3] += g[3] * (bfhi(a.y) + bfhi(c.y)); }
            if (MODE != 2) {
#pragma unroll
                for (int i = 0; i < 4; ++i) *(f32x4*)(xr + i * 256 + 4 * F.lane) = v[i];
            }
        }
        float ss = 0.f;
#pragma unroll
        for (int i = 0; i < 4; ++i) ss += v[i][0] * v[i][0] + v[i][1] * v[i][1] + v[i][2] * v[i][2] + v[i][3] * v[i][3];
        ss = wave_sum(ss);
        const float rstd = rsqrtf(ss * (1.0f / D) + EPS);
        if (MODE == 2) {
#pragma unroll
            for (int i = 0; i < 4; ++i) { const f32x4 g = *(const f32x4*)(gn + i * 256 + 4 * F.lane); f32x4 o;
#pragma unroll
                for (int e = 0; e < 4; ++e) o[e] = v[i][e] * rstd * g[e];
                *(f32x4*)(xr + i * 256 + 4 * F.lane) = o; }
        } else {
            const float* sh = modp + (size_t)b * (NMOD * D); const float* scp = sh + D;
            bf16_t* hrow = (bf16_t*)(F.ws + WS_H) + (size_t)row * D;
#pragma unroll
            for (int i = 0; i < 4; ++i) { const f32x4 g = *(const f32x4*)(gn + i * 256 + 4 * F.lane), s1 = *(const f32x4*)(sh + i * 256 + 4 * F.lane), s2 = *(const f32x4*)(scp + i * 256 + 4 * F.lane);
                float o[4];
#pragma unroll
                for (int e = 0; e < 4; ++e) o[e] = v[i][e] * rstd * g[e] * (1.0f + s2[e]) + s1[e];
                u32x2 w; w.x = pk_bf16(o[0], o[1]); w.y = pk_bf16(o[2], o[3]); *(u32x2*)(hrow + i * 256 + 4 * F.lane) = w; }
        }
    }
}

__device__ __forceinline__ void moe_weight_cvt(const Frame& F, int l) {
    __syncthreads();
    for (int it = F.bid; it < 12288; it += F.G) {
        if (it < 8192) { const int up = it >= 4096, j = it & 4095, e = j >> 7, r = j & 127, kt = r >> 3, nt = r & 7;
            const float* src = F.P->in[up ? I_WUP : I_WGATE] + ((size_t)l * 32 + e) * D * DEXP;
            bf16_t* dst = (bf16_t*)(F.ws + WS_MOEGU) + (size_t)e * 1024 * 1024;
            const int n0 = nt * 64, drow0 = (n0 >> 7) * 256 + (up ? 128 : 0) + (n0 & 127);
            tr_tile(F, src, DEXP, kt * 64, n0, dst, 1024, drow0); }
        else { const int j = it - 8192, e = j >> 7, r = j & 127, kt = r >> 4, nt = r & 15;
            const float* src = F.P->in[I_WDOWN] + ((size_t)l * 32 + e) * DEXP * D;
            bf16_t* dst = (bf16_t*)(F.ws + WS_MOEDN) + (size_t)e * 1024 * 512;
            tr_tile(F, src, D, kt * 64, nt * 64, dst, 512, nt * 64); }
    }
}

__device__ __forceinline__ void hy_pre(const Frame& F, int l, bool do_ctx) {
    constexpr int BST = 1154;
    static_assert(32 * BST * 2 <= LDS_BARW, "hy_pre LDS");
    LAS bf16_t* raw = (LAS bf16_t*)F.lds;
    const bf16_t* P = (const bf16_t*)(F.ws + WS_P);
    const float* cw = F.P->in[I_DCW] + (size_t)l * 3 * 768; const float* cb = F.P->in[I_DCB] + (size_t)l * 768;
    const int nlat = 128 * 12, nitems = nlat + (do_ctx ? 16 * 12 : 0);
    __syncthreads();
    for (int it = F.bid; it < nitems; it += F.G) {
        const bool isc = it >= nlat; const int jj = isc ? it - nlat : it; const int sblk = jj / 12, cgp = jj % 12;
        const int Lseg = isc ? LC : SEQ; const size_t tokbase = isc ? TL : 0;
        for (int pc = F.tid; pc < 32 * 18 * 8; pc += NTHREADS) {
            const int b = pc / 144, r = (pc % 144) >> 3, q = pc & 7; const int t = sblk * 16 + r - 1;
            u32x4 v = (u32x4){0u, 0u, 0u, 0u};
            if (t >= 0 && t < Lseg) v = *(const u32x4*)(P + (tokbase + (size_t)b * Lseg + t) * DIN + OFF_D + cgp * 64 + q * 8);
            LAS unsigned* dst = (LAS unsigned*)(raw + b * BST + r * 64 + q * 8);
            dst[0] = v.x; dst[1] = v.y; dst[2] = v.z; dst[3] = v.w;
        }
        __syncthreads();
        const int b = F.tid & 31, cs = F.tid >> 5;
        bf16_t* UF = (bf16_t*)(F.ws + WS_UF) + (isc ? (size_t)768 * 65536 : 0);
        const size_t chs = isc ? 8192 : 65536;
#pragma unroll 1
        for (int i = 0; i < 4; ++i) {
            const int chl = cs * 4 + i, ch = cgp * 64 + chl;
            const float w0 = cw[ch], w1 = cw[768 + ch], w2 = cw[1536 + ch], bb = cb[ch];
#pragma unroll
            for (int hh = 0; hh < 2; ++hh) {
                float x[10];
#pragma unroll
                for (int q = 0; q < 10; ++q) x[q] = bf2f(raw[b * BST + (8 * hh + q) * 64 + chl]);
                float u[8];
#pragma unroll
                for (int j = 0; j < 8; ++j) u[j] = bb + w0 * x[j] + w1 * x[j + 1] + w2 * x[j + 2];
                u32x4 w; w.x = pk_bf16(u[0], u[1]); w.y = pk_bf16(u[2], u[3]); w.z = pk_bf16(u[4], u[5]); w.w = pk_bf16(u[6], u[7]);
                *(u32x4*)(UF + (size_t)ch * chs + (((size_t)sblk * 2 + hh) * 32 + b) * 8) = w;
            }
        }
        __syncthreads();
    }
}

template <int ORDER>
__device__ __forceinline__ void hy_conv(const Frame& F, int l, bool do_ctx) {
    LAS bf16_t* Gl = (LAS bf16_t*)F.lds + F.wave * 4096;
    LAS bf16_t* stg = (LAS bf16_t*)(F.lds + 65536 + 1024);
    const int lane = F.lane, i31 = lane & 31, hh = lane >> 5;
    const int nlat = 256, nitems = nlat + (do_ctx ? 32 : 0);
    const bf16_t* UF0 = (const bf16_t*)(F.ws + WS_UF); bf16_t* Z10 = (bf16_t*)(F.ws + WS_Z1F);
    for (int it = F.bid; it < nitems; it += F.G) {
        const bool isc = it >= nlat; const int cg = isc ? it - nlat : (it >> 3), tg = isc ? 0 : (it & 7);
        const int Lf = isc ? LC : SEQ; const int c = cg * 8 + F.wave;
        const bf16_t* Gg = isc ? (const bf16_t*)(F.ws + WS_GRC) + ((size_t)(l * 2 + ORDER) * 256 + c) * 512
                               : (const bf16_t*)(F.ws + WS_GR) + ((size_t)(l * 2 + ORDER) * 256 + c) * 4096;
        for (int q = lane; q < Lf / 4; q += 64) *(LAS u32x4*)(Gl + q * 8) = *(const u32x4*)(Gg + q * 8);
        const size_t chs = isc ? 8192 : 65536;
        const bf16_t* UFb = UF0 + (isc ? (size_t)768 * 65536 : 0); bf16_t* Z1b = Z10 + (isc ? (size_t)256 * 65536 : 0);
        const bf16_t* zsrc = (ORDER == 0) ? UFb + (size_t)c * chs : Z1b + (size_t)c * chs;
        const bf16_t* gsrc = UFb + (size_t)(256 * (ORDER + 1) + c) * chs;
        const int t0 = tg * 256;
        f32x16 acc[8];
#pragma unroll
        for (int a = 0; a < 8; ++a)
#pragma unroll
            for (int r = 0; r < 16; ++r) acc[a][r] = 0.f;
        bf16x8 FR[8][2];
#define HY_FRAG(dst, xb) do { const LAS bf16_t* _g = Gl + (xb); _Pragma("unroll") for (int _j = 0; _j < 8; ++_j) dst[_j] = (short)_g[_j]; } while (0)
        const int xb0 = Lf - t0 - i31 + 8 * hh;
#pragma unroll
        for (int a = 0; a < 8; ++a)
#pragma unroll
            for (int ks = 0; ks < 2; ++ks) HY_FRAG(FR[a][ks], xb0 - 32 * a + 16 * ks);
        const int nkp = Lf / 32;
        bf16x8 Bn[2];
#pragma unroll
        for (int ks = 0; ks < 2; ++ks) Bn[ks] = *(const bf16x8*)(zsrc + ((size_t)(ks * 2 + hh) * 32 + i31) * 8);
        for (int nb = 0; nb < nkp; nb += 8) {
#pragma unroll
            for (int u = 0; u < 8; ++u) {
                const int s0 = (nb + u) * 32;
                bf16x8 Bf[2];
#pragma unroll
                for (int ks = 0; ks < 2; ++ks) Bf[ks] = Bn[ks];
                { const int s1 = (s0 + 32 < Lf) ? s0 + 32 : s0;
#pragma unroll
                  for (int ks = 0; ks < 2; ++ks) Bn[ks] = *(const bf16x8*)(zsrc + ((size_t)(((s1 >> 4) + ks) * 2 + hh) * 32 + i31) * 8); }
#pragma unroll
                for (int a = 0; a < 8; ++a)
#pragma unroll
                    for (int ks = 0; ks < 2; ++ks) acc[a] = MFMA32(FR[(a - u) & 7][ks], Bf[ks], acc[a]);
#pragma unroll
                for (int ks = 0; ks < 2; ++ks) HY_FRAG(FR[(7 - u) & 7][ks], xb0 + s0 + 32 + 16 * ks);
            }
        }
#undef HY_FRAG
        if (ORDER == 0) {
#pragma unroll
            for (int a = 0; a < 8; ++a)
#pragma unroll
                for (int rg = 0; rg < 4; ++rg) {
                    const size_t off = ((size_t)(((t0 >> 4) + 2 * a + (rg >> 1)) * 2 + (rg & 1)) * 32 + i31) * 8 + 4 * hh;
                    const u32x2 g = *(const u32x2*)(gsrc + off);
                    u32x2 w; w.x = pk_bf16(bflo(g.x) * acc[a][4 * rg], bfhi(g.x) * acc[a][4 * rg + 1]); w.y = pk_bf16(bflo(g.y) * acc[a][4 * rg + 2], bfhi(g.y) * acc[a][4 * rg + 3]);
                    *(u32x2*)(Z1b + (size_t)c * chs + off) = w;
                }
        } else {
            bf16_t* Y = (bf16_t*)(F.ws + WS_Y);
            const size_t tokbase = isc ? TL : 0;
#pragma unroll
            for (int a = 0; a < 8; ++a) {
                __syncthreads();
#pragma unroll
                for (int rg = 0; rg < 4; ++rg) {
                    const size_t off = ((size_t)(((t0 >> 4) + 2 * a + (rg >> 1)) * 2 + (rg & 1)) * 32 + i31) * 8 + 4 * hh;
                    const u32x2 g = *(const u32x2*)(gsrc + off);
                    float gv[4] = {bflo(g.x), bfhi(g.x), bflo(g.y), bfhi(g.y)};
#pragma unroll
                    for (int e = 0; e < 4; ++e) { const int tl = 8 * rg + 4 * hh + e; stg[(tl * 32 + i31) * 8 + F.wave] = (bf16_t)(pk_bf16(gv[e] * acc[a][4 * rg + e], 0.f) & 0xffffu); }
                }
                __syncthreads();
#pragma unroll
                for (int q = 0; q < 2; ++q) { const int pr = F.tid + q * NTHREADS, tl = pr >> 5, b = pr & 31;
                    const u32x4 v = *(const LAS u32x4*)(stg + pr * 8);
                    *(u32x4*)(Y + (tokbase + (size_t)b * Lf + t0 + 32 * a + tl) * D + 768 + cg * 8) = v; }
            }
            __syncthreads();
        }
    }
}

constexpr int LR_XR = 0;
constexpr int LR_UB = 17408;
constexpr int LR_WT = LR_UB + 18432;
constexpr int LR_A  = LR_WT + 18432;
constexpr int LR_B  = LR_A + 32768;
constexpr int LR_WS = LR_B + 32768;
static_assert(LR_WS + 4096 <= LDS_BARW, "LRU LDS");

__device__ __forceinline__ void lru_chunk_ab(const Frame& F, int l, int b, int hd, int dir, bool isc, int t_lo) {
    LAS bf16_t* xr = (LAS bf16_t*)(F.lds + LR_XR); LAS bf16_t* ub = (LAS bf16_t*)(F.lds + LR_UB); LAS bf16_t* wt = (LAS bf16_t*)(F.lds + LR_WT);
    LAS float* a_s = (LAS float*)(F.lds + LR_A); LAS float* b_s = (LAS float*)(F.lds + LR_B);
    const bf16_t* P = (const bf16_t*)(F.ws + WS_P);
    const int Lseg = isc ? LC : SEQ; const size_t tokbase = (isc ? (size_t)TL : 0) + (size_t)b * Lseg;
    __syncthreads();
    for (int pc = F.tid; pc < 134 * 8; pc += NTHREADS) { const int r = pc >> 3, q = pc & 7; const int t = t_lo - 3 + r;
        u32x4 v = (u32x4){0u, 0u, 0u, 0u};
        if (t >= 0 && t < Lseg) v = *(const u32x4*)(P + (tokbase + t) * DIN + hd * 64 + q * 8);
        *(LAS u32x4*)(xr + r * 64 + q * 8) = v; }
    {   const bf16_t* W = (const bf16_t*)(F.ws + WS_LRUW) + (size_t)(l * 2 + dir) * 2 * 4 * 4096;
        for (int pc = F.tid; pc < 2 * 64 * 8; pc += NTHREADS) { const int g = pc >> 9, n = (pc >> 3) & 63, q = pc & 7;
            *(LAS u32x4*)(wt + (g * 64 + n) * 72 + q * 8) = *(const u32x4*)(W + ((size_t)(g * 4 + hd) * 64 + n) * 64 + q * 8); } }
    __syncthreads();
    {
        const int ch = F.tid & 63, tq = F.tid >> 6; const int chg = hd * 64 + ch;
        const float* cw = F.P->in[I_ACW] + ((size_t)(l * 2 + dir) * 4) * 256 + chg; const float cb = F.P->in[I_ACB][(size_t)(l * 2 + dir) * 256 + chg];
        const float w0 = cw[0], w1 = cw[256], w2 = cw[512], w3 = cw[768];
        const int r0 = tq * 16 + (dir ? 3 : 0);
        float x[19];
#pragma unroll
        for (int q = 0; q < 19; ++q) x[q] = bf2f(xr[(r0 + q) * 64 + ch]);
#pragma unroll
        for (int k = 0; k < 16; ++k) { const float u = cb + w0 * x[k] + w1 * x[k + 1] + w2 * x[k + 2] + w3 * x[k + 3];
            ub[(tq * 16 + k) * 72 + ch] = (bf16_t)(pk_bf16(u, 0.f) & 0xffffu); }
    }
    __syncthreads();
    {
        const int w = F.wave, lane = F.lane, row = lane & 15, kq = lane >> 4;
        bf16x8 Af[2];
#pragma unroll
        for (int ks = 0; ks < 2; ++ks) Af[ks] = *(const LAS bf16x8*)(ub + (16 * w + row) * 72 + 32 * ks + 8 * kq);
        const float* br = F.P->in[I_ABR] + (size_t)(l * 2 + dir) * 256 + hd * 64; const float* bi = F.P->in[I_ABI] + (size_t)(l * 2 + dir) * 256 + hd * 64;
        const float* lam = F.P->in[I_ALAM] + (size_t)(l * 2 + dir) * 256 + hd * 64;
#pragma unroll
        for (int nt = 0; nt < 4; ++nt) {
            f32x4 cr = (f32x4){0.f, 0.f, 0.f, 0.f}, ci = cr;
#pragma unroll
            for (int ks = 0; ks < 2; ++ks) {
                const bf16x8 Br = *(const LAS bf16x8*)(wt + (0 * 64 + 16 * nt + row) * 72 + 32 * ks + 8 * kq);
                const bf16x8 Bi = *(const LAS bf16x8*)(wt + (1 * 64 + 16 * nt + row) * 72 + 32 * ks + 8 * kq);
                cr = MFMA16(Af[ks], Br, cr); ci = MFMA16(Af[ks], Bi, ci);
            }
            const int ch = 16 * nt + row;
            const float sp = log1pf(__expf(-lam[ch])), brc = br[ch], bic = bi[ch];
#pragma unroll
            for (int r = 0; r < 4; ++r) { const int tl = 16 * w + 4 * kq + r;
                const float rr = sigmoid_f(cr[r] + brc), ii = sigmoid_f(ci[r] + bic);
                const float a = __expf(-8.0f * rr * sp);
                const float uv = bf2f(ub[tl * 72 + ch]);
                a_s[tl * 64 + ch] = a; b_s[tl * 64 + ch] = sqrtf(fmaxf(1.0f - a * a, 0.f)) * (ii * uv); }
        }
    }
    __syncthreads();
}

__device__ __forceinline__ void lru_s1(const Frame& F, int l) {
    LAS float* a_s = (LAS float*)(F.lds + LR_A); LAS float* b_s = (LAS float*)(F.lds + LR_B); LAS float* wsum = (LAS float*)(F.lds + LR_WS);
    float* SUM = (float*)(F.ws + WS_LRUS);
    for (int it = F.bid; it < 32 * 4 * 2 * 18; it += F.G) {
        int r = it; const int n = r % 18; r /= 18; const int dir = r & 1; r >>= 1; const int hd = r & 3; const int b = r >> 2;
        const bool isc = n < 2; const int tc = isc ? (dir ? 1 - n : n) : (dir ? 15 - (n - 2) : n - 2);
        lru_chunk_ab(F, l, b, hd, dir, isc, tc * 128);
        const int w = F.wave, ch = F.lane;
        float A = 1.f, Bv = 0.f;
#pragma unroll
        for (int k = 0; k < 16; ++k) { const int tl = dir ? 127 - 16 * w - k : 16 * w + k; const float a = a_s[tl * 64 + ch], bb = b_s[tl * 64 + ch]; Bv = a * Bv + bb; A *= a; }
        wsum[(w * 2 + 0) * 64 + ch] = A; wsum[(w * 2 + 1) * 64 + ch] = Bv;
        __syncthreads();
        if (w == 0) { float At = 1.f, Bt = 0.f;
#pragma unroll
            for (int q = 0; q < 8; ++q) { const float Aq = wsum[(q * 2) * 64 + ch], Bq = wsum[(q * 2 + 1) * 64 + ch]; Bt = Aq * Bt + Bq; At *= Aq; }
            float* dst = SUM + ((size_t)((b * 2 + dir) * 4 + hd) * 18 + n) * 128;
            dst[ch] = At; dst[64 + ch] = Bt; }
    }
}
__device__ __forceinline__ void lru_s2(const Frame& F) {
    const float* SUM = (const float*)(F.ws + WS_LRUS); float* CAR = (float*)(F.ws + WS_LRUC);
    if (F.wave != 0) return;
    for (int it = F.bid; it < 32 * 2 * 4; it += F.G) {
        float As[18], Bs[18];
#pragma unroll
        for (int n = 0; n < 18; ++n) { const float* s = SUM + ((size_t)it * 18 + n) * 128; As[n] = s[F.lane]; Bs[n] = s[64 + F.lane]; }
        float carry = 0.f;
#pragma unroll
        for (int n = 0; n < 18; ++n) { CAR[((size_t)it * 18 + n) * 64 + F.lane] = carry; carry = As[n] * carry + Bs[n]; }
    }
}
__device__ __forceinline__ void lru_s3(const Frame& F, int l, bool do_ctx) {
    LAS float* a_s = (LAS float*)(F.lds + LR_A); LAS float* b_s = (LAS float*)(F.lds + LR_B); LAS float* wsum = (LAS float*)(F.lds + LR_WS);
    const float* CAR = (const float*)(F.ws + WS_LRUC);
    const bf16_t* P = (const bf16_t*)(F.ws + WS_P); bf16_t* Y = (bf16_t*)(F.ws + WS_Y);
    const int nlat = 32 * 4 * 16, nitems = nlat + (do_ctx ? 32 * 4 * 2 : 0);
    for (int it = F.bid; it < nitems; it += F.G) {
        const bool isc = it >= nlat; int r = isc ? it - nlat : it; const int ntc = isc ? 2 : 16; const int tc = r % ntc; r /= ntc; const int hd = r & 3; const int b = r >> 2;
        const int w = F.wave, ch = F.lane;
        float hs[16];
#pragma unroll
        for (int k = 0; k < 16; ++k) hs[k] = 0.f;
#pragma unroll
        for (int dir = 0; dir < 2; ++dir) {
            lru_chunk_ab(F, l, b, hd, dir, isc, tc * 128);
            const int n = isc ? (dir ? 1 - tc : tc) : 2 + (dir ? 15 - tc : tc);
            float hl[16], ca[16]; float A = 1.f, Bv = 0.f;
#pragma unroll
            for (int kk = 0; kk < 16; ++kk) { const int k = dir ? 15 - kk : kk; const int tl = 16 * w + k; const float a = a_s[tl * 64 + ch], bb = b_s[tl * 64 + ch]; Bv = a * Bv + bb; A *= a; hl[k] = Bv; ca[k] = A; }
            wsum[(w * 2 + 0) * 64 + ch] = A; wsum[(w * 2 + 1) * 64 + ch] = Bv;
            __syncthreads();
            float s = CAR[((size_t)((b * 2 + dir) * 4 + hd) * 18 + n) * 64 + ch];
            const int myord = dir ? 7 - w : w;
#pragma unroll
            for (int q = 0; q < 8; ++q) { const int wq = dir ? 7 - q : q; if (q < myord) s = wsum[(wq * 2) * 64 + ch] * s + wsum[(wq * 2 + 1) * 64 + ch]; }
#pragma unroll
            for (int k = 0; k < 16; ++k) hs[k] += hl[k] + ca[k] * s;
        }
        const int Lseg = isc ? LC : SEQ; const size_t tokbase = (isc ? (size_t)TL : 0) + (size_t)b * Lseg + tc * 128 + 16 * w;
#pragma unroll
        for (int k = 0; k < 16; ++k) { const float xg = bf2f(P[(tokbase + k) * DIN + 256 + hd * 64 + ch]);
            Y[(tokbase + k) * D + hd * 64 + ch] = (bf16_t)(pk_bf16(hs[k] * gelu_tanh_f(xg), 0.f) & 0xffffu); }
    }
}

constexpr int CF_GLU = 0;
constexpr int CF_CV  = 48128;
constexpr int CF_ACT = CF_CV + 65536;
static_assert(CF_ACT + 64 * 264 * 2 <= LDS_BARW, "conformer LDS");
#ifndef CONF_STEPS
#define CONF_STEPS 4
#endif
__device__ __forceinline__ void conf_phase(const Frame& F, int l, bool do_ctx) {
    LAS bf16_t* glu = (LAS bf16_t*)(F.lds + CF_GLU); LAS float* cv = (LAS float*)(F.lds + CF_CV); LAS bf16_t* act = (LAS bf16_t*)(F.lds + CF_ACT);
    const bf16_t* P = (const bf16_t*)(F.ws + WS_P); bf16_t* Y = (bf16_t*)(F.ws + WS_Y);
    const int nlat = TL / 64, nitems = nlat + (do_ctx ? TC / 64 : 0);
    const float* ccw = F.P->in[I_CCW] + (size_t)l * 31 * 256; const float* ccb = F.P->in[I_CCB] + (size_t)l * 256;
    const float* lng = F.P->in[I_CLG] + (size_t)l * 256; const float* lnb = F.P->in[I_CLB] + (size_t)l * 256; const float* bpw = F.P->in[I_CBPW] + (size_t)l * 256;
    const bf16_t* Wt = (const bf16_t*)(F.ws + WS_CPW) + (size_t)l * 65536;
    for (int it = F.bid; it < nitems; it += F.G) {
        const bool isc = it >= nlat; const int tile = isc ? it - nlat : it; const int Lseg = isc ? LC : SEQ; const int tps = Lseg / 64;
        const int b = tile / tps, t0 = (tile % tps) * 64; const size_t tokbase = (isc ? (size_t)TL : 0) + (size_t)b * Lseg;
        __syncthreads();
        for (int pc = F.tid; pc < 94 * 32; pc += NTHREADS) { const int r = pc >> 5, q = pc & 31; const int t = t0 - 15 + r;
            u32x4 o = (u32x4){0u, 0u, 0u, 0u};
            if (t >= 0 && t < Lseg) { const bf16_t* src = P + (tokbase + t) * DIN + OFF_C + q * 8; const u32x4 v = *(const u32x4*)src, g = *(const u32x4*)(src + 256);
                o.x = pk_bf16(bflo(v.x) * sigmoid_f(bflo(g.x)), bfhi(v.x) * sigmoid_f(bfhi(g.x))); o.y = pk_bf16(bflo(v.y) * sigmoid_f(bflo(g.y)), bfhi(v.y) * sigmoid_f(bfhi(g.y)));
                o.z = pk_bf16(bflo(v.z) * sigmoid_f(bflo(g.z)), bfhi(v.z) * sigmoid_f(bfhi(g.z))); o.w = pk_bf16(bflo(v.w) * sigmoid_f(bflo(g.w)), bfhi(v.w) * sigmoid_f(bfhi(g.w))); }
            *(LAS u32x4*)(glu + r * 256 + q * 8) = o; }
        __syncthreads();
        if (CONF_STEPS < 2) continue;
        {   const int ch = F.tid & 255, tg = F.tid >> 8;
            const float cbv = ccb[ch];
            float wv[31];
#pragma unroll
            for (int j = 0; j < 31; ++j) wv[j] = ccw[j * 256 + ch];
#pragma unroll 1
            for (int kg = 0; kg < 4; ++kg) {
                float xs[38];
#pragma unroll
                for (int q = 0; q < 38; ++q) xs[q] = bf2f(glu[(32 * tg + 8 * kg + q) * 256 + ch]);
#pragma unroll
                for (int kk = 0; kk < 8; ++kk) { float a = cbv;
#pragma unroll
                    for (int j = 0; j < 31; ++j) a += wv[j] * xs[kk + j];
                    cv[(32 * tg + 8 * kg + kk) * 256 + ch] = a; }
            }
        }
        __syncthreads();
        if (CONF_STEPS < 3) continue;
        {
            const f32x4 g4 = *(const f32x4*)(lng + 4 * F.lane), b4 = *(const f32x4*)(lnb + 4 * F.lane);
#pragma unroll 1
            for (int q = 0; q < 8; ++q) { const int tk = 8 * F.wave + q; const f32x4 v = *(const LAS f32x4*)(cv + tk * 256 + 4 * F.lane);
                const float mu = wave_sum(v[0] + v[1] + v[2] + v[3]) * (1.0f / 256.0f);
                const float d0 = v[0] - mu, d1 = v[1] - mu, d2 = v[2] - mu, d3 = v[3] - mu;
                const float var = wave_sum(d0 * d0 + d1 * d1 + d2 * d2 + d3 * d3) * (1.0f / 256.0f);
                const float rs = rsqrtf(var + 1e-5f);
                const float y0 = silu_f(d0 * rs * g4[0] + b4[0]), y1 = silu_f(d1 * rs * g4[1] + b4[1]), y2 = silu_f(d2 * rs * g4[2] + b4[2]), y3 = silu_f(d3 * rs * g4[3] + b4[3]);
                u32x2 o; o.x = pk_bf16(y0, y1); o.y = pk_bf16(y2, y3); *(LAS u32x2*)(act + tk * 264 + 4 * F.lane) = o; }
        }
        __syncthreads();
        if (CONF_STEPS < 4) continue;
        {
            const int lane = F.lane, row = lane & 15, kq = lane >> 4;
            f32x4 acc[2][4];
#pragma unroll
            for (int nt = 0; nt < 2; ++nt)
#pragma unroll
                for (int tt = 0; tt < 4; ++tt) acc[nt][tt] = (f32x4){0.f, 0.f, 0.f, 0.f};
#pragma unroll 2
            for (int ks = 0; ks < 8; ++ks) {
                bf16x8 Aw[2], Bt[4];
#pragma unroll
                for (int nt = 0; nt < 2; ++nt) Aw[nt] = *(const bf16x8*)(Wt + (size_t)(32 * F.wave + 16 * nt + row) * 256 + 32 * ks + 8 * kq);
#pragma unroll
                for (int tt = 0; tt < 4; ++tt) Bt[tt] = *(const LAS bf16x8*)(act + (16 * tt + row) * 264 + 32 * ks + 8 * kq);
#pragma unroll
                for (int nt = 0; nt < 2; ++nt)
#pragma unroll
                    for (int tt = 0; tt < 4; ++tt) acc[nt][tt] = MFMA16(Aw[nt], Bt[tt], acc[nt][tt]);
            }
#pragma unroll
            for (int nt = 0; nt < 2; ++nt) { const int n0 = 32 * F.wave + 16 * nt + 4 * kq; const f32x4 bb = *(const f32x4*)(bpw + n0);
#pragma unroll
                for (int tt = 0; tt < 4; ++tt) { const f32x4 v = acc[nt][tt] + bb; u32x2 o; o.x = pk_bf16(v[0], v[1]); o.y = pk_bf16(v[2], v[3]);
                    *(u32x2*)(Y + (tokbase + t0 + 16 * tt + row) * D + 512 + n0) = o; } }
        }
    }
}

constexpr int AT_KST = 72;
constexpr int AT_VST = 132;
constexpr int AT_KB  = 128 * AT_KST * 2;
constexpr int AT_VB  = 64 * AT_VST * 2;
constexpr int AT_K0 = 0, AT_V0 = 2 * AT_KB, AT_X = 2 * AT_KB + 2 * AT_VB;
static_assert(AT_X + 4 * 64 * 32 * 4 <= LDS_BARW, "attention LDS");
__device__ __forceinline__ void attn_phase(const Frame& F, int l, bool do_ctx) {
    const bf16_t* P = (const bf16_t*)(F.ws + WS_P); bf16_t* Y = (bf16_t*)(F.ws + WS_Y);
    const float* ropec = (const float*)(F.ws + WS_ROPE); const float* ropes = ropec + 2048 * 16;
    const int lane = F.lane, w = F.wave, i31 = lane & 31, hh = lane >> 5, qs = w >> 1, comp = w & 1;
    const float lam_init = (l == 0) ? 0.2f : (l == 1) ? 0.35550906759f : (l == 2) ? 0.47071301834f : 0.55605820419f;
    float lam;
    {   const float* q1 = F.P->in[I_LQ1] + l * 32; const float* k1 = F.P->in[I_LK1] + l * 32; const float* q2 = F.P->in[I_LQ2] + l * 32; const float* k2 = F.P->in[I_LK2] + l * 32;
        const float s1 = wave_sum(lane < 32 ? q1[i31] * k1[i31] : 0.f), s2 = wave_sum(lane < 32 ? q2[i31] * k2[i31] : 0.f);
        lam = expf(s1) - expf(s2) + lam_init; }
    const float* subg = F.P->in[I_SUBG] + l * 64;
    const int nlat = 32 * 4 * 16, nitems = nlat + (do_ctx ? 32 * 4 * 2 : 0);
    const float qscale = 0.17677669529663687f * 1.4426950408889634f;
    for (int it = F.bid; it < nitems; it += F.G) {
        const bool isc = it >= nlat; int r_ = isc ? it - nlat : it; const int nqb = isc ? 2 : 16; const int qb = r_ % nqb; r_ /= nqb; const int hd = r_ & 3; const int b = r_ >> 2;
        const int ntiles = isc ? 2 : 18;
        const size_t qtok = isc ? (size_t)TL + (size_t)b * LC + qb * 128 + qs * 32 + i31 : (size_t)b * SEQ + qb * 128 + qs * 32 + i31;
        bf16x8 Bq[2];
        {   const bf16_t* qp = P + qtok * DIN + OFF_B + hd * 64 + comp * 32 + 8 * hh;
            const u32x4 a = *(const u32x4*)qp, c = *(const u32x4*)(qp + 16);
            float x1[8] = {bflo(a.x), bfhi(a.x), bflo(a.y), bfhi(a.y), bflo(a.z), bfhi(a.z), bflo(a.w), bfhi(a.w)};
            float x2[8] = {bflo(c.x), bfhi(c.x), bflo(c.y), bfhi(c.y), bflo(c.z), bfhi(c.z), bflo(c.w), bfhi(c.w)};
            float o1[8], o2[8];
            if (!isc) { const int tpos = qb * 128 + qs * 32 + i31; const float* cp = ropec + tpos * 16 + 8 * hh; const float* sp = ropes + tpos * 16 + 8 * hh;
#pragma unroll
                for (int j = 0; j < 8; ++j) { const float cs = cp[j], sn = sp[j]; o1[j] = (x1[j] * cs - x2[j] * sn) * qscale; o2[j] = (x1[j] * sn + x2[j] * cs) * qscale; } }
            else {
#pragma unroll
                for (int j = 0; j < 8; ++j) { o1[j] = x1[j] * qscale; o2[j] = x2[j] * qscale; } }
            Bq[0] = pk8(o1); Bq[1] = pk8(o2); }
        const int skey = F.tid >> 2, scomp = (F.tid >> 1) & 1, shf = F.tid & 1;
        const int vkp = F.tid & 63, vg = F.tid >> 6;
        u32x4 kr0, kr1, vr0, vr1;
#define AT_LOAD(kt) do { const bool kc_ = isc || (kt) >= 16; const int ktl_ = kc_ ? (isc ? (kt) : (kt) - 16) : (kt); \
            const size_t kb_ = kc_ ? (size_t)TL + (size_t)b * LC + ktl_ * 128 : (size_t)b * SEQ + ktl_ * 128; \
            const bf16_t* kp_ = P + (kb_ + skey) * DIN + OFF_B + 256 + hd * 64 + scomp * 32 + 8 * shf; kr0 = *(const u32x4*)kp_; kr1 = *(const u32x4*)(kp_ + 16); \
            const bf16_t* vp_ = P + (kb_ + 2 * vkp) * DIN + OFF_B + 512 + hd * 64 + 8 * vg; vr0 = *(const u32x4*)vp_; vr1 = *(const u32x4*)(vp_ + DIN); } while (0)
#define AT_STORE(kt, buf) do { const bool kc_ = isc || (kt) >= 16; \
            float x1[8] = {bflo(kr0.x), bfhi(kr0.x), bflo(kr0.y), bfhi(kr0.y), bflo(kr0.z), bfhi(kr0.z), bflo(kr0.w), bfhi(kr0.w)}; \
            float x2[8] = {bflo(kr1.x), bfhi(kr1.x), bflo(kr1.y), bfhi(kr1.y), bflo(kr1.z), bfhi(kr1.z), bflo(kr1.w), bfhi(kr1.w)}; \
            float o1[8], o2[8]; \
            if (!kc_) { const int tpos_ = (kt) * 128 + skey; const float* cp_ = ropec + tpos_ * 16 + 8 * shf; const float* sp_ = ropes + tpos_ * 16 + 8 * shf; \
                _Pragma("unroll") for (int j = 0; j < 8; ++j) { const float cs = cp_[j], sn = sp_[j]; o1[j] = x1[j] * cs - x2[j] * sn; o2[j] = x1[j] * sn + x2[j] * cs; } } \
            else { _Pragma("unroll") for (int j = 0; j < 8; ++j) { o1[j] = x1[j]; o2[j] = x2[j]; } } \
            LAS bf16_t* kd_ = (LAS bf16_t*)(F.lds + AT_K0 + (buf) * AT_KB) + skey * AT_KST + scomp * 32 + 8 * shf; \
            *(LAS bf16x8*)kd_ = pk8(o1); *(LAS bf16x8*)(kd_ + 16) = pk8(o2); \
            LAS bf16_t* vd_ = (LAS bf16_t*)(F.lds + AT_V0 + (buf) * AT_VB) + (8 * vg) * AT_VST + 2 * vkp; \
            const unsigned va_[4] = {vr0.x, vr0.y, vr0.z, vr0.w}, vb_[4] = {vr1.x, vr1.y, vr1.z, vr1.w}; \
            _Pragma("unroll") for (int e = 0; e < 4; ++e) { \
                *(LAS unsigned*)(vd_ + (2 * e) * AT_VST) = (va_[e] & 0xffffu) | (vb_[e] << 16); \
                *(LAS unsigned*)(vd_ + (2 * e + 1) * AT_VST) = (va_[e] >> 16) | (vb_[e] & 0xffff0000u); } } while (0)
        __syncthreads();
        AT_LOAD(0); AT_STORE(0, 0);
        __syncthreads();
        f32x16 O0, O1;
#pragma unroll
        for (int r = 0; r < 16; ++r) { O0[r] = 0.f; O1[r] = 0.f; }
        float m = -1e30f, lsum = 0.f;
        for (int kt = 0; kt < ntiles; ++kt) {
            const int buf = kt & 1;
            if (kt + 1 < ntiles) AT_LOAD(kt + 1);
            const LAS bf16_t* Kl = (const LAS bf16_t*)(F.lds + AT_K0 + buf * AT_KB); const LAS bf16_t* Vl = (const LAS bf16_t*)(F.lds + AT_V0 + buf * AT_VB);
#pragma unroll 1
            for (int st = 0; st < 4; ++st) {
                const bf16x8 Ak0 = *(const LAS bf16x8*)(Kl + (32 * st + i31) * AT_KST + comp * 32 + 8 * hh);
                const bf16x8 Ak1 = *(const LAS bf16x8*)(Kl + (32 * st + i31) * AT_KST + comp * 32 + 16 + 8 * hh);
                f32x16 S;
#pragma unroll
                for (int r = 0; r < 16; ++r) S[r] = 0.f;
                S = MFMA32(Ak0, Bq[0], S); S = MFMA32(Ak1, Bq[1], S);
                float mx = S[0];
#pragma unroll
                for (int r = 1; r < 16; ++r) mx = fmaxf(mx, S[r]);
                mx = fmaxf(mx, __shfl_xor(mx, 32));
                const float mn = fmaxf(m, mx), alpha = __builtin_amdgcn_exp2f(m - mn);
                m = mn;
                float p[16], ps = 0.f;
#pragma unroll
                for (int r = 0; r < 16; ++r) { p[r] = __builtin_amdgcn_exp2f(S[r] - mn); ps += p[r]; }
                lsum = lsum * alpha + ps;
#pragma unroll
                for (int r = 0; r < 16; ++r) { O0[r] *= alpha; O1[r] *= alpha; }
#pragma unroll
                for (int s = 0; s < 2; ++s) {
                    float pp[8];
#pragma unroll
                    for (int j = 0; j < 8; ++j) pp[j] = p[8 * s + j];
                    const bf16x8 Bp = pk8(pp);
#pragma unroll
                    for (int mt = 0; mt < 2; ++mt) { const LAS bf16_t* vp = Vl + (32 * mt + i31) * AT_VST + 32 * st + 16 * s + 4 * hh;
                        const u32x2 lo = *(const LAS u32x2*)vp, hi = *(const LAS u32x2*)(vp + 8);
                        const u32x4 av = (u32x4){lo.x, lo.y, hi.x, hi.y};
                        if (mt == 0) O0 = MFMA32(__builtin_bit_cast(bf16x8, av), Bp, O0); else O1 = MFMA32(__builtin_bit_cast(bf16x8, av), Bp, O1); }
                }
            }
            if (kt + 1 < ntiles) AT_STORE(kt + 1, buf ^ 1);
            __syncthreads();
        }
#undef AT_LOAD
#undef AT_STORE
        const float ltot = lsum + __shfl_xor(lsum, 32); const float inv = 1.0f / ltot;
        LAS float* xch = (LAS float*)(F.lds + AT_X) + qs * 2048;
        if (comp == 1) {
#pragma unroll
            for (int r = 0; r < 16; ++r) { const int dv = (r & 3) + 8 * (r >> 2) + 4 * hh; xch[dv * 32 + i31] = O0[r] * inv; xch[(32 + dv) * 32 + i31] = O1[r] * inv; }
        }
        __syncthreads();
        if (comp == 0) {
            float d0[16], d1[16]; float ss = 0.f;
#pragma unroll
            for (int r = 0; r < 16; ++r) { const int dv = (r & 3) + 8 * (r >> 2) + 4 * hh;
                d0[r] = O0[r] * inv - lam * xch[dv * 32 + i31]; d1[r] = O1[r] * inv - lam * xch[(32 + dv) * 32 + i31]; ss += d0[r] * d0[r] + d1[r] * d1[r]; }
            ss += __shfl_xor(ss, 32);
            const float rs = rsqrtf(ss * (1.0f / 64.0f) + EPS) * (1.0f - lam_init);
            bf16_t* yp = Y + qtok * D + 256 + hd * 64;
#pragma unroll
            for (int rg = 0; rg < 4; ++rg) { const int dv = 8 * rg + 4 * hh; const f32x4 g0 = *(const f32x4*)(subg + dv), g1 = *(const f32x4*)(subg + 32 + dv);
                u32x2 o0, o1; o0.x = pk_bf16(d0[4 * rg] * rs * g0[0], d0[4 * rg + 1] * rs * g0[1]); o0.y = pk_bf16(d0[4 * rg + 2] * rs * g0[2], d0[4 * rg + 3] * rs * g0[3]);
                o1.x = pk_bf16(d1[4 * rg] * rs * g1[0], d1[4 * rg + 1] * rs * g1[1]); o1.y = pk_bf16(d1[4 * rg + 2] * rs * g1[2], d1[4 * rg + 3] * rs * g1[3]);
                *(u32x2*)(yp + dv) = o0; *(u32x2*)(yp + 32 + dv) = o1; }
        }
    }
}

constexpr int RT_W = 0;
constexpr int RT_REC = 147456;
constexpr int RT_LP = RT_REC + 304 * 16;
constexpr int RT_CNT = RT_LP + 304 * 8;
static_assert(RT_CNT + 256 <= LDS_BARW, "route LDS");
__device__ __forceinline__ void ffn_route(const Frame& F, int l, int nrows) {
    LAS float* Wt = (LAS float*)(F.lds + RT_W); LAS i32x4* rec = (LAS i32x4*)(F.lds + RT_REC); LAS i32x2* lp = (LAS i32x2*)(F.lds + RT_LP);
    LAS int* lcnt = (LAS int*)(F.lds + RT_CNT); LAS int* lbase = lcnt + 32;
    const float* wrg = F.P->in[I_WRG] + (size_t)l * D * 4; const float* wre = F.P->in[I_WRE] + (size_t)l * D * 32;
    const float* brg = F.P->in[I_BRG] + l * 4; const float* bre = F.P->in[I_BRE] + l * 32;
    __syncthreads();
    for (int i = F.tid; i < 1024 * 4; i += NTHREADS) { const int k = i >> 2, j = i & 3; Wt[j * 1024 + k] = wrg[i]; }
    for (int i = F.tid; i < 1024 * 32; i += NTHREADS) { const int k = i >> 5, j = i & 31; Wt[(4 + j) * 1024 + k] = wre[i]; }
    if (F.tid < 32) lcnt[F.tid] = 0;
    __syncthreads();
    const float* modp = (const float*)(F.ws + WS_MOD) + (size_t)l * 33 * (NMOD * D) + 3 * D;
    const float* gn = F.P->in[I_GFFN] + (size_t)l * D;
    int nrec = 0;
    for (int row = F.bid * 8 + F.wave; row < nrows; row += F.G * 8, ++nrec) {
        const bool isc = row >= TL; const int b = isc ? 32 : (row >> 11);
        const float* xr = isc ? (const float*)(F.ws + WS_XC) + (size_t)(row - TL) * D : F.P->out + (size_t)row * D;
        f32x4 v[4];
#pragma unroll
        for (int i = 0; i < 4; ++i) v[i] = *(const f32x4*)(xr + i * 256 + 4 * F.lane);
        float ss = 0.f;
#pragma unroll
        for (int i = 0; i < 4; ++i) ss += v[i][0] * v[i][0] + v[i][1] * v[i][1] + v[i][2] * v[i][2] + v[i][3] * v[i][3];
        ss = wave_sum(ss);
        const float rstd = rsqrtf(ss * (1.0f / D) + EPS);
        const float* sh = modp + (size_t)b * (NMOD * D); const float* scp = sh + D;
        bf16_t* hrow = (bf16_t*)(F.ws + WS_H) + (size_t)row * D;
#pragma unroll
        for (int i = 0; i < 4; ++i) { const f32x4 g = *(const f32x4*)(gn + i * 256 + 4 * F.lane), s1 = *(const f32x4*)(sh + i * 256 + 4 * F.lane), s2 = *(const f32x4*)(scp + i * 256 + 4 * F.lane);
#pragma unroll
            for (int e = 0; e < 4; ++e) v[i][e] = v[i][e] * rstd * g[e] * (1.0f + s2[e]) + s1[e];
            u32x2 wv; wv.x = pk_bf16(v[i][0], v[i][1]); wv.y = pk_bf16(v[i][2], v[i][3]); *(u32x2*)(hrow + i * 256 + 4 * F.lane) = wv; }
        float lg[4];
#pragma unroll
        for (int j = 0; j < 4; ++j) { float s = 0.f;
#pragma unroll
            for (int i = 0; i < 4; ++i) { const f32x4 wq = *(const LAS f32x4*)(Wt + j * 1024 + i * 256 + 4 * F.lane); s += v[i][0] * wq[0] + v[i][1] * wq[1] + v[i][2] * wq[2] + v[i][3] * wq[3]; }
            lg[j] = wave_sum(s); }
        float g0 = lg[0] + brg[0], g1 = lg[1] + brg[1], g2 = lg[2] + brg[2], g3 = lg[3] + brg[3];
        int gi = 0; float gm = g0; if (g1 > gm) { gm = g1; gi = 1; } if (g2 > gm) { gm = g2; gi = 2; } if (g3 > gm) { gm = g3; gi = 3; }
        const float pgrp = 1.0f / (expf(g0 - gm) + expf(g1 - gm) + expf(g2 - gm) + expf(g3 - gm));
        float le[8];
        {   const LAS float* We = Wt + (4 + 8 * gi) * 1024;
#pragma unroll
            for (int e = 0; e < 8; ++e) { float s = 0.f;
#pragma unroll
                for (int i = 0; i < 4; ++i) { const f32x4 wq = *(const LAS f32x4*)(We + e * 1024 + i * 256 + 4 * F.lane); s += v[i][0] * wq[0] + v[i][1] * wq[1] + v[i][2] * wq[2] + v[i][3] * wq[3]; }
                le[e] = wave_sum(s) + bre[8 * gi + e]; } }
        int e0 = 0; float m0 = le[0];
#pragma unroll
        for (int e = 1; e < 8; ++e) if (le[e] > m0) { m0 = le[e]; e0 = e; }
        int e1 = -1; float m1 = -3.0e38f;
#pragma unroll
        for (int e = 0; e < 8; ++e) if (e != e0 && le[e] > m1) { m1 = le[e]; e1 = e; }
        const float x1 = expf(m1 - m0);
        const float w0 = pgrp / (1.0f + x1), w1 = pgrp * x1 / (1.0f + x1);
        if (F.lane == 0) { const int E0 = gi * 8 + e0, E1 = gi * 8 + e1; const int ri = nrec * 8 + F.wave;
            rec[ri] = (i32x4){E0, E1, __float_as_int(w0), __float_as_int(w1)};
            const int p0 = atomicAdd((int*)&lcnt[E0], 1), p1 = atomicAdd((int*)&lcnt[E1], 1); lp[ri] = (i32x2){p0, p1}; }
    }
    __syncthreads();
    if (F.tid < 32) lbase[F.tid] = (int)__hip_atomic_fetch_add(F.ctl + CW_CNT + l * 32 + F.tid, (unsigned)lcnt[F.tid], __ATOMIC_RELAXED, __HIP_MEMORY_SCOPE_AGENT);
    __syncthreads();
    int* tokof = (int*)(F.ws + WS_TOKOF); float* gateof = (float*)(F.ws + WS_GATEOF); i32x4* tokinf = (i32x4*)(F.ws + WS_TOKINF);
    for (int ri = F.tid; ri < 304; ri += NTHREADS) { const int k = ri >> 3, wv = ri & 7; const int row = F.bid * 8 + wv + k * F.G * 8;
        if (row < nrows) { const i32x4 rc = rec[ri]; const i32x2 q = lp[ri]; const int p0 = lbase[rc.x] + q.x, p1 = lbase[rc.y] + q.y;
            tokof[(size_t)rc.x * TT + p0] = row; gateof[(size_t)rc.x * TT + p0] = __int_as_float(rc.z);
            tokof[(size_t)rc.y * TT + p1] = row; gateof[(size_t)rc.y * TT + p1] = __int_as_float(rc.w);
            tokinf[row] = (i32x4){rc.x, p0, rc.y, p1}; } }
}

constexpr int MO_TS = 131072;
constexpr int MO_TE = MO_TS + 256;
static_assert(MO_TE + 640 <= LDS_BARW, "moe LDS");
namespace pg8 {
struct MoeOrder {
    const LAS int* ts; const LAS unsigned char* te; const unsigned* cnt; const int* tokof; int G, c, nunits; bool gather;
    __device__ __forceinline__ bool next(int i, Unit& u) const {
        const long L = (long)i * G + c; if (L >= nunits) return false;
        u.pn = (int)(L & 3); u.pm = (int)(L >> 2); u.e = te[u.pm]; return true;
    }
    __device__ __forceinline__ unsigned arow(const Unit& u, int r) const {
        if (!gather) return (unsigned)(u.pm * BM + r);
        const int pos = (u.pm - ts[u.e]) * BM + r;
        return pos < (int)cnt[u.e] ? (unsigned)tokof[(size_t)u.e * TT + pos] : 0u;
    }
};
struct EpiSwiGLU {
    static constexpr bool PERM = true;
    bf16_t* H;
    __device__ __forceinline__ void operator()(const f32x4 (&acc)[2][2][4][2], const Unit& u, int wr, int wc, int fr, int fq) const {
        const int row0 = u.pm * BM + wr * 64 + fr, col0 = u.pn * 128 + wc * 32 + 8 * fq;
#pragma unroll
        for (int ai = 0; ai < 2; ++ai)
#pragma unroll
            for (int m = 0; m < 4; ++m) { const f32x4 g0 = acc[ai][0][m][0], g1 = acc[ai][0][m][1], u0 = acc[ai][1][m][0], u1 = acc[ai][1][m][1];
                u32x4 w; w.x = pk_bf16(silu_f(g0[0]) * u0[0], silu_f(g0[1]) * u0[1]); w.y = pk_bf16(silu_f(g0[2]) * u0[2], silu_f(g0[3]) * u0[3]);
                w.z = pk_bf16(silu_f(g1[0]) * u1[0], silu_f(g1[1]) * u1[1]); w.w = pk_bf16(silu_f(g1[2]) * u1[2], silu_f(g1[3]) * u1[3]);
                *(u32x4*)(H + (size_t)(row0 + ai * HALF + m * 16) * DEXP + col0) = w; }
    }
};
struct EpiMoeOut {
    static constexpr bool PERM = true;
    bf16_t* O; const float* gateof; const unsigned* cnt; const LAS int* ts;
    __device__ __forceinline__ void operator()(const f32x4 (&acc)[2][2][4][2], const Unit& u, int wr, int wc, int fr, int fq) const {
        const int r0 = wr * 64 + fr, col0 = u.pn * BM + wc * 32 + 8 * fq; const int pbase = (u.pm - ts[u.e]) * BM; const int ce = (int)cnt[u.e];
#pragma unroll
        for (int ai = 0; ai < 2; ++ai)
#pragma unroll
            for (int m = 0; m < 4; ++m) { const int r = r0 + ai * HALF + m * 16; const int pos = pbase + r;
                const float gt = pos < ce ? gateof[(size_t)u.e * TT + pos] : 0.f;
                bf16_t* rowp = O + (size_t)(u.pm * BM + r) * D + col0;
#pragma unroll
                for (int bj = 0; bj < 2; ++bj) { const f32x4 v0 = acc[ai][bj][m][0] * gt, v1 = acc[ai][bj][m][1] * gt;
                    u32x4 w; w.x = pk_bf16(v0[0], v0[1]); w.y = pk_bf16(v0[2], v0[3]); w.z = pk_bf16(v1[0], v1[1]); w.w = pk_bf16(v1[2], v1[3]);
                    *(u32x4*)(rowp + bj * HALF) = w; } }
    }
};
}
__device__ __forceinline__ int moe_tables(const Frame& F, int l) {
    LAS int* ts = (LAS int*)(F.lds + MO_TS); LAS unsigned char* te = (LAS unsigned char*)(F.lds + MO_TE);
    __syncthreads();
    if (F.tid == 0) { int acc = 0; for (int e = 0; e < 32; ++e) { ts[e] = acc; acc += ((int)F.ctl[CW_CNT + l * 32 + e] + 255) >> 8; } ts[32] = acc; }
    __syncthreads();
    if (F.tid < 32) { for (int t = ts[F.tid]; t < ts[F.tid + 1]; ++t) te[t] = (unsigned char)F.tid; }
    __syncthreads();
    return ts[32];
}

__global__ void __launch_bounds__(NTHREADS, 2) fwd_kernel(Params prm) {
    extern __shared__ __attribute__((aligned(16))) unsigned char lds_raw[];
    Frame F; F.P = (KParams)__builtin_amdgcn_kernarg_segment_ptr(); F.lds = (LAS unsigned char*)lds_raw; F.ws = prm.ws; F.tid = threadIdx.x; F.lane = F.tid & 63; F.wave = __builtin_amdgcn_readfirstlane(F.tid >> 6);
    F.G = gridDim.x; F.bid = blockIdx.x; F.ctl = (unsigned*)(prm.ws + WS_CTL);
    if (F.tid < 4) ((LAS unsigned*)(F.lds + LDS_BARW))[F.tid] = 0u;
    __syncthreads();
    (void)xcd_barrier_post(F.ctl + CW_BAR, (volatile LAS unsigned*)(F.lds + LDS_BARW));
    int phase = 0;
#define OPQ() do { asm volatile("" : "+s"(F.ws)); asm volatile("" : "+s"(F.P)); asm volatile("" : "+s"(F.ctl)); asm volatile("" : "+s"(F.bid)); asm volatile("" : "+s"(F.G)); \
        asm volatile("" : "+v"(F.tid)); F.lane = F.tid & 63; F.wave = __builtin_amdgcn_readfirstlane(F.tid >> 6); } while (0)
#define SEAM() do { OPQ(); XcdBarrier b2_; b2_.bar = F.ctl + CW_BAR; b2_.x = xb_xcc_id(); b2_.st = (volatile LAS unsigned*)(F.lds + LDS_BARW); xcd_barrier(b2_); if (++phase > STOP_AFTER) return; } while (0)

    OPQ(); if (PH(0)) { p0_mods(F); __syncthreads(); p0_rope(F); p0_transposes(F); p0_filters(F); p0_xc(F); }
    SEAM();
    OPQ(); if (PH(0)) p0_gr(F);
    SEAM();
    for (int l = 0; l < DEPTH; ++l) {
        const bool last = (l == DEPTH - 1);
        OPQ(); if (PH(1)) row_norm_phase<0>(F, l, l - 1, l == 0);
        OPQ(); if (PH(2)) moe_weight_cvt(F, l);
        SEAM();
        OPQ(); if (PH(3)) {   pg8::Gemm g{(const bf16_t*)(F.ws + WS_H), (const bf16_t*)(F.ws + WS_WINT) + (size_t)l * DIN * D, D, 0};
            pg8::StaticOrder S; S.init(TT, DIN, F.G, F.bid);
            pg8::EpiBf16 E{(bf16_t*)(F.ws + WS_P), DIN};
            pg8::gemm_phase<pg8::EpiBf16, pg8::StaticOrder>(F.lds, g, S, E, F.tid); }
        SEAM();
        OPQ(); if (PH(4)) attn_phase(F, l, !last);
        OPQ(); if (PH(5)) conf_phase(F, l, !last);
        OPQ(); if (PH(6)) hy_pre(F, l, !last);
        OPQ(); if (PH(7)) lru_s1(F, l);
        SEAM();
        OPQ(); if (PH(8)) hy_conv<0>(F, l, !last);
        OPQ(); if (PH(9)) lru_s2(F);
        SEAM();
        OPQ(); if (PH(10)) hy_conv<1>(F, l, !last);
        OPQ(); if (PH(11)) lru_s3(F, l, !last);
        SEAM();
        OPQ(); if (PH(12)) {   pg8::Gemm g{(const bf16_t*)(F.ws + WS_Y), (const bf16_t*)(F.ws + WS_WOUTT) + (size_t)l * D * D, D, 0};
            pg8::StaticOrder S; S.init(last ? TL : TT, D, F.G, F.bid);
            pg8::EpiResid E{l == 0 ? F.P->in[I_X] : F.P->out, F.P->out, (float*)(F.ws + WS_XC), (const float*)(F.ws + WS_MOD) + (size_t)l * 33 * (NMOD * D) + 2 * D};
            pg8::gemm_phase<pg8::EpiResid, pg8::StaticOrder>(F.lds, g, S, E, F.tid); }
        SEAM();
        OPQ(); if (PH(13)) ffn_route(F, l, last ? TL : TT);
        SEAM();
        OPQ(); if (PH(14)) {   const int ntile = moe_tables(F, l);
            pg8::MoeOrder S{(const LAS int*)(F.lds + MO_TS), (const LAS unsigned char*)(F.lds + MO_TE), F.ctl + CW_CNT + l * 32, (const int*)(F.ws + WS_TOKOF), F.G, F.bid, ntile * 4, true};
            pg8::Gemm g{(const bf16_t*)(F.ws + WS_H), (const bf16_t*)(F.ws + WS_MOEGU), D, (size_t)1024 * 1024 * 2};
            pg8::EpiSwiGLU E{(bf16_t*)(F.ws + WS_HID)};
            pg8::gemm_phase<pg8::EpiSwiGLU, pg8::MoeOrder>(F.lds, g, S, E, F.tid); }
        SEAM();
        OPQ(); if (PH(15)) {   const int ntile = moe_tables(F, l);
            pg8::MoeOrder S{(const LAS int*)(F.lds + MO_TS), (const LAS unsigned char*)(F.lds + MO_TE), F.ctl + CW_CNT + l * 32, (const int*)(F.ws + WS_TOKOF), F.G, F.bid, ntile * 4, false};
            pg8::Gemm g{(const bf16_t*)(F.ws + WS_HID), (const bf16_t*)(F.ws + WS_MOEDN), DEXP, (size_t)1024 * 512 * 2};
            pg8::EpiMoeOut E{(bf16_t*)(F.ws + WS_O), (const float*)(F.ws + WS_GATEOF), F.ctl + CW_CNT + l * 32, (const LAS int*)(F.lds + MO_TS)};
            pg8::gemm_phase<pg8::EpiMoeOut, pg8::MoeOrder>(F.lds, g, S, E, F.tid); }
        SEAM();
    }
    OPQ(); if (PH(16)) row_norm_phase<2>(F, 0, DEPTH - 1, false);
    if (xb_ld(F.ctl + CW_BAR + XB_TMO) != 0u) {
        __syncthreads();
        for (int row = F.bid * 8 + F.wave; row < TL; row += F.G * 8) { float* xr = F.P->out + (size_t)row * D;
            for (int i = 0; i < 4; ++i) *(f32x4*)(xr + i * 256 + 4 * F.lane) = (f32x4){0.f, 0.f, 0.f, 0.f}; }
    }
}

extern "C" void kernel_launch(void* const* d_in, const int* in_sizes, int n_in, void* d_out, int out_size, void* d_ws, size_t ws_size, hipStream_t stream) {
    static int grid = 0;
    if (!grid) {
        int dev = 0, cus = 0, per_cu = 0;
        hipGetDevice(&dev);
        hipDeviceGetAttribute(&cus, hipDeviceAttributeMultiprocessorCount, dev);
        hipFuncSetAttribute((const void*)fwd_kernel, hipFuncAttributeMaxDynamicSharedMemorySize, LDS_BYTES);
        hipOccupancyMaxActiveBlocksPerMultiprocessor(&per_cu, (const void*)fwd_kernel, NTHREADS, LDS_BYTES);
        if (per_cu < 1) fprintf(stderr, "kernel_launch: occupancy query says %d\n", per_cu);
        grid = cus > 0 ? cus : 256;
        if (ws_size < WS_END) fprintf(stderr, "kernel_launch: workspace too small: %zu < %zu\n", ws_size, (size_t)WS_END);
        if (n_in != 46) fprintf(stderr, "kernel_launch: expected 46 inputs, got %d\n", n_in);
    }
    hipMemsetAsync((char*)d_ws + WS_CTL, 0, CTL_BYTES, stream);
    Params p; memset(&p, 0, sizeof(p));
    for (int i = 0; i < 46 && i < n_in; ++i) p.in[i] = (const float*)d_in[i];
    p.out = (float*)d_out; p.ws = (unsigned char*)d_ws;
    hipLaunchKernelGGL(fwd_kernel, dim3(grid), dim3(NTHREADS), LDS_BYTES, stream, p);
}
```

```cpp
#include <hip/hip_runtime.h>
#include <cstdio>
#include <cstdint>
#include <cstring>

#ifndef PH_MASK
#define PH_MASK 0xffffffffu
#endif
#define PH(k) ((PH_MASK >> (k)) & 1u)
#ifndef REP_MASK
#define REP_MASK 0u
#endif
#define REPN(k) (1 + (int)((REP_MASK >> (k)) & 1u))
#ifndef STOP_AFTER
#define STOP_AFTER 9999
#endif

#define LAS __attribute__((address_space(3)))
typedef unsigned short bf16_t;
typedef short bf16x8 __attribute__((ext_vector_type(8)));
typedef float f32x4 __attribute__((ext_vector_type(4)));
typedef float f32x16 __attribute__((ext_vector_type(16)));
typedef unsigned u32x4 __attribute__((ext_vector_type(4)));
typedef unsigned u32x2 __attribute__((ext_vector_type(2)));
typedef int i32x4 __attribute__((ext_vector_type(4)));
typedef int i32x2 __attribute__((ext_vector_type(2)));

constexpr int D = 1024, NB = 32, SEQ = 2048, LC = 256, DEPTH = 4;
constexpr int TL = NB * SEQ, TC = NB * LC, TT = TL + TC;
constexpr int DIN = 2560, NMOD = 6;
constexpr int OFF_B = 512, OFF_C = 1280, OFF_D = 1792;
constexpr int NEXP = 32, DEXP = 512;
constexpr int MAXSLOT = 155648;
constexpr float EPS = 1e-6f;
constexpr int NTHREADS = 512;
constexpr int LDS_BYTES = 163840;
constexpr int LDS_BARW = LDS_BYTES - 16;

constexpr size_t MBy = 1ull << 20;
constexpr size_t WS_CTL   = 0;
constexpr size_t CTL_BYTES = 65536;
constexpr size_t WS_MOD   = WS_CTL + CTL_BYTES;
constexpr size_t WS_ROPE  = WS_MOD + 4 * MBy;
constexpr size_t WS_WINT  = WS_ROPE + 1 * MBy;
constexpr size_t WS_WOUTT = WS_WINT + 20 * MBy;
constexpr size_t WS_CPW   = WS_WOUTT + 8 * MBy;
constexpr size_t WS_LRUW  = WS_CPW + 1 * MBy;
constexpr size_t WS_FRAW  = WS_LRUW + 1 * MBy;
constexpr size_t WS_FEN   = WS_FRAW + 36 * MBy;
constexpr size_t WS_GR    = WS_FEN + 1 * MBy;
constexpr size_t WS_GRC   = WS_GR + 16 * MBy;
constexpr size_t WS_XC    = WS_GRC + 2 * MBy;
constexpr size_t WS_H     = WS_XC + 32 * MBy;
constexpr size_t WS_Y     = WS_H + 144 * MBy;
constexpr size_t WS_MOEGU = WS_Y + 144 * MBy;
constexpr size_t WS_MOEDN = WS_MOEGU + 64 * MBy;
constexpr size_t WS_TOKOF = WS_MOEDN + 32 * MBy;
constexpr size_t WS_GATEOF= WS_TOKOF + 9 * MBy;
constexpr size_t WS_TOKINF= WS_GATEOF + 9 * MBy;
constexpr size_t WS_LRUS  = WS_TOKINF + 2 * MBy;
constexpr size_t WS_LRUC  = WS_LRUS + 3 * MBy;
constexpr size_t WS_BIG   = WS_LRUC + 2 * MBy;
constexpr size_t WS_P     = WS_BIG;
constexpr size_t WS_UF    = WS_P + 360 * MBy;
constexpr size_t WS_Z1F   = WS_UF + 108 * MBy;
constexpr size_t WS_HID   = WS_BIG;
constexpr size_t WS_O     = WS_HID + 152 * MBy;
constexpr size_t WS_HT    = WS_Z1F + 36 * MBy;
constexpr size_t WS_END   = WS_HT + 72 * MBy;
static_assert(WS_O + 304 * MBy <= WS_END, "overlay");
static_assert(WS_END <= 1200 * MBy, "workspace budget");

constexpr int CW_BAR = 0;
constexpr int CW_CNT = 4096;
constexpr int CW_Q   = 4096 + 256;

struct Params {
    const float* in[46];
    float* out;
    unsigned char* ws;
};

typedef float f32x2 __attribute__((ext_vector_type(2)));
typedef __bf16 bf16x2v __attribute__((ext_vector_type(2)));
__device__ __forceinline__ unsigned pk_bf16(float lo, float hi) { const f32x2 v = {lo, hi}; const bf16x2v r = __builtin_convertvector(v, bf16x2v); return __builtin_bit_cast(unsigned, r); }
__device__ __forceinline__ bf16x8 pk8(const float (&v)[8]) { u32x4 w; w.x = pk_bf16(v[0], v[1]); w.y = pk_bf16(v[2], v[3]); w.z = pk_bf16(v[4], v[5]); w.w = pk_bf16(v[6], v[7]); return __builtin_bit_cast(bf16x8, w); }
#define MFMA32(a, b, c) __builtin_amdgcn_mfma_f32_32x32x16_bf16((a), (b), (c), 0, 0, 0)
#define MFMA16(a, b, c) __builtin_amdgcn_mfma_f32_16x16x32_bf16((a), (b), (c), 0, 0, 0)
__device__ __forceinline__ float bf2f(bf16_t v) { return __uint_as_float(((unsigned)v) << 16); }
__device__ __forceinline__ float bflo(unsigned w) { return __uint_as_float(w << 16); }
__device__ __forceinline__ float bfhi(unsigned w) { return __uint_as_float(w & 0xffff0000u); }
__device__ __forceinline__ float silu_f(float v) { return v * __builtin_amdgcn_rcpf(1.0f + __expf(-v)); }
__device__ __forceinline__ float sigmoid_f(float v) { return __builtin_amdgcn_rcpf(1.0f + __expf(-v)); }
__device__ __forceinline__ float gelu_tanh_f(float v) { const float u = 0.7978845608028654f * (v + 0.044715f * v * v * v); const float t = 1.0f - 2.0f * __builtin_amdgcn_rcpf(1.0f + __expf(2.0f * u)); return 0.5f * v * (1.0f + t); }
__device__ __forceinline__ float wave_sum(float v) {
#pragma unroll
    for (int o = 32; o > 0; o >>= 1) v += __shfl_xor(v, o);
    return v;
}

#define XB_TMO      128
#define XB_XCNT(j)  (256  + 64 * (j))
#define XB_XSUB(j)  (1280 + 64 * (j))
#define XB_XGEN(j)  (2304 + 64 * (j))
#define XB_TOP      3328
#define XB_TOPGEN   3392
#define XCD_BAR_WORDS 3456
#define XB_SPIN_CAP (1u << 18)
__device__ __forceinline__ unsigned xb_ld(unsigned* p)              { return __hip_atomic_load(p, __ATOMIC_RELAXED, __HIP_MEMORY_SCOPE_AGENT); }
__device__ __forceinline__ unsigned xb_add(unsigned* p, unsigned v) { return __hip_atomic_fetch_add(p, v, __ATOMIC_RELAXED, __HIP_MEMORY_SCOPE_AGENT); }
__device__ __forceinline__ unsigned xb_xcc_id() { return (unsigned)__builtin_amdgcn_s_getreg((3 << 11) | 20) & 0xFu; }
#define XB_SPIN(cond, bar) do { unsigned _sp = 0; while (cond) { __builtin_amdgcn_s_sleep(1); \
    if ((++_sp & 255u) == 0u) { if (xb_ld(&(bar)[XB_TMO])) break; if (_sp > XB_SPIN_CAP) { atomicAdd(&(bar)[XB_TMO], 1u); break; } } } } while (0)
struct XcdBarrier { unsigned* bar; unsigned x; volatile LAS unsigned* st; };
__device__ __forceinline__ XcdBarrier xcd_barrier_post(unsigned* bar, volatile LAS unsigned* st) {
    XcdBarrier b; b.bar = bar; b.x = xb_xcc_id(); b.st = st;
    if (threadIdx.x == 0) (void)xb_add(&bar[XB_XCNT(b.x)], 1u);
    return b;
}
__device__ __forceinline__ void xcd_barrier_complete(unsigned* bar, unsigned x, unsigned& nloc, unsigned& nx) {
    const unsigned G = gridDim.x * gridDim.y * gridDim.z;
    unsigned sum, cnt, mine, sp = 0u;
    for (;;) {
        sum = 0u; cnt = 0u; mine = 0u;
#pragma unroll
        for (unsigned j = 0; j < 16; ++j) { const unsigned c = xb_ld(&bar[XB_XCNT(j)]); sum += c; cnt += (c > 0u) ? 1u : 0u; mine = (j == x) ? c : mine; }
        if (sum == G) break;
        __builtin_amdgcn_s_sleep(1);
        if ((++sp & 255u) == 0u) { if (xb_ld(&bar[XB_TMO])) break; if (sp > XB_SPIN_CAP) { atomicAdd(&bar[XB_TMO], 1u); break; } }
    }
    nloc = mine > 0u ? mine : 1u; nx = cnt > 0u ? cnt : 1u;
}
__device__ __forceinline__ void xcd_barrier(const XcdBarrier& b) {
    asm volatile("s_waitcnt vmcnt(0)" ::: "memory");
    __syncthreads();
    if (threadIdx.x == 0) {
        unsigned* bar = b.bar;
        __builtin_amdgcn_s_waitcnt(0);
        unsigned nloc = b.st[0], nx = b.st[1];
        if (nloc == 0u) { xcd_barrier_complete(bar, b.x, nloc, nx); b.st[0] = nloc; b.st[1] = nx; }
        const unsigned old = xb_add(&bar[XB_XSUB(b.x)], 1u);
        const unsigned gen = old / nloc;
        if (old + 1u == (gen + 1u) * nloc) {
            __builtin_amdgcn_fence(__ATOMIC_RELEASE, "agent");
            asm volatile("s_waitcnt vmcnt(0)" ::: "memory");
            const unsigned og = xb_add(&bar[XB_TOP], 1u);
            const unsigned tg = og / nx;
            if (og + 1u == (tg + 1u) * nx) xb_add(&bar[XB_TOPGEN], 1u);
            else XB_SPIN(xb_ld(&bar[XB_TOPGEN]) == tg, bar);
            __builtin_amdgcn_fence(__ATOMIC_ACQUIRE, "agent");
            xb_add(&bar[XB_XGEN(b.x)], 1u);
            asm volatile("s_waitcnt vmcnt(0)" ::: "memory");
        } else {
            XB_SPIN(xb_ld(&bar[XB_XGEN(b.x)]) == gen, bar);
            __builtin_amdgcn_fence(__ATOMIC_ACQUIRE, "agent");
            asm volatile("s_waitcnt vmcnt(0)" ::: "memory");
        }
    }
    __syncthreads();
}

namespace pg8 {
constexpr int BM = 256, BK = 64, HALF = 128, HTB = HALF * BK * 2, STAGE_BYTES = 8 * HTB, NXCD = 8, WGM = 8;
__host__ __device__ __forceinline__ int lds_byte(int r, int c) { const int st = (r >> 4) * 2 + (c >> 5), rr = r & 15, cc = c & 31, ob = rr * 64 + cc * 2; return st * 1024 + (ob ^ (((ob >> 9) & 1) << 5)); }
__host__ __device__ __forceinline__ void stage_rc(int b, int& R, int& C) { const int st = b / 1024, sb = b % 1024, swz = sb ^ (((sb >> 9) & 1) << 5); R = (st >> 1) * 16 + swz / 64; C = (st & 1) * 32 + (swz % 64) / 2; }
__host__ __device__ __forceinline__ int perm32(int rho) { const int n = rho >> 4, i = rho & 15; return 8 * (i >> 2) + 4 * n + (i & 3); }

struct Unit { int pm, pn, e; };
struct Gemm { const bf16_t* A; const bf16_t* Bt; int K; size_t bstride; };

struct StaticOrder {
    int nM, nN, nwg, G, c;
    __device__ void init(int M, int N, int G_, int c_) { nM = M / BM; nN = N / BM; nwg = nM * nN; G = G_; c = c_; }
    __device__ __forceinline__ bool next(int i, Unit& u) const {
        const long L = (long)i * G + c; if (L >= nwg) return false;
        int wgid = (int)L; { const int q = nwg / NXCD, r = nwg % NXCD, xcd = wgid % NXCD, off = wgid / NXCD; wgid = (xcd < r ? xcd * (q + 1) : r * (q + 1) + (xcd - r) * q) + off; }
        const int nig = WGM * nN, gid = wgid / nig, fm = gid * WGM, gsz = (nM - fm) < WGM ? (nM - fm) : WGM;
        u.pm = fm + ((wgid % nig) % gsz); u.pn = (wgid % nig) / gsz; u.e = 0; return true;
    }
    __device__ __forceinline__ unsigned arow(const Unit& u, int r) const { return (unsigned)(u.pm * BM + r); }
};

template <class Epi, class Sched>
__device__ __forceinline__ void gemm_phase(LAS unsigned char* lds, const Gemm g, const Sched& S, const Epi& E, const int tid_in) {
    const int tid = tid_in, wid = __builtin_amdgcn_readfirstlane(tid >> 6), lane = tid & 63, wr = wid >> 2, wc = wid & 3, fr = lane & 15, fq = lane >> 4;
    const int K = g.K, nt = K / BK;
    unsigned voffB[2];
#pragma unroll
    for (int i = 0; i < 2; ++i) { int R, C; stage_rc(tid * 16 + i * 8192, R, C); const int Rb = Epi::PERM ? ((R & ~31) + perm32(R & 31)) : R;
        voffB[i] = (unsigned)(Rb * K + C) * 2u; }
    const size_t kstep = (size_t)(BK * 2);
    const size_t hstep = (size_t)HALF * K * 2;
    const size_t tstep = 2 * hstep;
    const unsigned rowb = (unsigned)K * 2u;
    const unsigned ldsw = (unsigned)wid * 1024u;
    const int aoff = lds_byte(wr * 64 + fr, fq * 8), boff = lds_byte(wc * 32 + fr, fq * 8);
#define PG8_SA(b, h) (((b) * 2 + (h)) * HTB)
#define PG8_SB(b, h) ((4 + (b) * 2 + (h)) * HTB)
#define PG8_STAGE(bufoff, gbase, voff) do { _Pragma("unroll") for (int _i = 0; _i < 2; ++_i) \
        __builtin_amdgcn_global_load_lds((const unsigned*)((const char*)(gbase) + (voff)[_i]), (LAS unsigned*)(lds + (bufoff) + ldsw + _i * 8192), 16, 0, 0); } while (0)
#define PG8_LDA(dst, b, h) do { _Pragma("unroll") for (int m = 0; m < 4; ++m) _Pragma("unroll") for (int k = 0; k < 2; ++k) dst[m][k] = *(const LAS bf16x8*)(lds + PG8_SA(b, h) + aoff + m * 2048 + k * 1024); } while (0)
#define PG8_LDB(dst, b, h) do { _Pragma("unroll") for (int n = 0; n < 2; ++n) _Pragma("unroll") for (int k = 0; k < 2; ++k) dst[n][k] = *(const LAS bf16x8*)(lds + PG8_SB(b, h) + boff + n * 2048 + k * 1024); } while (0)
#define PG8_MMA(ai, bj, At, Bt) do { __builtin_amdgcn_s_setprio(1); _Pragma("unroll") for (int m = 0; m < 4; ++m) _Pragma("unroll") for (int n = 0; n < 2; ++n) _Pragma("unroll") for (int k = 0; k < 2; ++k) \
        acc[ai][bj][m][n] = __builtin_amdgcn_mfma_f32_16x16x32_bf16(Bt[n][k], At[m][k], acc[ai][bj][m][n], 0, 0, 0); __builtin_amdgcn_s_setprio(0); } while (0)
#define PG8_WAIT_V(n) asm volatile("s_waitcnt vmcnt(" #n ")" ::: "memory")
#define PG8_WAIT_L(n) asm volatile("s_waitcnt lgkmcnt(" #n ")" ::: "memory")
#define PG8_BAR __builtin_amdgcn_s_barrier()
#define PG8_SCHED __builtin_amdgcn_sched_barrier(0)
    Unit cur, nxt; int ui = 0;
    if (!S.next(0, cur)) return;
    f32x4 acc[2][2][4][2];
#pragma unroll
    for (int a = 0; a < 2; ++a)
#pragma unroll
        for (int b = 0; b < 2; ++b)
#pragma unroll
            for (int m = 0; m < 4; ++m)
#pragma unroll
                for (int n = 0; n < 2; ++n) acc[a][b][m][n] = (f32x4){0.f, 0.f, 0.f, 0.f};
    bf16x8 At[4][2], B0[2][2], B1[2][2];
    unsigned ca0[2], ca1[2];
#define PG8_AROWS(u, o0, o1) do { int _tz = tid_in; asm volatile("" : "+v"(_tz)); _Pragma("unroll") for (int _i = 0; _i < 2; ++_i) { int _R, _C; stage_rc(_tz * 16 + _i * 8192, _R, _C); \
        o0[_i] = S.arow(u, _R) * rowb + (unsigned)_C * 2u; o1[_i] = S.arow(u, HALF + _R) * rowb + (unsigned)_C * 2u; } } while (0)
    PG8_AROWS(cur, ca0, ca1);
    const char* Ab = (const char*)g.A;
    const char* cB = (const char*)g.Bt + (size_t)cur.e * g.bstride + (size_t)cur.pn * tstep;
    PG8_STAGE(PG8_SB(0, 0), cB, voffB); PG8_STAGE(PG8_SA(0, 0), Ab, ca0); PG8_STAGE(PG8_SB(0, 1), cB + hstep, voffB); PG8_STAGE(PG8_SA(0, 1), Ab, ca1);
    if (wr == 1) PG8_BAR;
    PG8_WAIT_V(4); PG8_BAR;
    PG8_STAGE(PG8_SB(1, 0), cB + kstep, voffB); PG8_STAGE(PG8_SA(1, 0), Ab + kstep, ca0); PG8_STAGE(PG8_SB(1, 1), cB + hstep + kstep, voffB);
    PG8_WAIT_V(6); PG8_BAR;
    for (;;) {
        const bool has_next = S.next(ui + 1, nxt);
        const char* nB = has_next ? (const char*)g.Bt + (size_t)nxt.e * g.bstride + (size_t)nxt.pn * tstep : cB;
        for (int t = 0; t < nt; t += 2) {
            const bool last = (t == nt - 2);
            const char* a1 = Ab + (size_t)(t + 1) * kstep;
            const char* a2 = last ? Ab : Ab + (size_t)(t + 2) * kstep; const char* b2 = last ? nB : cB + (size_t)(t + 2) * kstep;
            const char* a3 = a2 + kstep; const char* b3 = b2 + kstep;
            PG8_LDB(B0, 0, 0); PG8_SCHED; PG8_LDA(At, 0, 0); PG8_STAGE(PG8_SA(1, 1), a1, ca1);
            if (last && has_next) PG8_AROWS(nxt, ca0, ca1);
            PG8_WAIT_L(8); PG8_BAR; PG8_WAIT_L(0); PG8_MMA(0, 0, At, B0); PG8_BAR; PG8_SCHED;
            PG8_LDB(B1, 0, 1); PG8_STAGE(PG8_SB(0, 0), b2, voffB);
            PG8_BAR; PG8_WAIT_L(0); PG8_MMA(0, 1, At, B1); PG8_BAR;
            PG8_LDA(At, 0, 1); PG8_STAGE(PG8_SA(0, 0), a2, ca0);
            PG8_BAR; PG8_WAIT_L(0); PG8_MMA(1, 0, At, B0); PG8_BAR; PG8_SCHED;
            PG8_STAGE(PG8_SB(0, 1), b2 + hstep, voffB);
            PG8_WAIT_V(6); PG8_BAR; PG8_MMA(1, 1, At, B1); PG8_BAR;
            PG8_LDB(B0, 1, 0); PG8_SCHED; PG8_LDA(At, 1, 0); PG8_STAGE(PG8_SA(0, 1), a2, ca1);
            PG8_WAIT_L(8); PG8_BAR; PG8_WAIT_L(0); PG8_MMA(0, 0, At, B0); PG8_BAR; PG8_SCHED;
            PG8_LDB(B1, 1, 1); PG8_STAGE(PG8_SB(1, 0), b3, voffB);
            PG8_BAR; PG8_WAIT_L(0); PG8_MMA(0, 1, At, B1); PG8_BAR;
            PG8_LDA(At, 1, 1); PG8_STAGE(PG8_SA(1, 0), a3, ca0);
            PG8_BAR; PG8_WAIT_L(0); PG8_MMA(1, 0, At, B0); PG8_BAR; PG8_SCHED;
            PG8_STAGE(PG8_SB(1, 1), b3 + hstep, voffB);
            PG8_WAIT_V(6); PG8_BAR; PG8_MMA(1, 1, At, B1); PG8_BAR;
        }
        E(acc, cur, wr, wc, fr, fq);
        if (!has_next) break;
#pragma unroll
        for (int a = 0; a < 2; ++a)
#pragma unroll
            for (int b = 0; b < 2; ++b)
#pragma unroll
                for (int m = 0; m < 4; ++m)
#pragma unroll
                    for (int n = 0; n < 2; ++n) acc[a][b][m][n] = (f32x4){0.f, 0.f, 0.f, 0.f};
        cur = nxt; cB = nB; ++ui;
    }
    PG8_WAIT_V(0);
    if (wr == 0) PG8_BAR;
    PG8_BAR;
#undef PG8_AROWS
#undef PG8_SA
#undef PG8_SB
#undef PG8_STAGE
#undef PG8_LDA
#undef PG8_LDB
#undef PG8_MMA
#undef PG8_WAIT_V
#undef PG8_WAIT_L
#undef PG8_BAR
#undef PG8_SCHED
}

struct EpiBf16 {
    static constexpr bool PERM = true;
    bf16_t* O; int ldc;
    __device__ __forceinline__ void operator()(const f32x4 (&acc)[2][2][4][2], const Unit& u, int wr, int wc, int fr, int fq) const {
        const int row0 = u.pm * BM + wr * 64 + fr, col0 = u.pn * BM + wc * 32 + 8 * fq;
#pragma unroll
        for (int ai = 0; ai < 2; ++ai)
#pragma unroll
            for (int m = 0; m < 4; ++m) { bf16_t* rowp = O + (size_t)(row0 + ai * HALF + m * 16) * ldc + col0;
#pragma unroll
                for (int bj = 0; bj < 2; ++bj) { const f32x4 v0 = acc[ai][bj][m][0], v1 = acc[ai][bj][m][1];
                    u32x4 w; w.x = pk_bf16(v0[0], v0[1]); w.y = pk_bf16(v0[2], v0[3]); w.z = pk_bf16(v1[0], v1[1]); w.w = pk_bf16(v1[2], v1[3]);
                    *(u32x4*)(rowp + bj * HALF) = w; } }
    }
};
struct EpiResid {
    static constexpr bool PERM = false;
    const float* xl_in; float* xl_out; float* xc; const float* mod2;
    __device__ __forceinline__ void operator()(const f32x4 (&acc)[2][2][4][2], const Unit& u, int wr, int wc, int fr, int fq) const {
        const int rowt = u.pm * BM; const bool isc = rowt >= TL;
        const float* xi = isc ? xc + (size_t)(rowt - TL) * D : xl_in + (size_t)rowt * D;
        float* xo = isc ? xc + (size_t)(rowt - TL) * D : xl_out + (size_t)rowt * D;
        const float* gv = mod2 + (size_t)(isc ? 32 : (rowt >> 11)) * (NMOD * D);
        const int r0 = wr * 64 + fr, col0 = u.pn * BM + wc * 32 + 4 * fq;
        f32x4 g4[2][2];
#pragma unroll
        for (int bj = 0; bj < 2; ++bj)
#pragma unroll
            for (int n = 0; n < 2; ++n) g4[bj][n] = *(const f32x4*)(gv + col0 + bj * HALF + n * 16);
#pragma unroll
        for (int ai = 0; ai < 2; ++ai)
#pragma unroll
            for (int m = 0; m < 4; ++m) { const size_t ro = (size_t)(r0 + ai * HALF + m * 16) * D + col0;
#pragma unroll
                for (int bj = 0; bj < 2; ++bj)
#pragma unroll
                    for (int n = 0; n < 2; ++n) { const f32x4 xv = *(const f32x4*)(xi + ro + bj * HALF + n * 16);
                        *(f32x4*)(xo + ro + bj * HALF + n * 16) = xv + g4[bj][n] * acc[ai][bj][m][n]; } }
    }
};
}

typedef const Params __attribute__((address_space(4)))* KParams;
struct Frame {
    KParams P; LAS unsigned char* lds; unsigned char* ws; int tid, lane, wave, G, bid;
    unsigned* ctl;
};

__device__ __forceinline__ void tr_tile(const Frame& F, const float* src, int ld, int k0, int n0, bf16_t* dst, int ldd, int drow0) {
    LAS float* tile = (LAS float*)F.lds;
    const int r = F.tid >> 4, c4 = F.tid & 15;
#pragma unroll
    for (int i = 0; i < 2; ++i) { const f32x4 v = *(const f32x4*)(src + (size_t)(k0 + r + 32 * i) * ld + n0 + 4 * c4);
#pragma unroll
        for (int e = 0; e < 4; ++e) tile[(r + 32 * i) * 65 + 4 * c4 + e] = v[e]; }
    __syncthreads();
    const int n = F.tid >> 3, kq = F.tid & 7;
    float v[8];
#pragma unroll
    for (int j = 0; j < 8; ++j) v[j] = tile[(8 * kq + j) * 65 + n];
    u32x4 w; w.x = pk_bf16(v[0], v[1]); w.y = pk_bf16(v[2], v[3]); w.z = pk_bf16(v[4], v[5]); w.w = pk_bf16(v[6], v[7]);
    *(u32x4*)(dst + (size_t)(drow0 + n) * ldd + k0 + 8 * kq) = w;
    __syncthreads();
}

enum { I_X = 0, I_C, I_CTX, I_CCTX, I_WADA, I_BADA, I_GMIX, I_GFFN, I_WIN, I_WOUT, I_ACW, I_ACB, I_AWR, I_ABR, I_AWI, I_ABI, I_ALAM,
       I_LQ1, I_LK1, I_LQ2, I_LK2, I_SUBG, I_CCW, I_CCB, I_CLG, I_CLB, I_CWPW, I_CBPW, I_DCW, I_DCB, I_DWF1, I_DBF1, I_DFREQ, I_DWF2, I_DBF2, I_DWF3,
       I_DDECAY, I_DBIAS, I_WRG, I_BRG, I_WRE, I_BRE, I_WGATE, I_WUP, I_WDOWN, I_GFINAL };

__device__ __forceinline__ void p0_mods(const Frame& F) {
    LAS float* sS = (LAS float*)F.lds;
    LAS float* red = sS + 33 * 512;
    static_assert((33 * 512 + 8 * 33 * 64) * 4 <= LDS_BARW, "p0_mods LDS");
    const float* c = F.P->in[I_C]; const float* cc = F.P->in[I_CCTX];
    for (int it = F.bid; it < 384; it += F.G) {
        const int l = it / 96, col0 = (it % 96) * 64;
        const float* W = F.P->in[I_WADA] + (size_t)l * D * (NMOD * D);
        const int cq = F.tid & 31, ks = F.tid >> 5;
        float acc[33][2];
#pragma unroll
        for (int b = 0; b < 33; ++b) { acc[b][0] = 0.f; acc[b][1] = 0.f; }
        for (int kh = 0; kh < 2; ++kh) {
            __syncthreads();
            for (int i = F.tid; i < 33 * 512; i += NTHREADS) { const int b = i >> 9, k = kh * 512 + (i & 511); const float v = (b < 32) ? c[b * 1024 + k] : cc[k]; sS[i] = silu_f(v); }
            __syncthreads();
            for (int kk = 0; kk < 32; ++kk) {
                const int kl = ks * 32 + kk, k = kh * 512 + kl;
                const float w0 = W[(size_t)k * (NMOD * D) + col0 + 2 * cq], w1 = W[(size_t)k * (NMOD * D) + col0 + 2 * cq + 1];
#pragma unroll
                for (int b = 0; b < 33; ++b) { const float s = sS[b * 512 + kl]; acc[b][0] += s * w0; acc[b][1] += s * w1; }
            }
        }
#pragma unroll
        for (int b = 0; b < 33; ++b) { acc[b][0] += __shfl_xor(acc[b][0], 32); acc[b][1] += __shfl_xor(acc[b][1], 32); }
        if (F.lane < 32) {
#pragma unroll
            for (int b = 0; b < 33; ++b) { red[(F.wave * 33 + b) * 64 + 2 * cq] = acc[b][0]; red[(F.wave * 33 + b) * 64 + 2 * cq + 1] = acc[b][1]; }
        }
        __syncthreads();
        float* mod = (float*)(F.ws + WS_MOD) + (size_t)l * 33 * (NMOD * D);
        const float* bada = F.P->in[I_BADA] + (size_t)l * (NMOD * D);
        for (int o = F.tid; o < 33 * 64; o += NTHREADS) { const int b = o >> 6, cl = o & 63; float s = 0.f;
#pragma unroll
            for (int w = 0; w < 8; ++w) s += red[(w * 33 + b) * 64 + cl];
            mod[(size_t)b * (NMOD * D) + col0 + cl] = s + bada[col0 + cl]; }
        __syncthreads();
    }
}

__device__ __forceinline__ void p0_rope(const Frame& F) {
    float* ct = (float*)(F.ws + WS_ROPE); float* st = ct + 2048 * 16;
    for (int i = F.bid * NTHREADS + F.tid; i < 2048 * 16; i += F.G * NTHREADS) {
        const int t = i >> 4, f = i & 15; const float inv = powf(10000.0f, -(float)(f & 7) / 8.0f);
        const float pos = (f < 8) ? (float)(t >> 6) : (float)(t & 63); const float a = pos * inv;
        ct[i] = cosf(a); st[i] = sinf(a);
    }
}

__device__ __forceinline__ void p0_transposes(const Frame& F) {
    constexpr int N1 = 2560, N2 = N1 + 1024, N3 = N2 + 64, N4 = N3 + 128;
    for (int it = F.bid; it < N4; it += F.G) {
        if (it < N1) { const int l = it / 640, r = it % 640, kt = r / 40, nt = r % 40;
            tr_tile(F, F.P->in[I_WIN] + (size_t)l * D * DIN, DIN, kt * 64, nt * 64, (bf16_t*)(F.ws + WS_WINT) + (size_t)l * DIN * D, D, nt * 64); }
        else if (it < N2) { const int j = it - N1, l = j / 256, r = j % 256, kt = r / 16, nt = r % 16;
            tr_tile(F, F.P->in[I_WOUT] + (size_t)l * D * D, D, kt * 64, nt * 64, (bf16_t*)(F.ws + WS_WOUTT) + (size_t)l * D * D, D, nt * 64); }
        else if (it < N3) { const int j = it - N2, l = j / 16, r = j % 16, kt = r / 4, nt = r % 4;
            tr_tile(F, F.P->in[I_CWPW] + (size_t)l * 256 * 256, 256, kt * 64, nt * 64, (bf16_t*)(F.ws + WS_CPW) + (size_t)l * 256 * 256, 256, nt * 64); }
        else { const int j = it - N3, gate = j / 64, m = j % 64;
            const int l = m / 8, dir = (m / 4) & 1, hd = m & 3;
            const float* src = F.P->in[gate ? I_AWI : I_AWR] + (size_t)m * 4096;
            bf16_t* dst = (bf16_t*)(F.ws + WS_LRUW) + ((size_t)((l * 2 + dir) * 2 + gate) * 4 + hd) * 4096;
            tr_tile(F, src, 64, 0, 0, dst, 64, 0); }
    }
}

__device__ __forceinline__ void p0_filters(const Frame& F) {
    LAS float* feats = (LAS float*)F.lds;
    LAS float* f1 = feats + 64 * 33;
    LAS float* f2 = f1 + 64 * 64;
    LAS float* tun = f2 + 64 * 64;
    for (int it = F.bid; it < 4 * 36; it += F.G) {
        const int l = it / 36, ch = it % 36; const bool isc = ch >= 32; const int Lf = isc ? LC : SEQ; const int t0 = isc ? (ch - 32) * 64 : ch * 64;
        const float* wf1 = F.P->in[I_DWF1] + (size_t)l * 33 * 64; const float* bf1 = F.P->in[I_DBF1] + l * 64; const float* frq = F.P->in[I_DFREQ] + l * 64;
        const float* wf2 = F.P->in[I_DWF2] + (size_t)l * 64 * 64; const float* bf2 = F.P->in[I_DBF2] + l * 64;
        const float* wf3 = F.P->in[I_DWF3] + (size_t)l * 64 * 1024; const float* dec = F.P->in[I_DDECAY] + l * 1024;
        for (int i = F.tid; i < 64 * 33; i += NTHREADS) { const int p = i / 33, f = i % 33; const float t = (float)(t0 + p);
            float v;
            if (f == 0) v = t / (float)(Lf - 1);
            else { const int bi = (f - 1) & 15; const float band = 1e-4f + (float)bi * ((15.0f - 1e-4f) / 15.0f);
                   const float ang = (6.283185307179586f / (float)Lf) * t * band; v = (f <= 16) ? cosf(ang) : -sinf(ang); }
            feats[i] = v; if (f == 0) tun[p] = v; }
        __syncthreads();
        for (int i = F.tid; i < 64 * 64; i += NTHREADS) { const int p = i >> 6, j = i & 63; float s = bf1[j];
            for (int f = 0; f < 33; ++f) s += feats[p * 33 + f] * wf1[f * 64 + j];
            f1[i] = sinf(frq[j] * s); }
        __syncthreads();
        for (int i = F.tid; i < 64 * 64; i += NTHREADS) { const int p = i >> 6, j = i & 63; float s = bf2[j];
            for (int f = 0; f < 64; ++f) s += f1[p * 64 + f] * wf2[f * 64 + j];
            f2[i] = sinf(frq[j] * s); }
        __syncthreads();
        {   const int c4 = (F.tid & 255) * 4, pg = F.tid >> 8;
            const f32x4 dc = *(const f32x4*)(dec + c4);
            float* raw = (float*)(F.ws + WS_FRAW) + ((size_t)l * 2304 + (isc ? 2048 : 0) + t0) * 1024;
            const bool bwd = ((c4 >> 8) & 1) != 0;
            float es[4] = {0.f, 0.f, 0.f, 0.f};
#pragma unroll 1
            for (int ps = 0; ps < 2; ++ps) {
                float acc[16][4];
#pragma unroll
                for (int p = 0; p < 16; ++p) { acc[p][0] = 0.f; acc[p][1] = 0.f; acc[p][2] = 0.f; acc[p][3] = 0.f; }
#pragma unroll 2
                for (int k = 0; k < 64; ++k) { const f32x4 w = *(const f32x4*)(wf3 + (size_t)k * 1024 + c4);
#pragma unroll
                    for (int p = 0; p < 16; ++p) { const float a = f2[(pg * 32 + ps * 16 + p) * 64 + k]; acc[p][0] += a * w[0]; acc[p][1] += a * w[1]; acc[p][2] += a * w[2]; acc[p][3] += a * w[3]; } }
#pragma unroll
                for (int p = 0; p < 16; ++p) { const int pp = pg * 32 + ps * 16 + p; const float tu = tun[pp]; f32x4 h;
#pragma unroll
                    for (int e = 0; e < 4; ++e) { h[e] = acc[p][e] * expf(-tu * fabsf(dc[e])); if (!(bwd && (t0 + pp) == 0)) es[e] += h[e] * h[e]; }
                    *(f32x4*)(raw + (size_t)pp * 1024 + c4) = h; }
            }
            __syncthreads();
            LAS float* er = (LAS float*)F.lds;
#pragma unroll
            for (int e = 0; e < 4; ++e) er[pg * 1024 + c4 + e] = es[e];
            __syncthreads();
            float* fen = (float*)(F.ws + WS_FEN) + ((size_t)l * 36 + ch) * 1024;
            for (int i = F.tid; i < 1024; i += NTHREADS) fen[i] = er[i] + er[1024 + i];
            __syncthreads();
        }
    }
}

__device__ __forceinline__ void p0_xc(const Frame& F) {
    const f32x4* s = (const f32x4*)F.P->in[I_CTX]; f32x4* d = (f32x4*)(F.ws + WS_XC);
    for (size_t i = (size_t)F.bid * NTHREADS + F.tid; i < (size_t)TC * D / 4; i += (size_t)F.G * NTHREADS) d[i] = s[i];
}

__device__ __forceinline__ void p0_gr(const Frame& F) {
    LAS float* tile = (LAS float*)F.lds;
    for (int it = F.bid; it < 4 * 2 * 2 * 4 * 36; it += F.G) {
        int r = it; const int ch = r % 36; r /= 36; const int cg = r % 4; r /= 4; const int d = r % 2; r /= 2; const int o = r % 2; r /= 2; const int l = r;
        const bool isc = ch >= 32; const int Lf = isc ? LC : SEQ; const int t0 = isc ? (ch - 32) * 64 : ch * 64;
        const int colb = (o * 2 + d) * 256 + cg * 64;
        const float* raw = (const float*)(F.ws + WS_FRAW) + ((size_t)l * 2304 + (isc ? 2048 : 0) + t0) * 1024 + colb;
        {   const int rr = F.tid >> 4, c4 = F.tid & 15;
#pragma unroll
            for (int i = 0; i < 2; ++i) { const f32x4 v = *(const f32x4*)(raw + (size_t)(rr + 32 * i) * 1024 + 4 * c4);
#pragma unroll
                for (int e = 0; e < 4; ++e) tile[(rr + 32 * i) * 65 + 4 * c4 + e] = v[e]; } }
        __syncthreads();
        const int cl = F.tid >> 3, pq = F.tid & 7; const int c = cg * 64 + cl;
        float en = 0.f;
        {   const float* fen = (const float*)(F.ws + WS_FEN) + (size_t)l * 36 * 1024;
            const int c0 = isc ? 32 : 0, c1 = isc ? 36 : 32;
            for (int q = c0; q < c1; ++q) en += fen[q * 1024 + (o * 2) * 256 + c] + fen[q * 1024 + (o * 2 + 1) * 256 + c]; }
        const float sc = rsqrtf(en + EPS);
        const float bias = F.P->in[I_DBIAS][(size_t)l * 512 + o * 256 + c];
        bf16_t* G = isc ? (bf16_t*)(F.ws + WS_GRC) + ((size_t)(l * 2 + o) * 256 + c) * 512 : (bf16_t*)(F.ws + WS_GR) + ((size_t)(l * 2 + o) * 256 + c) * 4096;
#pragma unroll
        for (int j = 0; j < 8; ++j) { const int p = pq * 8 + j, pos = t0 + p; float v = tile[p * 65 + cl] * sc;
            if (d == 0) { if (pos == 0) v += bias; G[Lf - pos] = (bf16_t)(pk_bf16(v, 0.f) & 0xffffu); }
            else if (pos > 0) G[Lf + pos] = (bf16_t)(pk_bf16(v, 0.f) & 0xffffu); }
        if (d == 0 && t0 == 0 && F.tid < 64) {   }
        __syncthreads();
    }
}

template <int MODE>
__device__ __forceinline__ void row_norm_phase(const Frame& F, int l, int lprev, bool from_input) {
    const bool addmoe = (lprev >= 0);
    const float* modp = (const float*)(F.ws + WS_MOD) + (size_t)l * 33 * (NMOD * D);
    const float* modm = (const float*)(F.ws + WS_MOD) + (size_t)(lprev >= 0 ? lprev : 0) * 33 * (NMOD * D) + 5 * D;
    const float* gn = (MODE == 2) ? F.P->in[I_GFINAL] : F.P->in[I_GMIX] + (size_t)l * D;
    LAS int* rb = (LAS int*)(F.lds + 131072);
    if (addmoe) {
        if (F.tid == 0) { const unsigned* cnt = F.ctl + CW_CNT + lprev * 32; int acc = 0; for (int e = 0; e < 32; ++e) { rb[e] = acc; acc += ((int)cnt[e] + 255) / 256 * 256; } }
        __syncthreads();
    }
    const int nrows = (MODE == 2) ? TL : TT;
    const bf16_t* O = (const bf16_t*)(F.ws + WS_O);
    const i32x4* tokinf = (const i32x4*)(F.ws + WS_TOKINF);
    for (int row = F.bid * 8 + F.wave; row < nrows; row += F.G * 8) {
        const bool isc = row >= TL; const int b = isc ? 32 : (row >> 11);
        float* xr = isc ? (float*)(F.ws + WS_XC) + (size_t)(row - TL) * D : F.P->out + (size_t)row * D;
        const float* xin = (from_input && !isc) ? F.P->in[I_X] + (size_t)row * D : xr;
        f32x4 v[4];
#pragma unroll
        for (int i = 0; i < 4; ++i) v[i] = *(const f32x4*)(xin + i * 256 + 4 * F.lane);
        if (addmoe) {
            const i32x4 ti = tokinf[row]; const size_t r0 = (size_t)(rb[ti.x] + ti.y), r1 = (size_t)(rb[ti.z] + ti.w);
            const float* gm = modm + (size_t)b * (NMOD * D);
#pragma unroll
            for (int i = 0; i < 4; ++i) { const u32x2 a = *(const u32x2*)(O + r0 * D + i * 256 + 4 * F.lane), c = *(const u32x2*)(O + r1 * D + i * 256 + 4 * F.lane);
                const f32x4 g = *(const f32x4*)(gm + i * 256 + 4 * F.lane);
                v[i][0] += g[0] * (bflo(a.x) + bflo(c.x)); v[i][1] += g[1] * (bfhi(a.x) + bfhi(c.x)); v[i][2] += g[2] * (bflo(a.y) + bflo(c.y)); v[i][3] += g[3] * (bfhi(a.y) + bfhi(c.y)); }
            if (MODE != 2) {
#pragma unroll
                for (int i = 0; i < 4; ++i) *(f32x4*)(xr + i * 256 + 4 * F.lane) = v[i];
            }
        }
        float ss = 0.f;
#pragma unroll
        for (int i = 0; i < 4; ++i) ss += v[i][0] * v[i][0] + v[i][1] * v[i][1] + v[i][2] * v[i][2] + v[i][3] * v[i][3];
        ss = wave_sum(ss);
        const float rstd = rsqrtf(ss * (1.0f / D) + EPS);
        if (MODE == 2) {
#pragma unroll
            for (int i = 0; i < 4; ++i) { const f32x4 g = *(const f32x4*)(gn + i * 256 + 4 * F.lane); f32x4 o;
#pragma unroll
                for (int e = 0; e < 4; ++e) o[e] = v[i][e] * rstd * g[e];
                *(f32x4*)(xr + i * 256 + 4 * F.lane) = o; }
        } else {
            const float* sh = modp + (size_t)b * (NMOD * D); const float* scp = sh + D;
            bf16_t* hrow = (bf16_t*)(F.ws + WS_H) + (size_t)row * D;
#pragma unroll
            for (int i = 0; i < 4; ++i) { const f32x4 g = *(const f32x4*)(gn + i * 256 + 4 * F.lane), s1 = *(const f32x4*)(sh + i * 256 + 4 * F.lane), s2 = *(const f32x4*)(scp + i * 256 + 4 * F.lane);
                float o[4];
#pragma unroll
                for (int e = 0; e < 4; ++e) o[e] = v[i][e] * rstd * g[e] * (1.0f + s2[e]) + s1[e];
                u32x2 w; w.x = pk_bf16(o[0], o[1]); w.y = pk_bf16(o[2], o[3]); *(u32x2*)(hrow + i * 256 + 4 * F.lane) = w; }
        }
    }
}

__device__ __forceinline__ void moe_weight_cvt(const Frame& F, int l) {
    __syncthreads();
    for (int it = F.bid; it < 12288; it += F.G) {
        if (it < 8192) { const int up = it >= 4096, j = it & 4095, e = j >> 7, r = j & 127, kt = r >> 3, nt = r & 7;
            const float* src = F.P->in[up ? I_WUP : I_WGATE] + ((size_t)l * 32 + e) * D * DEXP;
            bf16_t* dst = (bf16_t*)(F.ws + WS_MOEGU) + (size_t)e * 1024 * 1024;
            const int n0 = nt * 64, drow0 = (n0 >> 7) * 256 + (up ? 128 : 0) + (n0 & 127);
            tr_tile(F, src, DEXP, kt * 64, n0, dst, 1024, drow0); }
        else { const int j = it - 8192, e = j >> 7, r = j & 127, kt = r >> 4, nt = r & 15;
            const float* src = F.P->in[I_WDOWN] + ((size_t)l * 32 + e) * DEXP * D;
            bf16_t* dst = (bf16_t*)(F.ws + WS_MOEDN) + (size_t)e * 1024 * 512;
            tr_tile(F, src, D, kt * 64, nt * 64, dst, 512, nt * 64); }
    }
}

__device__ __forceinline__ void hy_pre(const Frame& F, int l, bool do_ctx) {
    constexpr int BST = 1154;
    static_assert(32 * BST * 2 <= LDS_BARW, "hy_pre LDS");
    LAS bf16_t* raw = (LAS bf16_t*)F.lds;
    const bf16_t* P = (const bf16_t*)(F.ws + WS_P);
    const float* cw = F.P->in[I_DCW] + (size_t)l * 3 * 768; const float* cb = F.P->in[I_DCB] + (size_t)l * 768;
    const int nlat = 128 * 12, nitems = nlat + (do_ctx ? 16 * 12 : 0);
    __syncthreads();
    for (int it = F.bid; it < nitems; it += F.G) {
        const bool isc = it >= nlat; const int jj = isc ? it - nlat : it; const int sblk = jj / 12, cgp = jj % 12;
        const int Lseg = isc ? LC : SEQ; const size_t tokbase = isc ? TL : 0;
        for (int pc = F.tid; pc < 32 * 18 * 8; pc += NTHREADS) {
            const int b = pc / 144, r = (pc % 144) >> 3, q = pc & 7; const int t = sblk * 16 + r - 1;
            u32x4 v = (u32x4){0u, 0u, 0u, 0u};
            if (t >= 0 && t < Lseg) v = *(const u32x4*)(P + (tokbase + (size_t)b * Lseg + t) * DIN + OFF_D + cgp * 64 + q * 8);
            LAS unsigned* dst = (LAS unsigned*)(raw + b * BST + r * 64 + q * 8);
            dst[0] = v.x; dst[1] = v.y; dst[2] = v.z; dst[3] = v.w;
        }
        __syncthreads();
        const int b = F.tid & 31, cs = F.tid >> 5;
        bf16_t* UF = (bf16_t*)(F.ws + WS_UF) + (isc ? (size_t)768 * 65536 : 0);
        const size_t chs = isc ? 8192 : 65536;
#pragma unroll 1
        for (int i = 0; i < 4; ++i) {
            const int chl = cs * 4 + i, ch = cgp * 64 + chl;
            const float w0 = cw[ch], w1 = cw[768 + ch], w2 = cw[1536 + ch], bb = cb[ch];
#pragma unroll
            for (int hh = 0; hh < 2; ++hh) {
                float x[10];
#pragma unroll
                for (int q = 0; q < 10; ++q) x[q] = bf2f(raw[b * BST + (8 * hh + q) * 64 + chl]);
                float u[8];
#pragma unroll
                for (int j = 0; j < 8; ++j) u[j] = bb + w0 * x[j] + w1 * x[j + 1] + w2 * x[j + 2];
                u32x4 w; w.x = pk_bf16(u[0], u[1]); w.y = pk_bf16(u[2], u[3]); w.z = pk_bf16(u[4], u[5]); w.w = pk_bf16(u[6], u[7]);
                *(u32x4*)(UF + (size_t)ch * chs + (((size_t)sblk * 2 + hh) * 32 + b) * 8) = w;
            }
        }
        __syncthreads();
    }
}

template <int ORDER>
__device__ __forceinline__ void hy_conv(const Frame& F, int l, bool do_ctx) {
    LAS bf16_t* Gl = (LAS bf16_t*)F.lds + F.wave * 4096;
    LAS bf16_t* stg = (LAS bf16_t*)(F.lds + 65536 + 1024);
    const int lane = F.lane, i31 = lane & 31, hh = lane >> 5;
    const int nlat = 256, nitems = nlat + (do_ctx ? 32 : 0);
    const bf16_t* UF0 = (const bf16_t*)(F.ws + WS_UF); bf16_t* Z10 = (bf16_t*)(F.ws + WS_Z1F);
    for (int it = F.bid; it < nitems; it += F.G) {
        const bool isc = it >= nlat; const int cg = isc ? it - nlat : (it >> 3), tg = isc ? 0 : (it & 7);
        const int Lf = isc ? LC : SEQ; const int c = cg * 8 + F.wave;
        const bf16_t* Gg = isc ? (const bf16_t*)(F.ws + WS_GRC) + ((size_t)(l * 2 + ORDER) * 256 + c) * 512
                               : (const bf16_t*)(F.ws + WS_GR) + ((size_t)(l * 2 + ORDER) * 256 + c) * 4096;
        for (int q = lane; q < Lf / 4; q += 64) *(LAS u32x4*)(Gl + q * 8) = *(const u32x4*)(Gg + q * 8);
        const size_t chs = isc ? 8192 : 65536;
        const bf16_t* UFb = UF0 + (isc ? (size_t)768 * 65536 : 0); bf16_t* Z1b = Z10 + (isc ? (size_t)256 * 65536 : 0);
        const bf16_t* zsrc = (ORDER == 0) ? UFb + (size_t)c * chs : Z1b + (size_t)c * chs;
        const bf16_t* gsrc = UFb + (size_t)(256 * (ORDER + 1) + c) * chs;
        const int t0 = tg * 256;
        f32x16 acc[8];
#pragma unroll
        for (int a = 0; a < 8; ++a)
#pragma unroll
            for (int r = 0; r < 16; ++r) acc[a][r] = 0.f;
        bf16x8 FR[8][2];
#define HY_FRAG(dst, xb) do { const LAS bf16_t* _g = Gl + (xb); _Pragma("unroll") for (int _j = 0; _j < 8; ++_j) dst[_j] = (short)_g[_j]; } while (0)
        const int xb0 = Lf - t0 - i31 + 8 * hh;
#pragma unroll
        for (int a = 0; a < 8; ++a)
#pragma unroll
            for (int ks = 0; ks < 2; ++ks) HY_FRAG(FR[a][ks], xb0 - 32 * a + 16 * ks);
        const int nkp = Lf / 32;
        bf16x8 Bn[2];
#pragma unroll
        for (int ks = 0; ks < 2; ++ks) Bn[ks] = *(const bf16x8*)(zsrc + ((size_t)(ks * 2 + hh) * 32 + i31) * 8);
        for (int nb = 0; nb < nkp; nb += 8) {
#pragma unroll
            for (int u = 0; u < 8; ++u) {
                const int s0 = (nb + u) * 32;
                bf16x8 Bf[2];
#pragma unroll
                for (int ks = 0; ks < 2; ++ks) Bf[ks] = Bn[ks];
                { const int s1 = (s0 + 32 < Lf) ? s0 + 32 : s0;
#pragma unroll
                  for (int ks = 0; ks < 2; ++ks) Bn[ks] = *(const bf16x8*)(zsrc + ((size_t)(((s1 >> 4) + ks) * 2 + hh) * 32 + i31) * 8); }
#pragma unroll
                for (int a = 0; a < 8; ++a)
#pragma unroll
                    for (int ks = 0; ks < 2; ++ks) acc[a] = MFMA32(FR[(a - u) & 7][ks], Bf[ks], acc[a]);
#pragma unroll
                for (int ks = 0; ks < 2; ++ks) HY_FRAG(FR[(7 - u) & 7][ks], xb0 + s0 + 32 + 16 * ks);
            }
        }
#undef HY_FRAG
        if (ORDER == 0) {
#pragma unroll
            for (int a = 0; a < 8; ++a)
#pragma unroll
                for (int rg = 0; rg < 4; ++rg) {
                    const size_t off = ((size_t)(((t0 >> 4) + 2 * a + (rg >> 1)) * 2 + (rg & 1)) * 32 + i31) * 8 + 4 * hh;
                    const u32x2 g = *(const u32x2*)(gsrc + off);
                    u32x2 w; w.x = pk_bf16(bflo(g.x) * acc[a][4 * rg], bfhi(g.x) * acc[a][4 * rg + 1]); w.y = pk_bf16(bflo(g.y) * acc[a][4 * rg + 2], bfhi(g.y) * acc[a][4 * rg + 3]);
                    *(u32x2*)(Z1b + (size_t)c * chs + off) = w;
                }
        } else {
            bf16_t* Y = (bf16_t*)(F.ws + WS_Y);
            const size_t tokbase = isc ? TL : 0;
#pragma unroll
            for (int a = 0; a < 8; ++a) {
                __syncthreads();
#pragma unroll
                for (int rg = 0; rg < 4; ++rg) {
                    const size_t off = ((size_t)(((t0 >> 4) + 2 * a + (rg >> 1)) * 2 + (rg & 1)) * 32 + i31) * 8 + 4 * hh;
                    const u32x2 g = *(const u32x2*)(gsrc + off);
                    float gv[4] = {bflo(g.x), bfhi(g.x), bflo(g.y), bfhi(g.y)};
#pragma unroll
                    for (int e = 0; e < 4; ++e) { const int tl = 8 * rg + 4 * hh + e; stg[(tl * 32 + i31) * 8 + F.wave] = (bf16_t)(pk_bf16(gv[e] * acc[a][4 * rg + e], 0.f) & 0xffffu); }
                }
                __syncthreads();
#pragma unroll
                for (int q = 0; q < 2; ++q) { const int pr = F.tid + q * NTHREADS, tl = pr >> 5, b = pr & 31;
                    const u32x4 v = *(const LAS u32x4*)(stg + pr * 8);
                    *(u32x4*)(Y + (tokbase + (size_t)b * Lf + t0 + 32 * a + tl) * D + 768 + cg * 8) = v; }
            }
            __syncthreads();
        }
    }
}

constexpr int LR_XR = 0;
constexpr int LR_UB = 17408;
constexpr int LR_WT = LR_UB + 18432;
constexpr int LR_A  = LR_WT + 18432;
constexpr int LR_B  = LR_A + 32768;
constexpr int LR_WS = LR_B + 32768;
static_assert(LR_WS + 4096 <= LDS_BARW, "LRU LDS");

__device__ __forceinline__ void lru_chunk_ab(const Frame& F, int l, int b, int hd, int dir, bool isc, int t_lo) {
    LAS bf16_t* xr = (LAS bf16_t*)(F.lds + LR_XR); LAS bf16_t* ub = (LAS bf16_t*)(F.lds + LR_UB); LAS bf16_t* wt = (LAS bf16_t*)(F.lds + LR_WT);
    LAS float* a_s = (LAS float*)(F.lds + LR_A); LAS float* b_s = (LAS float*)(F.lds + LR_B);
    const bf16_t* P = (const bf16_t*)(F.ws + WS_P);
    const int Lseg = isc ? LC : SEQ; const size_t tokbase = (isc ? (size_t)TL : 0) + (size_t)b * Lseg;
    __syncthreads();
    for (int pc = F.tid; pc < 134 * 8; pc += NTHREADS) { const int r = pc >> 3, q = pc & 7; const int t = t_lo - 3 + r;
        u32x4 v = (u32x4){0u, 0u, 0u, 0u};
        if (t >= 0 && t < Lseg) v = *(const u32x4*)(P + (tokbase + t) * DIN + hd * 64 + q * 8);
        *(LAS u32x4*)(xr + r * 64 + q * 8) = v; }
    {   const bf16_t* W = (const bf16_t*)(F.ws + WS_LRUW) + (size_t)(l * 2 + dir) * 2 * 4 * 4096;
        for (int pc = F.tid; pc < 2 * 64 * 8; pc += NTHREADS) { const int g = pc >> 9, n = (pc >> 3) & 63, q = pc & 7;
            *(LAS u32x4*)(wt + (g * 64 + n) * 72 + q * 8) = *(const u32x4*)(W + ((size_t)(g * 4 + hd) * 64 + n) * 64 + q * 8); } }
    __syncthreads();
    {
        const int ch = F.tid & 63, tq = F.tid >> 6; const int chg = hd * 64 + ch;
        const float* cw = F.P->in[I_ACW] + ((size_t)(l * 2 + dir) * 4) * 256 + chg; const float cb = F.P->in[I_ACB][(size_t)(l * 2 + dir) * 256 + chg];
        const float w0 = cw[0], w1 = cw[256], w2 = cw[512], w3 = cw[768];
        const int r0 = tq * 16 + (dir ? 3 : 0);
        float x[19];
#pragma unroll
        for (int q = 0; q < 19; ++q) x[q] = bf2f(xr[(r0 + q) * 64 + ch]);
#pragma unroll
        for (int k = 0; k < 16; ++k) { const float u = cb + w0 * x[k] + w1 * x[k + 1] + w2 * x[k + 2] + w3 * x[k + 3];
            ub[(tq * 16 + k) * 72 + ch] = (bf16_t)(pk_bf16(u, 0.f) & 0xffffu); }
    }
    __syncthreads();
    {
        const int w = F.wave, lane = F.lane, row = lane & 15, kq = lane >> 4;
        bf16x8 Af[2];
#pragma unroll
        for (int ks = 0; ks < 2; ++ks) Af[ks] = *(const LAS bf16x8*)(ub + (16 * w + row) * 72 + 32 * ks + 8 * kq);
        const float* br = F.P->in[I_ABR] + (size_t)(l * 2 + dir) * 256 + hd * 64; const float* bi = F.P->in[I_ABI] + (size_t)(l * 2 + dir) * 256 + hd * 64;
        const float* lam = F.P->in[I_ALAM] + (size_t)(l * 2 + dir) * 256 + hd * 64;
#pragma unroll
        for (int nt = 0; nt < 4; ++nt) {
            f32x4 cr = (f32x4){0.f, 0.f, 0.f, 0.f}, ci = cr;
#pragma unroll
            for (int ks = 0; ks < 2; ++ks) {
                const bf16x8 Br = *(const LAS bf16x8*)(wt + (0 * 64 + 16 * nt + row) * 72 + 32 * ks + 8 * kq);
                const bf16x8 Bi = *(const LAS bf16x8*)(wt + (1 * 64 + 16 * nt + row) * 72 + 32 * ks + 8 * kq);
                cr = MFMA16(Af[ks], Br, cr); ci = MFMA16(Af[ks], Bi, ci);
            }
            const int ch = 16 * nt + row;
            const float sp = log1pf(__expf(-lam[ch])), brc = br[ch], bic = bi[ch];
#pragma unroll
            for (int r = 0; r < 4; ++r) { const int tl = 16 * w + 4 * kq + r;
                const float rr = sigmoid_f(cr[r] + brc), ii = sigmoid_f(ci[r] + bic);
                const float a = __expf(-8.0f * rr * sp);
                const float uv = bf2f(ub[tl * 72 + ch]);
                a_s[tl * 64 + ch] = a; b_s[tl * 64 + ch] = sqrtf(fmaxf(1.0f - a * a, 0.f)) * (ii * uv); }
        }
    }
    __syncthreads();
}

__device__ __forceinline__ void lru_s1(const Frame& F, int l) {
    LAS float* a_s = (LAS float*)(F.lds + LR_A); LAS float* b_s = (LAS float*)(F.lds + LR_B); LAS float* wsum = (LAS float*)(F.lds + LR_WS);
    float* SUM = (float*)(F.ws + WS_LRUS);
    for (int it = F.bid; it < 32 * 4 * 2 * 18; it += F.G) {
        int r = it; const int n = r % 18; r /= 18; const int dir = r & 1; r >>= 1; const int hd = r & 3; const int b = r >> 2;
        const bool isc = n < 2; const int tc = isc ? (dir ? 1 - n : n) : (dir ? 15 - (n - 2) : n - 2);
        lru_chunk_ab(F, l, b, hd, dir, isc, tc * 128);
        const int w = F.wave, ch = F.lane;
        float A = 1.f, Bv = 0.f;
#pragma unroll
        for (int k = 0; k < 16; ++k) { const int tl = dir ? 127 - 16 * w - k : 16 * w + k; const float a = a_s[tl * 64 + ch], bb = b_s[tl * 64 + ch]; Bv = a * Bv + bb; A *= a; }
        wsum[(w * 2 + 0) * 64 + ch] = A; wsum[(w * 2 + 1) * 64 + ch] = Bv;
        __syncthreads();
        if (w == 0) { float At = 1.f, Bt = 0.f;
#pragma unroll
            for (int q = 0; q < 8; ++q) { const float Aq = wsum[(q * 2) * 64 + ch], Bq = wsum[(q * 2 + 1) * 64 + ch]; Bt = Aq * Bt + Bq; At *= Aq; }
            float* dst = SUM + ((size_t)((b * 2 + dir) * 4 + hd) * 18 + n) * 128;
            dst[ch] = At; dst[64 + ch] = Bt; }
    }
}
__device__ __forceinline__ void lru_s2(const Frame& F) {
    const float* SUM = (const float*)(F.ws + WS_LRUS); float* CAR = (float*)(F.ws + WS_LRUC);
    if (F.wave != 0) return;
    for (int it = F.bid; it < 32 * 2 * 4; it += F.G) {
        float As[18], Bs[18];
#pragma unroll
        for (int n = 0; n < 18; ++n) { const float* s = SUM + ((size_t)it * 18 + n) * 128; As[n] = s[F.lane]; Bs[n] = s[64 + F.lane]; }
        float carry = 0.f;
#pragma unroll
        for (int n = 0; n < 18; ++n) { CAR[((size_t)it * 18 + n) * 64 + F.lane] = carry; carry = As[n] * carry + Bs[n]; }
    }
}
__device__ __forceinline__ void lru_s3(const Frame& F, int l, bool do_ctx) {
    LAS float* a_s = (LAS float*)(F.lds + LR_A); LAS float* b_s = (LAS float*)(F.lds + LR_B); LAS float* wsum = (LAS float*)(F.lds + LR_WS);
    const float* CAR = (const float*)(F.ws + WS_LRUC);
    const bf16_t* P = (const bf16_t*)(F.ws + WS_P); bf16_t* Y = (bf16_t*)(F.ws + WS_Y);
    const int nlat = 32 * 4 * 16, nitems = nlat + (do_ctx ? 32 * 4 * 2 : 0);
    for (int it = F.bid; it < nitems; it += F.G) {
        const bool isc = it >= nlat; int r = isc ? it - nlat : it; const int ntc = isc ? 2 : 16; const int tc = r % ntc; r /= ntc; const int hd = r & 3; const int b = r >> 2;
        const int w = F.wave, ch = F.lane;
        float hs[16];
#pragma unroll
        for (int k = 0; k < 16; ++k) hs[k] = 0.f;
#pragma unroll
        for (int dir = 0; dir < 2; ++dir) {
            lru_chunk_ab(F, l, b, hd, dir, isc, tc * 128);
            const int n = isc ? (dir ? 1 - tc : tc) : 2 + (dir ? 15 - tc : tc);
            float hl[16], ca[16]; float A = 1.f, Bv = 0.f;
#pragma unroll
            for (int kk = 0; kk < 16; ++kk) { const int k = dir ? 15 - kk : kk; const int tl = 16 * w + k; const float a = a_s[tl * 64 + ch], bb = b_s[tl * 64 + ch]; Bv = a * Bv + bb; A *= a; hl[k] = Bv; ca[k] = A; }
            wsum[(w * 2 + 0) * 64 + ch] = A; wsum[(w * 2 + 1) * 64 + ch] = Bv;
            __syncthreads();
            float s = CAR[((size_t)((b * 2 + dir) * 4 + hd) * 18 + n) * 64 + ch];
            const int myord = dir ? 7 - w : w;
#pragma unroll
            for (int q = 0; q < 8; ++q) { const int wq = dir ? 7 - q : q; if (q < myord) s = wsum[(wq * 2) * 64 + ch] * s + wsum[(wq * 2 + 1) * 64 + ch]; }
#pragma unroll
            for (int k = 0; k < 16; ++k) hs[k] += hl[k] + ca[k] * s;
        }
        const int Lseg = isc ? LC : SEQ; const size_t tokbase = (isc ? (size_t)TL : 0) + (size_t)b * Lseg + tc * 128 + 16 * w;
#pragma unroll
        for (int k = 0; k < 16; ++k) { const float xg = bf2f(P[(tokbase + k) * DIN + 256 + hd * 64 + ch]);
            Y[(tokbase + k) * D + hd * 64 + ch] = (bf16_t)(pk_bf16(hs[k] * gelu_tanh_f(xg), 0.f) & 0xffffu); }
    }
}


__device__ __forceinline__ void lru_seq(const Frame& F, int l, bool ctx_out) {
    LAS bf16_t* xr = (LAS bf16_t*)(F.lds + LR_XR); LAS bf16_t* ub = (LAS bf16_t*)(F.lds + LR_UB); LAS bf16_t* wt = (LAS bf16_t*)(F.lds + LR_WT);
    LAS float* a_s = (LAS float*)(F.lds + LR_A); LAS float* b_s = (LAS float*)(F.lds + LR_B); LAS float* wsum = (LAS float*)(F.lds + LR_WS);
    const bf16_t* P = (const bf16_t*)(F.ws + WS_P); bf16_t* HT = (bf16_t*)(F.ws + WS_HT);
    const int w = F.wave, lane = F.lane, row = lane & 15, kq = lane >> 4;
    for (int it = F.bid; it < 32 * 4 * 2; it += F.G) {
        const int dir = it & 1, hd = (it >> 1) & 3, b = it >> 3;
        __syncthreads();
        {   const bf16_t* W = (const bf16_t*)(F.ws + WS_LRUW) + (size_t)(l * 2 + dir) * 2 * 4 * 4096;
            for (int pc = F.tid; pc < 2 * 64 * 8; pc += NTHREADS) { const int g = pc >> 9, n = (pc >> 3) & 63, q = pc & 7;
                *(LAS u32x4*)(wt + (g * 64 + n) * 72 + q * 8) = *(const u32x4*)(W + ((size_t)(g * 4 + hd) * 64 + n) * 64 + q * 8); } }
        const int cch = F.tid & 63, ctq = F.tid >> 6; const int chg = hd * 64 + cch;
        const float* cw = F.P->in[I_ACW] + ((size_t)(l * 2 + dir) * 4) * 256 + chg; const float cb = F.P->in[I_ACB][(size_t)(l * 2 + dir) * 256 + chg];
        const float w0 = cw[0], w1 = cw[256], w2 = cw[512], w3 = cw[768];
        float spv[4], brv[4], biv[4];
#pragma unroll
        for (int nt = 0; nt < 4; ++nt) { const int ch = hd * 64 + 16 * nt + row; const size_t o = (size_t)(l * 2 + dir) * 256 + ch;
            spv[nt] = log1pf(__expf(-F.P->in[I_ALAM][o])); brv[nt] = F.P->in[I_ABR][o]; biv[nt] = F.P->in[I_ABI][o]; }
        float carry = 0.f;
        u32x4 pf[3];
#define LRS_GEO(n, isc_, tlo_) const bool isc_ = (n) < 2; const int tlo_ = 128 * (isc_ ? (dir ? 1 - (n) : (n)) : (dir ? 15 - ((n) - 2) : (n) - 2))
#define LRS_PREFETCH(n) do { LRS_GEO(n, ic_, tl_); const int Ls_ = ic_ ? LC : SEQ; const size_t tb_ = (ic_ ? (size_t)TL : 0) + (size_t)b * Ls_; \
            _Pragma("unroll") for (int u_ = 0; u_ < 3; ++u_) { const int pc_ = F.tid + u_ * NTHREADS; const int r_ = pc_ >> 3, q_ = pc_ & 7; const int t_ = tl_ - 3 + r_; \
                pf[u_] = (u32x4){0u, 0u, 0u, 0u}; if (pc_ < 134 * 8 && t_ >= 0 && t_ < Ls_) pf[u_] = *(const u32x4*)(P + (tb_ + t_) * DIN + hd * 64 + q_ * 8); } } while (0)
        LRS_PREFETCH(0);
#pragma unroll 1
        for (int n = 0; n < 18; ++n) {
            LRS_GEO(n, isc, t_lo);
            const int Lseg = isc ? LC : SEQ; const size_t tokbase = (isc ? (size_t)TL : 0) + (size_t)b * Lseg + t_lo;
#pragma unroll
            for (int u = 0; u < 3; ++u) { const int pc = F.tid + u * NTHREADS; if (pc < 134 * 8) *(LAS u32x4*)(xr + (pc >> 3) * 64 + (pc & 7) * 8) = pf[u]; }
            __syncthreads();
            {   const int r0 = ctq * 16 + (dir ? 3 : 0);
                float x[19];
#pragma unroll
                for (int q = 0; q < 19; ++q) x[q] = bf2f(xr[(r0 + q) * 64 + cch]);
#pragma unroll
                for (int k = 0; k < 16; ++k) { const float u = cb + w0 * x[k] + w1 * x[k + 1] + w2 * x[k + 2] + w3 * x[k + 3];
                    ub[(ctq * 16 + k) * 72 + cch] = (bf16_t)(pk_bf16(u, 0.f) & 0xffffu); }
            }
            __syncthreads();
            if (n + 1 < 18) LRS_PREFETCH(n + 1);
            {   bf16x8 Af[2];
#pragma unroll
                for (int ks = 0; ks < 2; ++ks) Af[ks] = *(const LAS bf16x8*)(ub + (16 * w + row) * 72 + 32 * ks + 8 * kq);
#pragma unroll
                for (int nt = 0; nt < 4; ++nt) {
                    f32x4 cr = (f32x4){0.f, 0.f, 0.f, 0.f}, ci = cr;
#pragma unroll
                    for (int ks = 0; ks < 2; ++ks) {
                        const bf16x8 Br = *(const LAS bf16x8*)(wt + (0 * 64 + 16 * nt + row) * 72 + 32 * ks + 8 * kq);
                        const bf16x8 Bi = *(const LAS bf16x8*)(wt + (1 * 64 + 16 * nt + row) * 72 + 32 * ks + 8 * kq);
                        cr = MFMA16(Af[ks], Br, cr); ci = MFMA16(Af[ks], Bi, ci);
                    }
                    const int ch = 16 * nt + row;
#pragma unroll
                    for (int r = 0; r < 4; ++r) { const int tl = 16 * w + 4 * kq + r;
                        const float rr = sigmoid_f(cr[r] + brv[nt]), ii = sigmoid_f(ci[r] + biv[nt]);
                        const float a = __expf(-8.0f * rr * spv[nt]);
                        const float uv = bf2f(ub[tl * 72 + ch]);
                        a_s[tl * 64 + ch] = a; b_s[tl * 64 + ch] = sqrtf(fmaxf(1.0f - a * a, 0.f)) * (ii * uv); }
                }
            }
            __syncthreads();
            float hl[16], ca[16]; float A = 1.f, Bv = 0.f;
#pragma unroll
            for (int kk = 0; kk < 16; ++kk) { const int tl = 16 * w + (dir ? 15 - kk : kk); const float a = a_s[tl * 64 + lane], bb = b_s[tl * 64 + lane]; Bv = a * Bv + bb; A *= a; hl[kk] = Bv; ca[kk] = A; }
            wsum[(w * 2 + 0) * 64 + lane] = A; wsum[(w * 2 + 1) * 64 + lane] = Bv;
            __syncthreads();
            float s = carry; const int myord = dir ? 7 - w : w;
#pragma unroll
            for (int q = 0; q < 8; ++q) { const int wq = dir ? 7 - q : q; const float Aq = wsum[(wq * 2) * 64 + lane], Bq = wsum[(wq * 2 + 1) * 64 + lane];
                if (q < myord) s = Aq * s + Bq; carry = Aq * carry + Bq; }
            if (!isc || ctx_out) {
                bf16_t* dst = HT + ((size_t)dir * TT + tokbase + 16 * w) * 256 + hd * 64 + lane;
#pragma unroll
                for (int kk = 0; kk < 16; ++kk) { const int k = dir ? 15 - kk : kk; dst[(size_t)k * 256] = (bf16_t)(pk_bf16(hl[kk] + ca[kk] * s, 0.f) & 0xffffu); }
            }
        }
#undef LRS_GEO
#undef LRS_PREFETCH
    }
}
__device__ __forceinline__ void lru_comb(const Frame& F, bool ctx_out) {
    const bf16_t* P = (const bf16_t*)(F.ws + WS_P); const bf16_t* HT = (const bf16_t*)(F.ws + WS_HT); bf16_t* Y = (bf16_t*)(F.ws + WS_Y);
    const size_t n = (size_t)(ctx_out ? TT : TL) * 32;
    for (size_t i = (size_t)F.bid * NTHREADS + F.tid; i < n; i += (size_t)F.G * NTHREADS) { const size_t rowi = i >> 5; const int c8 = (int)(i & 31) * 8;
        const u32x4 hf = *(const u32x4*)(HT + rowi * 256 + c8), hb = *(const u32x4*)(HT + ((size_t)TT + rowi) * 256 + c8), xg = *(const u32x4*)(P + rowi * DIN + 256 + c8);
        const unsigned hfa[4] = {hf.x, hf.y, hf.z, hf.w}, hba[4] = {hb.x, hb.y, hb.z, hb.w}, xga[4] = {xg.x, xg.y, xg.z, xg.w}; unsigned o[4];
#pragma unroll
        for (int e = 0; e < 4; ++e) o[e] = pk_bf16((bflo(hfa[e]) + bflo(hba[e])) * gelu_tanh_f(bflo(xga[e])), (bfhi(hfa[e]) + bfhi(hba[e])) * gelu_tanh_f(bfhi(xga[e])));
        *(u32x4*)(Y + rowi * D + c8) = (u32x4){o[0], o[1], o[2], o[3]}; }
}

constexpr int CF_GLU = 0;
constexpr int CF_CV  = 48128;
constexpr int CF_ACT = CF_CV + 65536;
static_assert(CF_ACT + 64 * 264 * 2 <= LDS_BARW, "conformer LDS");
#ifndef CONF_STEPS
#define CONF_STEPS 4
#endif
__device__ __forceinline__ void conf_phase(const Frame& F, int l, bool do_ctx) {
    LAS bf16_t* glu = (LAS bf16_t*)(F.lds + CF_GLU); LAS float* cv = (LAS float*)(F.lds + CF_CV); LAS bf16_t* act = (LAS bf16_t*)(F.lds + CF_ACT);
    const bf16_t* P = (const bf16_t*)(F.ws + WS_P); bf16_t* Y = (bf16_t*)(F.ws + WS_Y);
    const int nlat = TL / 64, nitems = nlat + (do_ctx ? TC / 64 : 0);
    const float* ccw = F.P->in[I_CCW] + (size_t)l * 31 * 256; const float* ccb = F.P->in[I_CCB] + (size_t)l * 256;
    const float* lng = F.P->in[I_CLG] + (size_t)l * 256; const float* lnb = F.P->in[I_CLB] + (size_t)l * 256; const float* bpw = F.P->in[I_CBPW] + (size_t)l * 256;
    const bf16_t* Wt = (const bf16_t*)(F.ws + WS_CPW) + (size_t)l * 65536;
    bf16x8 Aw[2][8];
#pragma unroll
    for (int nt = 0; nt < 2; ++nt)
#pragma unroll
        for (int ks = 0; ks < 8; ++ks) Aw[nt][ks] = *(const bf16x8*)(Wt + (size_t)(32 * F.wave + 16 * nt + (F.lane & 15)) * 256 + 32 * ks + 8 * (F.lane >> 4));
    for (int it = F.bid; it < nitems; it += F.G) {
        const bool isc = it >= nlat; const int tile = isc ? it - nlat : it; const int Lseg = isc ? LC : SEQ; const int tps = Lseg / 64;
        const int b = tile / tps, t0 = (tile % tps) * 64; const size_t tokbase = (isc ? (size_t)TL : 0) + (size_t)b * Lseg;
        __syncthreads();
        for (int pc = F.tid; pc < 94 * 32; pc += NTHREADS) { const int r = pc >> 5, q = pc & 31; const int t = t0 - 15 + r;
            u32x4 o = (u32x4){0u, 0u, 0u, 0u};
            if (t >= 0 && t < Lseg) { const bf16_t* src = P + (tokbase + t) * DIN + OFF_C + q * 8; const u32x4 v = *(const u32x4*)src, g = *(const u32x4*)(src + 256);
                o.x = pk_bf16(bflo(v.x) * sigmoid_f(bflo(g.x)), bfhi(v.x) * sigmoid_f(bfhi(g.x))); o.y = pk_bf16(bflo(v.y) * sigmoid_f(bflo(g.y)), bfhi(v.y) * sigmoid_f(bfhi(g.y)));
                o.z = pk_bf16(bflo(v.z) * sigmoid_f(bflo(g.z)), bfhi(v.z) * sigmoid_f(bfhi(g.z))); o.w = pk_bf16(bflo(v.w) * sigmoid_f(bflo(g.w)), bfhi(v.w) * sigmoid_f(bfhi(g.w))); }
            *(LAS u32x4*)(glu + r * 256 + q * 8) = o; }
        __syncthreads();
        if (CONF_STEPS < 2) continue;
        {   const int ch = F.tid & 255, tg = F.tid >> 8;
            const float cbv = ccb[ch];
            float wv[31];
#pragma unroll
            for (int j = 0; j < 31; ++j) wv[j] = ccw[j * 256 + ch];
#pragma unroll 1
            for (int kg = 0; kg < 4; ++kg) {
                float xs[38];
#pragma unroll
                for (int q = 0; q < 38; ++q) xs[q] = bf2f(glu[(32 * tg + 8 * kg + q) * 256 + ch]);
#pragma unroll
                for (int kk = 0; kk < 8; ++kk) { float a = cbv;
#pragma unroll
                    for (int j = 0; j < 31; ++j) a += wv[j] * xs[kk + j];
                    cv[(32 * tg + 8 * kg + kk) * 256 + ch] = a; }
            }
        }
        __syncthreads();
        if (CONF_STEPS < 3) continue;
        {
            const f32x4 g4 = *(const f32x4*)(lng + 4 * F.lane), b4 = *(const f32x4*)(lnb + 4 * F.lane);
#pragma unroll 1
            for (int q = 0; q < 8; ++q) { const int tk = 8 * F.wave + q; const f32x4 v = *(const LAS f32x4*)(cv + tk * 256 + 4 * F.lane);
                const float mu = wave_sum(v[0] + v[1] + v[2] + v[3]) * (1.0f / 256.0f);
                const float d0 = v[0] - mu, d1 = v[1] - mu, d2 = v[2] - mu, d3 = v[3] - mu;
                const float var = wave_sum(d0 * d0 + d1 * d1 + d2 * d2 + d3 * d3) * (1.0f / 256.0f);
                const float rs = rsqrtf(var + 1e-5f);
                const float y0 = silu_f(d0 * rs * g4[0] + b4[0]), y1 = silu_f(d1 * rs * g4[1] + b4[1]), y2 = silu_f(d2 * rs * g4[2] + b4[2]), y3 = silu_f(d3 * rs * g4[3] + b4[3]);
                u32x2 o; o.x = pk_bf16(y0, y1); o.y = pk_bf16(y2, y3); *(LAS u32x2*)(act + tk * 264 + 4 * F.lane) = o; }
        }
        __syncthreads();
        if (CONF_STEPS < 4) continue;
        {
            const int lane = F.lane, row = lane & 15, kq = lane >> 4;
            f32x4 acc[2][4];
#pragma unroll
            for (int nt = 0; nt < 2; ++nt)
#pragma unroll
                for (int tt = 0; tt < 4; ++tt) acc[nt][tt] = (f32x4){0.f, 0.f, 0.f, 0.f};
#pragma unroll
            for (int ks = 0; ks < 8; ++ks) {
                bf16x8 Bt[4];
#pragma unroll
                for (int tt = 0; tt < 4; ++tt) Bt[tt] = *(const LAS bf16x8*)(act + (16 * tt + row) * 264 + 32 * ks + 8 * kq);
#pragma unroll
                for (int nt = 0; nt < 2; ++nt)
#pragma unroll
                    for (int tt = 0; tt < 4; ++tt) acc[nt][tt] = MFMA16(Aw[nt][ks], Bt[tt], acc[nt][tt]);
            }
#pragma unroll
            for (int nt = 0; nt < 2; ++nt) { const int n0 = 32 * F.wave + 16 * nt + 4 * kq; const f32x4 bb = *(const f32x4*)(bpw + n0);
#pragma unroll
                for (int tt = 0; tt < 4; ++tt) { const f32x4 v = acc[nt][tt] + bb; u32x2 o; o.x = pk_bf16(v[0], v[1]); o.y = pk_bf16(v[2], v[3]);
                    *(u32x2*)(Y + (tokbase + t0 + 16 * tt + row) * D + 512 + n0) = o; } }
        }
    }
}

constexpr int AT_KST = 72;
constexpr int AT_VST = 132;
constexpr int AT_KB  = 128 * AT_KST * 2;
constexpr int AT_VB  = 64 * AT_VST * 2;
constexpr int AT_K0 = 0, AT_V0 = 2 * AT_KB, AT_X = 2 * AT_KB + 2 * AT_VB;
static_assert(AT_X + 4 * 64 * 32 * 4 <= LDS_BARW, "attention LDS");
__device__ __forceinline__ void attn_phase(const Frame& F, int l, bool do_ctx) {
    const bf16_t* P = (const bf16_t*)(F.ws + WS_P); bf16_t* Y = (bf16_t*)(F.ws + WS_Y);
    const float* ropec = (const float*)(F.ws + WS_ROPE); const float* ropes = ropec + 2048 * 16;
    const int lane = F.lane, w = F.wave, i31 = lane & 31, hh = lane >> 5, qs = w >> 1, comp = w & 1;
    const float lam_init = (l == 0) ? 0.2f : (l == 1) ? 0.35550906759f : (l == 2) ? 0.47071301834f : 0.55605820419f;
    float lam;
    {   const float* q1 = F.P->in[I_LQ1] + l * 32; const float* k1 = F.P->in[I_LK1] + l * 32; const float* q2 = F.P->in[I_LQ2] + l * 32; const float* k2 = F.P->in[I_LK2] + l * 32;
        const float s1 = wave_sum(lane < 32 ? q1[i31] * k1[i31] : 0.f), s2 = wave_sum(lane < 32 ? q2[i31] * k2[i31] : 0.f);
        lam = expf(s1) - expf(s2) + lam_init; }
    const float* subg = F.P->in[I_SUBG] + l * 64;
    const int nlat = 32 * 4 * 16, nitems = nlat + (do_ctx ? 32 * 4 * 2 : 0);
    const float qscale = 0.17677669529663687f * 1.4426950408889634f;
    for (int it = F.bid; it < nitems; it += F.G) {
        const bool isc = it >= nlat; int r_ = isc ? it - nlat : it; const int nqb = isc ? 2 : 16; const int qb = r_ % nqb; r_ /= nqb; const int hd = r_ & 3; const int b = r_ >> 2;
        const int ntiles = isc ? 2 : 18;
        const size_t qtok = isc ? (size_t)TL + (size_t)b * LC + qb * 128 + qs * 32 + i31 : (size_t)b * SEQ + qb * 128 + qs * 32 + i31;
        bf16x8 Bq[2];
        {   const bf16_t* qp = P + qtok * DIN + OFF_B + hd * 64 + comp * 32 + 8 * hh;
            const u32x4 a = *(const u32x4*)qp, c = *(const u32x4*)(qp + 16);
            float x1[8] = {bflo(a.x), bfhi(a.x), bflo(a.y), bfhi(a.y), bflo(a.z), bfhi(a.z), bflo(a.w), bfhi(a.w)};
            float x2[8] = {bflo(c.x), bfhi(c.x), bflo(c.y), bfhi(c.y), bflo(c.z), bfhi(c.z), bflo(c.w), bfhi(c.w)};
            float o1[8], o2[8];
            if (!isc) { const int tpos = qb * 128 + qs * 32 + i31; const float* cp = ropec + tpos * 16 + 8 * hh; const float* sp = ropes + tpos * 16 + 8 * hh;
#pragma unroll
                for (int j = 0; j < 8; ++j) { const float cs = cp[j], sn = sp[j]; o1[j] = (x1[j] * cs - x2[j] * sn) * qscale; o2[j] = (x1[j] * sn + x2[j] * cs) * qscale; } }
            else {
#pragma unroll
                for (int j = 0; j < 8; ++j) { o1[j] = x1[j] * qscale; o2[j] = x2[j] * qscale; } }
            Bq[0] = pk8(o1); Bq[1] = pk8(o2); }
        const int skey = F.tid >> 2, scomp = (F.tid >> 1) & 1, shf = F.tid & 1;
        const int vkp = F.tid & 63, vg = F.tid >> 6;
        u32x4 kr0, kr1, vr0, vr1;
#define AT_LOAD(kt) do { const bool kc_ = isc || (kt) >= 16; const int ktl_ = kc_ ? (isc ? (kt) : (kt) - 16) : (kt); \
            const size_t kb_ = kc_ ? (size_t)TL + (size_t)b * LC + ktl_ * 128 : (size_t)b * SEQ + ktl_ * 128; \
            const bf16_t* kp_ = P + (kb_ + skey) * DIN + OFF_B + 256 + hd * 64 + scomp * 32 + 8 * shf; kr0 = *(const u32x4*)kp_; kr1 = *(const u32x4*)(kp_ + 16); \
            const bf16_t* vp_ = P + (kb_ + 2 * vkp) * DIN + OFF_B + 512 + hd * 64 + 8 * vg; vr0 = *(const u32x4*)vp_; vr1 = *(const u32x4*)(vp_ + DIN); } while (0)
#define AT_STORE(kt, buf) do { const bool kc_ = isc || (kt) >= 16; \
            float x1[8] = {bflo(kr0.x), bfhi(kr0.x), bflo(kr0.y), bfhi(kr0.y), bflo(kr0.z), bfhi(kr0.z), bflo(kr0.w), bfhi(kr0.w)}; \
            float x2[8] = {bflo(kr1.x), bfhi(kr1.x), bflo(kr1.y), bfhi(kr1.y), bflo(kr1.z), bfhi(kr1.z), bflo(kr1.w), bfhi(kr1.w)}; \
            float o1[8], o2[8]; \
            if (!kc_) { const int tpos_ = (kt) * 128 + skey; const float* cp_ = ropec + tpos_ * 16 + 8 * shf; const float* sp_ = ropes + tpos_ * 16 + 8 * shf; \
                _Pragma("unroll") for (int j = 0; j < 8; ++j) { const float cs = cp_[j], sn = sp_[j]; o1[j] = x1[j] * cs - x2[j] * sn; o2[j] = x1[j] * sn + x2[j] * cs; } } \
            else { _Pragma("unroll") for (int j = 0; j < 8; ++j) { o1[j] = x1[j]; o2[j] = x2[j]; } } \
            LAS bf16_t* kd_ = (LAS bf16_t*)(F.lds + AT_K0 + (buf) * AT_KB) + skey * AT_KST + scomp * 32 + 8 * shf; \
            *(LAS bf16x8*)kd_ = pk8(o1); *(LAS bf16x8*)(kd_ + 16) = pk8(o2); \
            LAS bf16_t* vd_ = (LAS bf16_t*)(F.lds + AT_V0 + (buf) * AT_VB) + (8 * vg) * AT_VST + 2 * vkp; \
            const unsigned va_[4] = {vr0.x, vr0.y, vr0.z, vr0.w}, vb_[4] = {vr1.x, vr1.y, vr1.z, vr1.w}; \
            _Pragma("unroll") for (int e = 0; e < 4; ++e) { \
                *(LAS unsigned*)(vd_ + (2 * e) * AT_VST) = (va_[e] & 0xffffu) | (vb_[e] << 16); \
                *(LAS unsigned*)(vd_ + (2 * e + 1) * AT_VST) = (va_[e] >> 16) | (vb_[e] & 0xffff0000u); } } while (0)
        __syncthreads();
        AT_LOAD(0); AT_STORE(0, 0);
        __syncthreads();
        f32x16 O0, O1, negm;
#pragma unroll
        for (int r = 0; r < 16; ++r) { O0[r] = 0.f; O1[r] = 0.f; negm[r] = 0.f; }
        float lsum = 0.f; bool first = true;
        for (int kt = 0; kt < ntiles; ++kt) {
            const int buf = kt & 1;
            if (kt + 1 < ntiles) AT_LOAD(kt + 1);
            const LAS bf16_t* Kl = (const LAS bf16_t*)(F.lds + AT_K0 + buf * AT_KB); const LAS bf16_t* Vl = (const LAS bf16_t*)(F.lds + AT_V0 + buf * AT_VB);
#pragma unroll 1
            for (int st = 0; st < 4; ++st) {
                const bf16x8 Ak0 = *(const LAS bf16x8*)(Kl + (32 * st + i31) * AT_KST + comp * 32 + 8 * hh);
                const bf16x8 Ak1 = *(const LAS bf16x8*)(Kl + (32 * st + i31) * AT_KST + comp * 32 + 16 + 8 * hh);
                f32x16 S = MFMA32(Ak0, Bq[0], negm); S = MFMA32(Ak1, Bq[1], S);
                float mx = fmaxf(fmaxf(S[0], S[1]), S[2]);
                mx = fmaxf(fmaxf(mx, S[3]), S[4]); mx = fmaxf(fmaxf(mx, S[5]), S[6]); mx = fmaxf(fmaxf(mx, S[7]), S[8]); mx = fmaxf(fmaxf(mx, S[9]), S[10]);
                mx = fmaxf(fmaxf(mx, S[11]), S[12]); mx = fmaxf(fmaxf(mx, S[13]), S[14]); mx = fmaxf(mx, S[15]);
                if (first || __any(mx > 8.0f)) {
                    const u32x2 sw = __builtin_amdgcn_permlane32_swap(__float_as_uint(mx), __float_as_uint(mx), false, false);
                    const float mp = fmaxf(__uint_as_float(sw.x), __uint_as_float(sw.y));
                    const float d = first ? mp : fmaxf(mp, 0.f);
                    const float alpha = __builtin_amdgcn_exp2f(-d);
#pragma unroll
                    for (int r = 0; r < 16; ++r) { S[r] -= d; O0[r] *= alpha; O1[r] *= alpha; negm[r] -= d; }
                    lsum *= alpha; first = false;
                }
                float p[16], ps = 0.f;
#pragma unroll
                for (int r = 0; r < 16; ++r) { p[r] = __builtin_amdgcn_exp2f(S[r]); ps += p[r]; }
                lsum += ps;
#pragma unroll
                for (int s = 0; s < 2; ++s) {
                    float pp[8];
#pragma unroll
                    for (int j = 0; j < 8; ++j) pp[j] = p[8 * s + j];
                    const bf16x8 Bp = pk8(pp);
#pragma unroll
                    for (int mt = 0; mt < 2; ++mt) { const LAS bf16_t* vp = Vl + (32 * mt + i31) * AT_VST + 32 * st + 16 * s + 4 * hh;
                        const u32x2 lo = *(const LAS u32x2*)vp, hi = *(const LAS u32x2*)(vp + 8);
                        const u32x4 av = (u32x4){lo.x, lo.y, hi.x, hi.y};
                        if (mt == 0) O0 = MFMA32(__builtin_bit_cast(bf16x8, av), Bp, O0); else O1 = MFMA32(__builtin_bit_cast(bf16x8, av), Bp, O1); }
                }
            }
            if (kt + 1 < ntiles) AT_STORE(kt + 1, buf ^ 1);
            __syncthreads();
        }
#undef AT_LOAD
#undef AT_STORE
        const float ltot = lsum + __shfl_xor(lsum, 32); const float inv = __builtin_amdgcn_rcpf(ltot);
        LAS float* xch = (LAS float*)(F.lds + AT_X) + qs * 2048;
        if (comp == 1) {
#pragma unroll
            for (int r = 0; r < 16; ++r) { const int dv = (r & 3) + 8 * (r >> 2) + 4 * hh; xch[dv * 32 + i31] = O0[r] * inv; xch[(32 + dv) * 32 + i31] = O1[r] * inv; }
        }
        __syncthreads();
        if (comp == 0) {
            float d0[16], d1[16]; float ss = 0.f;
#pragma unroll
            for (int r = 0; r < 16; ++r) { const int dv = (r & 3) + 8 * (r >> 2) + 4 * hh;
                d0[r] = O0[r] * inv - lam * xch[dv * 32 + i31]; d1[r] = O1[r] * inv - lam * xch[(32 + dv) * 32 + i31]; ss += d0[r] * d0[r] + d1[r] * d1[r]; }
            ss += __shfl_xor(ss, 32);
            const float rs = rsqrtf(ss * (1.0f / 64.0f) + EPS) * (1.0f - lam_init);
            bf16_t* yp = Y + qtok * D + 256 + hd * 64;
#pragma unroll
            for (int rg = 0; rg < 4; ++rg) { const int dv = 8 * rg + 4 * hh; const f32x4 g0 = *(const f32x4*)(subg + dv), g1 = *(const f32x4*)(subg + 32 + dv);
                u32x2 o0, o1; o0.x = pk_bf16(d0[4 * rg] * rs * g0[0], d0[4 * rg + 1] * rs * g0[1]); o0.y = pk_bf16(d0[4 * rg + 2] * rs * g0[2], d0[4 * rg + 3] * rs * g0[3]);
                o1.x = pk_bf16(d1[4 * rg] * rs * g1[0], d1[4 * rg + 1] * rs * g1[1]); o1.y = pk_bf16(d1[4 * rg + 2] * rs * g1[2], d1[4 * rg + 3] * rs * g1[3]);
                *(u32x2*)(yp + dv) = o0; *(u32x2*)(yp + 32 + dv) = o1; }
        }
    }
}

constexpr int RT_W = 0;
constexpr int RT_REC = 147456;
constexpr int RT_LP = RT_REC + 304 * 16;
constexpr int RT_CNT = RT_LP + 304 * 8;
static_assert(RT_CNT + 256 <= LDS_BARW, "route LDS");
__device__ __forceinline__ void ffn_route(const Frame& F, int l, int nrows) {
    LAS float* Wt = (LAS float*)(F.lds + RT_W); LAS i32x4* rec = (LAS i32x4*)(F.lds + RT_REC); LAS i32x2* lp = (LAS i32x2*)(F.lds + RT_LP);
    LAS int* lcnt = (LAS int*)(F.lds + RT_CNT); LAS int* lbase = lcnt + 32;
    const float* wrg = F.P->in[I_WRG] + (size_t)l * D * 4; const float* wre = F.P->in[I_WRE] + (size_t)l * D * 32;
    const float* brg = F.P->in[I_BRG] + l * 4; const float* bre = F.P->in[I_BRE] + l * 32;
    __syncthreads();
    for (int i = F.tid; i < 1024 * 4; i += NTHREADS) { const int k = i >> 2, j = i & 3; Wt[j * 1024 + k] = wrg[i]; }
    for (int i = F.tid; i < 1024 * 32; i += NTHREADS) { const int k = i >> 5, j = i & 31; Wt[(4 + j) * 1024 + k] = wre[i]; }
    if (F.tid < 32) lcnt[F.tid] = 0;
    __syncthreads();
    const float* modp = (const float*)(F.ws + WS_MOD) + (size_t)l * 33 * (NMOD * D) + 3 * D;
    const float* gn = F.P->in[I_GFFN] + (size_t)l * D;
    int nrec = 0;
    for (int row = F.bid * 8 + F.wave; row < nrows; row += F.G * 8, ++nrec) {
        const bool isc = row >= TL; const int b = isc ? 32 : (row >> 11);
        const float* xr = isc ? (const float*)(F.ws + WS_XC) + (size_t)(row - TL) * D : F.P->out + (size_t)row * D;
        f32x4 v[4];
#pragma unroll
        for (int i = 0; i < 4; ++i) v[i] = *(const f32x4*)(xr + i * 256 + 4 * F.lane);
        float ss = 0.f;
#pragma unroll
        for (int i = 0; i < 4; ++i) ss += v[i][0] * v[i][0] + v[i][1] * v[i][1] + v[i][2] * v[i][2] + v[i][3] * v[i][3];
        ss = wave_sum(ss);
        const float rstd = rsqrtf(ss * (1.0f / D) + EPS);
        const float* sh = modp + (size_t)b * (NMOD * D); const float* scp = sh + D;
        bf16_t* hrow = (bf16_t*)(F.ws + WS_H) + (size_t)row * D;
#pragma unroll
        for (int i = 0; i < 4; ++i) { const f32x4 g = *(const f32x4*)(gn + i * 256 + 4 * F.lane), s1 = *(const f32x4*)(sh + i * 256 + 4 * F.lane), s2 = *(const f32x4*)(scp + i * 256 + 4 * F.lane);
#pragma unroll
            for (int e = 0; e < 4; ++e) v[i][e] = v[i][e] * rstd * g[e] * (1.0f + s2[e]) + s1[e];
            u32x2 wv; wv.x = pk_bf16(v[i][0], v[i][1]); wv.y = pk_bf16(v[i][2], v[i][3]); *(u32x2*)(hrow + i * 256 + 4 * F.lane) = wv; }
        float lg[4];
#pragma unroll
        for (int j = 0; j < 4; ++j) { float s = 0.f;
#pragma unroll
            for (int i = 0; i < 4; ++i) { const f32x4 wq = *(const LAS f32x4*)(Wt + j * 1024 + i * 256 + 4 * F.lane); s += v[i][0] * wq[0] + v[i][1] * wq[1] + v[i][2] * wq[2] + v[i][3] * wq[3]; }
            lg[j] = wave_sum(s); }
        float g0 = lg[0] + brg[0], g1 = lg[1] + brg[1], g2 = lg[2] + brg[2], g3 = lg[3] + brg[3];
        int gi = 0; float gm = g0; if (g1 > gm) { gm = g1; gi = 1; } if (g2 > gm) { gm = g2; gi = 2; } if (g3 > gm) { gm = g3; gi = 3; }
        const float pgrp = 1.0f / (expf(g0 - gm) + expf(g1 - gm) + expf(g2 - gm) + expf(g3 - gm));
        float le[8];
        {   const LAS float* We = Wt + (4 + 8 * gi) * 1024;
#pragma unroll
            for (int e = 0; e < 8; ++e) { float s = 0.f;
#pragma unroll
                for (int i = 0; i < 4; ++i) { const f32x4 wq = *(const LAS f32x4*)(We + e * 1024 + i * 256 + 4 * F.lane); s += v[i][0] * wq[0] + v[i][1] * wq[1] + v[i][2] * wq[2] + v[i][3] * wq[3]; }
                le[e] = wave_sum(s) + bre[8 * gi + e]; } }
        int e0 = 0; float m0 = le[0];
#pragma unroll
        for (int e = 1; e < 8; ++e) if (le[e] > m0) { m0 = le[e]; e0 = e; }
        int e1 = -1; float m1 = -3.0e38f;
#pragma unroll
        for (int e = 0; e < 8; ++e) if (e != e0 && le[e] > m1) { m1 = le[e]; e1 = e; }
        const float x1 = expf(m1 - m0);
        const float w0 = pgrp / (1.0f + x1), w1 = pgrp * x1 / (1.0f + x1);
        if (F.lane == 0) { const int E0 = gi * 8 + e0, E1 = gi * 8 + e1; const int ri = nrec * 8 + F.wave;
            rec[ri] = (i32x4){E0, E1, __float_as_int(w0), __float_as_int(w1)};
            const int p0 = atomicAdd((int*)&lcnt[E0], 1), p1 = atomicAdd((int*)&lcnt[E1], 1); lp[ri] = (i32x2){p0, p1}; }
    }
    __syncthreads();
    if (F.tid < 32) lbase[F.tid] = (int)__hip_atomic_fetch_add(F.ctl + CW_CNT + l * 32 + F.tid, (unsigned)lcnt[F.tid], __ATOMIC_RELAXED, __HIP_MEMORY_SCOPE_AGENT);
    __syncthreads();
    int* tokof = (int*)(F.ws + WS_TOKOF); float* gateof = (float*)(F.ws + WS_GATEOF); i32x4* tokinf = (i32x4*)(F.ws + WS_TOKINF);
    for (int ri = F.tid; ri < 304; ri += NTHREADS) { const int k = ri >> 3, wv = ri & 7; const int row = F.bid * 8 + wv + k * F.G * 8;
        if (row < nrows) { const i32x4 rc = rec[ri]; const i32x2 q = lp[ri]; const int p0 = lbase[rc.x] + q.x, p1 = lbase[rc.y] + q.y;
            tokof[(size_t)rc.x * TT + p0] = row; gateof[(size_t)rc.x * TT + p0] = __int_as_float(rc.z);
            tokof[(size_t)rc.y * TT + p1] = row; gateof[(size_t)rc.y * TT + p1] = __int_as_float(rc.w);
            tokinf[row] = (i32x4){rc.x, p0, rc.y, p1}; } }
}

constexpr int MO_TS = 131072;
constexpr int MO_TE = MO_TS + 256;
static_assert(MO_TE + 640 <= LDS_BARW, "moe LDS");
namespace pg8 {
struct MoeOrder {
    const LAS int* ts; const LAS unsigned char* te; const unsigned* cnt; const int* tokof; int G, c, nunits; bool gather;
    __device__ __forceinline__ bool next(int i, Unit& u) const {
        const long L = (long)i * G + c; if (L >= nunits) return false;
        u.pn = (int)(L & 3); u.pm = (int)(L >> 2); u.e = te[u.pm]; return true;
    }
    __device__ __forceinline__ unsigned arow(const Unit& u, int r) const {
        if (!gather) return (unsigned)(u.pm * BM + r);
        const int pos = (u.pm - ts[u.e]) * BM + r;
        return pos < (int)cnt[u.e] ? (unsigned)tokof[(size_t)u.e * TT + pos] : 0u;
    }
};
struct EpiSwiGLU {
    static constexpr bool PERM = true;
    bf16_t* H;
    __device__ __forceinline__ void operator()(const f32x4 (&acc)[2][2][4][2], const Unit& u, int wr, int wc, int fr, int fq) const {
        const int row0 = u.pm * BM + wr * 64 + fr, col0 = u.pn * 128 + wc * 32 + 8 * fq;
#pragma unroll
        for (int ai = 0; ai < 2; ++ai)
#pragma unroll
            for (int m = 0; m < 4; ++m) { const f32x4 g0 = acc[ai][0][m][0], g1 = acc[ai][0][m][1], u0 = acc[ai][1][m][0], u1 = acc[ai][1][m][1];
                u32x4 w; w.x = pk_bf16(silu_f(g0[0]) * u0[0], silu_f(g0[1]) * u0[1]); w.y = pk_bf16(silu_f(g0[2]) * u0[2], silu_f(g0[3]) * u0[3]);
                w.z = pk_bf16(silu_f(g1[0]) * u1[0], silu_f(g1[1]) * u1[1]); w.w = pk_bf16(silu_f(g1[2]) * u1[2], silu_f(g1[3]) * u1[3]);
                *(u32x4*)(H + (size_t)(row0 + ai * HALF + m * 16) * DEXP + col0) = w; }
    }
};
struct EpiMoeOut {
    static constexpr bool PERM = true;
    bf16_t* O; const float* gateof; const unsigned* cnt; const LAS int* ts;
    __device__ __forceinline__ void operator()(const f32x4 (&acc)[2][2][4][2], const Unit& u, int wr, int wc, int fr, int fq) const {
        const int r0 = wr * 64 + fr, col0 = u.pn * BM + wc * 32 + 8 * fq; const int pbase = (u.pm - ts[u.e]) * BM; const int ce = (int)cnt[u.e];
#pragma unroll
        for (int ai = 0; ai < 2; ++ai)
#pragma unroll
            for (int m = 0; m < 4; ++m) { const int r = r0 + ai * HALF + m * 16; const int pos = pbase + r;
                const float gt = pos < ce ? gateof[(size_t)u.e * TT + pos] : 0.f;
                bf16_t* rowp = O + (size_t)(u.pm * BM + r) * D + col0;
#pragma unroll
                for (int bj = 0; bj < 2; ++bj) { const f32x4 v0 = acc[ai][bj][m][0] * gt, v1 = acc[ai][bj][m][1] * gt;
                    u32x4 w; w.x = pk_bf16(v0[0], v0[1]); w.y = pk_bf16(v0[2], v0[3]); w.z = pk_bf16(v1[0], v1[1]); w.w = pk_bf16(v1[2], v1[3]);
                    *(u32x4*)(rowp + bj * HALF) = w; } }
    }
};
}
__device__ __forceinline__ int moe_tables(const Frame& F, int l) {
    LAS int* ts = (LAS int*)(F.lds + MO_TS); LAS unsigned char* te = (LAS unsigned char*)(F.lds + MO_TE);
    __syncthreads();
    if (F.tid == 0) { int acc = 0; for (int e = 0; e < 32; ++e) { ts[e] = acc; acc += ((int)F.ctl[CW_CNT + l * 32 + e] + 255) >> 8; } ts[32] = acc; }
    __syncthreads();
    if (F.tid < 32) { for (int t = ts[F.tid]; t < ts[F.tid + 1]; ++t) te[t] = (unsigned char)F.tid; }
    __syncthreads();
    return ts[32];
}

__global__ void __launch_bounds__(NTHREADS, 2) fwd_kernel(Params prm) {
    extern __shared__ __attribute__((aligned(16))) unsigned char lds_raw[];
    Frame F; F.P = (KParams)__builtin_amdgcn_kernarg_segment_ptr(); F.lds = (LAS unsigned char*)lds_raw; F.ws = prm.ws; F.tid = threadIdx.x; F.lane = F.tid & 63; F.wave = __builtin_amdgcn_readfirstlane(F.tid >> 6);
    F.G = gridDim.x; F.bid = blockIdx.x; F.ctl = (unsigned*)(prm.ws + WS_CTL);
    if (F.tid < 4) ((LAS unsigned*)(F.lds + LDS_BARW))[F.tid] = 0u;
    __syncthreads();
    (void)xcd_barrier_post(F.ctl + CW_BAR, (volatile LAS unsigned*)(F.lds + LDS_BARW));
    int phase = 0;
#define OPQ() do { asm volatile("" : "+s"(F.ws)); asm volatile("" : "+s"(F.P)); asm volatile("" : "+s"(F.ctl)); asm volatile("" : "+s"(F.bid)); asm volatile("" : "+s"(F.G)); \
        asm volatile("" : "+v"(F.tid)); F.lane = F.tid & 63; F.wave = __builtin_amdgcn_readfirstlane(F.tid >> 6); } while (0)
#define SEAM() do { OPQ(); XcdBarrier b2_; b2_.bar = F.ctl + CW_BAR; b2_.x = xb_xcc_id(); b2_.st = (volatile LAS unsigned*)(F.lds + LDS_BARW); xcd_barrier(b2_); if (++phase > STOP_AFTER) return; } while (0)

    OPQ(); if (PH(0)) { p0_mods(F); __syncthreads(); p0_rope(F); p0_transposes(F); p0_filters(F); p0_xc(F); }
    SEAM();
    OPQ(); if (PH(0)) p0_gr(F);
    SEAM();
    for (int l = 0; l < DEPTH; ++l) {
        const bool last = (l == DEPTH - 1);
        OPQ(); if (PH(1)) row_norm_phase<0>(F, l, l - 1, l == 0);
        for (int rep_ = 0; rep_ < REPN(2); ++rep_) { OPQ(); if (PH(2)) moe_weight_cvt(F, l); }
        SEAM();
        for (int rep_ = 0; rep_ < REPN(3); ++rep_) { OPQ(); if (PH(3)) {   pg8::Gemm g{(const bf16_t*)(F.ws + WS_H), (const bf16_t*)(F.ws + WS_WINT) + (size_t)l * DIN * D, D, 0};
            pg8::StaticOrder S; S.init(TT, DIN, F.G, F.bid);
            pg8::EpiBf16 E{(bf16_t*)(F.ws + WS_P), DIN};
            pg8::gemm_phase<pg8::EpiBf16, pg8::StaticOrder>(F.lds, g, S, E, F.tid); } }
        SEAM();
        for (int rep_ = 0; rep_ < REPN(4); ++rep_) { OPQ(); if (PH(4)) attn_phase(F, l, !last); }
        for (int rep_ = 0; rep_ < REPN(5); ++rep_) { OPQ(); if (PH(5)) conf_phase(F, l, !last); }
        for (int rep_ = 0; rep_ < REPN(6); ++rep_) { OPQ(); if (PH(6)) hy_pre(F, l, !last); }
        for (int rep_ = 0; rep_ < REPN(7); ++rep_) { OPQ(); if (PH(7)) lru_seq(F, l, !last); }
        SEAM();
        for (int rep_ = 0; rep_ < REPN(8); ++rep_) { OPQ(); if (PH(8)) hy_conv<0>(F, l, !last); }
        for (int rep_ = 0; rep_ < REPN(9); ++rep_) { OPQ(); if (PH(9)) lru_comb(F, !last); }
        SEAM();
        for (int rep_ = 0; rep_ < REPN(10); ++rep_) { OPQ(); if (PH(10)) hy_conv<1>(F, l, !last); }
        for (int rep_ = 0; rep_ < REPN(11); ++rep_) { OPQ(); if (PH(11)) {} }
        SEAM();
        OPQ(); if (PH(12)) {   pg8::Gemm g{(const bf16_t*)(F.ws + WS_Y), (const bf16_t*)(F.ws + WS_WOUTT) + (size_t)l * D * D, D, 0};
            pg8::StaticOrder S; S.init(last ? TL : TT, D, F.G, F.bid);
            pg8::EpiResid E{l == 0 ? F.P->in[I_X] : F.P->out, F.P->out, (float*)(F.ws + WS_XC), (const float*)(F.ws + WS_MOD) + (size_t)l * 33 * (NMOD * D) + 2 * D};
            pg8::gemm_phase<pg8::EpiResid, pg8::StaticOrder>(F.lds, g, S, E, F.tid); }
        SEAM();
        OPQ(); if (PH(13)) ffn_route(F, l, last ? TL : TT);
        SEAM();
        for (int rep_ = 0; rep_ < REPN(14); ++rep_) { OPQ(); if (PH(14)) {   const int ntile = moe_tables(F, l);
            pg8::MoeOrder S{(const LAS int*)(F.lds + MO_TS), (const LAS unsigned char*)(F.lds + MO_TE), F.ctl + CW_CNT + l * 32, (const int*)(F.ws + WS_TOKOF), F.G, F.bid, ntile * 4, true};
            pg8::Gemm g{(const bf16_t*)(F.ws + WS_H), (const bf16_t*)(F.ws + WS_MOEGU), D, (size_t)1024 * 1024 * 2};
            pg8::EpiSwiGLU E{(bf16_t*)(F.ws + WS_HID)};
            pg8::gemm_phase<pg8::EpiSwiGLU, pg8::MoeOrder>(F.lds, g, S, E, F.tid); } }
        SEAM();
        for (int rep_ = 0; rep_ < REPN(15); ++rep_) { OPQ(); if (PH(15)) {   const int ntile = moe_tables(F, l);
            pg8::MoeOrder S{(const LAS int*)(F.lds + MO_TS), (const LAS unsigned char*)(F.lds + MO_TE), F.ctl + CW_CNT + l * 32, (const int*)(F.ws + WS_TOKOF), F.G, F.bid, ntile * 4, false};
            pg8::Gemm g{(const bf16_t*)(F.ws + WS_HID), (const bf16_t*)(F.ws + WS_MOEDN), DEXP, (size_t)1024 * 512 * 2};
            pg8::EpiMoeOut E{(bf16_t*)(F.ws + WS_O), (const float*)(F.ws + WS_GATEOF), F.ctl + CW_CNT + l * 32, (const LAS int*)(F.lds + MO_TS)};
            pg8::gemm_phase<pg8::EpiMoeOut, pg8::MoeOrder>(F.lds, g, S, E, F.tid); } }
        SEAM();
    }
    OPQ(); if (PH(16)) row_norm_phase<2>(F, 0, DEPTH - 1, false);
    if (xb_ld(F.ctl + CW_BAR + XB_TMO) != 0u) {
        __syncthreads();
        for (int row = F.bid * 8 + F.wave; row < TL; row += F.G * 8) { float* xr = F.P->out + (size_t)row * D;
            for (int i = 0; i < 4; ++i) *(f32x4*)(xr + i * 256 + 4 * F.lane) = (f32x4){0.f, 0.f, 0.f, 0.f}; }
    }
}

extern "C" void kernel_launch(void* const* d_in, const int* in_sizes, int n_in, void* d_out, int out_size, void* d_ws, size_t ws_size, hipStream_t stream) {
    static int grid = 0;
    if (!grid) {
        int dev = 0, cus = 0, per_cu = 0;
        hipGetDevice(&dev);
        hipDeviceGetAttribute(&cus, hipDeviceAttributeMultiprocessorCount, dev);
        hipFuncSetAttribute((const void*)fwd_kernel, hipFuncAttributeMaxDynamicSharedMemorySize, LDS_BYTES);
        hipOccupancyMaxActiveBlocksPerMultiprocessor(&per_cu, (const void*)fwd_kernel, NTHREADS, LDS_BYTES);
        if (per_cu < 1) fprintf(stderr, "kernel_launch: occupancy query says %d\n", per_cu);
        grid = cus > 0 ? cus : 256;
        if (ws_size < WS_END) fprintf(stderr, "kernel_launch: workspace too small: %zu < %zu\n", ws_size, (size_t)WS_END);
        if (n_in != 46) fprintf(stderr, "kernel_launch: expected 46 inputs, got %d\n", n_in);
    }
    hipMemsetAsync((char*)d_ws + WS_CTL, 0, CTL_BYTES, stream);
    Params p; memset(&p, 0, sizeof(p));
    for (int i = 0; i < 46 && i < n_in; ++i) p.in[i] = (const float*)d_in[i];
    p.out = (float*)d_out; p.ws = (unsigned char*)d_ws;
    hipLaunchKernelGGL(fwd_kernel, dim3(grid), dim3(NTHREADS), LDS_BYTES, stream, p);
}
```

```cpp
#include <hip/hip_runtime.h>
#include <cstdio>
#include <cstdint>
#include <cstring>

#ifndef PH_MASK
#define PH_MASK 0xffffffffu
#endif
#define PH(k) ((PH_MASK >> (k)) & 1u)
#ifndef REP_MASK
#define REP_MASK 0u
#endif
#define REPN(k) (1 + (int)((REP_MASK >> (k)) & 1u))
#ifndef STOP_AFTER
#define STOP_AFTER 9999
#endif

#define LAS __attribute__((address_space(3)))
#define GAS __attribute__((address_space(1)))
typedef unsigned short bf16_t;
typedef short bf16x8 __attribute__((ext_vector_type(8)));
typedef float f32x4 __attribute__((ext_vector_type(4)));
typedef float f32x16 __attribute__((ext_vector_type(16)));
typedef unsigned u32x4 __attribute__((ext_vector_type(4)));
typedef unsigned u32x2 __attribute__((ext_vector_type(2)));
typedef int i32x4 __attribute__((ext_vector_type(4)));
typedef int i32x2 __attribute__((ext_vector_type(2)));

constexpr int D = 1024, NB = 32, SEQ = 2048, LC = 256, DEPTH = 4;
constexpr int TL = NB * SEQ, TC = NB * LC, TT = TL + TC;
constexpr int DIN = 2560, NMOD = 6;
constexpr int OFF_B = 512, OFF_C = 1280, OFF_D = 1792;
constexpr int NEXP = 32, DEXP = 512;
constexpr int MAXSLOT = 155648;
constexpr float EPS = 1e-6f;
constexpr int NTHREADS = 512;
constexpr int LDS_BYTES = 163840;
constexpr int LDS_BARW = LDS_BYTES - 16;

constexpr size_t MBy = 1ull << 20;
constexpr size_t WS_CTL   = 0;
constexpr size_t CTL_BYTES = 65536;
constexpr size_t WS_MOD   = WS_CTL + CTL_BYTES;
constexpr size_t WS_ROPE  = WS_MOD + 4 * MBy;
constexpr size_t WS_WINT  = WS_ROPE + 1 * MBy;
constexpr size_t WS_WOUTT = WS_WINT + 20 * MBy;
constexpr size_t WS_CPW   = WS_WOUTT + 8 * MBy;
constexpr size_t WS_LRUW  = WS_CPW + 1 * MBy;
constexpr size_t WS_FRAW  = WS_LRUW + 1 * MBy;
constexpr size_t WS_FEN   = WS_FRAW + 36 * MBy;
constexpr size_t WS_GR    = WS_FEN + 1 * MBy;
constexpr size_t WS_GRC   = WS_GR + 16 * MBy;
constexpr size_t WS_XC    = WS_GRC + 2 * MBy;
constexpr size_t WS_H     = WS_XC + 32 * MBy;
constexpr size_t WS_Y     = WS_H + 144 * MBy;
constexpr size_t WS_MOEGU = WS_Y + 144 * MBy;
constexpr size_t WS_MOEDN = WS_MOEGU + 64 * MBy;
constexpr size_t WS_TOKOF = WS_MOEDN + 32 * MBy;
constexpr size_t WS_GATEOF= WS_TOKOF + 9 * MBy;
constexpr size_t WS_TOKINF= WS_GATEOF + 9 * MBy;
constexpr size_t WS_LRUS  = WS_TOKINF + 2 * MBy;
constexpr size_t WS_LRUC  = WS_LRUS + 3 * MBy;
constexpr size_t WS_BIG   = WS_LRUC + 2 * MBy;
constexpr size_t WS_P     = WS_BIG;
constexpr size_t WS_UF    = WS_P + 360 * MBy;
constexpr size_t WS_Z1F   = WS_UF + 108 * MBy;
constexpr size_t WS_HID   = WS_BIG;
constexpr size_t WS_O     = WS_HID + 152 * MBy;
constexpr size_t WS_END   = WS_Z1F + 36 * MBy;
constexpr size_t WS_HT    = WS_H;
constexpr size_t WS_KIMG  = WS_H + 72 * MBy;
constexpr size_t WS_VIMG  = WS_H + 108 * MBy;
static_assert(WS_O + 304 * MBy <= WS_END, "overlay");
static_assert(WS_END <= 1200 * MBy, "workspace budget");

constexpr int CW_BAR = 0;
constexpr int CW_CNT = 4096;
constexpr int CW_Q   = 4096 + 256;

struct Params {
    const GAS float* in[46];
    GAS float* out;
    GAS unsigned char* ws;
};

typedef float f32x2 __attribute__((ext_vector_type(2)));
typedef __bf16 bf16x2v __attribute__((ext_vector_type(2)));
__device__ __forceinline__ unsigned pk_bf16(float lo, float hi) { const f32x2 v = {lo, hi}; const bf16x2v r = __builtin_convertvector(v, bf16x2v); return __builtin_bit_cast(unsigned, r); }
__device__ __forceinline__ bf16x8 pk8(const float (&v)[8]) { u32x4 w; w.x = pk_bf16(v[0], v[1]); w.y = pk_bf16(v[2], v[3]); w.z = pk_bf16(v[4], v[5]); w.w = pk_bf16(v[6], v[7]); return __builtin_bit_cast(bf16x8, w); }
#define MFMA32(a, b, c) __builtin_amdgcn_mfma_f32_32x32x16_bf16((a), (b), (c), 0, 0, 0)
#define MFMA16(a, b, c) __builtin_amdgcn_mfma_f32_16x16x32_bf16((a), (b), (c), 0, 0, 0)
__device__ __forceinline__ float bf2f(bf16_t v) { return __uint_as_float(((unsigned)v) << 16); }
__device__ __forceinline__ float bflo(unsigned w) { return __uint_as_float(w << 16); }
__device__ __forceinline__ float bfhi(unsigned w) { return __uint_as_float(w & 0xffff0000u); }
__device__ __forceinline__ float silu_f(float v) { return v * __builtin_amdgcn_rcpf(1.0f + __expf(-v)); }
__device__ __forceinline__ float sigmoid_f(float v) { return __builtin_amdgcn_rcpf(1.0f + __expf(-v)); }
__device__ __forceinline__ float gelu_tanh_f(float v) { const float u = 0.7978845608028654f * (v + 0.044715f * v * v * v); const float t = 1.0f - 2.0f * __builtin_amdgcn_rcpf(1.0f + __expf(2.0f * u)); return 0.5f * v * (1.0f + t); }
__device__ __forceinline__ float wave_sum(float v) {
#pragma unroll
    for (int o = 32; o > 0; o >>= 1) v += __shfl_xor(v, o);
    return v;
}

#define XB_TMO      128
#define XB_XCNT(j)  (256  + 64 * (j))
#define XB_XSUB(j)  (1280 + 64 * (j))
#define XB_XGEN(j)  (2304 + 64 * (j))
#define XB_TOP      3328
#define XB_TOPGEN   3392
#define XCD_BAR_WORDS 3456
#define XB_SPIN_CAP (1u << 18)
__device__ __forceinline__ unsigned xb_ld(unsigned* p)              { return __hip_atomic_load(p, __ATOMIC_RELAXED, __HIP_MEMORY_SCOPE_AGENT); }
__device__ __forceinline__ unsigned xb_add(unsigned* p, unsigned v) { return __hip_atomic_fetch_add(p, v, __ATOMIC_RELAXED, __HIP_MEMORY_SCOPE_AGENT); }
__device__ __forceinline__ unsigned xb_xcc_id() { return (unsigned)__builtin_amdgcn_s_getreg((3 << 11) | 20) & 0xFu; }
#define XB_SPIN(cond, bar) do { unsigned _sp = 0; while (cond) { __builtin_amdgcn_s_sleep(1); \
    if ((++_sp & 255u) == 0u) { if (xb_ld(&(bar)[XB_TMO])) break; if (_sp > XB_SPIN_CAP) { atomicAdd(&(bar)[XB_TMO], 1u); break; } } } } while (0)
struct XcdBarrier { unsigned* bar; unsigned x; volatile LAS unsigned* st; };
__device__ __forceinline__ XcdBarrier xcd_barrier_post(unsigned* bar, volatile LAS unsigned* st) {
    XcdBarrier b; b.bar = bar; b.x = xb_xcc_id(); b.st = st;
    if (threadIdx.x == 0) (void)xb_add(&bar[XB_XCNT(b.x)], 1u);
    return b;
}
__device__ __forceinline__ void xcd_barrier_complete(unsigned* bar, unsigned x, unsigned& nloc, unsigned& nx) {
    const unsigned G = gridDim.x * gridDim.y * gridDim.z;
    unsigned sum, cnt, mine, sp = 0u;
    for (;;) {
        sum = 0u; cnt = 0u; mine = 0u;
#pragma unroll
        for (unsigned j = 0; j < 16; ++j) { const unsigned c = xb_ld(&bar[XB_XCNT(j)]); sum += c; cnt += (c > 0u) ? 1u : 0u; mine = (j == x) ? c : mine; }
        if (sum == G) break;
        __builtin_amdgcn_s_sleep(1);
        if ((++sp & 255u) == 0u) { if (xb_ld(&bar[XB_TMO])) break; if (sp > XB_SPIN_CAP) { atomicAdd(&bar[XB_TMO], 1u); break; } }
    }
    nloc = mine > 0u ? mine : 1u; nx = cnt > 0u ? cnt : 1u;
}
__device__ __forceinline__ void xcd_barrier(const XcdBarrier& b) {
    asm volatile("s_waitcnt vmcnt(0)" ::: "memory");
    __syncthreads();
    if (threadIdx.x == 0) {
        unsigned* bar = b.bar;
        __builtin_amdgcn_s_waitcnt(0);
        unsigned nloc = b.st[0], nx = b.st[1];
        if (nloc == 0u) { xcd_barrier_complete(bar, b.x, nloc, nx); b.st[0] = nloc; b.st[1] = nx; }
        const unsigned old = xb_add(&bar[XB_XSUB(b.x)], 1u);
        const unsigned gen = old / nloc;
        if (old + 1u == (gen + 1u) * nloc) {
            __builtin_amdgcn_fence(__ATOMIC_RELEASE, "agent");
            asm volatile("s_waitcnt vmcnt(0)" ::: "memory");
            const unsigned og = xb_add(&bar[XB_TOP], 1u);
            const unsigned tg = og / nx;
            if (og + 1u == (tg + 1u) * nx) xb_add(&bar[XB_TOPGEN], 1u);
            else XB_SPIN(xb_ld(&bar[XB_TOPGEN]) == tg, bar);
            __builtin_amdgcn_fence(__ATOMIC_ACQUIRE, "agent");
            xb_add(&bar[XB_XGEN(b.x)], 1u);
            asm volatile("s_waitcnt vmcnt(0)" ::: "memory");
        } else {
            XB_SPIN(xb_ld(&bar[XB_XGEN(b.x)]) == gen, bar);
            __builtin_amdgcn_fence(__ATOMIC_ACQUIRE, "agent");
            asm volatile("s_waitcnt vmcnt(0)" ::: "memory");
        }
    }
    __syncthreads();
}

namespace pg8 {
constexpr int BM = 256, BK = 64, HALF = 128, HTB = HALF * BK * 2, STAGE_BYTES = 8 * HTB, NXCD = 8, WGM = 8;
__host__ __device__ __forceinline__ int lds_byte(int r, int c) { const int st = (r >> 4) * 2 + (c >> 5), rr = r & 15, cc = c & 31, ob = rr * 64 + cc * 2; return st * 1024 + (ob ^ (((ob >> 9) & 1) << 5)); }
__host__ __device__ __forceinline__ void stage_rc(int b, int& R, int& C) { const int st = b / 1024, sb = b % 1024, swz = sb ^ (((sb >> 9) & 1) << 5); R = (st >> 1) * 16 + swz / 64; C = (st & 1) * 32 + (swz % 64) / 2; }
__host__ __device__ __forceinline__ int perm32(int rho) { const int n = rho >> 4, i = rho & 15; return 8 * (i >> 2) + 4 * n + (i & 3); }

struct Unit { int pm, pn, e; };
struct Gemm { const bf16_t* A; const bf16_t* Bt; int K; size_t bstride; };

struct StaticOrder {
    static constexpr bool PREFETCH = false;
    int nM, nN, nwg, G, c;
    __device__ void init(int M, int N, int G_, int c_) { nM = M / BM; nN = N / BM; nwg = nM * nN; G = G_; c = c_; }
    __device__ __forceinline__ bool next(int i, Unit& u) const {
        const long L = (long)i * G + c; if (L >= nwg) return false;
        int wgid = (int)L; { const int q = nwg / NXCD, r = nwg % NXCD, xcd = wgid % NXCD, off = wgid / NXCD; wgid = (xcd < r ? xcd * (q + 1) : r * (q + 1) + (xcd - r) * q) + off; }
        const int nig = WGM * nN, gid = wgid / nig, fm = gid * WGM, gsz = (nM - fm) < WGM ? (nM - fm) : WGM;
        u.pm = fm + ((wgid % nig) % gsz); u.pn = (wgid % nig) / gsz; u.e = 0; return true;
    }
    __device__ __forceinline__ unsigned arow(const Unit& u, int r) const { return (unsigned)(u.pm * BM + r); }
};

template <class Epi, class Sched>
__device__ __forceinline__ void gemm_phase(LAS unsigned char* lds, const Gemm g, const Sched& S, const Epi& E, const int tid_in) {
    const int tid = tid_in, wid = __builtin_amdgcn_readfirstlane(tid >> 6), lane = tid & 63, wr = wid >> 2, wc = wid & 3, fr = lane & 15, fq = lane >> 4;
    const int K = g.K, nt = K / BK;
    unsigned voffB[2];
#pragma unroll
    for (int i = 0; i < 2; ++i) { int R, C; stage_rc(tid * 16 + i * 8192, R, C); const int Rb = Epi::PERM ? ((R & ~31) + perm32(R & 31)) : R;
        voffB[i] = (unsigned)(Rb * K + C) * 2u; }
    const size_t kstep = (size_t)(BK * 2);
    const size_t hstep = (size_t)HALF * K * 2;
    const size_t tstep = 2 * hstep;
    const unsigned rowb = (unsigned)K * 2u;
    const unsigned ldsw = (unsigned)wid * 1024u;
    const int aoff = lds_byte(wr * 64 + fr, fq * 8), boff = lds_byte(wc * 32 + fr, fq * 8);
#define PG8_SA(b, h) (((b) * 2 + (h)) * HTB)
#define PG8_SB(b, h) ((4 + (b) * 2 + (h)) * HTB)
#define PG8_STAGE(bufoff, gbase, voff) do { _Pragma("unroll") for (int _i = 0; _i < 2; ++_i) \
        __builtin_amdgcn_global_load_lds((const unsigned*)((const char*)(gbase) + (voff)[_i]), (LAS unsigned*)(lds + (bufoff) + ldsw + _i * 8192), 16, 0, 0); } while (0)
#define PG8_LDA(dst, b, h) do { _Pragma("unroll") for (int m = 0; m < 4; ++m) _Pragma("unroll") for (int k = 0; k < 2; ++k) dst[m][k] = *(const LAS bf16x8*)(lds + PG8_SA(b, h) + aoff + m * 2048 + k * 1024); } while (0)
#define PG8_LDB(dst, b, h) do { _Pragma("unroll") for (int n = 0; n < 2; ++n) _Pragma("unroll") for (int k = 0; k < 2; ++k) dst[n][k] = *(const LAS bf16x8*)(lds + PG8_SB(b, h) + boff + n * 2048 + k * 1024); } while (0)
#define PG8_MMA(ai, bj, At, Bt) do { __builtin_amdgcn_s_setprio(1); _Pragma("unroll") for (int m = 0; m < 4; ++m) _Pragma("unroll") for (int n = 0; n < 2; ++n) _Pragma("unroll") for (int k = 0; k < 2; ++k) \
        acc[ai][bj][m][n] = __builtin_amdgcn_mfma_f32_16x16x32_bf16(Bt[n][k], At[m][k], acc[ai][bj][m][n], 0, 0, 0); __builtin_amdgcn_s_setprio(0); } while (0)
#define PG8_WAIT_V(n) asm volatile("s_waitcnt vmcnt(" #n ")" ::: "memory")
#define PG8_WAIT_L(n) asm volatile("s_waitcnt lgkmcnt(" #n ")" ::: "memory")
#define PG8_BAR __builtin_amdgcn_s_barrier()
#define PG8_SCHED __builtin_amdgcn_sched_barrier(0)
    Unit cur, nxt; int ui = 0;
    if (!S.next(0, cur)) return;
    f32x4 acc[2][2][4][2];
#pragma unroll
    for (int a = 0; a < 2; ++a)
#pragma unroll
        for (int b = 0; b < 2; ++b)
#pragma unroll
            for (int m = 0; m < 4; ++m)
#pragma unroll
                for (int n = 0; n < 2; ++n) acc[a][b][m][n] = (f32x4){0.f, 0.f, 0.f, 0.f};
    bf16x8 At[4][2], B0[2][2], B1[2][2];
    unsigned ca0[2], ca1[2], na0[2], na1[2];
#define PG8_AROWS(u, o0, o1) do { int _tz = tid_in; asm volatile("" : "+v"(_tz)); _Pragma("unroll") for (int _i = 0; _i < 2; ++_i) { int _R, _C; stage_rc(_tz * 16 + _i * 8192, _R, _C); \
        o0[_i] = S.arow(u, _R) * rowb + (unsigned)_C * 2u; o1[_i] = S.arow(u, HALF + _R) * rowb + (unsigned)_C * 2u; } } while (0)
    PG8_AROWS(cur, ca0, ca1);
    const char* Ab = (const char*)g.A;
    const char* cB = (const char*)g.Bt + (size_t)cur.e * g.bstride + (size_t)cur.pn * tstep;
    PG8_STAGE(PG8_SB(0, 0), cB, voffB); PG8_STAGE(PG8_SA(0, 0), Ab, ca0); PG8_STAGE(PG8_SB(0, 1), cB + hstep, voffB); PG8_STAGE(PG8_SA(0, 1), Ab, ca1);
    if (wr == 1) PG8_BAR;
    PG8_WAIT_V(4); PG8_BAR;
    PG8_STAGE(PG8_SB(1, 0), cB + kstep, voffB); PG8_STAGE(PG8_SA(1, 0), Ab + kstep, ca0); PG8_STAGE(PG8_SB(1, 1), cB + hstep + kstep, voffB);
    PG8_WAIT_V(6); PG8_BAR;
    for (;;) {
        const bool has_next = S.next(ui + 1, nxt);
        const char* nB = has_next ? (const char*)g.Bt + (size_t)nxt.e * g.bstride + (size_t)nxt.pn * tstep : cB;
        if (Sched::PREFETCH && has_next) PG8_AROWS(nxt, na0, na1);
        for (int t = 0; t < nt; t += 2) {
            const bool last = (t == nt - 2);
            const char* a1 = Ab + (size_t)(t + 1) * kstep;
            const char* a2 = last ? Ab : Ab + (size_t)(t + 2) * kstep; const char* b2 = last ? nB : cB + (size_t)(t + 2) * kstep;
            const char* a3 = a2 + kstep; const char* b3 = b2 + kstep;
            PG8_LDB(B0, 0, 0); PG8_SCHED; PG8_LDA(At, 0, 0); PG8_STAGE(PG8_SA(1, 1), a1, ca1);
            if (last && has_next) { if (Sched::PREFETCH) { ca0[0] = na0[0]; ca0[1] = na0[1]; ca1[0] = na1[0]; ca1[1] = na1[1]; } else PG8_AROWS(nxt, ca0, ca1); }
            PG8_WAIT_L(8); PG8_BAR; PG8_WAIT_L(0); PG8_MMA(0, 0, At, B0); PG8_BAR; PG8_SCHED;
            PG8_LDB(B1, 0, 1); PG8_STAGE(PG8_SB(0, 0), b2, voffB);
            PG8_BAR; PG8_WAIT_L(0); PG8_MMA(0, 1, At, B1); PG8_BAR;
            PG8_LDA(At, 0, 1); PG8_STAGE(PG8_SA(0, 0), a2, ca0);
            PG8_BAR; PG8_WAIT_L(0); PG8_MMA(1, 0, At, B0); PG8_BAR; PG8_SCHED;
            PG8_STAGE(PG8_SB(0, 1), b2 + hstep, voffB);
            PG8_WAIT_V(6); PG8_BAR; PG8_MMA(1, 1, At, B1); PG8_BAR;
            PG8_LDB(B0, 1, 0); PG8_SCHED; PG8_LDA(At, 1, 0); PG8_STAGE(PG8_SA(0, 1), a2, ca1);
            PG8_WAIT_L(8); PG8_BAR; PG8_WAIT_L(0); PG8_MMA(0, 0, At, B0); PG8_BAR; PG8_SCHED;
            PG8_LDB(B1, 1, 1); PG8_STAGE(PG8_SB(1, 0), b3, voffB);
            PG8_BAR; PG8_WAIT_L(0); PG8_MMA(0, 1, At, B1); PG8_BAR;
            PG8_LDA(At, 1, 1); PG8_STAGE(PG8_SA(1, 0), a3, ca0);
            PG8_BAR; PG8_WAIT_L(0); PG8_MMA(1, 0, At, B0); PG8_BAR; PG8_SCHED;
            PG8_STAGE(PG8_SB(1, 1), b3 + hstep, voffB);
            PG8_WAIT_V(6); PG8_BAR; PG8_MMA(1, 1, At, B1); PG8_BAR;
        }
        E(acc, cur, wr, wc, fr, fq);
        if (!has_next) break;
#pragma unroll
        for (int a = 0; a < 2; ++a)
#pragma unroll
            for (int b = 0; b < 2; ++b)
#pragma unroll
                for (int m = 0; m < 4; ++m)
#pragma unroll
                    for (int n = 0; n < 2; ++n) acc[a][b][m][n] = (f32x4){0.f, 0.f, 0.f, 0.f};
        cur = nxt; cB = nB; ++ui;
    }
    PG8_WAIT_V(0);
    if (wr == 0) PG8_BAR;
    PG8_BAR;
#undef PG8_AROWS
#undef PG8_SA
#undef PG8_SB
#undef PG8_STAGE
#undef PG8_LDA
#undef PG8_LDB
#undef PG8_MMA
#undef PG8_WAIT_V
#undef PG8_WAIT_L
#undef PG8_BAR
#undef PG8_SCHED
}

struct EpiBf16 {
    static constexpr bool PERM = true;
    bf16_t* O; int ldc;
    __device__ __forceinline__ void operator()(const f32x4 (&acc)[2][2][4][2], const Unit& u, int wr, int wc, int fr, int fq) const {
        const int row0 = u.pm * BM + wr * 64 + fr, col0 = u.pn * BM + wc * 32 + 8 * fq;
#pragma unroll
        for (int ai = 0; ai < 2; ++ai)
#pragma unroll
            for (int m = 0; m < 4; ++m) { bf16_t* rowp = O + (size_t)(row0 + ai * HALF + m * 16) * ldc + col0;
#pragma unroll
                for (int bj = 0; bj < 2; ++bj) { const f32x4 v0 = acc[ai][bj][m][0], v1 = acc[ai][bj][m][1];
                    u32x4 w; w.x = pk_bf16(v0[0], v0[1]); w.y = pk_bf16(v0[2], v0[3]); w.z = pk_bf16(v1[0], v1[1]); w.w = pk_bf16(v1[2], v1[3]);
                    *(u32x4*)(rowp + bj * HALF) = w; } }
    }
};
struct EpiResid {
    static constexpr bool PERM = false;
    const float* xl_in; float* xl_out; float* xc; const float* mod2;
    __device__ __forceinline__ void operator()(const f32x4 (&acc)[2][2][4][2], const Unit& u, int wr, int wc, int fr, int fq) const {
        const int rowt = u.pm * BM; const bool isc = rowt >= TL;
        const float* xi = isc ? xc + (size_t)(rowt - TL) * D : xl_in + (size_t)rowt * D;
        float* xo = isc ? xc + (size_t)(rowt - TL) * D : xl_out + (size_t)rowt * D;
        const float* gv = mod2 + (size_t)(isc ? 32 : (rowt >> 11)) * (NMOD * D);
        const int r0 = wr * 64 + fr, col0 = u.pn * BM + wc * 32 + 4 * fq;
        f32x4 g4[2][2];
#pragma unroll
        for (int bj = 0; bj < 2; ++bj)
#pragma unroll
            for (int n = 0; n < 2; ++n) g4[bj][n] = *(const f32x4*)(gv + col0 + bj * HALF + n * 16);
#pragma unroll
        for (int ai = 0; ai < 2; ++ai)
#pragma unroll
            for (int m = 0; m < 4; ++m) { const size_t ro = (size_t)(r0 + ai * HALF + m * 16) * D + col0;
#pragma unroll
                for (int bj = 0; bj < 2; ++bj)
#pragma unroll
                    for (int n = 0; n < 2; ++n) { const f32x4 xv = *(const f32x4*)(xi + ro + bj * HALF + n * 16);
                        *(f32x4*)(xo + ro + bj * HALF + n * 16) = xv + g4[bj][n] * acc[ai][bj][m][n]; } }
    }
};
}

typedef const Params __attribute__((address_space(4)))* KParams;
struct Frame {
    KParams P; LAS unsigned char* lds; GAS unsigned char* wsg;
    __device__ __forceinline__ unsigned char* ws_() const { return (unsigned char*)wsg; }
    __device__ __forceinline__ const float* in(int k) const { return (const float*)P->in[k]; }
    __device__ __forceinline__ float* out() const { return (float*)P->out; } int tid, lane, wave, G, bid;
    unsigned* ctl;
};

__device__ __forceinline__ void tr_tile(const Frame& F, const float* src, int ld, int k0, int n0, bf16_t* dst, int ldd, int drow0) {
    LAS float* tile = (LAS float*)F.lds;
    const int r = F.tid >> 4, c4 = F.tid & 15;
#pragma unroll
    for (int i = 0; i < 2; ++i) { const f32x4 v = *(const f32x4*)(src + (size_t)(k0 + r + 32 * i) * ld + n0 + 4 * c4);
#pragma unroll
        for (int e = 0; e < 4; ++e) tile[(r + 32 * i) * 65 + 4 * c4 + e] = v[e]; }
    __syncthreads();
    const int n = F.tid >> 3, kq = F.tid & 7;
    float v[8];
#pragma unroll
    for (int j = 0; j < 8; ++j) v[j] = tile[(8 * kq + j) * 65 + n];
    u32x4 w; w.x = pk_bf16(v[0], v[1]); w.y = pk_bf16(v[2], v[3]); w.z = pk_bf16(v[4], v[5]); w.w = pk_bf16(v[6], v[7]);
    *(u32x4*)(dst + (size_t)(drow0 + n) * ldd + k0 + 8 * kq) = w;
    __syncthreads();
}

enum { I_X = 0, I_C, I_CTX, I_CCTX, I_WADA, I_BADA, I_GMIX, I_GFFN, I_WIN, I_WOUT, I_ACW, I_ACB, I_AWR, I_ABR, I_AWI, I_ABI, I_ALAM,
       I_LQ1, I_LK1, I_LQ2, I_LK2, I_SUBG, I_CCW, I_CCB, I_CLG, I_CLB, I_CWPW, I_CBPW, I_DCW, I_DCB, I_DWF1, I_DBF1, I_DFREQ, I_DWF2, I_DBF2, I_DWF3,
       I_DDECAY, I_DBIAS, I_WRG, I_BRG, I_WRE, I_BRE, I_WGATE, I_WUP, I_WDOWN, I_GFINAL };

__device__ __forceinline__ void p0_mods(const Frame& F) {
    LAS float* sS = (LAS float*)F.lds;
    LAS float* red = sS + 33 * 512;
    static_assert((33 * 512 + 8 * 33 * 64) * 4 <= LDS_BARW, "p0_mods LDS");
    const float* c = F.in(I_C); const float* cc = F.in(I_CCTX);
    for (int it = F.bid; it < 384; it += F.G) {
        const int l = it / 96, col0 = (it % 96) * 64;
        const float* W = F.in(I_WADA) + (size_t)l * D * (NMOD * D);
        const int cq = F.tid & 31, ks = F.tid >> 5;
        float acc[33][2];
#pragma unroll
        for (int b = 0; b < 33; ++b) { acc[b][0] = 0.f; acc[b][1] = 0.f; }
        for (int kh = 0; kh < 2; ++kh) {
            __syncthreads();
            for (int i = F.tid; i < 33 * 512; i += NTHREADS) { const int b = i >> 9, k = kh * 512 + (i & 511); const float v = (b < 32) ? c[b * 1024 + k] : cc[k]; sS[i] = silu_f(v); }
            __syncthreads();
            for (int kk = 0; kk < 32; ++kk) {
                const int kl = ks * 32 + kk, k = kh * 512 + kl;
                const float w0 = W[(size_t)k * (NMOD * D) + col0 + 2 * cq], w1 = W[(size_t)k * (NMOD * D) + col0 + 2 * cq + 1];
#pragma unroll
                for (int b = 0; b < 33; ++b) { const float s = sS[b * 512 + kl]; acc[b][0] += s * w0; acc[b][1] += s * w1; }
            }
        }
#pragma unroll
        for (int b = 0; b < 33; ++b) { acc[b][0] += __shfl_xor(acc[b][0], 32); acc[b][1] += __shfl_xor(acc[b][1], 32); }
        if (F.lane < 32) {
#pragma unroll
            for (int b = 0; b < 33; ++b) { red[(F.wave * 33 + b) * 64 + 2 * cq] = acc[b][0]; red[(F.wave * 33 + b) * 64 + 2 * cq + 1] = acc[b][1]; }
        }
        __syncthreads();
        float* mod = (float*)(F.ws_() + WS_MOD) + (size_t)l * 33 * (NMOD * D);
        const float* bada = F.in(I_BADA) + (size_t)l * (NMOD * D);
        for (int o = F.tid; o < 33 * 64; o += NTHREADS) { const int b = o >> 6, cl = o & 63; float s = 0.f;
#pragma unroll
            for (int w = 0; w < 8; ++w) s += red[(w * 33 + b) * 64 + cl];
            mod[(size_t)b * (NMOD * D) + col0 + cl] = s + bada[col0 + cl]; }
        __syncthreads();
    }
}

__device__ __forceinline__ void p0_rope(const Frame& F) {
    float* ct = (float*)(F.ws_() + WS_ROPE); float* st = ct + 2048 * 16;
    for (int i = F.bid * NTHREADS + F.tid; i < 2048 * 16; i += F.G * NTHREADS) {
        const int t = i >> 4, f = i & 15; const float inv = powf(10000.0f, -(float)(f & 7) / 8.0f);
        const float pos = (f < 8) ? (float)(t >> 6) : (float)(t & 63); const float a = pos * inv;
        ct[i] = cosf(a); st[i] = sinf(a);
    }
}

__device__ __forceinline__ void p0_transposes(const Frame& F) {
    constexpr int N1 = 2560, N2 = N1 + 1024, N3 = N2 + 64, N4 = N3 + 128;
    for (int it = F.bid; it < N4; it += F.G) {
        if (it < N1) { const int l = it / 640, r = it % 640, kt = r / 40, nt = r % 40;
            tr_tile(F, F.in(I_WIN) + (size_t)l * D * DIN, DIN, kt * 64, nt * 64, (bf16_t*)(F.ws_() + WS_WINT) + (size_t)l * DIN * D, D, nt * 64); }
        else if (it < N2) { const int j = it - N1, l = j / 256, r = j % 256, kt = r / 16, nt = r % 16;
            tr_tile(F, F.in(I_WOUT) + (size_t)l * D * D, D, kt * 64, nt * 64, (bf16_t*)(F.ws_() + WS_WOUTT) + (size_t)l * D * D, D, nt * 64); }
        else if (it < N3) { const int j = it - N2, l = j / 16, r = j % 16, kt = r / 4, nt = r % 4;
            tr_tile(F, F.in(I_CWPW) + (size_t)l * 256 * 256, 256, kt * 64, nt * 64, (bf16_t*)(F.ws_() + WS_CPW) + (size_t)l * 256 * 256, 256, nt * 64); }
        else { const int j = it - N3, gate = j / 64, m = j % 64;
            const int l = m / 8, dir = (m / 4) & 1, hd = m & 3;
            const float* src = F.in(gate ? I_AWI : I_AWR) + (size_t)m * 4096;
            bf16_t* dst = (bf16_t*)(F.ws_() + WS_LRUW) + ((size_t)((l * 2 + dir) * 2 + gate) * 4 + hd) * 4096;
            tr_tile(F, src, 64, 0, 0, dst, 64, 0); }
    }
}

__device__ __forceinline__ void p0_filters(const Frame& F) {
    LAS float* feats = (LAS float*)F.lds;
    LAS float* f1 = feats + 64 * 33;
    LAS float* f2 = f1 + 64 * 64;
    LAS float* tun = f2 + 64 * 64;
    for (int it = F.bid; it < 4 * 36; it += F.G) {
        const int l = it / 36, ch = it % 36; const bool isc = ch >= 32; const int Lf = isc ? LC : SEQ; const int t0 = isc ? (ch - 32) * 64 : ch * 64;
        const float* wf1 = F.in(I_DWF1) + (size_t)l * 33 * 64; const float* bf1 = F.in(I_DBF1) + l * 64; const float* frq = F.in(I_DFREQ) + l * 64;
        const float* wf2 = F.in(I_DWF2) + (size_t)l * 64 * 64; const float* bf2 = F.in(I_DBF2) + l * 64;
        const float* wf3 = F.in(I_DWF3) + (size_t)l * 64 * 1024; const float* dec = F.in(I_DDECAY) + l * 1024;
        for (int i = F.tid; i < 64 * 33; i += NTHREADS) { const int p = i / 33, f = i % 33; const float t = (float)(t0 + p);
            float v;
            if (f == 0) v = t / (float)(Lf - 1);
            else { const int bi = (f - 1) & 15; const float band = 1e-4f + (float)bi * ((15.0f - 1e-4f) / 15.0f);
                   const float ang = (6.283185307179586f / (float)Lf) * t * band; v = (f <= 16) ? cosf(ang) : -sinf(ang); }
            feats[i] = v; if (f == 0) tun[p] = v; }
        __syncthreads();
        for (int i = F.tid; i < 64 * 64; i += NTHREADS) { const int p = i >> 6, j = i & 63; float s = bf1[j];
            for (int f = 0; f < 33; ++f) s += feats[p * 33 + f] * wf1[f * 64 + j];
            f1[i] = sinf(frq[j] * s); }
        __syncthreads();
        for (int i = F.tid; i < 64 * 64; i += NTHREADS) { const int p = i >> 6, j = i & 63; float s = bf2[j];
            for (int f = 0; f < 64; ++f) s += f1[p * 64 + f] * wf2[f * 64 + j];
            f2[i] = sinf(frq[j] * s); }
        __syncthreads();
        {   const int c4 = (F.tid & 255) * 4, pg = F.tid >> 8;
            const f32x4 dc = *(const f32x4*)(dec + c4);
            float* raw = (float*)(F.ws_() + WS_FRAW) + ((size_t)l * 2304 + (isc ? 2048 : 0) + t0) * 1024;
            const bool bwd = ((c4 >> 8) & 1) != 0;
            float es[4] = {0.f, 0.f, 0.f, 0.f};
#pragma unroll 1
            for (int ps = 0; ps < 2; ++ps) {
                float acc[16][4];
#pragma unroll
                for (int p = 0; p < 16; ++p) { acc[p][0] = 0.f; acc[p][1] = 0.f; acc[p][2] = 0.f; acc[p][3] = 0.f; }
#pragma unroll 2
                for (int k = 0; k < 64; ++k) { const f32x4 w = *(const f32x4*)(wf3 + (size_t)k * 1024 + c4);
#pragma unroll
                    for (int p = 0; p < 16; ++p) { const float a = f2[(pg * 32 + ps * 16 + p) * 64 + k]; acc[p][0] += a * w[0]; acc[p][1] += a * w[1]; acc[p][2] += a * w[2]; acc[p][3] += a * w[3]; } }
#pragma unroll
                for (int p = 0; p < 16; ++p) { const int pp = pg * 32 + ps * 16 + p; const float tu = tun[pp]; f32x4 h;
#pragma unroll
                    for (int e = 0; e < 4; ++e) { h[e] = acc[p][e] * expf(-tu * fabsf(dc[e])); if (!(bwd && (t0 + pp) == 0)) es[e] += h[e] * h[e]; }
                    *(f32x4*)(raw + (size_t)pp * 1024 + c4) = h; }
            }
            __syncthreads();
            LAS float* er = (LAS float*)F.lds;
#pragma unroll
            for (int e = 0; e < 4; ++e) er[pg * 1024 + c4 + e] = es[e];
            __syncthreads();
            float* fen = (float*)(F.ws_() + WS_FEN) + ((size_t)l * 36 + ch) * 1024;
            for (int i = F.tid; i < 1024; i += NTHREADS) fen[i] = er[i] + er[1024 + i];
            __syncthreads();
        }
    }
}

__device__ __forceinline__ void p0_xc(const Frame& F) {
    const f32x4* s = (const f32x4*)F.in(I_CTX); f32x4* d = (f32x4*)(F.ws_() + WS_XC);
    for (size_t i = (size_t)F.bid * NTHREADS + F.tid; i < (size_t)TC * D / 4; i += (size_t)F.G * NTHREADS) d[i] = s[i];
}

__device__ __forceinline__ void p0_gr(const Frame& F) {
    LAS float* tile = (LAS float*)F.lds;
    for (int it = F.bid; it < 4 * 2 * 2 * 4 * 36; it += F.G) {
        int r = it; const int ch = r % 36; r /= 36; const int cg = r % 4; r /= 4; const int d = r % 2; r /= 2; const int o = r % 2; r /= 2; const int l = r;
        const bool isc = ch >= 32; const int Lf = isc ? LC : SEQ; const int t0 = isc ? (ch - 32) * 64 : ch * 64;
        const int colb = (o * 2 + d) * 256 + cg * 64;
        const float* raw = (const float*)(F.ws_() + WS_FRAW) + ((size_t)l * 2304 + (isc ? 2048 : 0) + t0) * 1024 + colb;
        {   const int rr = F.tid >> 4, c4 = F.tid & 15;
#pragma unroll
            for (int i = 0; i < 2; ++i) { const f32x4 v = *(const f32x4*)(raw + (size_t)(rr + 32 * i) * 1024 + 4 * c4);
#pragma unroll
                for (int e = 0; e < 4; ++e) tile[(rr + 32 * i) * 65 + 4 * c4 + e] = v[e]; } }
        __syncthreads();
        const int cl = F.tid >> 3, pq = F.tid & 7; const int c = cg * 64 + cl;
        float en = 0.f;
        {   const float* fen = (const float*)(F.ws_() + WS_FEN) + (size_t)l * 36 * 1024;
            const int c0 = isc ? 32 : 0, c1 = isc ? 36 : 32;
            for (int q = c0; q < c1; ++q) en += fen[q * 1024 + (o * 2) * 256 + c] + fen[q * 1024 + (o * 2 + 1) * 256 + c]; }
        const float sc = rsqrtf(en + EPS);
        const float bias = F.in(I_DBIAS)[(size_t)l * 512 + o * 256 + c];
        bf16_t* G = isc ? (bf16_t*)(F.ws_() + WS_GRC) + ((size_t)(l * 2 + o) * 256 + c) * 512 : (bf16_t*)(F.ws_() + WS_GR) + ((size_t)(l * 2 + o) * 256 + c) * 4096;
#pragma unroll
        for (int j = 0; j < 8; ++j) { const int p = pq * 8 + j, pos = t0 + p; float v = tile[p * 65 + cl] * sc;
            if (d == 0) { if (pos == 0) v += bias; G[Lf - pos] = (bf16_t)(pk_bf16(v, 0.f) & 0xffffu); }
            else if (pos > 0) G[Lf + pos] = (bf16_t)(pk_bf16(v, 0.f) & 0xffffu); }
        if (d == 0 && t0 == 0 && F.tid < 64) {   }
        __syncthreads();
    }
}

template <int MODE>
__device__ __forceinline__ void row_norm_phase(const Frame& F, int l, int lprev, bool from_input) {
    const bool addmoe = (lprev >= 0);
    const float* modp = (const float*)(F.ws_() + WS_MOD) + (size_t)l * 33 * (NMOD * D);
    const float* modm = (const float*)(F.ws_() + WS_MOD) + (size_t)(lprev >= 0 ? lprev : 0) * 33 * (NMOD * D) + 5 * D;
    const float* gn = (MODE == 2) ? F.in(I_GFINAL) : F.in(I_GMIX) + (size_t)l * D;
    LAS int* rb = (LAS int*)(F.lds + 131072);
    if (addmoe) {
        if (F.tid == 0) { const unsigned* cnt = F.ctl + CW_CNT + lprev * 32; int acc = 0; for (int e = 0; e < 32; ++e) { rb[e] = acc; acc += ((int)cnt[e] + 255) / 256 * 256; } }
        __syncthreads();
    }
    const int nrows = (MODE == 2) ? TL : TT;
    const bf16_t* O = (const bf16_t*)(F.ws_() + WS_O);
    const i32x4* tokinf = (const i32x4*)(F.ws_() + WS_TOKINF);
    for (int row = F.bid * 8 + F.wave; row < nrows; row += F.G * 8) {
        const bool isc = row >= TL; const int b = isc ? 32 : (row >> 11);
        float* xr = isc ? (float*)(F.ws_() + WS_XC) + (size_t)(row - TL) * D : F.out() + (size_t)row * D;
        const float* xin = (from_input && !isc) ? F.in(I_X) + (size_t)row * D : xr;
        f32x4 v[4];
#pragma unroll
        for (int i = 0; i < 4; ++i) v[i] = *(const f32x4*)(xin + i * 256 + 4 * F.lane);
        if (addmoe) {
            const i32x4 ti = tokinf[row]; const size_t r0 = (size_t)(rb[ti.x] + ti.y), r1 = (size_t)(rb[ti.z] + ti.w);
            const float* gm = modm + (size_t)b * (NMOD * D);
#pragma unroll
            for (int i = 0; i < 4; ++i) { const u32x2 a = *(const u32x2*)(O + r0 * D + i * 256 + 4 * F.lane), c = *(const u32x2*)(O + r1 * D + i * 256 + 4 * F.lane);
                const f32x4 g = *(const f32x4*)(gm + i * 256 + 4 * F.lane);
                v[i][0] += g[0] * (bflo(a.x) + bflo(c.x)); v[i][1] += g[1] * (bfhi(a.x) + bfhi(c.x)); v[i][2] += g[2] * (bflo(a.y) + bflo(c.y)); v[i][3] += g[3] * (bfhi(a.y) + bfhi(c.y)); }
            if (MODE != 2) {
#pragma unroll
                for (int i = 0; i < 4; ++i) *(f32x4*)(xr + i * 256 + 4 * F.lane) = v[i];
            }
        }
        float ss = 0.f;
#pragma unroll
        for (int i = 0; i < 4; ++i) ss += v[i][0] * v[i][0] + v[i][1] * v[i][1] + v[i][2] * v[i][2] + v[i][3] * v[i][3];
        ss = wave_sum(ss);
        const float rstd = rsqrtf(ss * (1.0f / D) + EPS);
        if (MODE == 2) {
#pragma unroll
            for (int i = 0; i < 4; ++i) { const f32x4 g = *(const f32x4*)(gn + i * 256 + 4 * F.lane); f32x4 o;
#pragma unroll
                for (int e = 0; e < 4; ++e) o[e] = v[i][e] * rstd * g[e];
                *(f32x4*)(xr + i * 256 + 4 * F.lane) = o; }
        } else {
            const float* sh = modp + (size_t)b * (NMOD * D); const float* scp = sh + D;
            bf16_t* hrow = (bf16_t*)(F.ws_() + WS_H) + (size_t)row * D;
#pragma unroll
            for (int i = 0; i < 4; ++i) { const f32x4 g = *(const f32x4*)(gn + i * 256 + 4 * F.lane), s1 = *(const f32x4*)(sh + i * 256 + 4 * F.lane), s2 = *(const f32x4*)(scp + i * 256 + 4 * F.lane);
                float o[4];
#pragma unroll
                for (int e = 0; e < 4; ++e) o[e] = v[i][e] * rstd * g[e] * (1.0f + s2[e]) + s1[e];
                u32x2 w; w.x = pk_bf16(o[0], o[1]); w.y = pk_bf16(o[2], o[3]); *(u32x2*)(hrow + i * 256 + 4 * F.lane) = w; }
        }
    }
}

__device__ __forceinline__ void moe_weight_cvt(const Frame& F, int l) {
    __syncthreads();
    for (int it = F.bid; it < 12288; it += F.G) {
        if (it < 8192) { const int up = it >= 4096, j = it & 4095, e = j >> 7, r = j & 127, kt = r >> 3, nt = r & 7;
            const float* src = F.in(up ? I_WUP : I_WGATE) + ((size_t)l * 32 + e) * D * DEXP;
            bf16_t* dst = (bf16_t*)(F.ws_() + WS_MOEGU) + (size_t)e * 1024 * 1024;
            const int n0 = nt * 64, drow0 = (n0 >> 7) * 256 + (up ? 128 : 0) + (n0 & 127);
            tr_tile(F, src, DEXP, kt * 64, n0, dst, 1024, drow0); }
        else { const int j = it - 8192, e = j >> 7, r = j & 127, kt = r >> 4, nt = r & 15;
            const float* src = F.in(I_WDOWN) + ((size_t)l * 32 + e) * DEXP * D;
            bf16_t* dst = (bf16_t*)(F.ws_() + WS_MOEDN) + (size_t)e * 1024 * 512;
            tr_tile(F, src, D, kt * 64, nt * 64, dst, 512, nt * 64); }
    }
}

__device__ __forceinline__ void hy_pre(const Frame& F, int l, bool do_ctx) {
    constexpr int BST = 1154;
    static_assert(32 * BST * 2 <= LDS_BARW, "hy_pre LDS");
    LAS bf16_t* raw = (LAS bf16_t*)F.lds;
    const bf16_t* P = (const bf16_t*)(F.ws_() + WS_P);
    const float* cw = F.in(I_DCW) + (size_t)l * 3 * 768; const float* cb = F.in(I_DCB) + (size_t)l * 768;
    const int nlat = 128 * 12, nitems = nlat + (do_ctx ? 16 * 12 : 0);
    __syncthreads();
    for (int it = F.bid; it < nitems; it += F.G) {
        const bool isc = it >= nlat; const int jj = isc ? it - nlat : it; const int sblk = jj / 12, cgp = jj % 12;
        const int Lseg = isc ? LC : SEQ; const size_t tokbase = isc ? TL : 0;
        for (int pc = F.tid; pc < 32 * 18 * 8; pc += NTHREADS) {
            const int b = pc / 144, r = (pc % 144) >> 3, q = pc & 7; const int t = sblk * 16 + r - 1;
            u32x4 v = (u32x4){0u, 0u, 0u, 0u};
            if (t >= 0 && t < Lseg) v = *(const u32x4*)(P + (tokbase + (size_t)b * Lseg + t) * DIN + OFF_D + cgp * 64 + q * 8);
            LAS unsigned* dst = (LAS unsigned*)(raw + b * BST + r * 64 + q * 8);
            dst[0] = v.x; dst[1] = v.y; dst[2] = v.z; dst[3] = v.w;
        }
        __syncthreads();
        const int b = F.tid & 31, cs = F.tid >> 5;
        bf16_t* UF = (bf16_t*)(F.ws_() + WS_UF) + (isc ? (size_t)768 * 65536 : 0);
        const size_t chs = isc ? 8192 : 65536;
#pragma unroll 1
        for (int i = 0; i < 4; ++i) {
            const int chl = cs * 4 + i, ch = cgp * 64 + chl;
            const float w0 = cw[ch], w1 = cw[768 + ch], w2 = cw[1536 + ch], bb = cb[ch];
#pragma unroll
            for (int hh = 0; hh < 2; ++hh) {
                float x[10];
#pragma unroll
                for (int q = 0; q < 10; ++q) x[q] = bf2f(raw[b * BST + (8 * hh + q) * 64 + chl]);
                float u[8];
#pragma unroll
                for (int j = 0; j < 8; ++j) u[j] = bb + w0 * x[j] + w1 * x[j + 1] + w2 * x[j + 2];
                u32x4 w; w.x = pk_bf16(u[0], u[1]); w.y = pk_bf16(u[2], u[3]); w.z = pk_bf16(u[4], u[5]); w.w = pk_bf16(u[6], u[7]);
                *(u32x4*)(UF + (size_t)ch * chs + (((size_t)sblk * 2 + hh) * 32 + b) * 8) = w;
            }
        }
        __syncthreads();
    }
}

template <int ORDER>
__device__ __forceinline__ void hy_conv(const Frame& F, int l, bool do_ctx) {
    LAS bf16_t* Gl = (LAS bf16_t*)F.lds + F.wave * 4096;
    LAS bf16_t* stg = (LAS bf16_t*)(F.lds + 65536 + 1024);
    const int lane = F.lane, i31 = lane & 31, hh = lane >> 5;
    const int nlat = 256, nitems = nlat + (do_ctx ? 32 : 0);
    const bf16_t* UF0 = (const bf16_t*)(F.ws_() + WS_UF); bf16_t* Z10 = (bf16_t*)(F.ws_() + WS_Z1F);
    for (int it = F.bid; it < nitems; it += F.G) {
        const bool isc = it >= nlat; const int cg = isc ? it - nlat : (it >> 3), tg = isc ? 0 : (it & 7);
        const int Lf = isc ? LC : SEQ; const int c = cg * 8 + F.wave;
        const bf16_t* Gg = isc ? (const bf16_t*)(F.ws_() + WS_GRC) + ((size_t)(l * 2 + ORDER) * 256 + c) * 512
                               : (const bf16_t*)(F.ws_() + WS_GR) + ((size_t)(l * 2 + ORDER) * 256 + c) * 4096;
        for (int q = lane; q < Lf / 4; q += 64) *(LAS u32x4*)(Gl + q * 8) = *(const u32x4*)(Gg + q * 8);
        const size_t chs = isc ? 8192 : 65536;
        const bf16_t* UFb = UF0 + (isc ? (size_t)768 * 65536 : 0); bf16_t* Z1b = Z10 + (isc ? (size_t)256 * 65536 : 0);
        const bf16_t* zsrc = (ORDER == 0) ? UFb + (size_t)c * chs : Z1b + (size_t)c * chs;
        const bf16_t* gsrc = UFb + (size_t)(256 * (ORDER + 1) + c) * chs;
        const int t0 = tg * 256;
        f32x16 acc[8];
#pragma unroll
        for (int a = 0; a < 8; ++a)
#pragma unroll
            for (int r = 0; r < 16; ++r) acc[a][r] = 0.f;
        bf16x8 FR[8][2];
#define HY_FRAG(dst, xb) do { const LAS bf16_t* _g = Gl + (xb); _Pragma("unroll") for (int _j = 0; _j < 8; ++_j) dst[_j] = (short)_g[_j]; } while (0)
        const int xb0 = Lf - t0 - i31 + 8 * hh;
#pragma unroll
        for (int a = 0; a < 8; ++a)
#pragma unroll
            for (int ks = 0; ks < 2; ++ks) HY_FRAG(FR[a][ks], xb0 - 32 * a + 16 * ks);
        const int nkp = Lf / 32;
        bf16x8 Bn[2];
        const char* zp = (const char*)zsrc + hh * 512 + i31 * 16;
#define HY_BLOAD(dst, sq) do { _Pragma("unroll") for (int ks = 0; ks < 2; ++ks) dst[ks] = *(const bf16x8*)(zp + (size_t)(sq) * 64 + ks * 1024); } while (0)
        HY_BLOAD(Bn, 0);
        for (int nb = 0; nb < nkp; nb += 8) {
#pragma unroll
            for (int u = 0; u < 8; ++u) {
                const int s0 = (nb + u) * 32;
                bf16x8 Bf[2];
#pragma unroll
                for (int ks = 0; ks < 2; ++ks) Bf[ks] = Bn[ks];
                HY_BLOAD(Bn, s0 + 32);
                __builtin_amdgcn_sched_barrier(0);
#pragma unroll
                for (int a = 0; a < 8; ++a)
#pragma unroll
                    for (int ks = 0; ks < 2; ++ks) acc[a] = MFMA32(FR[(a - u) & 7][ks], Bf[ks], acc[a]);
#pragma unroll
                for (int ks = 0; ks < 2; ++ks) HY_FRAG(FR[(7 - u) & 7][ks], xb0 + s0 + 32 + 16 * ks);
            }
        }
#undef HY_FRAG
#undef HY_BLOAD
        if (ORDER == 0) {
#pragma unroll
            for (int a = 0; a < 8; ++a)
#pragma unroll
                for (int rg = 0; rg < 4; ++rg) {
                    const size_t off = ((size_t)(((t0 >> 4) + 2 * a + (rg >> 1)) * 2 + (rg & 1)) * 32 + i31) * 8 + 4 * hh;
                    const u32x2 g = *(const u32x2*)(gsrc + off);
                    u32x2 w; w.x = pk_bf16(bflo(g.x) * acc[a][4 * rg], bfhi(g.x) * acc[a][4 * rg + 1]); w.y = pk_bf16(bflo(g.y) * acc[a][4 * rg + 2], bfhi(g.y) * acc[a][4 * rg + 3]);
                    *(u32x2*)(Z1b + (size_t)c * chs + off) = w;
                }
        } else {
            bf16_t* Y = (bf16_t*)(F.ws_() + WS_Y);
            const size_t tokbase = isc ? TL : 0;
#pragma unroll
            for (int a = 0; a < 8; ++a) {
                __syncthreads();
#pragma unroll
                for (int rg = 0; rg < 4; ++rg) {
                    const size_t off = ((size_t)(((t0 >> 4) + 2 * a + (rg >> 1)) * 2 + (rg & 1)) * 32 + i31) * 8 + 4 * hh;
                    const u32x2 g = *(const u32x2*)(gsrc + off);
                    float gv[4] = {bflo(g.x), bfhi(g.x), bflo(g.y), bfhi(g.y)};
#pragma unroll
                    for (int e = 0; e < 4; ++e) { const int tl = 8 * rg + 4 * hh + e; stg[(tl * 32 + i31) * 8 + F.wave] = (bf16_t)(pk_bf16(gv[e] * acc[a][4 * rg + e], 0.f) & 0xffffu); }
                }
                __syncthreads();
#pragma unroll
                for (int q = 0; q < 2; ++q) { const int pr = F.tid + q * NTHREADS, tl = pr >> 5, b = pr & 31;
                    const u32x4 v = *(const LAS u32x4*)(stg + pr * 8);
                    *(u32x4*)(Y + (tokbase + (size_t)b * Lf + t0 + 32 * a + tl) * D + 768 + cg * 8) = v; }
            }
            __syncthreads();
        }
    }
}

constexpr int LR_XR = 0;
constexpr int LR_UB = 17408;
constexpr int LR_WT = LR_UB + 18432;
constexpr int LR_A  = LR_WT + 18432;
constexpr int LR_B  = LR_A + 32768;
constexpr int LR_WS = LR_B + 32768;
static_assert(LR_WS + 4096 <= LDS_BARW, "LRU LDS");

__device__ __forceinline__ void lru_chunk_ab(const Frame& F, int l, int b, int hd, int dir, bool isc, int t_lo) {
    LAS bf16_t* xr = (LAS bf16_t*)(F.lds + LR_XR); LAS bf16_t* ub = (LAS bf16_t*)(F.lds + LR_UB); LAS bf16_t* wt = (LAS bf16_t*)(F.lds + LR_WT);
    LAS float* a_s = (LAS float*)(F.lds + LR_A); LAS float* b_s = (LAS float*)(F.lds + LR_B);
    const bf16_t* P = (const bf16_t*)(F.ws_() + WS_P);
    const int Lseg = isc ? LC : SEQ; const size_t tokbase = (isc ? (size_t)TL : 0) + (size_t)b * Lseg;
    __syncthreads();
    for (int pc = F.tid; pc < 134 * 8; pc += NTHREADS) { const int r = pc >> 3, q = pc & 7; const int t = t_lo - 3 + r;
        u32x4 v = (u32x4){0u, 0u, 0u, 0u};
        if (t >= 0 && t < Lseg) v = *(const u32x4*)(P + (tokbase + t) * DIN + hd * 64 + q * 8);
        *(LAS u32x4*)(xr + r * 64 + q * 8) = v; }
    {   const bf16_t* W = (const bf16_t*)(F.ws_() + WS_LRUW) + (size_t)(l * 2 + dir) * 2 * 4 * 4096;
        for (int pc = F.tid; pc < 2 * 64 * 8; pc += NTHREADS) { const int g = pc >> 9, n = (pc >> 3) & 63, q = pc & 7;
            *(LAS u32x4*)(wt + (g * 64 + n) * 72 + q * 8) = *(const u32x4*)(W + ((size_t)(g * 4 + hd) * 64 + n) * 64 + q * 8); } }
    __syncthreads();
    {
        const int ch = F.tid & 63, tq = F.tid >> 6; const int chg = hd * 64 + ch;
        const float* cw = F.in(I_ACW) + ((size_t)(l * 2 + dir) * 4) * 256 + chg; const float cb = F.in(I_ACB)[(size_t)(l * 2 + dir) * 256 + chg];
        const float w0 = cw[0], w1 = cw[256], w2 = cw[512], w3 = cw[768];
        const int r0 = tq * 16 + (dir ? 3 : 0);
        float x[19];
#pragma unroll
        for (int q = 0; q < 19; ++q) x[q] = bf2f(xr[(r0 + q) * 64 + ch]);
#pragma unroll
        for (int k = 0; k < 16; ++k) { const float u = cb + w0 * x[k] + w1 * x[k + 1] + w2 * x[k + 2] + w3 * x[k + 3];
            ub[(tq * 16 + k) * 72 + ch] = (bf16_t)(pk_bf16(u, 0.f) & 0xffffu); }
    }
    __syncthreads();
    {
        const int w = F.wave, lane = F.lane, row = lane & 15, kq = lane >> 4;
        bf16x8 Af[2];
#pragma unroll
        for (int ks = 0; ks < 2; ++ks) Af[ks] = *(const LAS bf16x8*)(ub + (16 * w + row) * 72 + 32 * ks + 8 * kq);
        const float* br = F.in(I_ABR) + (size_t)(l * 2 + dir) * 256 + hd * 64; const float* bi = F.in(I_ABI) + (size_t)(l * 2 + dir) * 256 + hd * 64;
        const float* lam = F.in(I_ALAM) + (size_t)(l * 2 + dir) * 256 + hd * 64;
#pragma unroll
        for (int nt = 0; nt < 4; ++nt) {
            f32x4 cr = (f32x4){0.f, 0.f, 0.f, 0.f}, ci = cr;
#pragma unroll
            for (int ks = 0; ks < 2; ++ks) {
                const bf16x8 Br = *(const LAS bf16x8*)(wt + (0 * 64 + 16 * nt + row) * 72 + 32 * ks + 8 * kq);
                const bf16x8 Bi = *(const LAS bf16x8*)(wt + (1 * 64 + 16 * nt + row) * 72 + 32 * ks + 8 * kq);
                cr = MFMA16(Af[ks], Br, cr); ci = MFMA16(Af[ks], Bi, ci);
            }
            const int ch = 16 * nt + row;
            const float sp = log1pf(__expf(-lam[ch])), brc = br[ch], bic = bi[ch];
#pragma unroll
            for (int r = 0; r < 4; ++r) { const int tl = 16 * w + 4 * kq + r;
                const float rr = sigmoid_f(cr[r] + brc), ii = sigmoid_f(ci[r] + bic);
                const float a = __expf(-8.0f * rr * sp);
                const float uv = bf2f(ub[tl * 72 + ch]);
                a_s[tl * 64 + ch] = a; b_s[tl * 64 + ch] = sqrtf(fmaxf(1.0f - a * a, 0.f)) * (ii * uv); }
        }
    }
    __syncthreads();
}

__device__ __forceinline__ void lru_s1(const Frame& F, int l) {
    LAS float* a_s = (LAS float*)(F.lds + LR_A); LAS float* b_s = (LAS float*)(F.lds + LR_B); LAS float* wsum = (LAS float*)(F.lds + LR_WS);
    float* SUM = (float*)(F.ws_() + WS_LRUS);
    for (int it = F.bid; it < 32 * 4 * 2 * 18; it += F.G) {
        int r = it; const int n = r % 18; r /= 18; const int dir = r & 1; r >>= 1; const int hd = r & 3; const int b = r >> 2;
        const bool isc = n < 2; const int tc = isc ? (dir ? 1 - n : n) : (dir ? 15 - (n - 2) : n - 2);
        lru_chunk_ab(F, l, b, hd, dir, isc, tc * 128);
        const int w = F.wave, ch = F.lane;
        float A = 1.f, Bv = 0.f;
#pragma unroll
        for (int k = 0; k < 16; ++k) { const int tl = dir ? 127 - 16 * w - k : 16 * w + k; const float a = a_s[tl * 64 + ch], bb = b_s[tl * 64 + ch]; Bv = a * Bv + bb; A *= a; }
        wsum[(w * 2 + 0) * 64 + ch] = A; wsum[(w * 2 + 1) * 64 + ch] = Bv;
        __syncthreads();
        if (w == 0) { float At = 1.f, Bt = 0.f;
#pragma unroll
            for (int q = 0; q < 8; ++q) { const float Aq = wsum[(q * 2) * 64 + ch], Bq = wsum[(q * 2 + 1) * 64 + ch]; Bt = Aq * Bt + Bq; At *= Aq; }
            float* dst = SUM + ((size_t)((b * 2 + dir) * 4 + hd) * 18 + n) * 128;
            dst[ch] = At; dst[64 + ch] = Bt; }
    }
}
__device__ __forceinline__ void lru_s2(const Frame& F) {
    const float* SUM = (const float*)(F.ws_() + WS_LRUS); float* CAR = (float*)(F.ws_() + WS_LRUC);
    if (F.wave != 0) return;
    for (int it = F.bid; it < 32 * 2 * 4; it += F.G) {
        float As[18], Bs[18];
#pragma unroll
        for (int n = 0; n < 18; ++n) { const float* s = SUM + ((size_t)it * 18 + n) * 128; As[n] = s[F.lane]; Bs[n] = s[64 + F.lane]; }
        float carry = 0.f;
#pragma unroll
        for (int n = 0; n < 18; ++n) { CAR[((size_t)it * 18 + n) * 64 + F.lane] = carry; carry = As[n] * carry + Bs[n]; }
    }
}
__device__ __forceinline__ void lru_s3(const Frame& F, int l, bool do_ctx) {
    LAS float* a_s = (LAS float*)(F.lds + LR_A); LAS float* b_s = (LAS float*)(F.lds + LR_B); LAS float* wsum = (LAS float*)(F.lds + LR_WS);
    const float* CAR = (const float*)(F.ws_() + WS_LRUC);
    const bf16_t* P = (const bf16_t*)(F.ws_() + WS_P); bf16_t* Y = (bf16_t*)(F.ws_() + WS_Y);
    const int nlat = 32 * 4 * 16, nitems = nlat + (do_ctx ? 32 * 4 * 2 : 0);
    for (int it = F.bid; it < nitems; it += F.G) {
        const bool isc = it >= nlat; int r = isc ? it - nlat : it; const int ntc = isc ? 2 : 16; const int tc = r % ntc; r /= ntc; const int hd = r & 3; const int b = r >> 2;
        const int w = F.wave, ch = F.lane;
        float hs[16];
#pragma unroll
        for (int k = 0; k < 16; ++k) hs[k] = 0.f;
#pragma unroll
        for (int dir = 0; dir < 2; ++dir) {
            lru_chunk_ab(F, l, b, hd, dir, isc, tc * 128);
            const int n = isc ? (dir ? 1 - tc : tc) : 2 + (dir ? 15 - tc : tc);
            float hl[16], ca[16]; float A = 1.f, Bv = 0.f;
#pragma unroll
            for (int kk = 0; kk < 16; ++kk) { const int k = dir ? 15 - kk : kk; const int tl = 16 * w + k; const float a = a_s[tl * 64 + ch], bb = b_s[tl * 64 + ch]; Bv = a * Bv + bb; A *= a; hl[k] = Bv; ca[k] = A; }
            wsum[(w * 2 + 0) * 64 + ch] = A; wsum[(w * 2 + 1) * 64 + ch] = Bv;
            __syncthreads();
            float s = CAR[((size_t)((b * 2 + dir) * 4 + hd) * 18 + n) * 64 + ch];
            const int myord = dir ? 7 - w : w;
#pragma unroll
            for (int q = 0; q < 8; ++q) { const int wq = dir ? 7 - q : q; if (q < myord) s = wsum[(wq * 2) * 64 + ch] * s + wsum[(wq * 2 + 1) * 64 + ch]; }
#pragma unroll
            for (int k = 0; k < 16; ++k) hs[k] += hl[k] + ca[k] * s;
        }
        const int Lseg = isc ? LC : SEQ; const size_t tokbase = (isc ? (size_t)TL : 0) + (size_t)b * Lseg + tc * 128 + 16 * w;
#pragma unroll
        for (int k = 0; k < 16; ++k) { const float xg = bf2f(P[(tokbase + k) * DIN + 256 + hd * 64 + ch]);
            Y[(tokbase + k) * D + hd * 64 + ch] = (bf16_t)(pk_bf16(hs[k] * gelu_tanh_f(xg), 0.f) & 0xffffu); }
    }
}


__device__ __forceinline__ void lru_seq(const Frame& F, int l, bool ctx_out) {
    LAS bf16_t* xr = (LAS bf16_t*)(F.lds + LR_XR); LAS bf16_t* ub = (LAS bf16_t*)(F.lds + LR_UB); LAS bf16_t* wt = (LAS bf16_t*)(F.lds + LR_WT);
    LAS float* a_s = (LAS float*)(F.lds + LR_A); LAS float* b_s = (LAS float*)(F.lds + LR_B); LAS float* wsum = (LAS float*)(F.lds + LR_WS);
    const bf16_t* P = (const bf16_t*)(F.ws_() + WS_P); bf16_t* HT = (bf16_t*)(F.ws_() + WS_HT);
    const int w = F.wave, lane = F.lane, row = lane & 15, kq = lane >> 4;
    for (int it = F.bid; it < 32 * 4 * 2; it += F.G) {
        const int dir = it & 1, hd = (it >> 1) & 3, b = it >> 3;
        __syncthreads();
        {   const bf16_t* W = (const bf16_t*)(F.ws_() + WS_LRUW) + (size_t)(l * 2 + dir) * 2 * 4 * 4096;
            for (int pc = F.tid; pc < 2 * 64 * 8; pc += NTHREADS) { const int g = pc >> 9, n = (pc >> 3) & 63, q = pc & 7;
                *(LAS u32x4*)(wt + (g * 64 + n) * 72 + q * 8) = *(const u32x4*)(W + ((size_t)(g * 4 + hd) * 64 + n) * 64 + q * 8); } }
        const int cch = F.tid & 63, ctq = F.tid >> 6; const int chg = hd * 64 + cch;
        const float* cw = F.in(I_ACW) + ((size_t)(l * 2 + dir) * 4) * 256 + chg; const float cb = F.in(I_ACB)[(size_t)(l * 2 + dir) * 256 + chg];
        const float w0 = cw[0], w1 = cw[256], w2 = cw[512], w3 = cw[768];
        float spv[4], brv[4], biv[4];
#pragma unroll
        for (int nt = 0; nt < 4; ++nt) { const int ch = hd * 64 + 16 * nt + row; const size_t o = (size_t)(l * 2 + dir) * 256 + ch;
            spv[nt] = log1pf(__expf(-F.in(I_ALAM)[o])); brv[nt] = F.in(I_ABR)[o]; biv[nt] = F.in(I_ABI)[o]; }
        float carry = 0.f;
        u32x4 pf[3];
#define LRS_GEO(n, isc_, tlo_) const bool isc_ = (n) < 2; const int tlo_ = 128 * (isc_ ? (dir ? 1 - (n) : (n)) : (dir ? 15 - ((n) - 2) : (n) - 2))
#define LRS_PREFETCH(n) do { LRS_GEO(n, ic_, tl_); const int Ls_ = ic_ ? LC : SEQ; const size_t tb_ = (ic_ ? (size_t)TL : 0) + (size_t)b * Ls_; \
            _Pragma("unroll") for (int u_ = 0; u_ < 3; ++u_) { const int pc_ = F.tid + u_ * NTHREADS; const int r_ = pc_ >> 3, q_ = pc_ & 7; const int t_ = tl_ - 3 + r_; \
                pf[u_] = (u32x4){0u, 0u, 0u, 0u}; if (pc_ < 134 * 8 && t_ >= 0 && t_ < Ls_) pf[u_] = *(const u32x4*)(P + (tb_ + t_) * DIN + hd * 64 + q_ * 8); } } while (0)
        LRS_PREFETCH(0);
#pragma unroll 1
        for (int n = 0; n < 18; ++n) {
            LRS_GEO(n, isc, t_lo);
            const int Lseg = isc ? LC : SEQ; const size_t tokbase = (isc ? (size_t)TL : 0) + (size_t)b * Lseg + t_lo;
#pragma unroll
            for (int u = 0; u < 3; ++u) { const int pc = F.tid + u * NTHREADS; if (pc < 134 * 8) *(LAS u32x4*)(xr + (pc >> 3) * 64 + (pc & 7) * 8) = pf[u]; }
            __syncthreads();
            {   const int r0 = ctq * 16 + (dir ? 3 : 0);
                float x[19];
#pragma unroll
                for (int q = 0; q < 19; ++q) x[q] = bf2f(xr[(r0 + q) * 64 + cch]);
#pragma unroll
                for (int k = 0; k < 16; ++k) { const float u = cb + w0 * x[k] + w1 * x[k + 1] + w2 * x[k + 2] + w3 * x[k + 3];
                    ub[(ctq * 16 + k) * 72 + cch] = (bf16_t)(pk_bf16(u, 0.f) & 0xffffu); }
            }
            __syncthreads();
            if (n + 1 < 18) LRS_PREFETCH(n + 1);
            {   bf16x8 Af[2];
#pragma unroll
                for (int ks = 0; ks < 2; ++ks) Af[ks] = *(const LAS bf16x8*)(ub + (16 * w + row) * 72 + 32 * ks + 8 * kq);
#pragma unroll
                for (int nt = 0; nt < 4; ++nt) {
                    f32x4 cr = (f32x4){0.f, 0.f, 0.f, 0.f}, ci = cr;
#pragma unroll
                    for (int ks = 0; ks < 2; ++ks) {
                        const bf16x8 Br = *(const LAS bf16x8*)(wt + (0 * 64 + 16 * nt + row) * 72 + 32 * ks + 8 * kq);
                        const bf16x8 Bi = *(const LAS bf16x8*)(wt + (1 * 64 + 16 * nt + row) * 72 + 32 * ks + 8 * kq);
                        cr = MFMA16(Af[ks], Br, cr); ci = MFMA16(Af[ks], Bi, ci);
                    }
                    const int ch = 16 * nt + row;
#pragma unroll
                    for (int r = 0; r < 4; ++r) { const int tl = 16 * w + 4 * kq + r;
                        const float rr = sigmoid_f(cr[r] + brv[nt]), ii = sigmoid_f(ci[r] + biv[nt]);
                        const float a = __expf(-8.0f * rr * spv[nt]);
                        const float uv = bf2f(ub[tl * 72 + ch]);
                        a_s[tl * 64 + ch] = a; b_s[tl * 64 + ch] = sqrtf(fmaxf(1.0f - a * a, 0.f)) * (ii * uv); }
                }
            }
            __syncthreads();
            float hl[16], ca[16]; float A = 1.f, Bv = 0.f;
#pragma unroll
            for (int kk = 0; kk < 16; ++kk) { const int tl = 16 * w + (dir ? 15 - kk : kk); const float a = a_s[tl * 64 + lane], bb = b_s[tl * 64 + lane]; Bv = a * Bv + bb; A *= a; hl[kk] = Bv; ca[kk] = A; }
            wsum[(w * 2 + 0) * 64 + lane] = A; wsum[(w * 2 + 1) * 64 + lane] = Bv;
            __syncthreads();
            float s = carry; const int myord = dir ? 7 - w : w;
#pragma unroll
            for (int q = 0; q < 8; ++q) { const int wq = dir ? 7 - q : q; const float Aq = wsum[(wq * 2) * 64 + lane], Bq = wsum[(wq * 2 + 1) * 64 + lane];
                if (q < myord) s = Aq * s + Bq; carry = Aq * carry + Bq; }
            if (!isc || ctx_out) {
                bf16_t* dst = HT + ((size_t)dir * TT + tokbase + 16 * w) * 256 + hd * 64 + lane;
#pragma unroll
                for (int kk = 0; kk < 16; ++kk) { const int k = dir ? 15 - kk : kk; dst[(size_t)k * 256] = (bf16_t)(pk_bf16(hl[kk] + ca[kk] * s, 0.f) & 0xffffu); }
            }
        }
#undef LRS_GEO
#undef LRS_PREFETCH
    }
}
__device__ __forceinline__ void lru_comb(const Frame& F, bool ctx_out) {
    const bf16_t* P = (const bf16_t*)(F.ws_() + WS_P); const bf16_t* HT = (const bf16_t*)(F.ws_() + WS_HT); bf16_t* Y = (bf16_t*)(F.ws_() + WS_Y);
    const size_t n = (size_t)(ctx_out ? TT : TL) * 32;
    for (size_t i = (size_t)F.bid * NTHREADS + F.tid; i < n; i += (size_t)F.G * NTHREADS) { const size_t rowi = i >> 5; const int c8 = (int)(i & 31) * 8;
        const u32x4 hf = *(const u32x4*)(HT + rowi * 256 + c8), hb = *(const u32x4*)(HT + ((size_t)TT + rowi) * 256 + c8), xg = *(const u32x4*)(P + rowi * DIN + 256 + c8);
        const unsigned hfa[4] = {hf.x, hf.y, hf.z, hf.w}, hba[4] = {hb.x, hb.y, hb.z, hb.w}, xga[4] = {xg.x, xg.y, xg.z, xg.w}; unsigned o[4];
#pragma unroll
        for (int e = 0; e < 4; ++e) o[e] = pk_bf16((bflo(hfa[e]) + bflo(hba[e])) * gelu_tanh_f(bflo(xga[e])), (bfhi(hfa[e]) + bfhi(hba[e])) * gelu_tanh_f(bfhi(xga[e])));
        *(u32x4*)(Y + rowi * D + c8) = (u32x4){o[0], o[1], o[2], o[3]}; }
}

constexpr int CF_GLU = 0;
constexpr int CF_CV  = 48128;
constexpr int CF_ACT = CF_CV + 65536;
static_assert(CF_ACT + 64 * 264 * 2 <= LDS_BARW, "conformer LDS");
#ifndef CONF_STEPS
#define CONF_STEPS 4
#endif
__device__ __forceinline__ void conf_phase(const Frame& F, int l, bool do_ctx) {
    LAS bf16_t* glu = (LAS bf16_t*)(F.lds + CF_GLU); LAS float* cv = (LAS float*)(F.lds + CF_CV); LAS bf16_t* act = (LAS bf16_t*)(F.lds + CF_ACT);
    const bf16_t* P = (const bf16_t*)(F.ws_() + WS_P); bf16_t* Y = (bf16_t*)(F.ws_() + WS_Y);
    const int nlat = TL / 64, nitems = nlat + (do_ctx ? TC / 64 : 0);
    const float* ccw = F.in(I_CCW) + (size_t)l * 31 * 256; const float* ccb = F.in(I_CCB) + (size_t)l * 256;
    const float* lng = F.in(I_CLG) + (size_t)l * 256; const float* lnb = F.in(I_CLB) + (size_t)l * 256; const float* bpw = F.in(I_CBPW) + (size_t)l * 256;
    const bf16_t* Wt = (const bf16_t*)(F.ws_() + WS_CPW) + (size_t)l * 65536;
    bf16x8 Aw[2][8];
#pragma unroll
    for (int nt = 0; nt < 2; ++nt)
#pragma unroll
        for (int ks = 0; ks < 8; ++ks) Aw[nt][ks] = *(const bf16x8*)(Wt + (size_t)(32 * F.wave + 16 * nt + (F.lane & 15)) * 256 + 32 * ks + 8 * (F.lane >> 4));
    for (int it = F.bid; it < nitems; it += F.G) {
        const bool isc = it >= nlat; const int tile = isc ? it - nlat : it; const int Lseg = isc ? LC : SEQ; const int tps = Lseg / 64;
        const int b = tile / tps, t0 = (tile % tps) * 64; const size_t tokbase = (isc ? (size_t)TL : 0) + (size_t)b * Lseg;
        __syncthreads();
        for (int pc = F.tid; pc < 94 * 32; pc += NTHREADS) { const int r = pc >> 5, q = pc & 31; const int t = t0 - 15 + r;
            u32x4 o = (u32x4){0u, 0u, 0u, 0u};
            if (t >= 0 && t < Lseg) { const bf16_t* src = P + (tokbase + t) * DIN + OFF_C + q * 8; const u32x4 v = *(const u32x4*)src, g = *(const u32x4*)(src + 256);
                o.x = pk_bf16(bflo(v.x) * sigmoid_f(bflo(g.x)), bfhi(v.x) * sigmoid_f(bfhi(g.x))); o.y = pk_bf16(bflo(v.y) * sigmoid_f(bflo(g.y)), bfhi(v.y) * sigmoid_f(bfhi(g.y)));
                o.z = pk_bf16(bflo(v.z) * sigmoid_f(bflo(g.z)), bfhi(v.z) * sigmoid_f(bfhi(g.z))); o.w = pk_bf16(bflo(v.w) * sigmoid_f(bflo(g.w)), bfhi(v.w) * sigmoid_f(bfhi(g.w))); }
            *(LAS u32x4*)(glu + r * 256 + q * 8) = o; }
        __syncthreads();
        if (CONF_STEPS < 2) continue;
        {   const int ch = F.tid & 255, tg = F.tid >> 8;
            const float cbv = ccb[ch];
            float wv[31];
#pragma unroll
            for (int j = 0; j < 31; ++j) wv[j] = ccw[j * 256 + ch];
#pragma unroll 1
            for (int kg = 0; kg < 4; ++kg) {
                float xs[38];
#pragma unroll
                for (int q = 0; q < 38; ++q) xs[q] = bf2f(glu[(32 * tg + 8 * kg + q) * 256 + ch]);
#pragma unroll
                for (int kk = 0; kk < 8; ++kk) { float a = cbv;
#pragma unroll
                    for (int j = 0; j < 31; ++j) a += wv[j] * xs[kk + j];
                    cv[(32 * tg + 8 * kg + kk) * 256 + ch] = a; }
            }
        }
        __syncthreads();
        if (CONF_STEPS < 3) continue;
        {
            const f32x4 g4 = *(const f32x4*)(lng + 4 * F.lane), b4 = *(const f32x4*)(lnb + 4 * F.lane);
#pragma unroll 1
            for (int q = 0; q < 8; ++q) { const int tk = 8 * F.wave + q; const f32x4 v = *(const LAS f32x4*)(cv + tk * 256 + 4 * F.lane);
                const float mu = wave_sum(v[0] + v[1] + v[2] + v[3]) * (1.0f / 256.0f);
                const float d0 = v[0] - mu, d1 = v[1] - mu, d2 = v[2] - mu, d3 = v[3] - mu;
                const float var = wave_sum(d0 * d0 + d1 * d1 + d2 * d2 + d3 * d3) * (1.0f / 256.0f);
                const float rs = rsqrtf(var + 1e-5f);
                const float y0 = silu_f(d0 * rs * g4[0] + b4[0]), y1 = silu_f(d1 * rs * g4[1] + b4[1]), y2 = silu_f(d2 * rs * g4[2] + b4[2]), y3 = silu_f(d3 * rs * g4[3] + b4[3]);
                u32x2 o; o.x = pk_bf16(y0, y1); o.y = pk_bf16(y2, y3); *(LAS u32x2*)(act + tk * 264 + 4 * F.lane) = o; }
        }
        __syncthreads();
        if (CONF_STEPS < 4) continue;
        {
            const int lane = F.lane, row = lane & 15, kq = lane >> 4;
            f32x4 acc[2][4];
#pragma unroll
            for (int nt = 0; nt < 2; ++nt)
#pragma unroll
                for (int tt = 0; tt < 4; ++tt) acc[nt][tt] = (f32x4){0.f, 0.f, 0.f, 0.f};
#pragma unroll
            for (int ks = 0; ks < 8; ++ks) {
                bf16x8 Bt[4];
#pragma unroll
                for (int tt = 0; tt < 4; ++tt) Bt[tt] = *(const LAS bf16x8*)(act + (16 * tt + row) * 264 + 32 * ks + 8 * kq);
#pragma unroll
                for (int nt = 0; nt < 2; ++nt)
#pragma unroll
                    for (int tt = 0; tt < 4; ++tt) acc[nt][tt] = MFMA16(Aw[nt][ks], Bt[tt], acc[nt][tt]);
            }
#pragma unroll
            for (int nt = 0; nt < 2; ++nt) { const int n0 = 32 * F.wave + 16 * nt + 4 * kq; const f32x4 bb = *(const f32x4*)(bpw + n0);
#pragma unroll
                for (int tt = 0; tt < 4; ++tt) { const f32x4 v = acc[nt][tt] + bb; u32x2 o; o.x = pk_bf16(v[0], v[1]); o.y = pk_bf16(v[2], v[3]);
                    *(u32x2*)(Y + (tokbase + t0 + 16 * tt + row) * D + 512 + n0) = o; } }
        }
    }
}

constexpr int AP_VT = 0;
__device__ __forceinline__ void attn_pre(const Frame& F, int l) {
    const bf16_t* P = (const bf16_t*)(F.ws_() + WS_P);
    const float* ropec = (const float*)(F.ws_() + WS_ROPE); const float* ropes = ropec + 2048 * 16;
    LAS bf16_t* vt = (LAS bf16_t*)(F.lds + AP_VT);
    const int skey = F.tid >> 2, scomp = (F.tid >> 1) & 1, shf = F.tid & 1;
    const int vkp = F.tid & 63, vg = F.tid >> 6;
    for (int it = F.bid; it < 32 * 4 * 18; it += F.G) {
        const int kt = it % 18, hd = (it / 18) & 3, b = it / 72;
        const bool kc = kt >= 16; const size_t kb = kc ? (size_t)TL + (size_t)b * LC + (kt - 16) * 128 : (size_t)b * SEQ + kt * 128;
        unsigned char* kimg = F.ws_() + WS_KIMG + (size_t)it * 16384; unsigned char* vimg = F.ws_() + WS_VIMG + (size_t)it * 16384;
        {   const bf16_t* kp = P + (kb + skey) * DIN + OFF_B + 256 + hd * 64 + scomp * 32 + 8 * shf; const u32x4 kr0 = *(const u32x4*)kp, kr1 = *(const u32x4*)(kp + 16);
            float x1[8] = {bflo(kr0.x), bfhi(kr0.x), bflo(kr0.y), bfhi(kr0.y), bflo(kr0.z), bfhi(kr0.z), bflo(kr0.w), bfhi(kr0.w)};
            float x2[8] = {bflo(kr1.x), bfhi(kr1.x), bflo(kr1.y), bfhi(kr1.y), bflo(kr1.z), bfhi(kr1.z), bflo(kr1.w), bfhi(kr1.w)};
            float o1[8], o2[8];
            if (!kc) { const int tpos = kt * 128 + skey; const float* cp = ropec + tpos * 16 + 8 * shf; const float* sp = ropes + tpos * 16 + 8 * shf;
#pragma unroll
                for (int j = 0; j < 8; ++j) { const float cs = cp[j], sn = sp[j]; o1[j] = x1[j] * cs - x2[j] * sn; o2[j] = x1[j] * sn + x2[j] * cs; } }
            else {
#pragma unroll
                for (int j = 0; j < 8; ++j) { o1[j] = x1[j]; o2[j] = x2[j]; } }
            const int sw = (skey >> 1) & 7, p0 = scomp * 4 + shf, p1 = p0 + 2;
            *(bf16x8*)(kimg + skey * 128 + ((p0 ^ sw) << 4)) = pk8(o1); *(bf16x8*)(kimg + skey * 128 + ((p1 ^ sw) << 4)) = pk8(o2); }
        {   const bf16_t* vp = P + (kb + 2 * vkp) * DIN + OFF_B + 512 + hd * 64 + 8 * vg; const u32x4 vr0 = *(const u32x4*)vp, vr1 = *(const u32x4*)(vp + DIN);
            const unsigned va[4] = {vr0.x, vr0.y, vr0.z, vr0.w}, vb[4] = {vr1.x, vr1.y, vr1.z, vr1.w};
            __syncthreads();
            LAS bf16_t* vd = vt + (8 * vg) * 136 + 2 * vkp;
#pragma unroll
            for (int e = 0; e < 4; ++e) { *(LAS unsigned*)(vd + (2 * e) * 136) = (va[e] & 0xffffu) | (vb[e] << 16); *(LAS unsigned*)(vd + (2 * e + 1) * 136) = (va[e] >> 16) | (vb[e] & 0xffff0000u); }
            __syncthreads();
#pragma unroll
            for (int u = 0; u < 2; ++u) { const int pc = F.tid + u * NTHREADS, dv = pc >> 4, pi = pc & 15, G = pi >> 1, h = pi & 1;
                const u32x2 lo = *(const LAS u32x2*)(vt + dv * 136 + 16 * G + 4 * h), hi = *(const LAS u32x2*)(vt + dv * 136 + 16 * G + 8 + 4 * h);
                *(u32x4*)(vimg + dv * 256 + ((pi ^ (dv & 15)) << 4)) = (u32x4){lo.x, lo.y, hi.x, hi.y}; }
        }
    }
}
constexpr int AT_K0 = 0, AT_V0 = 65536, AT_X = 0;
static_assert(AT_V0 + 65536 <= LDS_BARW, "attention LDS");
__device__ __forceinline__ void attn_phase(const Frame& F, int l, bool do_ctx) {
    const bf16_t* P = (const bf16_t*)(F.ws_() + WS_P); bf16_t* Y = (bf16_t*)(F.ws_() + WS_Y);
    const float* ropec = (const float*)(F.ws_() + WS_ROPE); const float* ropes = ropec + 2048 * 16;
    const int lane = F.lane, w = F.wave, i31 = lane & 31, hh = lane >> 5, qs = w >> 1, comp = w & 1;
    const float lam_init = (l == 0) ? 0.2f : (l == 1) ? 0.35550906759f : (l == 2) ? 0.47071301834f : 0.55605820419f;
    float lam;
    {   const float* q1 = F.in(I_LQ1) + l * 32; const float* k1 = F.in(I_LK1) + l * 32; const float* q2 = F.in(I_LQ2) + l * 32; const float* k2 = F.in(I_LK2) + l * 32;
        const float s1 = wave_sum(lane < 32 ? q1[i31] * k1[i31] : 0.f), s2 = wave_sum(lane < 32 ? q2[i31] * k2[i31] : 0.f);
        lam = expf(s1) - expf(s2) + lam_init; }
    const float* subg = F.in(I_SUBG) + l * 64;
    const int nlat = 32 * 4 * 16, nitems = nlat + (do_ctx ? 32 * 4 * 2 : 0);
    const float qscale = 0.17677669529663687f * 1.4426950408889634f;
    const int ksw = (i31 >> 1) & 7;
    const int koff0 = i31 * 128 + (((comp * 4 + hh) ^ ksw) << 4), koff1 = i31 * 128 + (((comp * 4 + 2 + hh) ^ ksw) << 4);
    for (int it = F.bid; it < nitems; it += F.G) {
        const bool isc = it >= nlat; int r_ = isc ? it - nlat : it; const int nqb = isc ? 2 : 16; const int qb = r_ % nqb; r_ /= nqb; const int hd = r_ & 3; const int b = r_ >> 2;
        const int ntiles = isc ? 1 : 9, kt0 = isc ? 16 : 0;
        const size_t qtok = isc ? (size_t)TL + (size_t)b * LC + qb * 128 + qs * 32 + i31 : (size_t)b * SEQ + qb * 128 + qs * 32 + i31;
        const unsigned char* kimg = F.ws_() + WS_KIMG + ((size_t)(b * 4 + hd) * 18 + kt0) * 16384; const unsigned char* vimg = F.ws_() + WS_VIMG + ((size_t)(b * 4 + hd) * 18 + kt0) * 16384;
        bf16x8 Bq[2];
        {   const bf16_t* qp = P + qtok * DIN + OFF_B + hd * 64 + comp * 32 + 8 * hh;
            const u32x4 a = *(const u32x4*)qp, c = *(const u32x4*)(qp + 16);
            float x1[8] = {bflo(a.x), bfhi(a.x), bflo(a.y), bfhi(a.y), bflo(a.z), bfhi(a.z), bflo(a.w), bfhi(a.w)};
            float x2[8] = {bflo(c.x), bfhi(c.x), bflo(c.y), bfhi(c.y), bflo(c.z), bfhi(c.z), bflo(c.w), bfhi(c.w)};
            float o1[8], o2[8];
            if (!isc) { const int tpos = qb * 128 + qs * 32 + i31; const float* cp = ropec + tpos * 16 + 8 * hh; const float* sp = ropes + tpos * 16 + 8 * hh;
#pragma unroll
                for (int j = 0; j < 8; ++j) { const float cs = cp[j], sn = sp[j]; o1[j] = (x1[j] * cs - x2[j] * sn) * qscale; o2[j] = (x1[j] * sn + x2[j] * cs) * qscale; } }
            else {
#pragma unroll
                for (int j = 0; j < 8; ++j) { o1[j] = x1[j] * qscale; o2[j] = x2[j] * qscale; } }
            Bq[0] = pk8(o1); Bq[1] = pk8(o2); }
#define AT_DMA(kt, buf) do { _Pragma("unroll") for (int u_ = 0; u_ < 4; ++u_) { const int ch_ = (u_ * 8 + w) * 1024; \
            __builtin_amdgcn_global_load_lds((const unsigned*)(kimg + (size_t)(kt) * 32768 + ch_ + lane * 16), (LAS unsigned*)(F.lds + AT_K0 + (buf) * 32768 + ch_), 16, 0, 0); \
            __builtin_amdgcn_global_load_lds((const unsigned*)(vimg + (size_t)(kt) * 32768 + ch_ + lane * 16), (LAS unsigned*)(F.lds + AT_V0 + (buf) * 32768 + ch_), 16, 0, 0); } } while (0)
        __syncthreads();
        AT_DMA(0, 0);
        asm volatile("s_waitcnt vmcnt(0)" ::: "memory");
        __syncthreads();
        f32x16 O0, O1, negm;
#pragma unroll
        for (int r = 0; r < 16; ++r) { O0[r] = 0.f; O1[r] = 0.f; negm[r] = 0.f; }
        float lsum = 0.f; bool first = true;
        for (int kt = 0; kt < ntiles; ++kt) {
            const int buf = kt & 1;
            if (kt + 1 < ntiles) AT_DMA(kt + 1, buf ^ 1);
            const LAS unsigned char* Kl = F.lds + AT_K0 + buf * 32768; const LAS unsigned char* Vl = F.lds + AT_V0 + buf * 32768;
            f32x16 S;
            {   const bf16x8 Ak0 = *(const LAS bf16x8*)(Kl + koff0), Ak1 = *(const LAS bf16x8*)(Kl + koff1);
                S = MFMA32(Ak0, Bq[0], negm); S = MFMA32(Ak1, Bq[1], S); }
#pragma unroll
            for (int st = 0; st < 8; ++st) {
                f32x16 Sn;
                if (st < 7) { const bf16x8 Ak0 = *(const LAS bf16x8*)(Kl + (st + 1) * 4096 + koff0), Ak1 = *(const LAS bf16x8*)(Kl + (st + 1) * 4096 + koff1);
                    Sn = MFMA32(Ak0, Bq[0], negm); Sn = MFMA32(Ak1, Bq[1], Sn); }
                float mx = fmaxf(fmaxf(S[0], S[1]), S[2]);
                mx = fmaxf(fmaxf(mx, S[3]), S[4]); mx = fmaxf(fmaxf(mx, S[5]), S[6]); mx = fmaxf(fmaxf(mx, S[7]), S[8]); mx = fmaxf(fmaxf(mx, S[9]), S[10]);
                mx = fmaxf(fmaxf(mx, S[11]), S[12]); mx = fmaxf(fmaxf(mx, S[13]), S[14]); mx = fmaxf(mx, S[15]);
                if (first || __any(mx > 8.0f)) {
                    const u32x2 sw = __builtin_amdgcn_permlane32_swap(__float_as_uint(mx), __float_as_uint(mx), false, false);
                    const float mp = fmaxf(__uint_as_float(sw.x), __uint_as_float(sw.y));
                    const float d = first ? mp : fmaxf(mp, 0.f);
                    const float alpha = __builtin_amdgcn_exp2f(-d);
#pragma unroll
                    for (int r = 0; r < 16; ++r) { S[r] -= d; O0[r] *= alpha; O1[r] *= alpha; negm[r] -= d; if (st < 7) Sn[r] -= d; }
                    lsum *= alpha; first = false;
                }
                float p[16], ps = 0.f;
#pragma unroll
                for (int r = 0; r < 16; ++r) { p[r] = __builtin_amdgcn_exp2f(S[r]); ps += p[r]; }
                lsum += ps;
#pragma unroll
                for (int s = 0; s < 2; ++s) {
                    float pp[8];
#pragma unroll
                    for (int j = 0; j < 8; ++j) pp[j] = p[8 * s + j];
                    const bf16x8 Bp = pk8(pp);
                    const int pi = 2 * (2 * (st & 3) + s) + hh;
#pragma unroll
                    for (int mt = 0; mt < 2; ++mt) { const bf16x8 av = *(const LAS bf16x8*)(Vl + (st >> 2) * 16384 + (32 * mt + i31) * 256 + ((pi ^ (i31 & 15)) << 4));
                        if (mt == 0) O0 = MFMA32(av, Bp, O0); else O1 = MFMA32(av, Bp, O1); }
                }
                if (st < 7) S = Sn;
            }
            asm volatile("s_waitcnt vmcnt(0)" ::: "memory");
            __syncthreads();
        }
#undef AT_DMA
        const float ltot = lsum + __shfl_xor(lsum, 32); const float inv = __builtin_amdgcn_rcpf(ltot);
        LAS float* xch = (LAS float*)(F.lds + AT_X) + qs * 2048;
        if (comp == 1) {
#pragma unroll
            for (int r = 0; r < 16; ++r) { const int dv = (r & 3) + 8 * (r >> 2) + 4 * hh; xch[dv * 32 + i31] = O0[r] * inv; xch[(32 + dv) * 32 + i31] = O1[r] * inv; }
        }
        __syncthreads();
        if (comp == 0) {
            float d0[16], d1[16]; float ss = 0.f;
#pragma unroll
            for (int r = 0; r < 16; ++r) { const int dv = (r & 3) + 8 * (r >> 2) + 4 * hh;
                d0[r] = O0[r] * inv - lam * xch[dv * 32 + i31]; d1[r] = O1[r] * inv - lam * xch[(32 + dv) * 32 + i31]; ss += d0[r] * d0[r] + d1[r] * d1[r]; }
            ss += __shfl_xor(ss, 32);
            const float rs = rsqrtf(ss * (1.0f / 64.0f) + EPS) * (1.0f - lam_init);
            bf16_t* yp = Y + qtok * D + 256 + hd * 64;
#pragma unroll
            for (int rg = 0; rg < 4; ++rg) { const int dv = 8 * rg + 4 * hh; const f32x4 g0 = *(const f32x4*)(subg + dv), g1 = *(const f32x4*)(subg + 32 + dv);
                u32x2 o0, o1; o0.x = pk_bf16(d0[4 * rg] * rs * g0[0], d0[4 * rg + 1] * rs * g0[1]); o0.y = pk_bf16(d0[4 * rg + 2] * rs * g0[2], d0[4 * rg + 3] * rs * g0[3]);
                o1.x = pk_bf16(d1[4 * rg] * rs * g1[0], d1[4 * rg + 1] * rs * g1[1]); o1.y = pk_bf16(d1[4 * rg + 2] * rs * g1[2], d1[4 * rg + 3] * rs * g1[3]);
                *(u32x2*)(yp + dv) = o0; *(u32x2*)(yp + 32 + dv) = o1; }
        }
    }
}

constexpr int RT_W = 0;
constexpr int RT_REC = 147456;
constexpr int RT_LP = RT_REC + 304 * 16;
constexpr int RT_CNT = RT_LP + 304 * 8;
static_assert(RT_CNT + 256 <= LDS_BARW, "route LDS");
__device__ __forceinline__ void ffn_route(const Frame& F, int l, int nrows) {
    LAS float* Wt = (LAS float*)(F.lds + RT_W); LAS i32x4* rec = (LAS i32x4*)(F.lds + RT_REC); LAS i32x2* lp = (LAS i32x2*)(F.lds + RT_LP);
    LAS int* lcnt = (LAS int*)(F.lds + RT_CNT); LAS int* lbase = lcnt + 32;
    const float* wrg = F.in(I_WRG) + (size_t)l * D * 4; const float* wre = F.in(I_WRE) + (size_t)l * D * 32;
    const float* brg = F.in(I_BRG) + l * 4; const float* bre = F.in(I_BRE) + l * 32;
    __syncthreads();
    for (int i = F.tid; i < 1024 * 4; i += NTHREADS) { const int k = i >> 2, j = i & 3; Wt[j * 1024 + k] = wrg[i]; }
    for (int i = F.tid; i < 1024 * 32; i += NTHREADS) { const int k = i >> 5, j = i & 31; Wt[(4 + j) * 1024 + k] = wre[i]; }
    if (F.tid < 32) lcnt[F.tid] = 0;
    __syncthreads();
    const float* modp = (const float*)(F.ws_() + WS_MOD) + (size_t)l * 33 * (NMOD * D) + 3 * D;
    const float* gn = F.in(I_GFFN) + (size_t)l * D;
    int nrec = 0;
    for (int row = F.bid * 8 + F.wave; row < nrows; row += F.G * 8, ++nrec) {
        const bool isc = row >= TL; const int b = isc ? 32 : (row >> 11);
        const float* xr = isc ? (const float*)(F.ws_() + WS_XC) + (size_t)(row - TL) * D : F.out() + (size_t)row * D;
        f32x4 v[4];
#pragma unroll
        for (int i = 0; i < 4; ++i) v[i] = *(const f32x4*)(xr + i * 256 + 4 * F.lane);
        float ss = 0.f;
#pragma unroll
        for (int i = 0; i < 4; ++i) ss += v[i][0] * v[i][0] + v[i][1] * v[i][1] + v[i][2] * v[i][2] + v[i][3] * v[i][3];
        ss = wave_sum(ss);
        const float rstd = rsqrtf(ss * (1.0f / D) + EPS);
        const float* sh = modp + (size_t)b * (NMOD * D); const float* scp = sh + D;
        bf16_t* hrow = (bf16_t*)(F.ws_() + WS_H) + (size_t)row * D;
#pragma unroll
        for (int i = 0; i < 4; ++i) { const f32x4 g = *(const f32x4*)(gn + i * 256 + 4 * F.lane), s1 = *(const f32x4*)(sh + i * 256 + 4 * F.lane), s2 = *(const f32x4*)(scp + i * 256 + 4 * F.lane);
#pragma unroll
            for (int e = 0; e < 4; ++e) v[i][e] = v[i][e] * rstd * g[e] * (1.0f + s2[e]) + s1[e];
            u32x2 wv; wv.x = pk_bf16(v[i][0], v[i][1]); wv.y = pk_bf16(v[i][2], v[i][3]); *(u32x2*)(hrow + i * 256 + 4 * F.lane) = wv; }
        float lg[4];
#pragma unroll
        for (int j = 0; j < 4; ++j) { float s = 0.f;
#pragma unroll
            for (int i = 0; i < 4; ++i) { const f32x4 wq = *(const LAS f32x4*)(Wt + j * 1024 + i * 256 + 4 * F.lane); s += v[i][0] * wq[0] + v[i][1] * wq[1] + v[i][2] * wq[2] + v[i][3] * wq[3]; }
            lg[j] = wave_sum(s); }
        float g0 = lg[0] + brg[0], g1 = lg[1] + brg[1], g2 = lg[2] + brg[2], g3 = lg[3] + brg[3];
        int gi = 0; float gm = g0; if (g1 > gm) { gm = g1; gi = 1; } if (g2 > gm) { gm = g2; gi = 2; } if (g3 > gm) { gm = g3; gi = 3; }
        const float pgrp = 1.0f / (expf(g0 - gm) + expf(g1 - gm) + expf(g2 - gm) + expf(g3 - gm));
        float le[8];
        {   const LAS float* We = Wt + (4 + 8 * gi) * 1024;
#pragma unroll
            for (int e = 0; e < 8; ++e) { float s = 0.f;
#pragma unroll
                for (int i = 0; i < 4; ++i) { const f32x4 wq = *(const LAS f32x4*)(We + e * 1024 + i * 256 + 4 * F.lane); s += v[i][0] * wq[0] + v[i][1] * wq[1] + v[i][2] * wq[2] + v[i][3] * wq[3]; }
                le[e] = wave_sum(s) + bre[8 * gi + e]; } }
        int e0 = 0; float m0 = le[0];
#pragma unroll
        for (int e = 1; e < 8; ++e) if (le[e] > m0) { m0 = le[e]; e0 = e; }
        int e1 = -1; float m1 = -3.0e38f;
#pragma unroll
        for (int e = 0; e < 8; ++e) if (e != e0 && le[e] > m1) { m1 = le[e]; e1 = e; }
        const float x1 = expf(m1 - m0);
        const float w0 = pgrp / (1.0f + x1), w1 = pgrp * x1 / (1.0f + x1);
        if (F.lane == 0) { const int E0 = gi * 8 + e0, E1 = gi * 8 + e1; const int ri = nrec * 8 + F.wave;
            rec[ri] = (i32x4){E0, E1, __float_as_int(w0), __float_as_int(w1)};
            const int p0 = atomicAdd((int*)&lcnt[E0], 1), p1 = atomicAdd((int*)&lcnt[E1], 1); lp[ri] = (i32x2){p0, p1}; }
    }
    __syncthreads();
    if (F.tid < 32) lbase[F.tid] = (int)__hip_atomic_fetch_add(F.ctl + CW_CNT + l * 32 + F.tid, (unsigned)lcnt[F.tid], __ATOMIC_RELAXED, __HIP_MEMORY_SCOPE_AGENT);
    __syncthreads();
    int* tokof = (int*)(F.ws_() + WS_TOKOF); float* gateof = (float*)(F.ws_() + WS_GATEOF); i32x4* tokinf = (i32x4*)(F.ws_() + WS_TOKINF);
    for (int ri = F.tid; ri < 304; ri += NTHREADS) { const int k = ri >> 3, wv = ri & 7; const int row = F.bid * 8 + wv + k * F.G * 8;
        if (row < nrows) { const i32x4 rc = rec[ri]; const i32x2 q = lp[ri]; const int p0 = lbase[rc.x] + q.x, p1 = lbase[rc.y] + q.y;
            tokof[(size_t)rc.x * TT + p0] = row; gateof[(size_t)rc.x * TT + p0] = __int_as_float(rc.z);
            tokof[(size_t)rc.y * TT + p1] = row; gateof[(size_t)rc.y * TT + p1] = __int_as_float(rc.w);
            tokinf[row] = (i32x4){rc.x, p0, rc.y, p1}; } }
}

constexpr int MO_TS = 131072;
constexpr int MO_TE = MO_TS + 256;
static_assert(MO_TE + 640 <= LDS_BARW, "moe LDS");
namespace pg8 {
struct MoeOrder {
    static constexpr bool PREFETCH = true;
    const LAS int* ts; const LAS unsigned char* te; const unsigned* cnt; const int* tokof; int G, c, nunits; bool gather;
    __device__ __forceinline__ bool next(int i, Unit& u) const {
        const long L = (long)i * G + c; if (L >= nunits) return false;
        u.pn = (int)(L & 3); u.pm = (int)(L >> 2); u.e = te[u.pm]; return true;
    }
    __device__ __forceinline__ unsigned arow(const Unit& u, int r) const {
        if (!gather) return (unsigned)(u.pm * BM + r);
        const int pos = (u.pm - ts[u.e]) * BM + r;
        return pos < (int)cnt[u.e] ? (unsigned)tokof[(size_t)u.e * TT + pos] : 0u;
    }
};
struct EpiSwiGLU {
    static constexpr bool PERM = true;
    bf16_t* H; const float* gateof; const unsigned* cnt; const LAS int* ts;
    __device__ __forceinline__ void operator()(const f32x4 (&acc)[2][2][4][2], const Unit& u, int wr, int wc, int fr, int fq) const {
        const int r0 = wr * 64 + fr, col0 = u.pn * 128 + wc * 32 + 8 * fq; const int pbase = (u.pm - ts[u.e]) * BM; const int ce = (int)cnt[u.e];
        float gt[2][4];
#pragma unroll
        for (int ai = 0; ai < 2; ++ai)
#pragma unroll
            for (int m = 0; m < 4; ++m) { const int pos = pbase + r0 + ai * HALF + m * 16; gt[ai][m] = pos < ce ? gateof[(size_t)u.e * TT + pos] : 0.f; }
#pragma unroll
        for (int ai = 0; ai < 2; ++ai)
#pragma unroll
            for (int m = 0; m < 4; ++m) { const f32x4 g0 = acc[ai][0][m][0], g1 = acc[ai][0][m][1], u0 = acc[ai][1][m][0], u1 = acc[ai][1][m][1]; const float q = gt[ai][m];
                u32x4 w; w.x = pk_bf16(silu_f(g0[0]) * u0[0] * q, silu_f(g0[1]) * u0[1] * q); w.y = pk_bf16(silu_f(g0[2]) * u0[2] * q, silu_f(g0[3]) * u0[3] * q);
                w.z = pk_bf16(silu_f(g1[0]) * u1[0] * q, silu_f(g1[1]) * u1[1] * q); w.w = pk_bf16(silu_f(g1[2]) * u1[2] * q, silu_f(g1[3]) * u1[3] * q);
                *(u32x4*)(H + (size_t)(u.pm * BM + r0 + ai * HALF + m * 16) * DEXP + col0) = w; }
    }
};
struct EpiMoeOut {
    static constexpr bool PERM = true;
    bf16_t* O; const float* gateof; const unsigned* cnt; const LAS int* ts;
    __device__ __forceinline__ void operator()(const f32x4 (&acc)[2][2][4][2], const Unit& u, int wr, int wc, int fr, int fq) const {
        const int r0 = wr * 64 + fr, col0 = u.pn * BM + wc * 32 + 8 * fq; const int pbase = (u.pm - ts[u.e]) * BM; const int ce = (int)cnt[u.e];
#pragma unroll
        for (int ai = 0; ai < 2; ++ai)
#pragma unroll
            for (int m = 0; m < 4; ++m) { const int r = r0 + ai * HALF + m * 16; const int pos = pbase + r;
                const float gt = pos < ce ? gateof[(size_t)u.e * TT + pos] : 0.f;
                bf16_t* rowp = O + (size_t)(u.pm * BM + r) * D + col0;
#pragma unroll
                for (int bj = 0; bj < 2; ++bj) { const f32x4 v0 = acc[ai][bj][m][0] * gt, v1 = acc[ai][bj][m][1] * gt;
                    u32x4 w; w.x = pk_bf16(v0[0], v0[1]); w.y = pk_bf16(v0[2], v0[3]); w.z = pk_bf16(v1[0], v1[1]); w.w = pk_bf16(v1[2], v1[3]);
                    *(u32x4*)(rowp + bj * HALF) = w; } }
    }
};
}
__device__ __forceinline__ int moe_tables(const Frame& F, int l) {
    LAS int* ts = (LAS int*)(F.lds + MO_TS); LAS unsigned char* te = (LAS unsigned char*)(F.lds + MO_TE);
    __syncthreads();
    if (F.tid == 0) { int acc = 0; for (int e = 0; e < 32; ++e) { ts[e] = acc; acc += ((int)F.ctl[CW_CNT + l * 32 + e] + 255) >> 8; } ts[32] = acc; }
    __syncthreads();
    if (F.tid < 32) { for (int t = ts[F.tid]; t < ts[F.tid + 1]; ++t) te[t] = (unsigned char)F.tid; }
    __syncthreads();
    return ts[32];
}

__global__ void __launch_bounds__(NTHREADS, 2) fwd_kernel(Params prm) {
    extern __shared__ __attribute__((aligned(16))) unsigned char lds_raw[];
    Frame F; F.P = (KParams)__builtin_amdgcn_kernarg_segment_ptr(); F.lds = (LAS unsigned char*)lds_raw; F.wsg = prm.ws; F.tid = threadIdx.x; F.lane = F.tid & 63; F.wave = __builtin_amdgcn_readfirstlane(F.tid >> 6);
    F.G = gridDim.x; F.bid = blockIdx.x; F.ctl = (unsigned*)((unsigned char*)prm.ws + WS_CTL);
    if (F.tid < 4) ((LAS unsigned*)(F.lds + LDS_BARW))[F.tid] = 0u;
    __syncthreads();
    (void)xcd_barrier_post(F.ctl + CW_BAR, (volatile LAS unsigned*)(F.lds + LDS_BARW));
    int phase = 0;
#define OPQ() do { asm volatile("" : "+s"(F.wsg)); asm volatile("" : "+s"(F.P)); asm volatile("" : "+s"(F.ctl)); asm volatile("" : "+s"(F.bid)); asm volatile("" : "+s"(F.G)); \
        asm volatile("" : "+v"(F.tid)); F.lane = F.tid & 63; F.wave = __builtin_amdgcn_readfirstlane(F.tid >> 6); } while (0)
#define SEAM() do { OPQ(); XcdBarrier b2_; b2_.bar = F.ctl + CW_BAR; b2_.x = xb_xcc_id(); b2_.st = (volatile LAS unsigned*)(F.lds + LDS_BARW); xcd_barrier(b2_); if (++phase > STOP_AFTER) return; } while (0)

    OPQ(); if (PH(0)) { p0_mods(F); __syncthreads(); p0_rope(F); p0_transposes(F); p0_filters(F); p0_xc(F); }
    SEAM();
    OPQ(); if (PH(0)) p0_gr(F);
    SEAM();
    for (int l = 0; l < DEPTH; ++l) {
        const bool last = (l == DEPTH - 1);
        OPQ(); if (PH(1)) row_norm_phase<0>(F, l, l - 1, l == 0);
        for (int rep_ = 0; rep_ < REPN(2); ++rep_) { OPQ(); if (PH(2)) moe_weight_cvt(F, l); }
        SEAM();
        for (int rep_ = 0; rep_ < REPN(3); ++rep_) { OPQ(); if (PH(3)) {   pg8::Gemm g{(const bf16_t*)(F.ws_() + WS_H), (const bf16_t*)(F.ws_() + WS_WINT) + (size_t)l * DIN * D, D, 0};
            pg8::StaticOrder S; S.init(TT, DIN, F.G, F.bid);
            pg8::EpiBf16 E{(bf16_t*)(F.ws_() + WS_P), DIN};
            pg8::gemm_phase<pg8::EpiBf16, pg8::StaticOrder>(F.lds, g, S, E, F.tid); } }
        SEAM();
        for (int rep_ = 0; rep_ < REPN(4); ++rep_) { OPQ(); if (PH(4)) attn_pre(F, l); }
        for (int rep_ = 0; rep_ < REPN(5); ++rep_) { OPQ(); if (PH(5)) conf_phase(F, l, !last); }
        for (int rep_ = 0; rep_ < REPN(6); ++rep_) { OPQ(); if (PH(6)) hy_pre(F, l, !last); }
        for (int rep_ = 0; rep_ < REPN(7); ++rep_) { OPQ(); if (PH(7)) lru_seq(F, l, !last); }
        SEAM();
        for (int rep_ = 0; rep_ < REPN(8); ++rep_) { OPQ(); if (PH(8)) hy_conv<0>(F, l, !last); }
        for (int rep_ = 0; rep_ < REPN(9); ++rep_) { OPQ(); if (PH(9)) lru_comb(F, !last); }
        SEAM();
        for (int rep_ = 0; rep_ < REPN(10); ++rep_) { OPQ(); if (PH(10)) hy_conv<1>(F, l, !last); }
        for (int rep_ = 0; rep_ < REPN(11); ++rep_) { OPQ(); if (PH(11)) attn_phase(F, l, !last); }
        SEAM();
        OPQ(); if (PH(12)) {   pg8::Gemm g{(const bf16_t*)(F.ws_() + WS_Y), (const bf16_t*)(F.ws_() + WS_WOUTT) + (size_t)l * D * D, D, 0};
            pg8::StaticOrder S; S.init(last ? TL : TT, D, F.G, F.bid);
            pg8::EpiResid E{l == 0 ? F.in(I_X) : F.out(), F.out(), (float*)(F.ws_() + WS_XC), (const float*)(F.ws_() + WS_MOD) + (size_t)l * 33 * (NMOD * D) + 2 * D};
            pg8::gemm_phase<pg8::EpiResid, pg8::StaticOrder>(F.lds, g, S, E, F.tid); }
        SEAM();
        OPQ(); if (PH(13)) ffn_route(F, l, last ? TL : TT);
        SEAM();
        for (int rep_ = 0; rep_ < REPN(14); ++rep_) { OPQ(); if (PH(14)) {   const int ntile = moe_tables(F, l);
            pg8::MoeOrder S{(const LAS int*)(F.lds + MO_TS), (const LAS unsigned char*)(F.lds + MO_TE), F.ctl + CW_CNT + l * 32, (const int*)(F.ws_() + WS_TOKOF), F.G, (F.G % 8 == 0) ? (F.bid % 8) * (F.G / 8) + F.bid / 8 : F.bid, ntile * 4, true};
            pg8::Gemm g{(const bf16_t*)(F.ws_() + WS_H), (const bf16_t*)(F.ws_() + WS_MOEGU), D, (size_t)1024 * 1024 * 2};
            pg8::EpiSwiGLU E{(bf16_t*)(F.ws_() + WS_HID), (const float*)(F.ws_() + WS_GATEOF), F.ctl + CW_CNT + l * 32, (const LAS int*)(F.lds + MO_TS)};
            pg8::gemm_phase<pg8::EpiSwiGLU, pg8::MoeOrder>(F.lds, g, S, E, F.tid); } }
        SEAM();
        for (int rep_ = 0; rep_ < REPN(15); ++rep_) { OPQ(); if (PH(15)) {   const int ntile = moe_tables(F, l);
            pg8::MoeOrder S{(const LAS int*)(F.lds + MO_TS), (const LAS unsigned char*)(F.lds + MO_TE), F.ctl + CW_CNT + l * 32, (const int*)(F.ws_() + WS_TOKOF), F.G, (F.G % 8 == 0) ? (F.bid % 8) * (F.G / 8) + F.bid / 8 : F.bid, ntile * 4, false};
            pg8::Gemm g{(const bf16_t*)(F.ws_() + WS_HID), (const bf16_t*)(F.ws_() + WS_MOEDN), DEXP, (size_t)1024 * 512 * 2};
            pg8::EpiBf16 E{(bf16_t*)(F.ws_() + WS_O), D};
            pg8::gemm_phase<pg8::EpiBf16, pg8::MoeOrder>(F.lds, g, S, E, F.tid); } }
        SEAM();
    }
    OPQ(); if (PH(16)) row_norm_phase<2>(F, 0, DEPTH - 1, false);
    if (xb_ld(F.ctl + CW_BAR + XB_TMO) != 0u) {
        __syncthreads();
        for (int row = F.bid * 8 + F.wave; row < TL; row += F.G * 8) { float* xr = F.out() + (size_t)row * D;
            for (int i = 0; i < 4; ++i) *(f32x4*)(xr + i * 256 + 4 * F.lane) = (f32x4){0.f, 0.f, 0.f, 0.f}; }
    }
}

extern "C" void kernel_launch(void* const* d_in, const int* in_sizes, int n_in, void* d_out, int out_size, void* d_ws, size_t ws_size, hipStream_t stream) {
    static int grid = 0;
    if (!grid) {
        int dev = 0, cus = 0, per_cu = 0;
        hipGetDevice(&dev);
        hipDeviceGetAttribute(&cus, hipDeviceAttributeMultiprocessorCount, dev);
        hipFuncSetAttribute((const void*)fwd_kernel, hipFuncAttributeMaxDynamicSharedMemorySize, LDS_BYTES);
        hipOccupancyMaxActiveBlocksPerMultiprocessor(&per_cu, (const void*)fwd_kernel, NTHREADS, LDS_BYTES);
        if (per_cu < 1) fprintf(stderr, "kernel_launch: occupancy query says %d\n", per_cu);
        grid = cus > 0 ? cus : 256;
        if (ws_size < WS_END) fprintf(stderr, "kernel_launch: workspace too small: %zu < %zu\n", ws_size, (size_t)WS_END);
        if (n_in != 46) fprintf(stderr, "kernel_launch: expected 46 inputs, got %d\n", n_in);
    }
    hipMemsetAsync((char*)d_ws + WS_CTL, 0, CTL_BYTES, stream);
    Params p; memset(&p, 0, sizeof(p));
    for (int i = 0; i < 46 && i < n_in; ++i) p.in[i] = (const GAS float*)d_in[i];
    p.out = (GAS float*)d_out; p.ws = (GAS unsigned char*)d_ws;
    hipLaunchKernelGGL(fwd_kernel, dim3(grid), dim3(NTHREADS), LDS_BYTES, stream, p);
}
```

```cpp
#include <hip/hip_runtime.h>
#include <cstdio>
#include <cstdint>
#include <cstring>

#ifndef PH_MASK
#define PH_MASK 0xffffffffu
#endif
#define PH(k) ((PH_MASK >> (k)) & 1u)
#ifndef REP_MASK
#define REP_MASK 0u
#endif
#define REPN(k) (1 + (int)((REP_MASK >> (k)) & 1u))
#ifndef TIME_MASK
#define TIME_MASK 0u
#endif
#ifndef STOP_AFTER
#define STOP_AFTER 9999
#endif

#define LAS __attribute__((address_space(3)))
#define GAS __attribute__((address_space(1)))
typedef unsigned short bf16_t;
typedef short bf16x8 __attribute__((ext_vector_type(8)));
typedef float f32x4 __attribute__((ext_vector_type(4)));
typedef float f32x16 __attribute__((ext_vector_type(16)));
typedef unsigned u32x4 __attribute__((ext_vector_type(4)));
typedef unsigned u32x2 __attribute__((ext_vector_type(2)));
typedef int i32x4 __attribute__((ext_vector_type(4)));
typedef int i32x2 __attribute__((ext_vector_type(2)));
typedef int i32x8v __attribute__((ext_vector_type(8)));

constexpr int D = 1024, NB = 32, SEQ = 2048, LC = 256, DEPTH = 4;
constexpr int TL = NB * SEQ, TC = NB * LC, TT = TL + TC;
constexpr int DIN = 2560, NMOD = 6;
constexpr int OFF_B = 0, OFF_C = 768, OFF_A = 1280, OFF_D = 1792;
constexpr int NEXP = 32, DEXP = 512;
constexpr int MAXSLOT = 155648;
constexpr float EPS = 1e-6f;
constexpr int NTHREADS = 512;
constexpr int LDS_BYTES = 163840;
constexpr int LDS_BARW = LDS_BYTES - 16;

constexpr size_t MBy = 1ull << 20;
constexpr size_t WS_CTL   = 0;
constexpr size_t CTL_BYTES = 65536;
constexpr size_t WS_MOD   = WS_CTL + CTL_BYTES;
constexpr size_t WS_GG    = WS_MOD + 3328 * 1024;
constexpr size_t WS_RB    = WS_GG + 576 * 1024;
constexpr size_t WS_ROPE  = WS_MOD + 4 * MBy;
constexpr size_t WS_WINT  = WS_ROPE + 1 * MBy;
constexpr size_t WS_WOUTT = WS_WINT + 20 * MBy;
constexpr size_t WS_CPW   = WS_WOUTT + 8 * MBy;
constexpr size_t WS_LRUW  = WS_CPW + 1 * MBy;
constexpr size_t WS_FRAW  = WS_LRUW + 1 * MBy;
constexpr size_t WS_FEN   = WS_FRAW + 36 * MBy;
constexpr size_t WS_GR    = WS_FEN + 1 * MBy;
constexpr size_t WS_GRC   = WS_GR + 16 * MBy;
constexpr size_t WS_XB    = WS_GRC + 2 * MBy;
constexpr size_t WS_H     = WS_XB + 144 * MBy;
constexpr size_t WS_Y     = WS_H + 144 * MBy;
constexpr size_t WS_MOEGU = WS_Y + 144 * MBy;
constexpr size_t WS_MOEDN = WS_MOEGU + 64 * MBy;
constexpr size_t WS_TOKOF = WS_MOEDN + 32 * MBy;
constexpr size_t WS_GATEOF= WS_TOKOF + 9 * MBy;
constexpr size_t WS_TOKINF= WS_GATEOF + 9 * MBy;
constexpr size_t WS_LRUS  = WS_TOKINF + 2 * MBy;
constexpr size_t WS_LRUC  = WS_LRUS + 3 * MBy;
constexpr size_t WS_BIG   = WS_LRUC + 2 * MBy;
constexpr size_t WS_P     = WS_BIG;
constexpr size_t WS_UF    = WS_P + 360 * MBy;
constexpr size_t WS_Z1F   = WS_UF + 108 * MBy;
constexpr size_t WS_HID   = WS_BIG;
constexpr size_t WS_O     = WS_HID + 152 * MBy;
constexpr size_t WS_WIN8  = WS_Z1F + 36 * MBy;
constexpr size_t WS_END   = WS_WIN8 + 8 * MBy;
constexpr size_t WS_H8    = WS_Y;
constexpr size_t WS_HT    = WS_H;
constexpr size_t WS_KIMG  = WS_H + 72 * MBy;
constexpr size_t WS_VIMG  = WS_H + 108 * MBy;
static_assert(WS_O + 304 * MBy <= WS_END, "overlay");
static_assert(WS_END <= 1200 * MBy, "workspace budget");

constexpr int CW_BAR = 0;
constexpr int CW_CNT = 4096;
constexpr int CW_Q   = 4096 + 256;
constexpr int CW_MQ  = CW_Q + 16;

struct Params {
    const GAS float* in[46];
    GAS float* out;
    GAS unsigned char* ws;
};

typedef float f32x2 __attribute__((ext_vector_type(2)));
typedef __bf16 bf16x2v __attribute__((ext_vector_type(2)));
__device__ __forceinline__ unsigned pk_bf16(float lo, float hi) { const f32x2 v = {lo, hi}; const bf16x2v r = __builtin_convertvector(v, bf16x2v); return __builtin_bit_cast(unsigned, r); }
__device__ __forceinline__ bf16x8 pk8(const float (&v)[8]) { u32x4 w; w.x = pk_bf16(v[0], v[1]); w.y = pk_bf16(v[2], v[3]); w.z = pk_bf16(v[4], v[5]); w.w = pk_bf16(v[6], v[7]); return __builtin_bit_cast(bf16x8, w); }
__device__ __forceinline__ unsigned pk_fp8x4(float a, float b, float c, float d) {
    a = __builtin_amdgcn_fmed3f(a, -448.f, 448.f); b = __builtin_amdgcn_fmed3f(b, -448.f, 448.f); c = __builtin_amdgcn_fmed3f(c, -448.f, 448.f); d = __builtin_amdgcn_fmed3f(d, -448.f, 448.f);
    int p = __builtin_amdgcn_cvt_pk_fp8_f32(a, b, 0, false); p = __builtin_amdgcn_cvt_pk_fp8_f32(c, d, p, true); return (unsigned)p; }
__device__ __forceinline__ void dec_fp8x8(const u32x2 w, float (&x)[8]) {
    x[0] = __builtin_amdgcn_cvt_f32_fp8((int)w.x, 0); x[1] = __builtin_amdgcn_cvt_f32_fp8((int)w.x, 1); x[2] = __builtin_amdgcn_cvt_f32_fp8((int)w.x, 2); x[3] = __builtin_amdgcn_cvt_f32_fp8((int)w.x, 3);
    x[4] = __builtin_amdgcn_cvt_f32_fp8((int)w.y, 0); x[5] = __builtin_amdgcn_cvt_f32_fp8((int)w.y, 1); x[6] = __builtin_amdgcn_cvt_f32_fp8((int)w.y, 2); x[7] = __builtin_amdgcn_cvt_f32_fp8((int)w.y, 3); }
#define MFMA32(a, b, c) __builtin_amdgcn_mfma_f32_32x32x16_bf16((a), (b), (c), 0, 0, 0)
#define MFMA16(a, b, c) __builtin_amdgcn_mfma_f32_16x16x32_bf16((a), (b), (c), 0, 0, 0)
__device__ __forceinline__ float bf2f(bf16_t v) { return __uint_as_float(((unsigned)v) << 16); }
__device__ __forceinline__ float bflo(unsigned w) { return __uint_as_float(w << 16); }
__device__ __forceinline__ float bfhi(unsigned w) { return __uint_as_float(w & 0xffff0000u); }
__device__ __forceinline__ float silu_f(float v) { return v * __builtin_amdgcn_rcpf(1.0f + __expf(-v)); }
__device__ __forceinline__ float sigmoid_f(float v) { return __builtin_amdgcn_rcpf(1.0f + __expf(-v)); }
__device__ __forceinline__ float gelu_tanh_f(float v) { const float u = 0.7978845608028654f * (v + 0.044715f * v * v * v); const float t = 1.0f - 2.0f * __builtin_amdgcn_rcpf(1.0f + __expf(2.0f * u)); return 0.5f * v * (1.0f + t); }
__device__ __forceinline__ float wave_sum(float v) {
    v += __builtin_bit_cast(float, __builtin_amdgcn_update_dpp(0, __builtin_bit_cast(int, v), 0xB1, 0xF, 0xF, true));
    v += __builtin_bit_cast(float, __builtin_amdgcn_update_dpp(0, __builtin_bit_cast(int, v), 0x4E, 0xF, 0xF, true));
    v += __builtin_bit_cast(float, __builtin_amdgcn_update_dpp(0, __builtin_bit_cast(int, v), 0x141, 0xF, 0xF, true));
    v += __builtin_bit_cast(float, __builtin_amdgcn_update_dpp(0, __builtin_bit_cast(int, v), 0x140, 0xF, 0xF, true));
    const int iv = __builtin_bit_cast(int, v);
    return (__builtin_bit_cast(float, __builtin_amdgcn_readlane(iv, 0)) + __builtin_bit_cast(float, __builtin_amdgcn_readlane(iv, 16)))
         + (__builtin_bit_cast(float, __builtin_amdgcn_readlane(iv, 32)) + __builtin_bit_cast(float, __builtin_amdgcn_readlane(iv, 48)));
}

#define XB_TMO      128
#define XB_XCNT(j)  (256  + 64 * (j))
#define XB_XSUB(j)  (1280 + 64 * (j))
#define XB_XGEN(j)  (2304 + 64 * (j))
#define XB_TOP      3328
#define XB_TOPGEN   3392
#define XCD_BAR_WORDS 3456
#define XB_SPIN_CAP (1u << 18)
__device__ __forceinline__ unsigned xb_ld(unsigned* p)              { return __hip_atomic_load(p, __ATOMIC_RELAXED, __HIP_MEMORY_SCOPE_AGENT); }
__device__ __forceinline__ unsigned xb_add(unsigned* p, unsigned v) { return __hip_atomic_fetch_add(p, v, __ATOMIC_RELAXED, __HIP_MEMORY_SCOPE_AGENT); }
__device__ __forceinline__ unsigned xb_xcc_id() { return (unsigned)__builtin_amdgcn_s_getreg((3 << 11) | 20) & 0xFu; }
#define XB_SPIN(cond, bar) do { unsigned _sp = 0; while (cond) { __builtin_amdgcn_s_sleep(1); \
    if ((++_sp & 255u) == 0u) { if (xb_ld(&(bar)[XB_TMO])) break; if (_sp > XB_SPIN_CAP) { atomicAdd(&(bar)[XB_TMO], 1u); break; } } } } while (0)
struct XcdBarrier { unsigned* bar; unsigned x; volatile LAS unsigned* st; };
__device__ __forceinline__ XcdBarrier xcd_barrier_post(unsigned* bar, volatile LAS unsigned* st) {
    XcdBarrier b; b.bar = bar; b.x = xb_xcc_id(); b.st = st;
    if (threadIdx.x == 0) (void)xb_add(&bar[XB_XCNT(b.x)], 1u);
    return b;
}
__device__ __forceinline__ void xcd_barrier_complete(unsigned* bar, unsigned x, unsigned& nloc, unsigned& nx) {
    const unsigned G = gridDim.x * gridDim.y * gridDim.z;
    unsigned sum, cnt, mine, sp = 0u;
    for (;;) {
        sum = 0u; cnt = 0u; mine = 0u;
#pragma unroll
        for (unsigned j = 0; j < 16; ++j) { const unsigned c = xb_ld(&bar[XB_XCNT(j)]); sum += c; cnt += (c > 0u) ? 1u : 0u; mine = (j == x) ? c : mine; }
        if (sum == G) break;
        __builtin_amdgcn_s_sleep(1);
        if ((++sp & 255u) == 0u) { if (xb_ld(&bar[XB_TMO])) break; if (sp > XB_SPIN_CAP) { atomicAdd(&bar[XB_TMO], 1u); break; } }
    }
    nloc = mine > 0u ? mine : 1u; nx = cnt > 0u ? cnt : 1u;
}
__device__ __forceinline__ void xcd_barrier(const XcdBarrier& b) {
    asm volatile("s_waitcnt vmcnt(0)" ::: "memory");
    __syncthreads();
    if (threadIdx.x == 0) {
        unsigned* bar = b.bar;
        __builtin_amdgcn_s_waitcnt(0);
        unsigned nloc = b.st[0], nx = b.st[1];
        if (nloc == 0u) { xcd_barrier_complete(bar, b.x, nloc, nx); b.st[0] = nloc; b.st[1] = nx; }
        const unsigned old = xb_add(&bar[XB_XSUB(b.x)], 1u);
        const unsigned gen = old / nloc;
        if (old + 1u == (gen + 1u) * nloc) {
            __builtin_amdgcn_fence(__ATOMIC_RELEASE, "agent");
            asm volatile("s_waitcnt vmcnt(0)" ::: "memory");
            const unsigned og = xb_add(&bar[XB_TOP], 1u);
            const unsigned tg = og / nx;
            if (og + 1u == (tg + 1u) * nx) xb_add(&bar[XB_TOPGEN], 1u);
            else XB_SPIN(xb_ld(&bar[XB_TOPGEN]) == tg, bar);
            __builtin_amdgcn_fence(__ATOMIC_ACQUIRE, "agent");
            xb_add(&bar[XB_XGEN(b.x)], 1u);
            asm volatile("s_waitcnt vmcnt(0)" ::: "memory");
        } else {
            XB_SPIN(xb_ld(&bar[XB_XGEN(b.x)]) == gen, bar);
            __builtin_amdgcn_fence(__ATOMIC_ACQUIRE, "agent");
            asm volatile("s_waitcnt vmcnt(0)" ::: "memory");
        }
    }
    __syncthreads();
}

namespace pg8 {
constexpr int BM = 256, BK = 64, HALF = 128, HTB = HALF * BK * 2, STAGE_BYTES = 8 * HTB, NXCD = 8, WGM = 8;
__host__ __device__ __forceinline__ int lds_byte(int r, int c) { const int st = (r >> 4) * 2 + (c >> 5), rr = r & 15, cc = c & 31, ob = rr * 64 + cc * 2; return st * 1024 + (ob ^ (((ob >> 9) & 1) << 5)); }
__host__ __device__ __forceinline__ void stage_rc(int b, int& R, int& C) { const int st = b / 1024, sb = b % 1024, swz = sb ^ (((sb >> 9) & 1) << 5); R = (st >> 1) * 16 + swz / 64; C = (st & 1) * 32 + (swz % 64) / 2; }
__host__ __device__ __forceinline__ int perm32(int rho) { const int n = rho >> 4, i = rho & 15; return 8 * (i >> 2) + 4 * n + (i & 3); }

struct Unit { int pm, pn, e; };
struct Gemm { const bf16_t* A; const bf16_t* Bt; int K; size_t bstride; int sc_w, sc_a; };

struct StaticOrder {
    static constexpr bool PREFETCH = false;
    int nM, nN, nwg, G, c;
    __device__ void init(int M, int N, int G_, int c_) { nM = M / BM; nN = N / BM; nwg = nM * nN; G = G_; c = c_; }
    __device__ __forceinline__ bool next(int i, Unit& u) const {
        const long L = (long)i * G + c; if (L >= nwg) return false;
        int wgid = (int)L; { const int q = nwg / NXCD, r = nwg % NXCD, xcd = wgid % NXCD, off = wgid / NXCD; wgid = (xcd < r ? xcd * (q + 1) : r * (q + 1) + (xcd - r) * q) + off; }
        const int nig = WGM * nN, gid = wgid / nig, fm = gid * WGM, gsz = (nM - fm) < WGM ? (nM - fm) : WGM;
        u.pm = fm + ((wgid % nig) % gsz); u.pn = (wgid % nig) / gsz; u.e = 0; return true;
    }
    __device__ __forceinline__ unsigned arow(const Unit& u, int r) const { return (unsigned)(u.pm * BM + r); }
};

template <class Epi, class Sched, bool ALIGN_EPI = true, bool SP2 = true, bool FP8 = false>
__device__ __forceinline__ void gemm_phase(LAS unsigned char* lds, const Gemm g, const Sched& S, const Epi& E, const int tid_in) {
    const int tid = tid_in, wid = __builtin_amdgcn_readfirstlane(tid >> 6), lane = tid & 63, wr = wid >> 2, wc = wid & 3, fr = lane & 15, fq = lane >> 4;
    const int K = g.K, nt = K / BK;
    unsigned voffB[2];
#pragma unroll
    for (int i = 0; i < 2; ++i) { int R, C; stage_rc(tid * 16 + i * 8192, R, C); const int Rb = Epi::PERM ? ((R & ~31) + perm32(R & 31)) : R;
        voffB[i] = (unsigned)(Rb * K + C) * 2u; }
    const size_t kstep = (size_t)(BK * 2);
    const size_t hstep = (size_t)HALF * K * 2;
    const size_t tstep = 2 * hstep;
    const unsigned rowb = (unsigned)K * 2u;
    const unsigned ldsw = (unsigned)wid * 1024u;
    const int aoff = lds_byte(wr * 64 + fr, fq * 8), boff = lds_byte(wc * 32 + fr, fq * 8);
#define PG8_SA(b, h) (((b) * 2 + (h)) * HTB)
#define PG8_SB(b, h) ((4 + (b) * 2 + (h)) * HTB)
#define PG8_STAGE(bufoff, gbase, voff) do { _Pragma("unroll") for (int _i = 0; _i < 2; ++_i) \
        __builtin_amdgcn_global_load_lds((const unsigned*)((const char*)(gbase) + (voff)[_i]), (LAS unsigned*)(lds + (bufoff) + ldsw + _i * 8192), 16, 0, 0); } while (0)
#define PG8_RD8(dst8, addr) do { const u32x4 x0_ = *(const LAS u32x4*)(addr), x1_ = *(const LAS u32x4*)((addr) + 1024); \
        dst8 = (i32x8v){(int)x0_.x, (int)x0_.y, (int)x0_.z, (int)x0_.w, (int)x1_.x, (int)x1_.y, (int)x1_.z, (int)x1_.w}; } while (0)
#define PG8_LDA(dst, b, h) do { if constexpr (FP8) { _Pragma("unroll") for (int m = 0; m < 4; ++m) PG8_RD8(dst##8[m], lds + PG8_SA(b, h) + aoff + m * 2048); } \
        else { _Pragma("unroll") for (int m = 0; m < 4; ++m) _Pragma("unroll") for (int k = 0; k < 2; ++k) dst[m][k] = *(const LAS bf16x8*)(lds + PG8_SA(b, h) + aoff + m * 2048 + k * 1024); } } while (0)
#define PG8_LDB(dst, b, h) do { if constexpr (FP8) { _Pragma("unroll") for (int n = 0; n < 2; ++n) PG8_RD8(dst##8[n], lds + PG8_SB(b, h) + boff + n * 2048); } \
        else { _Pragma("unroll") for (int n = 0; n < 2; ++n) _Pragma("unroll") for (int k = 0; k < 2; ++k) dst[n][k] = *(const LAS bf16x8*)(lds + PG8_SB(b, h) + boff + n * 2048 + k * 1024); } } while (0)
#define PG8_MMA(ai, bj, At, Bt) do { __builtin_amdgcn_s_setprio(1); \
        if constexpr (FP8) { _Pragma("unroll") for (int m = 0; m < 4; ++m) _Pragma("unroll") for (int n = 0; n < 2; ++n) \
            acc[ai][bj][m][n] = __builtin_amdgcn_mfma_scale_f32_16x16x128_f8f6f4(Bt##8[n], At##8[m], acc[ai][bj][m][n], 0, 0, 0, g.sc_w, 0, g.sc_a); } \
        else { _Pragma("unroll") for (int m = 0; m < 4; ++m) _Pragma("unroll") for (int n = 0; n < 2; ++n) _Pragma("unroll") for (int k = 0; k < 2; ++k) \
            acc[ai][bj][m][n] = __builtin_amdgcn_mfma_f32_16x16x32_bf16(Bt[n][k], At[m][k], acc[ai][bj][m][n], 0, 0, 0); } \
        __builtin_amdgcn_s_setprio(0); } while (0)
#define PG8_WAIT_V(n) asm volatile("s_waitcnt vmcnt(" #n ")" ::: "memory")
#define PG8_WAIT_L(n) asm volatile("s_waitcnt lgkmcnt(" #n ")" ::: "memory")
#define PG8_BAR __builtin_amdgcn_s_barrier()
#define PG8_SCHED __builtin_amdgcn_sched_barrier(0)
    Unit cur, nxt; int ui = 0;
    if (!S.next(0, cur)) return;
    f32x4 acc[2][2][4][2];
#pragma unroll
    for (int a = 0; a < 2; ++a)
#pragma unroll
        for (int b = 0; b < 2; ++b)
#pragma unroll
            for (int m = 0; m < 4; ++m)
#pragma unroll
                for (int n = 0; n < 2; ++n) acc[a][b][m][n] = (f32x4){0.f, 0.f, 0.f, 0.f};
    bf16x8 At[4][2], B0[2][2], B1[2][2]; i32x8v At8[4], B08[2], B18[2];
    unsigned ca0[2], ca1[2], na0[2], na1[2];
#define PG8_AROWS(u, o0, o1) do { int _tz = tid_in; asm volatile("" : "+v"(_tz)); _Pragma("unroll") for (int _i = 0; _i < 2; ++_i) { int _R, _C; stage_rc(_tz * 16 + _i * 8192, _R, _C); \
        o0[_i] = S.arow(u, _R) * rowb + (unsigned)_C * 2u; o1[_i] = S.arow(u, HALF + _R) * rowb + (unsigned)_C * 2u; } } while (0)
    PG8_AROWS(cur, ca0, ca1);
    const char* Ab = (const char*)g.A;
    const char* cB = (const char*)g.Bt + (size_t)cur.e * g.bstride + (size_t)cur.pn * tstep;
    if constexpr (SP2) {
        PG8_STAGE(PG8_SB(0, 0), cB, voffB); PG8_STAGE(PG8_SB(0, 1), cB + hstep, voffB); PG8_STAGE(PG8_SA(0, 0), Ab, ca0); PG8_STAGE(PG8_SA(0, 1), Ab, ca1);
        if (wr == 1) PG8_BAR;
        PG8_WAIT_V(2); PG8_BAR;
        PG8_STAGE(PG8_SB(1, 0), cB + kstep, voffB); PG8_STAGE(PG8_SA(1, 0), Ab + kstep, ca0); PG8_STAGE(PG8_SB(1, 1), cB + hstep + kstep, voffB);
        PG8_WAIT_V(6); PG8_BAR;
    } else {
        PG8_STAGE(PG8_SB(0, 0), cB, voffB); PG8_STAGE(PG8_SA(0, 0), Ab, ca0); PG8_STAGE(PG8_SB(0, 1), cB + hstep, voffB); PG8_STAGE(PG8_SA(0, 1), Ab, ca1);
        if (wr == 1) PG8_BAR;
        PG8_WAIT_V(4); PG8_BAR;
        PG8_STAGE(PG8_SB(1, 0), cB + kstep, voffB); PG8_STAGE(PG8_SA(1, 0), Ab + kstep, ca0); PG8_STAGE(PG8_SB(1, 1), cB + hstep + kstep, voffB);
        PG8_WAIT_V(6); PG8_BAR;
    }
    for (;;) {
        const bool has_next = S.next(ui + 1, nxt);
        const char* nB = has_next ? (const char*)g.Bt + (size_t)nxt.e * g.bstride + (size_t)nxt.pn * tstep : cB;
        if (Sched::PREFETCH && has_next) PG8_AROWS(nxt, na0, na1);
#pragma unroll 1
        for (int t = 0; t < nt; t += 2) {
            const bool last = (t == nt - 2);
            const char* a1 = Ab + (size_t)(t + 1) * kstep;
            const char* a2 = last ? Ab : Ab + (size_t)(t + 2) * kstep; const char* b2 = last ? nB : cB + (size_t)(t + 2) * kstep;
            const char* a3 = a2 + kstep; const char* b3 = b2 + kstep;
            if constexpr (SP2) {
            PG8_LDB(B0, 0, 0); PG8_LDB(B1, 0, 1); PG8_SCHED; PG8_LDA(At, 0, 0); PG8_STAGE(PG8_SA(1, 1), a1, ca1);
            if (last && has_next) { if (Sched::PREFETCH) { ca0[0] = na0[0]; ca0[1] = na0[1]; ca1[0] = na1[0]; ca1[1] = na1[1]; } else PG8_AROWS(nxt, ca0, ca1); }
            PG8_WAIT_V(8); PG8_WAIT_L(0); PG8_BAR; PG8_MMA(0, 0, At, B0); PG8_MMA(0, 1, At, B1); PG8_BAR; PG8_SCHED;
            PG8_LDA(At, 0, 1); PG8_STAGE(PG8_SB(0, 0), b2, voffB); PG8_STAGE(PG8_SB(0, 1), b2 + hstep, voffB); PG8_STAGE(PG8_SA(0, 0), a2, ca0);
            PG8_WAIT_V(8); PG8_WAIT_L(0); PG8_BAR; PG8_MMA(1, 0, At, B0); PG8_MMA(1, 1, At, B1); PG8_BAR; PG8_SCHED;
            PG8_LDB(B0, 1, 0); PG8_LDB(B1, 1, 1); PG8_SCHED; PG8_LDA(At, 1, 0); PG8_STAGE(PG8_SA(0, 1), a2, ca1);
            PG8_WAIT_V(8); PG8_WAIT_L(0); PG8_BAR; PG8_MMA(0, 0, At, B0); PG8_MMA(0, 1, At, B1); PG8_BAR; PG8_SCHED;
            PG8_LDA(At, 1, 1); PG8_STAGE(PG8_SB(1, 0), b3, voffB); PG8_STAGE(PG8_SB(1, 1), b3 + hstep, voffB); PG8_STAGE(PG8_SA(1, 0), a3, ca0);
            PG8_WAIT_V(8); PG8_WAIT_L(0); PG8_BAR; PG8_MMA(1, 0, At, B0); PG8_MMA(1, 1, At, B1); PG8_BAR; PG8_SCHED;
            } else {
            PG8_LDB(B0, 0, 0); PG8_SCHED; PG8_LDA(At, 0, 0); PG8_STAGE(PG8_SA(1, 1), a1, ca1);
            if (last && has_next) { if (Sched::PREFETCH) { ca0[0] = na0[0]; ca0[1] = na0[1]; ca1[0] = na1[0]; ca1[1] = na1[1]; } else PG8_AROWS(nxt, ca0, ca1); }
            PG8_WAIT_L(8); PG8_BAR; PG8_WAIT_L(0); PG8_MMA(0, 0, At, B0); PG8_BAR; PG8_SCHED;
            PG8_LDB(B1, 0, 1); PG8_STAGE(PG8_SB(0, 0), b2, voffB);
            PG8_BAR; PG8_WAIT_L(0); PG8_MMA(0, 1, At, B1); PG8_BAR;
            PG8_LDA(At, 0, 1); PG8_STAGE(PG8_SA(0, 0), a2, ca0);
            PG8_BAR; PG8_WAIT_L(0); PG8_MMA(1, 0, At, B0); PG8_BAR; PG8_SCHED;
            PG8_STAGE(PG8_SB(0, 1), b2 + hstep, voffB);
            PG8_WAIT_V(6); PG8_BAR; PG8_MMA(1, 1, At, B1); PG8_BAR;
            PG8_LDB(B0, 1, 0); PG8_SCHED; PG8_LDA(At, 1, 0); PG8_STAGE(PG8_SA(0, 1), a2, ca1);
            PG8_WAIT_L(8); PG8_BAR; PG8_WAIT_L(0); PG8_MMA(0, 0, At, B0); PG8_BAR; PG8_SCHED;
            PG8_LDB(B1, 1, 1); PG8_STAGE(PG8_SB(1, 0), b3, voffB);
            PG8_BAR; PG8_WAIT_L(0); PG8_MMA(0, 1, At, B1); PG8_BAR;
            PG8_LDA(At, 1, 1); PG8_STAGE(PG8_SA(1, 0), a3, ca0);
            PG8_BAR; PG8_WAIT_L(0); PG8_MMA(1, 0, At, B0); PG8_BAR; PG8_SCHED;
            PG8_STAGE(PG8_SB(1, 1), b3 + hstep, voffB);
            PG8_WAIT_V(6); PG8_BAR; PG8_MMA(1, 1, At, B1); PG8_BAR;
            }
        }
        if constexpr (ALIGN_EPI) { if (wr == 0) PG8_BAR; }
        E(acc, cur, wr, wc, fr, fq);
        if (!has_next) break;
#pragma unroll
        for (int a = 0; a < 2; ++a)
#pragma unroll
            for (int b = 0; b < 2; ++b)
#pragma unroll
                for (int m = 0; m < 4; ++m)
#pragma unroll
                    for (int n = 0; n < 2; ++n) acc[a][b][m][n] = (f32x4){0.f, 0.f, 0.f, 0.f};
        cur = nxt; cB = nB; ++ui;
        if constexpr (ALIGN_EPI) { if (wr == 1) PG8_BAR; }
    }
    PG8_WAIT_V(0);
    if constexpr (!ALIGN_EPI) { if (wr == 0) PG8_BAR; }
    PG8_BAR;
#undef PG8_AROWS
#undef PG8_SA
#undef PG8_SB
#undef PG8_STAGE
#undef PG8_LDA
#undef PG8_RD8
#undef PG8_LDB
#undef PG8_MMA
#undef PG8_WAIT_V
#undef PG8_WAIT_L
#undef PG8_BAR
#undef PG8_SCHED
}

struct EpiBf16 {
    static constexpr bool PERM = true;
    bf16_t* O; int ldc;
    __device__ __forceinline__ void operator()(const f32x4 (&acc)[2][2][4][2], const Unit& u, int wr, int wc, int fr, int fq) const {
        const int row0 = u.pm * BM + wr * 64 + fr, col0 = u.pn * BM + wc * 32 + 8 * fq;
#pragma unroll
        for (int ai = 0; ai < 2; ++ai)
#pragma unroll
            for (int m = 0; m < 4; ++m) { bf16_t* rowp = O + (size_t)(row0 + ai * HALF + m * 16) * ldc + col0;
#pragma unroll
                for (int bj = 0; bj < 2; ++bj) { const f32x4 v0 = acc[ai][bj][m][0], v1 = acc[ai][bj][m][1];
                    u32x4 w; w.x = pk_bf16(v0[0], v0[1]); w.y = pk_bf16(v0[2], v0[3]); w.z = pk_bf16(v1[0], v1[1]); w.w = pk_bf16(v1[2], v1[3]);
                    *(u32x4*)(rowp + bj * HALF) = w; } }
    }
};
struct EpiFp8 {
    static constexpr bool PERM = true;
    unsigned char* O; int ldc; float sc;
    __device__ __forceinline__ void operator()(const f32x4 (&acc)[2][2][4][2], const Unit& u, int wr, int wc, int fr, int fq) const {
        const int row0 = u.pm * BM + wr * 64 + fr, col0 = u.pn * BM + wc * 32 + 8 * fq;
#pragma unroll
        for (int ai = 0; ai < 2; ++ai)
#pragma unroll
            for (int m = 0; m < 4; ++m) { unsigned char* rowp = O + (size_t)(row0 + ai * HALF + m * 16) * ldc + col0;
#pragma unroll
                for (int bj = 0; bj < 2; ++bj) { const f32x4 v0 = acc[ai][bj][m][0] * sc, v1 = acc[ai][bj][m][1] * sc;
                    u32x2 w; w.x = pk_fp8x4(v0[0], v0[1], v0[2], v0[3]); w.y = pk_fp8x4(v1[0], v1[1], v1[2], v1[3]);
                    *(u32x2*)(rowp + bj * HALF) = w; } }
    }
};
struct EpiResid {
    static constexpr bool PERM = true;
    bf16_t* xb; const float* mod2;
    __device__ __forceinline__ void operator()(const f32x4 (&acc)[2][2][4][2], const Unit& u, int wr, int wc, int fr, int fq) const {
        const int rowt = u.pm * BM; const bool isc = rowt >= TL;
        const float* gv = mod2 + (size_t)(isc ? 32 : (rowt >> 11)) * (NMOD * D);
        const int r0 = rowt + wr * 64 + fr, col0 = u.pn * BM + wc * 32 + 8 * fq;
        f32x4 g4[2][2];
#pragma unroll
        for (int bj = 0; bj < 2; ++bj)
#pragma unroll
            for (int n = 0; n < 2; ++n) g4[bj][n] = *(const f32x4*)(gv + col0 + bj * HALF + 4 * n);
#pragma unroll
        for (int ai = 0; ai < 2; ++ai)
#pragma unroll
            for (int m = 0; m < 4; ++m) { bf16_t* rowp = xb + (size_t)(r0 + ai * HALF + m * 16) * D + col0;
#pragma unroll
                for (int bj = 0; bj < 2; ++bj) { const u32x4 xv = *(const u32x4*)(rowp + bj * HALF);
                    const f32x4 v0 = acc[ai][bj][m][0] * g4[bj][0], v1 = acc[ai][bj][m][1] * g4[bj][1];
                    u32x4 w; w.x = pk_bf16(bflo(xv.x) + v0[0], bfhi(xv.x) + v0[1]); w.y = pk_bf16(bflo(xv.y) + v0[2], bfhi(xv.y) + v0[3]);
                    w.z = pk_bf16(bflo(xv.z) + v1[0], bfhi(xv.z) + v1[1]); w.w = pk_bf16(bflo(xv.w) + v1[2], bfhi(xv.w) + v1[3]);
                    *(u32x4*)(rowp + bj * HALF) = w; } }
    }
};
}

typedef const Params __attribute__((address_space(4)))* KParams;
struct Frame {
    KParams P; LAS unsigned char* lds; GAS unsigned char* wsg; int vcu;
    __device__ __forceinline__ unsigned char* ws_() const { return (unsigned char*)wsg; }
    __device__ __forceinline__ const float* in(int k) const { return (const float*)P->in[k]; }
    __device__ __forceinline__ float* out() const { return (float*)P->out; } int tid, lane, wave, G, bid;
    unsigned* ctl;
};

struct TrDesc { const float* src; int ld, k0, n0; bf16_t* dst; int ldd, drow0; int f8; };
__device__ __forceinline__ void tr_load(const Frame& F, const TrDesc& d, f32x4 (&v)[2]) {
    const int r = F.tid >> 4, c4 = F.tid & 15;
#pragma unroll
    for (int i = 0; i < 2; ++i) v[i] = *(const f32x4*)(d.src + (size_t)(d.k0 + r + 32 * i) * d.ld + d.n0 + 4 * c4);
}
__device__ __forceinline__ void tr_put(const Frame& F, LAS float* tile, const f32x4 (&v)[2]) {
    const int r = F.tid >> 4, c4 = F.tid & 15;
#pragma unroll
    for (int i = 0; i < 2; ++i)
#pragma unroll
        for (int e = 0; e < 4; ++e) tile[(r + 32 * i) * 65 + 4 * c4 + e] = v[i][e];
}
__device__ __forceinline__ void tr_out(const Frame& F, const LAS float* tile, const TrDesc& d) {
    const int n = F.tid >> 3, kq = F.tid & 7;
    float v[8];
#pragma unroll
    for (int j = 0; j < 8; ++j) v[j] = tile[(8 * kq + j) * 65 + n];
    if (d.f8) { u32x2 w; w.x = pk_fp8x4(v[0] * 64.f, v[1] * 64.f, v[2] * 64.f, v[3] * 64.f); w.y = pk_fp8x4(v[4] * 64.f, v[5] * 64.f, v[6] * 64.f, v[7] * 64.f);
        *(u32x2*)((unsigned char*)d.dst + (size_t)(d.drow0 + n) * d.ldd + d.k0 + 8 * kq) = w; return; }
    u32x4 w; w.x = pk_bf16(v[0], v[1]); w.y = pk_bf16(v[2], v[3]); w.z = pk_bf16(v[4], v[5]); w.w = pk_bf16(v[6], v[7]);
    *(u32x4*)(d.dst + (size_t)(d.drow0 + n) * d.ldd + d.k0 + 8 * kq) = w;
}
#define TR_PIPELINE(F, first, stride, count, DESC) do { \
    LAS float* tb0_ = (LAS float*)(F).lds; LAS float* tb1_ = tb0_ + 64 * 65; \
    int it_ = (first); \
    if (it_ < (count)) { TrDesc dc_ = DESC(it_); f32x4 rv_[2]; tr_load(F, dc_, rv_); int par_ = 0; \
        __syncthreads(); \
        for (;;) { LAS float* tb_ = par_ ? tb1_ : tb0_; tr_put(F, tb_, rv_); \
            const int nx_ = it_ + (stride); const bool mo_ = nx_ < (count); TrDesc dn_ = dc_; \
            if (mo_) { dn_ = DESC(nx_); tr_load(F, dn_, rv_); } \
            __syncthreads(); tr_out(F, tb_, dc_); \
            if (!mo_) break; dc_ = dn_; it_ = nx_; par_ ^= 1; } \
        __syncthreads(); } } while (0)

enum { I_X = 0, I_C, I_CTX, I_CCTX, I_WADA, I_BADA, I_GMIX, I_GFFN, I_WIN, I_WOUT, I_ACW, I_ACB, I_AWR, I_ABR, I_AWI, I_ABI, I_ALAM,
       I_LQ1, I_LK1, I_LQ2, I_LK2, I_SUBG, I_CCW, I_CCB, I_CLG, I_CLB, I_CWPW, I_CBPW, I_DCW, I_DCB, I_DWF1, I_DBF1, I_DFREQ, I_DWF2, I_DBF2, I_DWF3,
       I_DDECAY, I_DBIAS, I_WRG, I_BRG, I_WRE, I_BRE, I_WGATE, I_WUP, I_WDOWN, I_GFINAL };

__device__ __forceinline__ void p0_mods_item(const Frame& F, const int it) {
    LAS float* sS = (LAS float*)F.lds;
    LAS float* red = sS + 33 * 512;
    static_assert((33 * 512 + 8 * 33 * 64) * 4 <= LDS_BARW, "p0_mods LDS");
    const float* c = F.in(I_C); const float* cc = F.in(I_CCTX);
    {
        const int l = it / 96, col0 = (it % 96) * 64;
        const float* W = F.in(I_WADA) + (size_t)l * D * (NMOD * D);
        const int cq = F.tid & 31, ks = F.tid >> 5;
        float acc[33][2];
#pragma unroll
        for (int b = 0; b < 33; ++b) { acc[b][0] = 0.f; acc[b][1] = 0.f; }
        for (int kh = 0; kh < 2; ++kh) {
            __syncthreads();
            {   float cv[33];
                const int k = kh * 512 + F.tid;
#pragma unroll
                for (int b = 0; b < 33; ++b) cv[b] = (b < 32) ? c[b * 1024 + k] : cc[k];
                __builtin_amdgcn_sched_barrier(0);
#pragma unroll
                for (int b = 0; b < 33; ++b) sS[b * 512 + F.tid] = silu_f(cv[b]); }
            __syncthreads();
#pragma unroll 1
            for (int kb = 0; kb < 32; kb += 8) {
                f32x2 wv[8];
#pragma unroll
                for (int u = 0; u < 8; ++u) wv[u] = *(const f32x2*)(W + (size_t)(kh * 512 + ks * 32 + kb + u) * (NMOD * D) + col0 + 2 * cq);
#pragma unroll
                for (int b = 0; b < 33; ++b) { const f32x4 s0 = *(const LAS f32x4*)(sS + b * 512 + ks * 32 + kb), s1 = *(const LAS f32x4*)(sS + b * 512 + ks * 32 + kb + 4);
                    const float sv[8] = {s0[0], s0[1], s0[2], s0[3], s1[0], s1[1], s1[2], s1[3]};
#pragma unroll
                    for (int u = 0; u < 8; ++u) { acc[b][0] += sv[u] * wv[u][0]; acc[b][1] += sv[u] * wv[u][1]; } }
            }
        }
#pragma unroll
        for (int b = 0; b < 33; ++b) { acc[b][0] += __shfl_xor(acc[b][0], 32); acc[b][1] += __shfl_xor(acc[b][1], 32); }
        if (F.lane < 32) {
#pragma unroll
            for (int b = 0; b < 33; ++b) { red[(F.wave * 33 + b) * 64 + 2 * cq] = acc[b][0]; red[(F.wave * 33 + b) * 64 + 2 * cq + 1] = acc[b][1]; }
        }
        __syncthreads();
        float* mod = (float*)(F.ws_() + WS_MOD) + (size_t)l * 33 * (NMOD * D);
        const float* bada = F.in(I_BADA) + (size_t)l * (NMOD * D);
        for (int o = F.tid; o < 33 * 64; o += NTHREADS) { const int b = o >> 6, cl = o & 63; float s = 0.f;
#pragma unroll
            for (int w = 0; w < 8; ++w) s += red[(w * 33 + b) * 64 + cl];
            mod[(size_t)b * (NMOD * D) + col0 + cl] = s + bada[col0 + cl]; }
        __syncthreads();
    }
}

__device__ __forceinline__ void p0_rope(const Frame& F) {
    float* ct = (float*)(F.ws_() + WS_ROPE); float* st = ct + 2048 * 16;
    for (int i = F.bid * NTHREADS + F.tid; i < 2048 * 16; i += F.G * NTHREADS) {
        const int t = i >> 4, f = i & 15; const float inv = powf(10000.0f, -(float)(f & 7) / 8.0f);
        const float pos = (f < 8) ? (float)(t >> 6) : (float)(t & 63); const float a = pos * inv;
        ct[i] = cosf(a); st[i] = sinf(a);
    }
}

__device__ __forceinline__ TrDesc p0_tr_desc(const Frame& F, int it) {
    constexpr int N1 = 2560, N2 = N1 + 1024, N3 = N2 + 64, N4 = N3 + 128;
    TrDesc d;
    if (it >= N4) { const int j = it - N4, l = j / 320, r = j % 320, kt = r / 20, nt = r % 20;
        d = TrDesc{F.in(I_WIN) + (size_t)l * D * DIN, DIN, kt * 64, 512 + nt * 64, (bf16_t*)(F.ws_() + WS_WIN8 + (size_t)l * 1280 * 1024), 1024, nt * 64, 1}; return d; }
    if (it < N1) { const int l = it / 640, r = it % 640, kt = r / 40, nt = r % 40;
        const int n0 = nt * 64, pr = n0 < 512 ? n0 + 1280 : (n0 < 1792 ? n0 - 512 : n0);
        d = TrDesc{F.in(I_WIN) + (size_t)l * D * DIN, DIN, kt * 64, n0, (bf16_t*)(F.ws_() + WS_WINT) + (size_t)l * DIN * D, D, pr, 0}; }
    else if (it < N2) { const int j = it - N1, l = j / 256, r = j % 256, kt = r / 16, nt = r % 16;
        d = TrDesc{F.in(I_WOUT) + (size_t)l * D * D, D, kt * 64, nt * 64, (bf16_t*)(F.ws_() + WS_WOUTT) + (size_t)l * D * D, D, nt * 64, 0}; }
    else if (it < N3) { const int j = it - N2, l = j / 16, r = j % 16, kt = r / 4, nt = r % 4;
        d = TrDesc{F.in(I_CWPW) + (size_t)l * 256 * 256, 256, kt * 64, nt * 64, (bf16_t*)(F.ws_() + WS_CPW) + (size_t)l * 256 * 256, 256, nt * 64, 0}; }
    else { const int j = it - N3, gate = j / 64, m = j % 64;
        const int l = m / 8, dir = (m / 4) & 1, hd = m & 3;
        d = TrDesc{F.in(gate ? I_AWI : I_AWR) + (size_t)m * 4096, 64, 0, 0, (bf16_t*)(F.ws_() + WS_LRUW) + ((size_t)((l * 2 + dir) * 2 + gate) * 4 + hd) * 4096, 64, 0, 0}; }
    return d;
}
__device__ __forceinline__ void p0_transposes_chunk(const Frame& F, const int ck) {
#define P0_DESC(i) p0_tr_desc(F, (i))
    TR_PIPELINE(F, ck * 8, 1, ck * 8 + 8, P0_DESC);
#undef P0_DESC
}

__device__ __forceinline__ void p0_filter_item(const Frame& F, const int it) {
    LAS float* feats = (LAS float*)F.lds;
    LAS float* f1 = feats + 32 * 33;
    LAS float* f2 = f1 + 32 * 64;
    LAS float* tun = f2 + 32 * 64;
    {
        const int l = it / 72, ch = it % 72; const bool isc = ch >= 64; const int Lf = isc ? LC : SEQ; const int t0 = isc ? (ch - 64) * 32 : ch * 32;
        const float* wf1 = F.in(I_DWF1) + (size_t)l * 33 * 64; const float* bf1 = F.in(I_DBF1) + l * 64; const float* frq = F.in(I_DFREQ) + l * 64;
        const float* wf2 = F.in(I_DWF2) + (size_t)l * 64 * 64; const float* bf2 = F.in(I_DBF2) + l * 64;
        const float* wf3 = F.in(I_DWF3) + (size_t)l * 64 * 1024; const float* dec = F.in(I_DDECAY) + l * 1024;
        __syncthreads();
        for (int i = F.tid; i < 32 * 33; i += NTHREADS) { const int p = i / 33, f = i % 33; const float t = (float)(t0 + p);
            float v;
            if (f == 0) v = t / (float)(Lf - 1);
            else { const int bi = (f - 1) & 15; const float band = 1e-4f + (float)bi * ((15.0f - 1e-4f) / 15.0f);
                   const float ang = (6.283185307179586f / (float)Lf) * t * band; v = (f <= 16) ? cosf(ang) : -sinf(ang); }
            feats[i] = v; if (f == 0) tun[p] = v; }
        __syncthreads();
        for (int i = F.tid; i < 32 * 64; i += NTHREADS) { const int p = i >> 6, j = i & 63; float s = bf1[j];
            for (int f = 0; f < 33; ++f) s += feats[p * 33 + f] * wf1[f * 64 + j];
            f1[i] = sinf(frq[j] * s); }
        __syncthreads();
        for (int i = F.tid; i < 32 * 64; i += NTHREADS) { const int p = i >> 6, j = i & 63; float s = bf2[j];
            for (int f = 0; f < 64; ++f) s += f1[p * 64 + f] * wf2[f * 64 + j];
            f2[i] = sinf(frq[j] * s); }
        __syncthreads();
        {   const int c4 = (F.tid & 255) * 4, pg = F.tid >> 8;
            const f32x4 dc = *(const f32x4*)(dec + c4);
            float acc[16][4];
#pragma unroll
            for (int p = 0; p < 16; ++p) { acc[p][0] = 0.f; acc[p][1] = 0.f; acc[p][2] = 0.f; acc[p][3] = 0.f; }
#pragma unroll 2
            for (int k = 0; k < 64; ++k) { const f32x4 w = *(const f32x4*)(wf3 + (size_t)k * 1024 + c4);
#pragma unroll
                for (int p = 0; p < 16; ++p) { const float a = f2[(pg * 16 + p) * 64 + k]; acc[p][0] += a * w[0]; acc[p][1] += a * w[1]; acc[p][2] += a * w[2]; acc[p][3] += a * w[3]; } }
#pragma unroll
            for (int p = 0; p < 16; ++p) { const float tu = tun[pg * 16 + p];
#pragma unroll
                for (int e = 0; e < 4; ++e) acc[p][e] *= expf(-tu * fabsf(dc[e])); }
            float* rawt = (float*)(F.ws_() + WS_FRAW) + (size_t)l * 2304 * 1024 + (isc ? (size_t)1024 * 2048 : 0);
#pragma unroll
            for (int e = 0; e < 4; ++e) { float* dst = rawt + (size_t)(c4 + e) * Lf + t0 + pg * 16;
#pragma unroll
                for (int q = 0; q < 4; ++q) *(f32x4*)(dst + 4 * q) = (f32x4){acc[4 * q][e], acc[4 * q + 1][e], acc[4 * q + 2][e], acc[4 * q + 3][e]}; }
        }
    }
}

__device__ __forceinline__ void p0_xc_chunk(const Frame& F, const int ck) {
    u32x4* d = (u32x4*)(F.ws_() + WS_XB);
    const size_t nl8 = (size_t)TL * D / 8, base = (size_t)ck * 128 * D / 8;
#pragma unroll 2
    for (int q0 = 0; q0 < 32; q0 += 4) {
        f32x4 a[4], c[4];
#pragma unroll
        for (int u = 0; u < 4; ++u) { const size_t i = base + (size_t)(q0 + u) * NTHREADS + F.tid; const f32x4* sp = (i < nl8) ? (const f32x4*)F.in(I_X) + 2 * i : (const f32x4*)F.in(I_CTX) + 2 * (i - nl8); a[u] = sp[0]; c[u] = sp[1]; }
#pragma unroll
        for (int u = 0; u < 4; ++u) { const size_t i = base + (size_t)(q0 + u) * NTHREADS + F.tid; d[i] = (u32x4){pk_bf16(a[u][0], a[u][1]), pk_bf16(a[u][2], a[u][3]), pk_bf16(c[u][0], c[u][1]), pk_bf16(c[u][2], c[u][3])}; }
    }
}

__device__ __forceinline__ void p0_gr(const Frame& F) {
    LAS float* red = (LAS float*)F.lds;
    for (int it = F.bid; it < 2048 + 256; it += F.G) {
        const bool isc = it >= 2048; const int Lf = isc ? LC : SEQ;
        const int row = isc ? (it - 2048) * 8 + F.wave : it;
        const int c = row & 255, o = (row >> 8) & 1, l = row >> 9;
        const float* rawt = (const float*)(F.ws_() + WS_FRAW) + (size_t)l * 2304 * 1024 + (isc ? (size_t)1024 * 2048 : 0);
        const float* fw = rawt + (size_t)((2 * o) * 256 + c) * Lf; const float* bw = rawt + (size_t)((2 * o + 1) * 256 + c) * Lf;
        const int x0 = 8 * (isc ? F.lane : F.tid);
        float v[8]; float es = 0.f;
#pragma unroll
        for (int j = 0; j < 8; ++j) { const int x = x0 + j; v[j] = (x == 0) ? 0.f : (x <= Lf ? fw[Lf - x] : bw[x - Lf]); es += v[j] * v[j]; }
        es = wave_sum(es);
        if (!isc) { __syncthreads(); if (F.lane == 0) red[F.wave] = es; __syncthreads(); es = ((red[0] + red[1]) + (red[2] + red[3])) + ((red[4] + red[5]) + (red[6] + red[7])); }
        const float sc = rsqrtf(es + EPS);
        const float bias = F.in(I_DBIAS)[(size_t)l * 512 + o * 256 + c];
#pragma unroll
        for (int j = 0; j < 8; ++j) { v[j] *= sc; if (x0 + j == Lf) v[j] += bias; }
        bf16_t* G = isc ? (bf16_t*)(F.ws_() + WS_GRC) + (size_t)row * 512 : (bf16_t*)(F.ws_() + WS_GR) + (size_t)row * 4096;
        *(bf16x8*)(G + x0) = pk8(v);
    }
}

__device__ __forceinline__ void p0_rtab(const Frame& F) {
    for (int it = F.bid; it < 4 * 33; it += F.G) {
        const int l = it / 33, b = it % 33;
        const float* mod = (const float*)(F.ws_() + WS_MOD) + ((size_t)l * 33 + b) * (NMOD * D);
        const float* sh = mod + 3 * D; const float* sc = mod + 4 * D; const float* gn = F.in(I_GFFN) + (size_t)l * D;
        float* GG = (float*)(F.ws_() + WS_GG) + ((size_t)l * 33 + b) * D; float* RB = (float*)(F.ws_() + WS_RB) + ((size_t)l * 33 + b) * 48;
        for (int k = F.tid; k < D; k += NTHREADS) GG[k] = gn[k] * (1.0f + sc[k]);
        const float* wrg = F.in(I_WRG) + (size_t)l * D * 4; const float* wre = F.in(I_WRE) + (size_t)l * D * 32;
        for (int j = F.wave; j < 48; j += 8) {
            float s = 0.f;
            if (j < 36) { for (int k = F.lane; k < D; k += 64) s += sh[k] * (j < 32 ? wre[(size_t)k * 32 + j] : wrg[(size_t)k * 4 + (j - 32)]); }
            s = wave_sum(s);
            if (F.lane == 0) RB[j] = (j < 32) ? s + F.in(I_BRE)[l * 32 + j] : (j < 36 ? s + F.in(I_BRG)[l * 4 + (j - 32)] : 0.f);
        }
    }
}

template <int MODE>
__device__ __forceinline__ void row_norm_phase(const Frame& F, int l, int lprev, bool from_input) {
    const bool addmoe = (lprev >= 0);
    const float* modp = (const float*)(F.ws_() + WS_MOD) + (size_t)l * 33 * (NMOD * D);
    const float* modm = (const float*)(F.ws_() + WS_MOD) + (size_t)(lprev >= 0 ? lprev : 0) * 33 * (NMOD * D) + 5 * D;
    const float* gn = (MODE == 2) ? F.in(I_GFINAL) : F.in(I_GMIX) + (size_t)l * D;
    LAS int* rb = (LAS int*)(F.lds + 131072);
    if (addmoe) {
        if (F.tid == 0) { const unsigned* cnt = F.ctl + CW_CNT + lprev * 32; int acc = 0; for (int e = 0; e < 32; ++e) { rb[e] = acc; acc += ((int)cnt[e] + 255) / 256 * 256; } }
        __syncthreads();
    }
    const int nrows = (MODE == 2) ? TL : TT;
    const int RPB = (nrows + F.G - 1) / F.G, rbeg = F.bid * RPB, rend = (rbeg + RPB < nrows) ? rbeg + RPB : nrows;
    const unsigned char* O = F.ws_() + WS_O;
    const i32x4* tokinf = (const i32x4*)(F.ws_() + WS_TOKINF);
    const int lo4 = 4 * F.lane;
    f32x4 gq[4];
#pragma unroll
    for (int i = 0; i < 4; ++i) gq[i] = *(const f32x4*)(gn + i * 256 + lo4);
    f32x4 gmq[4], shq[4], scq[4]; int curb = -1;
#pragma unroll
    for (int i = 0; i < 4; ++i) { gmq[i] = (f32x4){0.f, 0.f, 0.f, 0.f}; shq[i] = gmq[i]; scq[i] = gmq[i]; }
    u32x2 xa[4]; unsigned oa[4], oc[4]; i32x4 tin = (i32x4){0, 0, 0, 0};
    bf16_t* XB = (bf16_t*)(F.ws_() + WS_XB);
#define RN_LOADX(r) do { const bf16_t* xp_ = XB + (size_t)(r) * D; _Pragma("unroll") for (int i = 0; i < 4; ++i) xa[i] = *(const u32x2*)(xp_ + i * 256 + lo4); } while (0)
#define RN_LOADO(ti_) do { const size_t r0_ = (size_t)(rb[(ti_).x] + (ti_).y), r1_ = (size_t)(rb[(ti_).z] + (ti_).w); \
        _Pragma("unroll") for (int i = 0; i < 4; ++i) { oa[i] = *(const unsigned*)(O + r0_ * D + i * 256 + lo4); oc[i] = *(const unsigned*)(O + r1_ * D + i * 256 + lo4); } } while (0)
    int row = rbeg + F.wave;
    if (row < rend) { RN_LOADX(row); if (addmoe) { const i32x4 t0 = tokinf[row]; RN_LOADO(t0); if (row + 8 < rend) tin = tokinf[row + 8]; } }
    for (; row < rend; row += 8) {
        f32x4 v[4]; unsigned a[4], c[4];
#pragma unroll
        for (int i = 0; i < 4; ++i) { v[i] = (f32x4){bflo(xa[i].x), bfhi(xa[i].x), bflo(xa[i].y), bfhi(xa[i].y)}; a[i] = oa[i]; c[i] = oc[i]; }
        if (row + 8 < rend) { RN_LOADX(row + 8); if (addmoe) { const i32x4 t1 = tin; RN_LOADO(t1); if (row + 16 < rend) tin = tokinf[row + 16]; } }
        const bool isc = row >= TL; const int b = isc ? 32 : (row >> 11);
        if (b != curb) { curb = b;
            if (addmoe) { const float* gm = modm + (size_t)b * (NMOD * D);
#pragma unroll
                for (int i = 0; i < 4; ++i) gmq[i] = *(const f32x4*)(gm + i * 256 + lo4); }
            if (MODE != 2) { const float* sh = modp + (size_t)b * (NMOD * D);
#pragma unroll
                for (int i = 0; i < 4; ++i) { shq[i] = *(const f32x4*)(sh + i * 256 + lo4); scq[i] = *(const f32x4*)(sh + D + i * 256 + lo4); } }
        }
        if (addmoe) {
#pragma unroll
            for (int i = 0; i < 4; ++i) { const int ai_ = (int)a[i], ci_ = (int)c[i];
                v[i][0] += gmq[i][0] * 0.0625f * (__builtin_amdgcn_cvt_f32_fp8(ai_, 0) + __builtin_amdgcn_cvt_f32_fp8(ci_, 0)); v[i][1] += gmq[i][1] * 0.0625f * (__builtin_amdgcn_cvt_f32_fp8(ai_, 1) + __builtin_amdgcn_cvt_f32_fp8(ci_, 1));
                v[i][2] += gmq[i][2] * 0.0625f * (__builtin_amdgcn_cvt_f32_fp8(ai_, 2) + __builtin_amdgcn_cvt_f32_fp8(ci_, 2)); v[i][3] += gmq[i][3] * 0.0625f * (__builtin_amdgcn_cvt_f32_fp8(ai_, 3) + __builtin_amdgcn_cvt_f32_fp8(ci_, 3)); }
            if (MODE != 2) { bf16_t* xw = XB + (size_t)row * D;
#pragma unroll
                for (int i = 0; i < 4; ++i) { u32x2 w; w.x = pk_bf16(v[i][0], v[i][1]); w.y = pk_bf16(v[i][2], v[i][3]); *(u32x2*)(xw + i * 256 + lo4) = w; }
            }
        }
        float ss = 0.f;
#pragma unroll
        for (int i = 0; i < 4; ++i) ss += v[i][0] * v[i][0] + v[i][1] * v[i][1] + v[i][2] * v[i][2] + v[i][3] * v[i][3];
        ss = wave_sum(ss);
        const float rstd = rsqrtf(ss * (1.0f / D) + EPS);
        if (MODE == 2) { float* xr = F.out() + (size_t)row * D;
#pragma unroll
            for (int i = 0; i < 4; ++i) { f32x4 o;
#pragma unroll
                for (int e = 0; e < 4; ++e) o[e] = v[i][e] * rstd * gq[i][e];
                *(f32x4*)(xr + i * 256 + lo4) = o; }
        } else {
            bf16_t* hrow = (bf16_t*)(F.ws_() + WS_H) + (size_t)row * D; unsigned char* h8 = F.ws_() + WS_H8 + (size_t)row * D;
#pragma unroll
            for (int i = 0; i < 4; ++i) { float o[4];
#pragma unroll
                for (int e = 0; e < 4; ++e) o[e] = v[i][e] * rstd * gq[i][e] * (1.0f + scq[i][e]) + shq[i][e];
                u32x2 w; w.x = pk_bf16(o[0], o[1]); w.y = pk_bf16(o[2], o[3]); *(u32x2*)(hrow + i * 256 + lo4) = w;
                *(unsigned*)(h8 + i * 256 + lo4) = pk_fp8x4(o[0], o[1], o[2], o[3]); }
        }
    }
#undef RN_LOADX
#undef RN_LOADO
}

__device__ __forceinline__ TrDesc moe_tr_desc(const Frame& F, int l, int it) {
    TrDesc d;
    if (it < 8192) { const int up = it >= 4096, j = it & 4095, e = j >> 7, r = j & 127, kt = r >> 3, nt = r & 7;
        const int n0 = nt * 64, drow0 = (n0 >> 7) * 256 + (up ? 128 : 0) + (n0 & 127) - n0;
        d = TrDesc{F.in(up ? I_WUP : I_WGATE) + ((size_t)l * 32 + e) * D * DEXP, DEXP, kt * 64, n0, (bf16_t*)(F.ws_() + WS_MOEGU + (size_t)e * 1024 * 1024), 1024, drow0 + n0, 1}; }
    else { const int j = it - 8192, e = j >> 7, r = j & 127, kt = r >> 4, nt = r & 15;
        d = TrDesc{F.in(I_WDOWN) + ((size_t)l * 32 + e) * DEXP * D, D, kt * 64, nt * 64, (bf16_t*)(F.ws_() + WS_MOEDN + (size_t)e * 1024 * 512), 512, nt * 64, 1}; }
    return d;
}
constexpr int MOE_TILES_P1 = 2048, MOE_CH_Q0 = 640, MOE_CH_Q1 = 640;
static_assert(MOE_TILES_P1 % 8 == 0 && MOE_TILES_P1 + 8 * (MOE_CH_Q0 + MOE_CH_Q1) == 12288, "MoE weight tiles");
__device__ __forceinline__ void moe_weight_cvt(const Frame& F, int l) {
#define MOE_DESC(i) moe_tr_desc(F, l, (i))
    TR_PIPELINE(F, F.bid, F.G, MOE_TILES_P1, MOE_DESC);
#undef MOE_DESC
}
__device__ __forceinline__ void moe_weight_cvt_queue(const Frame& F, int l, int q) {
#define MOE_DESC(i) moe_tr_desc(F, l, (i))
    const int base = MOE_TILES_P1 / 8 + (q ? MOE_CH_Q0 : 0), n = q ? MOE_CH_Q1 : MOE_CH_Q0;
    LAS int* qslot = (LAS int*)(F.lds + LDS_BARW - 16);
    for (;;) {
        __syncthreads();
        if (F.tid == 0) *qslot = (int)__hip_atomic_fetch_add(F.ctl + CW_MQ + l * 2 + q, 1u, __ATOMIC_RELAXED, __HIP_MEMORY_SCOPE_AGENT);
        __syncthreads();
        const int ck = *qslot;
        if (ck >= n) break;
        TR_PIPELINE(F, (base + ck) * 8, 1, (base + ck) * 8 + 8, MOE_DESC);
    }
#undef MOE_DESC
}

__device__ __forceinline__ void hy_pre(const Frame& F, int l, bool do_ctx) {
    constexpr int BST = 1154;
    static_assert(32 * BST * 2 <= LDS_BARW, "hy_pre LDS");
    LAS bf16_t* raw = (LAS bf16_t*)F.lds;
    const bf16_t* P = (const bf16_t*)(F.ws_() + WS_P);
    const float* cw = F.in(I_DCW) + (size_t)l * 3 * 768; const float* cb = F.in(I_DCB) + (size_t)l * 768;
    const int nlat = 128 * 12, nitems = nlat + (do_ctx ? 16 * 12 : 0);
    __syncthreads();
    for (int it = F.bid; it < nitems; it += F.G) {
        const bool isc = it >= nlat; const int jj = isc ? it - nlat : it; const int sblk = jj / 12, cgp = jj % 12;
        const int Lseg = isc ? LC : SEQ; const size_t tokbase = isc ? TL : 0;
        {   u32x4 vv[9];
#pragma unroll
            for (int j = 0; j < 9; ++j) { const int pc = F.tid + j * NTHREADS; const int b = pc / 144, r = (pc % 144) >> 3, q = pc & 7; const int t = sblk * 16 + r - 1;
                const int tc = (t >= 0 && t < Lseg) ? t : 0;
                vv[j] = *(const u32x4*)(P + (tokbase + (size_t)b * Lseg + tc) * DIN + OFF_D + cgp * 64 + q * 8); }
            __builtin_amdgcn_sched_barrier(0);
#pragma unroll
            for (int j = 0; j < 9; ++j) { const int pc = F.tid + j * NTHREADS; const int b = pc / 144, r = (pc % 144) >> 3, q = pc & 7; const int t = sblk * 16 + r - 1;
                const bool ok = t >= 0 && t < Lseg; const u32x4 v = vv[j];
                LAS unsigned* dst = (LAS unsigned*)(raw + b * BST + r * 64 + q * 8);
                dst[0] = ok ? v.x : 0u; dst[1] = ok ? v.y : 0u; dst[2] = ok ? v.z : 0u; dst[3] = ok ? v.w : 0u; }
        }
        __syncthreads();
        const int b = F.tid & 31, cs = F.tid >> 5;
        bf16_t* UF = (bf16_t*)(F.ws_() + WS_UF) + (isc ? (size_t)768 * 65536 : 0);
        const size_t chs = isc ? 8192 : 65536;
#pragma unroll 1
        for (int i = 0; i < 4; ++i) {
            const int chl = cs * 4 + i, ch = cgp * 64 + chl;
            const float w0 = cw[ch], w1 = cw[768 + ch], w2 = cw[1536 + ch], bb = cb[ch];
#pragma unroll
            for (int hh = 0; hh < 2; ++hh) {
                float x[10];
#pragma unroll
                for (int q = 0; q < 10; ++q) x[q] = bf2f(raw[b * BST + (8 * hh + q) * 64 + chl]);
                float u[8];
#pragma unroll
                for (int j = 0; j < 8; ++j) u[j] = bb + w0 * x[j] + w1 * x[j + 1] + w2 * x[j + 2];
                u32x4 w; w.x = pk_bf16(u[0], u[1]); w.y = pk_bf16(u[2], u[3]); w.z = pk_bf16(u[4], u[5]); w.w = pk_bf16(u[6], u[7]);
                *(u32x4*)(UF + (size_t)ch * chs + (((size_t)sblk * 2 + hh) * 32 + b) * 8) = w;
            }
        }
        __syncthreads();
    }
}

template <int ORDER>
__device__ __forceinline__ void hy_conv(const Frame& F, int l, bool do_ctx) {
    LAS bf16_t* Gl = (LAS bf16_t*)F.lds + F.wave * 4096;
    LAS bf16_t* stg = (LAS bf16_t*)(F.lds + 65536 + 1024);
    const int lane = F.lane, i31 = lane & 31, hh = lane >> 5;
    const int nlat = 256, nitems = nlat + (do_ctx ? 32 : 0);
    const bf16_t* UF0 = (const bf16_t*)(F.ws_() + WS_UF); bf16_t* Z10 = (bf16_t*)(F.ws_() + WS_Z1F);
    for (int it = F.vcu; it < nitems; it += F.G) {
        const bool isc = it >= nlat; const int cg = isc ? it - nlat : (it >> 3), tg = isc ? 0 : (it & 7);
        const int Lf = isc ? LC : SEQ; const int c = cg * 8 + F.wave;
        const bf16_t* Gg = isc ? (const bf16_t*)(F.ws_() + WS_GRC) + ((size_t)(l * 2 + ORDER) * 256 + c) * 512
                               : (const bf16_t*)(F.ws_() + WS_GR) + ((size_t)(l * 2 + ORDER) * 256 + c) * 4096;
        {   u32x4 gq[8];
#pragma unroll
            for (int i = 0; i < 8; ++i) { const int q = isc ? lane : lane + 64 * i; gq[i] = *(const u32x4*)(Gg + q * 8); }
#pragma unroll
            for (int i = 0; i < 8; ++i) { const int q = isc ? lane : lane + 64 * i; *(LAS u32x4*)(Gl + q * 8) = gq[i]; } }
        const size_t chs = isc ? 8192 : 65536;
        const bf16_t* UFb = UF0 + (isc ? (size_t)768 * 65536 : 0); bf16_t* Z1b = Z10 + (isc ? (size_t)256 * 65536 : 0);
        const bf16_t* zsrc = (ORDER == 0) ? UFb + (size_t)c * chs : Z1b + (size_t)c * chs;
        const bf16_t* gsrc = UFb + (size_t)(256 * (ORDER + 1) + c) * chs;
        const int t0 = tg * 256;
        f32x16 acc[8];
#pragma unroll
        for (int a = 0; a < 8; ++a)
#pragma unroll
            for (int r = 0; r < 16; ++r) acc[a][r] = 0.f;
        bf16x8 FR[8][2];
#define HY_FRAG(dst, xb) do { const LAS bf16_t* _g = Gl + (xb); _Pragma("unroll") for (int _j = 0; _j < 8; ++_j) dst[_j] = (short)_g[_j]; } while (0)
        const int xb0 = Lf - t0 - i31 + 8 * hh;
#pragma unroll
        for (int a = 0; a < 8; ++a)
#pragma unroll
            for (int ks = 0; ks < 2; ++ks) HY_FRAG(FR[a][ks], xb0 - 32 * a + 16 * ks);
        const int nkp = Lf / 32;
        bf16x8 Bn[2];
        const char* zp = (const char*)zsrc + hh * 512 + i31 * 16;
#define HY_BLOAD(dst, sq) do { _Pragma("unroll") for (int ks = 0; ks < 2; ++ks) dst[ks] = *(const bf16x8*)(zp + (size_t)(sq) * 64 + ks * 1024); } while (0)
        constexpr bool DEEP = (ORDER == 0);
        bf16x8 Bm[2];
        HY_BLOAD(Bn, 0); if (DEEP) HY_BLOAD(Bm, 32);
        for (int nb = 0; nb < nkp; nb += 8) {
#pragma unroll
            for (int u = 0; u < 8; ++u) {
                const int s0 = (nb + u) * 32;
                bf16x8 Bf[2];
                if (DEEP) {
#pragma unroll
                    for (int ks = 0; ks < 2; ++ks) { Bf[ks] = Bn[ks]; Bn[ks] = Bm[ks]; }
                    HY_BLOAD(Bm, s0 + 64);
                } else {
#pragma unroll
                    for (int ks = 0; ks < 2; ++ks) Bf[ks] = Bn[ks];
                    HY_BLOAD(Bn, s0 + 32);
                }
                __builtin_amdgcn_sched_barrier(0);
#pragma unroll
                for (int a = 7; a >= 0; --a)
#pragma unroll
                    for (int ks = 0; ks < 2; ++ks) acc[a] = MFMA32(FR[(a - u) & 7][ks], Bf[ks], acc[a]);
#pragma unroll
                for (int ks = 0; ks < 2; ++ks) HY_FRAG(FR[(7 - u) & 7][ks], xb0 + s0 + 32 + 16 * ks);
            }
        }
#undef HY_FRAG
#undef HY_BLOAD
        if (ORDER == 0) {
#pragma unroll
            for (int a = 0; a < 8; ++a)
#pragma unroll
                for (int rg = 0; rg < 4; ++rg) {
                    const size_t off = ((size_t)(((t0 >> 4) + 2 * a + (rg >> 1)) * 2 + (rg & 1)) * 32 + i31) * 8 + 4 * hh;
                    const u32x2 g = *(const u32x2*)(gsrc + off);
                    u32x2 w; w.x = pk_bf16(bflo(g.x) * acc[a][4 * rg], bfhi(g.x) * acc[a][4 * rg + 1]); w.y = pk_bf16(bflo(g.y) * acc[a][4 * rg + 2], bfhi(g.y) * acc[a][4 * rg + 3]);
                    *(u32x2*)(Z1b + (size_t)c * chs + off) = w;
                }
        } else {
            bf16_t* Y = (bf16_t*)(F.ws_() + WS_Y);
            const size_t tokbase = isc ? TL : 0;
#pragma unroll
            for (int a = 0; a < 8; ++a) {
                __syncthreads();
#pragma unroll
                for (int rg = 0; rg < 4; ++rg) {
                    const size_t off = ((size_t)(((t0 >> 4) + 2 * a + (rg >> 1)) * 2 + (rg & 1)) * 32 + i31) * 8 + 4 * hh;
                    const u32x2 g = *(const u32x2*)(gsrc + off);
                    float gv[4] = {bflo(g.x), bfhi(g.x), bflo(g.y), bfhi(g.y)};
#pragma unroll
                    for (int e = 0; e < 4; ++e) { const int tl = 8 * rg + 4 * hh + e; stg[(tl * 32 + i31) * 8 + F.wave] = (bf16_t)(pk_bf16(gv[e] * acc[a][4 * rg + e], 0.f) & 0xffffu); }
                }
                __syncthreads();
#pragma unroll
                for (int q = 0; q < 2; ++q) { const int pr = F.tid + q * NTHREADS, tl = pr >> 5, b = pr & 31;
                    const u32x4 v = *(const LAS u32x4*)(stg + pr * 8);
                    *(u32x4*)(Y + (tokbase + (size_t)b * Lf + t0 + 32 * a + tl) * D + 768 + cg * 8) = v; }
            }
            __syncthreads();
        }
    }
}

constexpr int LR_XR = 0;
constexpr int LR_UB = 17408;
constexpr int LR_WT = LR_UB + 18432;
constexpr int LR_A  = LR_WT + 18432;
constexpr int LR_B  = LR_A + 32768;
constexpr int LR_WS = LR_B + 32768;
static_assert(LR_WS + 4096 <= LDS_BARW, "LRU LDS");

__device__ __forceinline__ void lru_chunk_ab(const Frame& F, int l, int b, int hd, int dir, bool isc, int t_lo) {
    LAS bf16_t* xr = (LAS bf16_t*)(F.lds + LR_XR); LAS bf16_t* ub = (LAS bf16_t*)(F.lds + LR_UB); LAS bf16_t* wt = (LAS bf16_t*)(F.lds + LR_WT);
    LAS float* a_s = (LAS float*)(F.lds + LR_A); LAS float* b_s = (LAS float*)(F.lds + LR_B);
    const bf16_t* P = (const bf16_t*)(F.ws_() + WS_P);
    const int Lseg = isc ? LC : SEQ; const size_t tokbase = (isc ? (size_t)TL : 0) + (size_t)b * Lseg;
    __syncthreads();
    for (int pc = F.tid; pc < 134 * 8; pc += NTHREADS) { const int r = pc >> 3, q = pc & 7; const int t = t_lo - 3 + r;
        u32x4 v = (u32x4){0u, 0u, 0u, 0u};
        if (t >= 0 && t < Lseg) v = *(const u32x4*)(P + (tokbase + t) * DIN + OFF_A + hd * 64 + q * 8);
        *(LAS u32x4*)(xr + r * 64 + q * 8) = v; }
    {   const bf16_t* W = (const bf16_t*)(F.ws_() + WS_LRUW) + (size_t)(l * 2 + dir) * 2 * 4 * 4096;
        for (int pc = F.tid; pc < 2 * 64 * 8; pc += NTHREADS) { const int g = pc >> 9, n = (pc >> 3) & 63, q = pc & 7;
            *(LAS u32x4*)(wt + (g * 64 + n) * 72 + q * 8) = *(const u32x4*)(W + ((size_t)(g * 4 + hd) * 64 + n) * 64 + q * 8); } }
    __syncthreads();
    {
        const int ch = F.tid & 63, tq = F.tid >> 6; const int chg = hd * 64 + ch;
        const float* cw = F.in(I_ACW) + ((size_t)(l * 2 + dir) * 4) * 256 + chg; const float cb = F.in(I_ACB)[(size_t)(l * 2 + dir) * 256 + chg];
        const float w0 = cw[0], w1 = cw[256], w2 = cw[512], w3 = cw[768];
        const int r0 = tq * 16 + (dir ? 3 : 0);
        float x[19];
#pragma unroll
        for (int q = 0; q < 19; ++q) x[q] = bf2f(xr[(r0 + q) * 64 + ch]);
#pragma unroll
        for (int k = 0; k < 16; ++k) { const float u = cb + w0 * x[k] + w1 * x[k + 1] + w2 * x[k + 2] + w3 * x[k + 3];
            ub[(tq * 16 + k) * 72 + ch] = (bf16_t)(pk_bf16(u, 0.f) & 0xffffu); }
    }
    __syncthreads();
    {
        const int w = F.wave, lane = F.lane, row = lane & 15, kq = lane >> 4;
        bf16x8 Af[2];
#pragma unroll
        for (int ks = 0; ks < 2; ++ks) Af[ks] = *(const LAS bf16x8*)(ub + (16 * w + row) * 72 + 32 * ks + 8 * kq);
        const float* br = F.in(I_ABR) + (size_t)(l * 2 + dir) * 256 + hd * 64; const float* bi = F.in(I_ABI) + (size_t)(l * 2 + dir) * 256 + hd * 64;
        const float* lam = F.in(I_ALAM) + (size_t)(l * 2 + dir) * 256 + hd * 64;
#pragma unroll
        for (int nt = 0; nt < 4; ++nt) {
            f32x4 cr = (f32x4){0.f, 0.f, 0.f, 0.f}, ci = cr;
#pragma unroll
            for (int ks = 0; ks < 2; ++ks) {
                const bf16x8 Br = *(const LAS bf16x8*)(wt + (0 * 64 + 16 * nt + row) * 72 + 32 * ks + 8 * kq);
                const bf16x8 Bi = *(const LAS bf16x8*)(wt + (1 * 64 + 16 * nt + row) * 72 + 32 * ks + 8 * kq);
                cr = MFMA16(Af[ks], Br, cr); ci = MFMA16(Af[ks], Bi, ci);
            }
            const int ch = 16 * nt + row;
            const float sp = log1pf(__expf(-lam[ch])), brc = br[ch], bic = bi[ch];
#pragma unroll
            for (int r = 0; r < 4; ++r) { const int tl = 16 * w + 4 * kq + r;
                const float rr = sigmoid_f(cr[r] + brc), ii = sigmoid_f(ci[r] + bic);
                const float a = __expf(-8.0f * rr * sp);
                const float uv = bf2f(ub[tl * 72 + ch]);
                a_s[tl * 64 + ch] = a; b_s[tl * 64 + ch] = sqrtf(fmaxf(1.0f - a * a, 0.f)) * (ii * uv); }
        }
    }
    __syncthreads();
}

__device__ __forceinline__ void lru_s1(const Frame& F, int l) {
    LAS float* a_s = (LAS float*)(F.lds + LR_A); LAS float* b_s = (LAS float*)(F.lds + LR_B); LAS float* wsum = (LAS float*)(F.lds + LR_WS);
    float* SUM = (float*)(F.ws_() + WS_LRUS);
    for (int it = F.bid; it < 32 * 4 * 2 * 18; it += F.G) {
        int r = it; const int n = r % 18; r /= 18; const int dir = r & 1; r >>= 1; const int hd = r & 3; const int b = r >> 2;
        const bool isc = n < 2; const int tc = isc ? (dir ? 1 - n : n) : (dir ? 15 - (n - 2) : n - 2);
        lru_chunk_ab(F, l, b, hd, dir, isc, tc * 128);
        const int w = F.wave, ch = F.lane;
        float A = 1.f, Bv = 0.f;
#pragma unroll
        for (int k = 0; k < 16; ++k) { const int tl = dir ? 127 - 16 * w - k : 16 * w + k; const float a = a_s[tl * 64 + ch], bb = b_s[tl * 64 + ch]; Bv = a * Bv + bb; A *= a; }
        wsum[(w * 2 + 0) * 64 + ch] = A; wsum[(w * 2 + 1) * 64 + ch] = Bv;
        __syncthreads();
        if (w == 0) { float At = 1.f, Bt = 0.f;
#pragma unroll
            for (int q = 0; q < 8; ++q) { const float Aq = wsum[(q * 2) * 64 + ch], Bq = wsum[(q * 2 + 1) * 64 + ch]; Bt = Aq * Bt + Bq; At *= Aq; }
            float* dst = SUM + ((size_t)((b * 2 + dir) * 4 + hd) * 18 + n) * 128;
            dst[ch] = At; dst[64 + ch] = Bt; }
    }
}
__device__ __forceinline__ void lru_s2(const Frame& F) {
    const float* SUM = (const float*)(F.ws_() + WS_LRUS); float* CAR = (float*)(F.ws_() + WS_LRUC);
    if (F.wave != 0) return;
    for (int it = F.bid; it < 32 * 2 * 4; it += F.G) {
        float As[18], Bs[18];
#pragma unroll
        for (int n = 0; n < 18; ++n) { const float* s = SUM + ((size_t)it * 18 + n) * 128; As[n] = s[F.lane]; Bs[n] = s[64 + F.lane]; }
        float carry = 0.f;
#pragma unroll
        for (int n = 0; n < 18; ++n) { CAR[((size_t)it * 18 + n) * 64 + F.lane] = carry; carry = As[n] * carry + Bs[n]; }
    }
}
__device__ __forceinline__ void lru_s3(const Frame& F, int l, bool do_ctx) {
    LAS float* a_s = (LAS float*)(F.lds + LR_A); LAS float* b_s = (LAS float*)(F.lds + LR_B); LAS float* wsum = (LAS float*)(F.lds + LR_WS);
    const float* CAR = (const float*)(F.ws_() + WS_LRUC);
    const bf16_t* P = (const bf16_t*)(F.ws_() + WS_P); bf16_t* Y = (bf16_t*)(F.ws_() + WS_Y);
    const int nlat = 32 * 4 * 16, nitems = nlat + (do_ctx ? 32 * 4 * 2 : 0);
    for (int it = F.bid; it < nitems; it += F.G) {
        const bool isc = it >= nlat; int r = isc ? it - nlat : it; const int ntc = isc ? 2 : 16; const int tc = r % ntc; r /= ntc; const int hd = r & 3; const int b = r >> 2;
        const int w = F.wave, ch = F.lane;
        float hs[16];
#pragma unroll
        for (int k = 0; k < 16; ++k) hs[k] = 0.f;
#pragma unroll
        for (int dir = 0; dir < 2; ++dir) {
            lru_chunk_ab(F, l, b, hd, dir, isc, tc * 128);
            const int n = isc ? (dir ? 1 - tc : tc) : 2 + (dir ? 15 - tc : tc);
            float hl[16], ca[16]; float A = 1.f, Bv = 0.f;
#pragma unroll
            for (int kk = 0; kk < 16; ++kk) { const int k = dir ? 15 - kk : kk; const int tl = 16 * w + k; const float a = a_s[tl * 64 + ch], bb = b_s[tl * 64 + ch]; Bv = a * Bv + bb; A *= a; hl[k] = Bv; ca[k] = A; }
            wsum[(w * 2 + 0) * 64 + ch] = A; wsum[(w * 2 + 1) * 64 + ch] = Bv;
            __syncthreads();
            float s = CAR[((size_t)((b * 2 + dir) * 4 + hd) * 18 + n) * 64 + ch];
            const int myord = dir ? 7 - w : w;
#pragma unroll
            for (int q = 0; q < 8; ++q) { const int wq = dir ? 7 - q : q; if (q < myord) s = wsum[(wq * 2) * 64 + ch] * s + wsum[(wq * 2 + 1) * 64 + ch]; }
#pragma unroll
            for (int k = 0; k < 16; ++k) hs[k] += hl[k] + ca[k] * s;
        }
        const int Lseg = isc ? LC : SEQ; const size_t tokbase = (isc ? (size_t)TL : 0) + (size_t)b * Lseg + tc * 128 + 16 * w;
#pragma unroll
        for (int k = 0; k < 16; ++k) { const float xg = bf2f(P[(tokbase + k) * DIN + OFF_A + 256 + hd * 64 + ch]);
            Y[(tokbase + k) * D + hd * 64 + ch] = (bf16_t)(pk_bf16(hs[k] * gelu_tanh_f(xg), 0.f) & 0xffffu); }
    }
}


__device__ __forceinline__ void lru_seq(const Frame& F, int l, bool ctx_out) {
    LAS bf16_t* xr = (LAS bf16_t*)(F.lds + LR_XR); LAS bf16_t* ub = (LAS bf16_t*)(F.lds + LR_UB); LAS bf16_t* wt = (LAS bf16_t*)(F.lds + LR_WT);
    LAS float* a_s = (LAS float*)(F.lds + LR_A); LAS float* b_s = (LAS float*)(F.lds + LR_B); LAS float* wsum = (LAS float*)(F.lds + LR_WS);
    const bf16_t* P = (const bf16_t*)(F.ws_() + WS_P); bf16_t* HT = (bf16_t*)(F.ws_() + WS_HT);
    const int w = F.wave, lane = F.lane, row = lane & 15, kq = lane >> 4;
    for (int it = F.bid; it < 32 * 4 * 2; it += F.G) {
        const int dir = it & 1, hd = (it >> 1) & 3, b = it >> 3;
        __syncthreads();
        {   const bf16_t* W = (const bf16_t*)(F.ws_() + WS_LRUW) + (size_t)(l * 2 + dir) * 2 * 4 * 4096;
            for (int pc = F.tid; pc < 2 * 64 * 8; pc += NTHREADS) { const int g = pc >> 9, n = (pc >> 3) & 63, q = pc & 7;
                *(LAS u32x4*)(wt + (g * 64 + n) * 72 + q * 8) = *(const u32x4*)(W + ((size_t)(g * 4 + hd) * 64 + n) * 64 + q * 8); } }
        const int cch = F.tid & 63, ctq = F.tid >> 6; const int chg = hd * 64 + cch;
        const float* cw = F.in(I_ACW) + ((size_t)(l * 2 + dir) * 4) * 256 + chg; const float cb = F.in(I_ACB)[(size_t)(l * 2 + dir) * 256 + chg];
        const float w0 = cw[0], w1 = cw[256], w2 = cw[512], w3 = cw[768];
        float spv[4], brv[4], biv[4];
#pragma unroll
        for (int nt = 0; nt < 4; ++nt) { const int ch = hd * 64 + 16 * nt + row; const size_t o = (size_t)(l * 2 + dir) * 256 + ch;
            spv[nt] = log1pf(__expf(-F.in(I_ALAM)[o])); brv[nt] = F.in(I_ABR)[o]; biv[nt] = F.in(I_ABI)[o]; }
        float carry = 0.f;
        u32x4 pf[3];
#define LRS_GEO(n, isc_, tlo_) const bool isc_ = (n) < 2; const int tlo_ = 128 * (isc_ ? (dir ? 1 - (n) : (n)) : (dir ? 15 - ((n) - 2) : (n) - 2))
#define LRS_PREFETCH(n) do { LRS_GEO(n, ic_, tl_); const int Ls_ = ic_ ? LC : SEQ; const size_t tb_ = (ic_ ? (size_t)TL : 0) + (size_t)b * Ls_; \
            _Pragma("unroll") for (int u_ = 0; u_ < 3; ++u_) { const int pc_ = F.tid + u_ * NTHREADS; const int r_ = pc_ >> 3, q_ = pc_ & 7; const int t_ = tl_ - 3 + r_; \
                pf[u_] = (u32x4){0u, 0u, 0u, 0u}; if (pc_ < 134 * 8 && t_ >= 0 && t_ < Ls_) pf[u_] = *(const u32x4*)(P + (tb_ + t_) * DIN + OFF_A + hd * 64 + q_ * 8); } } while (0)
        LRS_PREFETCH(0);
#pragma unroll 1
        for (int n = 0; n < 18; ++n) {
            LRS_GEO(n, isc, t_lo);
            const int Lseg = isc ? LC : SEQ; const size_t tokbase = (isc ? (size_t)TL : 0) + (size_t)b * Lseg + t_lo;
#pragma unroll
            for (int u = 0; u < 3; ++u) { const int pc = F.tid + u * NTHREADS; if (pc < 134 * 8) *(LAS u32x4*)(xr + (pc >> 3) * 64 + (pc & 7) * 8) = pf[u]; }
            __syncthreads();
            {   const int r0 = ctq * 16 + (dir ? 3 : 0);
                float x[19];
#pragma unroll
                for (int q = 0; q < 19; ++q) x[q] = bf2f(xr[(r0 + q) * 64 + cch]);
#pragma unroll
                for (int k = 0; k < 16; ++k) { const float u = cb + w0 * x[k] + w1 * x[k + 1] + w2 * x[k + 2] + w3 * x[k + 3];
                    ub[(ctq * 16 + k) * 72 + cch] = (bf16_t)(pk_bf16(u, 0.f) & 0xffffu); }
            }
            __syncthreads();
            if (n + 1 < 18) LRS_PREFETCH(n + 1);
            {   bf16x8 Af[2];
#pragma unroll
                for (int ks = 0; ks < 2; ++ks) Af[ks] = *(const LAS bf16x8*)(ub + (16 * w + row) * 72 + 32 * ks + 8 * kq);
#pragma unroll
                for (int nt = 0; nt < 4; ++nt) {
                    f32x4 cr = (f32x4){0.f, 0.f, 0.f, 0.f}, ci = cr;
#pragma unroll
                    for (int ks = 0; ks < 2; ++ks) {
                        const bf16x8 Br = *(const LAS bf16x8*)(wt + (0 * 64 + 16 * nt + row) * 72 + 32 * ks + 8 * kq);
                        const bf16x8 Bi = *(const LAS bf16x8*)(wt + (1 * 64 + 16 * nt + row) * 72 + 32 * ks + 8 * kq);
                        cr = MFMA16(Af[ks], Br, cr); ci = MFMA16(Af[ks], Bi, ci);
                    }
                    const int ch = 16 * nt + row;
#pragma unroll
                    for (int r = 0; r < 4; ++r) { const int tl = 16 * w + 4 * kq + r;
                        const float rr = sigmoid_f(cr[r] + brv[nt]), ii = sigmoid_f(ci[r] + biv[nt]);
                        const float a = __expf(-8.0f * rr * spv[nt]);
                        const float uv = bf2f(ub[tl * 72 + ch]);
                        a_s[tl * 64 + ch] = a; b_s[tl * 64 + ch] = sqrtf(fmaxf(1.0f - a * a, 0.f)) * (ii * uv); }
                }
            }
            __syncthreads();
            float hl[16], ca[16]; float A = 1.f, Bv = 0.f;
#pragma unroll
            for (int kk = 0; kk < 16; ++kk) { const int tl = 16 * w + (dir ? 15 - kk : kk); const float a = a_s[tl * 64 + lane], bb = b_s[tl * 64 + lane]; Bv = a * Bv + bb; A *= a; hl[kk] = Bv; ca[kk] = A; }
            wsum[(w * 2 + 0) * 64 + lane] = A; wsum[(w * 2 + 1) * 64 + lane] = Bv;
            __syncthreads();
            float s = carry; const int myord = dir ? 7 - w : w;
#pragma unroll
            for (int q = 0; q < 8; ++q) { const int wq = dir ? 7 - q : q; const float Aq = wsum[(wq * 2) * 64 + lane], Bq = wsum[(wq * 2 + 1) * 64 + lane];
                if (q < myord) s = Aq * s + Bq; carry = Aq * carry + Bq; }
            if (!isc || ctx_out) {
                bf16_t* dst = HT + ((size_t)dir * TT + tokbase + 16 * w) * 256 + hd * 64 + lane;
#pragma unroll
                for (int kk = 0; kk < 16; ++kk) { const int k = dir ? 15 - kk : kk; dst[(size_t)k * 256] = (bf16_t)(pk_bf16(hl[kk] + ca[kk] * s, 0.f) & 0xffffu); }
            }
        }
#undef LRS_GEO
#undef LRS_PREFETCH
    }
}
__device__ __forceinline__ void lru_comb(const Frame& F, bool ctx_out) {
    const bf16_t* P = (const bf16_t*)(F.ws_() + WS_P); const bf16_t* HT = (const bf16_t*)(F.ws_() + WS_HT); bf16_t* Y = (bf16_t*)(F.ws_() + WS_Y);
    const size_t n = (size_t)(ctx_out ? TT : TL) * 32;
    for (size_t i = (size_t)F.bid * NTHREADS + F.tid; i < n; i += (size_t)F.G * NTHREADS) { const size_t rowi = i >> 5; const int c8 = (int)(i & 31) * 8;
        const u32x4 hf = *(const u32x4*)(HT + rowi * 256 + c8), hb = *(const u32x4*)(HT + ((size_t)TT + rowi) * 256 + c8), xg = *(const u32x4*)(P + rowi * DIN + OFF_A + 256 + c8);
        const unsigned hfa[4] = {hf.x, hf.y, hf.z, hf.w}, hba[4] = {hb.x, hb.y, hb.z, hb.w}, xga[4] = {xg.x, xg.y, xg.z, xg.w}; unsigned o[4];
#pragma unroll
        for (int e = 0; e < 4; ++e) o[e] = pk_bf16((bflo(hfa[e]) + bflo(hba[e])) * gelu_tanh_f(bflo(xga[e])), (bfhi(hfa[e]) + bfhi(hba[e])) * gelu_tanh_f(bfhi(xga[e])));
        *(u32x4*)(Y + rowi * D + c8) = (u32x4){o[0], o[1], o[2], o[3]}; }
}

constexpr int CF_GLU = 0;
constexpr int CF_CV  = 48128;
constexpr int CF_ACT = CF_CV + 65536;
static_assert(CF_ACT + 64 * 264 * 2 <= LDS_BARW, "conformer LDS");
#ifndef CONF_STEPS
#define CONF_STEPS 4
#endif
__device__ __forceinline__ void conf_phase(const Frame& F, int l, bool do_ctx) {
    LAS bf16_t* glu = (LAS bf16_t*)(F.lds + CF_GLU); LAS float* cv = (LAS float*)(F.lds + CF_CV); LAS bf16_t* act = (LAS bf16_t*)(F.lds + CF_ACT);
    const bf16_t* P = (const bf16_t*)(F.ws_() + WS_P); bf16_t* Y = (bf16_t*)(F.ws_() + WS_Y);
    const int nlat = TL / 64, nitems = nlat + (do_ctx ? TC / 64 : 0);
    const float* ccw = F.in(I_CCW) + (size_t)l * 31 * 256; const float* ccb = F.in(I_CCB) + (size_t)l * 256;
    const float* lng = F.in(I_CLG) + (size_t)l * 256; const float* lnb = F.in(I_CLB) + (size_t)l * 256; const float* bpw = F.in(I_CBPW) + (size_t)l * 256;
    const bf16_t* Wt = (const bf16_t*)(F.ws_() + WS_CPW) + (size_t)l * 65536;
    bf16x8 Aw[2][8];
#pragma unroll
    for (int nt = 0; nt < 2; ++nt)
#pragma unroll
        for (int ks = 0; ks < 8; ++ks) Aw[nt][ks] = *(const bf16x8*)(Wt + (size_t)(32 * F.wave + 16 * nt + (F.lane & 15)) * 256 + 32 * ks + 8 * (F.lane >> 4));
    for (int it = F.bid; it < nitems; it += F.G) {
        const bool isc = it >= nlat; const int tile = isc ? it - nlat : it; const int Lseg = isc ? LC : SEQ; const int tps = Lseg / 64;
        const int b = tile / tps, t0 = (tile % tps) * 64; const size_t tokbase = (isc ? (size_t)TL : 0) + (size_t)b * Lseg;
        __syncthreads();
        {   u32x2 rv[6], rg[6];
#pragma unroll
            for (int j = 0; j < 6; ++j) { const int pc = F.tid + j * NTHREADS; const int r = (pc >> 5) < 94 ? (pc >> 5) : 93, q = pc & 31; const int t = t0 - 15 + r;
                const int tc = (t >= 0 && t < Lseg) ? t : 0; const unsigned char* src = (const unsigned char*)P + (tokbase + tc) * (DIN * 2) + OFF_C + q * 8;
                rv[j] = *(const u32x2*)src; rg[j] = *(const u32x2*)(src + 256); }
            __builtin_amdgcn_sched_barrier(0);
#pragma unroll
            for (int j = 0; j < 6; ++j) { const int pc = F.tid + j * NTHREADS; const int r = pc >> 5, q = pc & 31; const int t = t0 - 15 + r;
                if (pc < 94 * 32) {
                    u32x4 o = (u32x4){0u, 0u, 0u, 0u};
                    if (t >= 0 && t < Lseg) { float v[8], g[8];
                        dec_fp8x8(rv[j], v); dec_fp8x8(rg[j], g);
                        o.x = pk_bf16(v[0] * sigmoid_f(g[0]), v[1] * sigmoid_f(g[1])); o.y = pk_bf16(v[2] * sigmoid_f(g[2]), v[3] * sigmoid_f(g[3]));
                        o.z = pk_bf16(v[4] * sigmoid_f(g[4]), v[5] * sigmoid_f(g[5])); o.w = pk_bf16(v[6] * sigmoid_f(g[6]), v[7] * sigmoid_f(g[7])); }
                    *(LAS u32x4*)(glu + r * 256 + q * 8) = o; } }
        }
        __syncthreads();
        if (CONF_STEPS < 2) continue;
        {   const int ch = F.tid & 255, tg = F.tid >> 8;
            const float cbv = ccb[ch];
            float wv[31];
#pragma unroll
            for (int j = 0; j < 31; ++j) wv[j] = ccw[j * 256 + ch];
#pragma unroll 1
            for (int kg = 0; kg < 4; ++kg) {
                float xs[38];
#pragma unroll
                for (int q = 0; q < 38; ++q) xs[q] = bf2f(glu[(32 * tg + 8 * kg + q) * 256 + ch]);
#pragma unroll
                for (int kk = 0; kk < 8; ++kk) { float a = cbv;
#pragma unroll
                    for (int j = 0; j < 31; ++j) a += wv[j] * xs[kk + j];
                    cv[(32 * tg + 8 * kg + kk) * 256 + ch] = a; }
            }
        }
        __syncthreads();
        if (CONF_STEPS < 3) continue;
        {
            const f32x4 g4 = *(const f32x4*)(lng + 4 * F.lane), b4 = *(const f32x4*)(lnb + 4 * F.lane);
#pragma unroll 1
            for (int q = 0; q < 8; ++q) { const int tk = 8 * F.wave + q; const f32x4 v = *(const LAS f32x4*)(cv + tk * 256 + 4 * F.lane);
                const float mu = wave_sum(v[0] + v[1] + v[2] + v[3]) * (1.0f / 256.0f);
                const float d0 = v[0] - mu, d1 = v[1] - mu, d2 = v[2] - mu, d3 = v[3] - mu;
                const float var = wave_sum(d0 * d0 + d1 * d1 + d2 * d2 + d3 * d3) * (1.0f / 256.0f);
                const float rs = rsqrtf(var + 1e-5f);
                const float y0 = silu_f(d0 * rs * g4[0] + b4[0]), y1 = silu_f(d1 * rs * g4[1] + b4[1]), y2 = silu_f(d2 * rs * g4[2] + b4[2]), y3 = silu_f(d3 * rs * g4[3] + b4[3]);
                u32x2 o; o.x = pk_bf16(y0, y1); o.y = pk_bf16(y2, y3); *(LAS u32x2*)(act + tk * 264 + 4 * F.lane) = o; }
        }
        __syncthreads();
        if (CONF_STEPS < 4) continue;
        {
            const int lane = F.lane, row = lane & 15, kq = lane >> 4;
            f32x4 acc[2][4];
#pragma unroll
            for (int nt = 0; nt < 2; ++nt)
#pragma unroll
                for (int tt = 0; tt < 4; ++tt) acc[nt][tt] = (f32x4){0.f, 0.f, 0.f, 0.f};
#pragma unroll
            for (int ks = 0; ks < 8; ++ks) {
                bf16x8 Bt[4];
#pragma unroll
                for (int tt = 0; tt < 4; ++tt) Bt[tt] = *(const LAS bf16x8*)(act + (16 * tt + row) * 264 + 32 * ks + 8 * kq);
#pragma unroll
                for (int nt = 0; nt < 2; ++nt)
#pragma unroll
                    for (int tt = 0; tt < 4; ++tt) acc[nt][tt] = MFMA16(Aw[nt][ks], Bt[tt], acc[nt][tt]);
            }
#pragma unroll
            for (int nt = 0; nt < 2; ++nt) { const int n0 = 32 * F.wave + 16 * nt + 4 * kq; const f32x4 bb = *(const f32x4*)(bpw + n0);
#pragma unroll
                for (int tt = 0; tt < 4; ++tt) { const f32x4 v = acc[nt][tt] + bb; u32x2 o; o.x = pk_bf16(v[0], v[1]); o.y = pk_bf16(v[2], v[3]);
                    *(u32x2*)(Y + (tokbase + t0 + 16 * tt + row) * D + 512 + n0) = o; } }
        }
    }
}

constexpr int AP_VT = 0;
__device__ __forceinline__ void attn_pre(const Frame& F, int l) {
    const bf16_t* P = (const bf16_t*)(F.ws_() + WS_P);
    const float* ropec = (const float*)(F.ws_() + WS_ROPE); const float* ropes = ropec + 2048 * 16;
    LAS bf16_t* vt = (LAS bf16_t*)(F.lds + AP_VT);
    const int skey = F.tid >> 2, scomp = (F.tid >> 1) & 1, shf = F.tid & 1;
    const int vkp = F.tid & 63, vg = F.tid >> 6;
    for (int it = F.bid; it < 32 * 4 * 18; it += F.G) {
        const int kt = it % 18, hd = (it / 18) & 3, b = it / 72;
        const bool kc = kt >= 16; const size_t kb = kc ? (size_t)TL + (size_t)b * LC + (kt - 16) * 128 : (size_t)b * SEQ + kt * 128;
        unsigned char* kimg = F.ws_() + WS_KIMG + (size_t)it * 16384; unsigned char* vimg = F.ws_() + WS_VIMG + (size_t)it * 16384;
        {   const unsigned char* kp = (const unsigned char*)P + (kb + skey) * (DIN * 2) + OFF_B + 256 + hd * 64 + scomp * 32 + 8 * shf;
            float x1[8], x2[8]; dec_fp8x8(*(const u32x2*)kp, x1); dec_fp8x8(*(const u32x2*)(kp + 16), x2);
            float o1[8], o2[8];
            if (!kc) { const int tpos = kt * 128 + skey; const float* cp = ropec + tpos * 16 + 8 * shf; const float* sp = ropes + tpos * 16 + 8 * shf;
#pragma unroll
                for (int j = 0; j < 8; ++j) { const float cs = cp[j], sn = sp[j]; o1[j] = x1[j] * cs - x2[j] * sn; o2[j] = x1[j] * sn + x2[j] * cs; } }
            else {
#pragma unroll
                for (int j = 0; j < 8; ++j) { o1[j] = x1[j]; o2[j] = x2[j]; } }
            const int sw = (skey >> 1) & 7, p0 = scomp * 4 + shf, p1 = p0 + 2;
            *(bf16x8*)(kimg + skey * 128 + ((p0 ^ sw) << 4)) = pk8(o1); *(bf16x8*)(kimg + skey * 128 + ((p1 ^ sw) << 4)) = pk8(o2); }
        {   const unsigned char* vp = (const unsigned char*)P + (kb + 2 * vkp) * (DIN * 2) + OFF_B + 512 + hd * 64 + 8 * vg;
            float va[8], vb[8]; dec_fp8x8(*(const u32x2*)vp, va); dec_fp8x8(*(const u32x2*)(vp + DIN * 2), vb);
            __syncthreads();
            LAS bf16_t* vd = vt + (8 * vg) * 136 + 2 * vkp;
#pragma unroll
            for (int e = 0; e < 8; ++e) *(LAS unsigned*)(vd + e * 136) = (__float_as_uint(va[e]) >> 16) | (__float_as_uint(vb[e]) & 0xffff0000u);
            __syncthreads();
#pragma unroll
            for (int u = 0; u < 2; ++u) { const int pc = F.tid + u * NTHREADS, dv = pc >> 4, pi = pc & 15, G = pi >> 1, h = pi & 1;
                const u32x2 lo = *(const LAS u32x2*)(vt + dv * 136 + 16 * G + 4 * h), hi = *(const LAS u32x2*)(vt + dv * 136 + 16 * G + 8 + 4 * h);
                *(u32x4*)(vimg + dv * 256 + ((pi ^ (dv & 15)) << 4)) = (u32x4){lo.x, lo.y, hi.x, hi.y}; }
        }
    }
}
constexpr int AT_K0 = 0, AT_V0 = 65536, AT_X = 0;
static_assert(AT_V0 + 65536 <= LDS_BARW, "attention LDS");
__device__ __forceinline__ void attn_phase(const Frame& F, int l, bool do_ctx) {
    const bf16_t* P = (const bf16_t*)(F.ws_() + WS_P); bf16_t* Y = (bf16_t*)(F.ws_() + WS_Y);
    const float* ropec = (const float*)(F.ws_() + WS_ROPE); const float* ropes = ropec + 2048 * 16;
    const int lane = F.lane, w = F.wave, i31 = lane & 31, hh = lane >> 5, qs = w >> 1, comp = w & 1;
    const float lam_init = (l == 0) ? 0.2f : (l == 1) ? 0.35550906759f : (l == 2) ? 0.47071301834f : 0.55605820419f;
    float lam;
    {   const float* q1 = F.in(I_LQ1) + l * 32; const float* k1 = F.in(I_LK1) + l * 32; const float* q2 = F.in(I_LQ2) + l * 32; const float* k2 = F.in(I_LK2) + l * 32;
        const float s1 = wave_sum(lane < 32 ? q1[i31] * k1[i31] : 0.f), s2 = wave_sum(lane < 32 ? q2[i31] * k2[i31] : 0.f);
        lam = expf(s1) - expf(s2) + lam_init; }
    const float* subg = F.in(I_SUBG) + l * 64;
    const int nlat = 32 * 4 * 16, nitems = nlat + (do_ctx ? 32 * 4 * 2 : 0);
    const float qscale = 0.17677669529663687f * 1.4426950408889634f;
    const int ksw = (i31 >> 1) & 7;
    const int koff0 = i31 * 128 + (((comp * 4 + hh) ^ ksw) << 4), koff1 = i31 * 128 + (((comp * 4 + 2 + hh) ^ ksw) << 4);
    for (int it = F.vcu; it < nitems; it += F.G) {
        const bool isc = it >= nlat; int r_ = isc ? it - nlat : it; const int nqb = isc ? 2 : 16; const int qb = r_ % nqb; r_ /= nqb; const int hd = r_ & 3; const int b = r_ >> 2;
        const int ntiles = isc ? 1 : 9, kt0 = isc ? 16 : 0;
        const size_t qtok = isc ? (size_t)TL + (size_t)b * LC + qb * 128 + qs * 32 + i31 : (size_t)b * SEQ + qb * 128 + qs * 32 + i31;
        const unsigned char* kimg = F.ws_() + WS_KIMG + ((size_t)(b * 4 + hd) * 18 + kt0) * 16384; const unsigned char* vimg = F.ws_() + WS_VIMG + ((size_t)(b * 4 + hd) * 18 + kt0) * 16384;
        bf16x8 Bq[2];
        {   const unsigned char* qp = (const unsigned char*)P + qtok * (DIN * 2) + OFF_B + hd * 64 + comp * 32 + 8 * hh;
            float x1[8], x2[8]; dec_fp8x8(*(const u32x2*)qp, x1); dec_fp8x8(*(const u32x2*)(qp + 16), x2);
            float o1[8], o2[8];
            if (!isc) { const int tpos = qb * 128 + qs * 32 + i31; const float* cp = ropec + tpos * 16 + 8 * hh; const float* sp = ropes + tpos * 16 + 8 * hh;
#pragma unroll
                for (int j = 0; j < 8; ++j) { const float cs = cp[j], sn = sp[j]; o1[j] = (x1[j] * cs - x2[j] * sn) * qscale; o2[j] = (x1[j] * sn + x2[j] * cs) * qscale; } }
            else {
#pragma unroll
                for (int j = 0; j < 8; ++j) { o1[j] = x1[j] * qscale; o2[j] = x2[j] * qscale; } }
            Bq[0] = pk8(o1); Bq[1] = pk8(o2); }
#define AT_DMA(kt, buf) do { _Pragma("unroll") for (int u_ = 0; u_ < 4; ++u_) { const int ch_ = (u_ * 8 + w) * 1024; \
            __builtin_amdgcn_global_load_lds((const unsigned*)(kimg + (size_t)(kt) * 32768 + ch_ + lane * 16), (LAS unsigned*)(F.lds + AT_K0 + (buf) * 32768 + ch_), 16, 0, 0); \
            __builtin_amdgcn_global_load_lds((const unsigned*)(vimg + (size_t)(kt) * 32768 + ch_ + lane * 16), (LAS unsigned*)(F.lds + AT_V0 + (buf) * 32768 + ch_), 16, 0, 0); } } while (0)
        __syncthreads();
        AT_DMA(0, 0);
        asm volatile("s_waitcnt vmcnt(0)" ::: "memory");
        __syncthreads();
        f32x16 O0, O1, negm;
#pragma unroll
        for (int r = 0; r < 16; ++r) { O0[r] = 0.f; O1[r] = 0.f; negm[r] = 0.f; }
        f32x2 lsum2 = {0.f, 0.f}; bool first = true;
        f32x16 S;
        {   const LAS unsigned char* K0 = F.lds + AT_K0; const bf16x8 Ak0 = *(const LAS bf16x8*)(K0 + koff0), Ak1 = *(const LAS bf16x8*)(K0 + koff1);
            S = MFMA32(Ak0, Bq[0], negm); S = MFMA32(Ak1, Bq[1], S); }
#define AT_EXPS() do { _Pragma("unroll") for (int r = 0; r < 16; ++r) p[r] = __builtin_amdgcn_exp2f(S[r]); \
                    const f32x2 q0_ = {p[0], p[1]}, q1_ = {p[2], p[3]}, q2_ = {p[4], p[5]}, q3_ = {p[6], p[7]}, q4_ = {p[8], p[9]}, q5_ = {p[10], p[11]}, q6_ = {p[12], p[13]}, q7_ = {p[14], p[15]}; \
                    asm("s_nop 0\n\tv_pk_add_f32 %0, %1, %2\n\tv_pk_add_f32 %0, %0, %3\n\tv_pk_add_f32 %0, %0, %4\n\tv_pk_add_f32 %0, %0, %5\n\tv_pk_add_f32 %0, %0, %6\n\tv_pk_add_f32 %0, %0, %7\n\tv_pk_add_f32 %0, %0, %8" \
                        : "=&v"(ps2) : "v"(q0_), "v"(q1_), "v"(q2_), "v"(q3_), "v"(q4_), "v"(q5_), "v"(q6_), "v"(q7_)); } while (0)
#define AT_SYNCQK(st) do { \
                if ((st) == 1) { __syncthreads(); if (more) AT_DMA(kt + 1, buf ^ 1); }            \
                if ((st) == 7) { asm volatile("s_waitcnt vmcnt(0)" ::: "memory"); __syncthreads(); }     \
                if ((st) < 7) { const bf16x8 Ak0 = *(const LAS bf16x8*)(Kl + ((st) + 1) * 4096 + koff0), Ak1 = *(const LAS bf16x8*)(Kl + ((st) + 1) * 4096 + koff1); \
                    Sn = MFMA32(Ak0, Bq[0], negm); Sn = MFMA32(Ak1, Bq[1], Sn); } \
                else if (more) { const bf16x8 Ak0 = *(const LAS bf16x8*)(Kn + koff0), Ak1 = *(const LAS bf16x8*)(Kn + koff1); \
                    Sn = MFMA32(Ak0, Bq[0], negm); Sn = MFMA32(Ak1, Bq[1], Sn); } \
                else Sn = negm; } while (0)
#define AT_LOOP(LATE) \
        for (int kt = 0; kt < ntiles; ++kt) { \
            const int buf = kt & 1; const bool more = kt + 1 < ntiles; \
            const LAS unsigned char* Kl = F.lds + AT_K0 + buf * 32768; const LAS unsigned char* Vl = F.lds + AT_V0 + buf * 32768; \
            const LAS unsigned char* Kn = F.lds + AT_K0 + (buf ^ 1) * 32768; \
            _Pragma("unroll") \
            for (int st = 0; st < 8; ++st) { \
                f32x16 Sn; \
                if (!(LATE)) AT_SYNCQK(st); \
                float p[16]; f32x2 ps2; \
                AT_EXPS(); \
                if (first || __any(!(ps2[0] + ps2[1] <= 4096.0f))) {     \
                    float mx = fmaxf(fmaxf(S[0], S[1]), S[2]); \
                    mx = fmaxf(fmaxf(mx, S[3]), S[4]); mx = fmaxf(fmaxf(mx, S[5]), S[6]); mx = fmaxf(fmaxf(mx, S[7]), S[8]); mx = fmaxf(fmaxf(mx, S[9]), S[10]); \
                    mx = fmaxf(fmaxf(mx, S[11]), S[12]); mx = fmaxf(fmaxf(mx, S[13]), S[14]); mx = fmaxf(mx, S[15]); \
                    const u32x2 sw = __builtin_amdgcn_permlane32_swap(__float_as_uint(mx), __float_as_uint(mx), false, false); \
                    const float mp = fmaxf(__uint_as_float(sw.x), __uint_as_float(sw.y)); \
                    const float d = first ? mp : fmaxf(mp, 0.f); \
                    const float alpha = __builtin_amdgcn_exp2f(-d); \
                    _Pragma("unroll") \
                    for (int r = 0; r < 16; ++r) { S[r] -= d; O0[r] *= alpha; O1[r] *= alpha; negm[r] -= d; if (!(LATE)) Sn[r] -= d; }     \
                    lsum2 *= (f32x2){alpha, alpha}; first = false; \
                    AT_EXPS(); \
                } \
                asm("v_pk_add_f32 %0, %1, %0" : "+v"(lsum2) : "v"(ps2)); \
                if (LATE) AT_SYNCQK(st); \
                _Pragma("unroll") \
                for (int s = 0; s < 2; ++s) { \
                    float pp[8]; \
                    _Pragma("unroll") \
                    for (int j = 0; j < 8; ++j) pp[j] = p[8 * s + j]; \
                    const bf16x8 Bp = pk8(pp); \
                    const int pi = 2 * (2 * (st & 3) + s) + hh;            \
                    _Pragma("unroll") \
                    for (int mt = 0; mt < 2; ++mt) { const bf16x8 av = *(const LAS bf16x8*)(Vl + (st >> 2) * 16384 + (32 * mt + i31) * 256 + ((pi ^ (i31 & 15)) << 4)); \
                        if (mt == 0) O0 = MFMA32(av, Bp, O0); else O1 = MFMA32(av, Bp, O1); } \
                } \
                S = Sn; \
            } \
        }
        if (w < 4) { AT_LOOP(false) } else { AT_LOOP(true) }
#undef AT_LOOP
#undef AT_SYNCQK
        __syncthreads();
#undef AT_DMA
#undef AT_EXPS
        const float lsum = lsum2[0] + lsum2[1]; const float ltot = lsum + __shfl_xor(lsum, 32); const float inv = __builtin_amdgcn_rcpf(ltot);
        LAS float* xch = (LAS float*)(F.lds + AT_X) + qs * 2048;
        if (comp == 1) {
#pragma unroll
            for (int r = 0; r < 16; ++r) { const int dv = (r & 3) + 8 * (r >> 2) + 4 * hh; xch[dv * 32 + i31] = O0[r] * inv; xch[(32 + dv) * 32 + i31] = O1[r] * inv; }
        }
        __syncthreads();
        if (comp == 0) {
            float d0[16], d1[16]; float ss = 0.f;
#pragma unroll
            for (int r = 0; r < 16; ++r) { const int dv = (r & 3) + 8 * (r >> 2) + 4 * hh;
                d0[r] = O0[r] * inv - lam * xch[dv * 32 + i31]; d1[r] = O1[r] * inv - lam * xch[(32 + dv) * 32 + i31]; ss += d0[r] * d0[r] + d1[r] * d1[r]; }
            ss += __shfl_xor(ss, 32);
            const float rs = rsqrtf(ss * (1.0f / 64.0f) + EPS) * (1.0f - lam_init);
            bf16_t* yp = Y + qtok * D + 256 + hd * 64;
#pragma unroll
            for (int rg = 0; rg < 4; ++rg) { const int dv = 8 * rg + 4 * hh; const f32x4 g0 = *(const f32x4*)(subg + dv), g1 = *(const f32x4*)(subg + 32 + dv);
                u32x2 o0, o1; o0.x = pk_bf16(d0[4 * rg] * rs * g0[0], d0[4 * rg + 1] * rs * g0[1]); o0.y = pk_bf16(d0[4 * rg + 2] * rs * g0[2], d0[4 * rg + 3] * rs * g0[3]);
                o1.x = pk_bf16(d1[4 * rg] * rs * g1[0], d1[4 * rg + 1] * rs * g1[1]); o1.y = pk_bf16(d1[4 * rg + 2] * rs * g1[2], d1[4 * rg + 3] * rs * g1[3]);
                *(u32x2*)(yp + dv) = o0; *(u32x2*)(yp + 32 + dv) = o1; }
        }
    }
}

constexpr int RT_W = 0;
constexpr int RT_WST = 1028;
constexpr int RT_REC = 36 * RT_WST * 4;
constexpr int RT_LP = RT_REC + 304 * 16;
constexpr int RT_CNT = RT_LP + 304 * 8;
static_assert(RT_CNT + 256 <= LDS_BARW, "route LDS");
__device__ __forceinline__ void ffn_route(const Frame& F, int l, int nrows) {
    LAS float* Wt = (LAS float*)(F.lds + RT_W); LAS i32x4* rec = (LAS i32x4*)(F.lds + RT_REC); LAS i32x2* lp = (LAS i32x2*)(F.lds + RT_LP);
    LAS int* lcnt = (LAS int*)(F.lds + RT_CNT); LAS int* lbase = lcnt + 32;
    const float* wrg = F.in(I_WRG) + (size_t)l * D * 4; const float* wre = F.in(I_WRE) + (size_t)l * D * 32;
    const float* brg = F.in(I_BRG) + l * 4; const float* bre = F.in(I_BRE) + l * 32;
    __syncthreads();
    for (int i = F.tid; i < 1024 * 4; i += NTHREADS) { const int k = i >> 2, j = i & 3; Wt[j * RT_WST + k] = wrg[i]; }
    for (int i = F.tid; i < 1024 * 32; i += NTHREADS) { const int k = i >> 5, j = i & 31; Wt[(4 + j) * RT_WST + k] = wre[i]; }
    if (F.tid < 32) lcnt[F.tid] = 0;
    __syncthreads();
    const float* modp = (const float*)(F.ws_() + WS_MOD) + (size_t)l * 33 * (NMOD * D) + 3 * D;
    const float* gn = F.in(I_GFFN) + (size_t)l * D;
    const int RPB = (nrows + F.G - 1) / F.G, rbeg = F.bid * RPB, rend = (rbeg + RPB < nrows) ? rbeg + RPB : nrows;
    const int lo4 = 4 * F.lane;
    f32x4 gq[4], shq[4], scq[4]; u32x2 xa[4]; int curb = -1;
    const bf16_t* XB = (const bf16_t*)(F.ws_() + WS_XB);
#pragma unroll
    for (int i = 0; i < 4; ++i) { gq[i] = *(const f32x4*)(gn + i * 256 + lo4); shq[i] = (f32x4){0.f, 0.f, 0.f, 0.f}; scq[i] = shq[i]; }
#define RT_LOADX(r) do { const bf16_t* xp_ = XB + (size_t)(r) * D; _Pragma("unroll") for (int i = 0; i < 4; ++i) xa[i] = *(const u32x2*)(xp_ + i * 256 + lo4); } while (0)
    int row = rbeg + F.wave;
    if (row < rend) RT_LOADX(row);
    for (; row < rend; row += 8) {
        const bool isc = row >= TL; const int b = isc ? 32 : (row >> 11);
        f32x4 v[4];
#pragma unroll
        for (int i = 0; i < 4; ++i) v[i] = (f32x4){bflo(xa[i].x), bfhi(xa[i].x), bflo(xa[i].y), bfhi(xa[i].y)};
        if (row + 8 < rend) RT_LOADX(row + 8);
        if (b != curb) { curb = b; const float* sh = modp + (size_t)b * (NMOD * D);
#pragma unroll
            for (int i = 0; i < 4; ++i) { shq[i] = *(const f32x4*)(sh + i * 256 + lo4); scq[i] = *(const f32x4*)(sh + D + i * 256 + lo4); } }
        float ss = 0.f;
#pragma unroll
        for (int i = 0; i < 4; ++i) ss += v[i][0] * v[i][0] + v[i][1] * v[i][1] + v[i][2] * v[i][2] + v[i][3] * v[i][3];
        ss = wave_sum(ss);
        const float rstd = rsqrtf(ss * (1.0f / D) + EPS);
        bf16_t* hrow = (bf16_t*)(F.ws_() + WS_H) + (size_t)row * D;
#pragma unroll
        for (int i = 0; i < 4; ++i) {
#pragma unroll
            for (int e = 0; e < 4; ++e) v[i][e] = v[i][e] * rstd * gq[i][e] * (1.0f + scq[i][e]) + shq[i][e];
            u32x2 wv; wv.x = pk_bf16(v[i][0], v[i][1]); wv.y = pk_bf16(v[i][2], v[i][3]); *(u32x2*)(hrow + i * 256 + lo4) = wv; }
        float lg[4];
#pragma unroll
        for (int j = 0; j < 4; ++j) { float s = 0.f;
#pragma unroll
            for (int i = 0; i < 4; ++i) { const f32x4 wq = *(const LAS f32x4*)(Wt + j * RT_WST + i * 256 + 4 * F.lane); s += v[i][0] * wq[0] + v[i][1] * wq[1] + v[i][2] * wq[2] + v[i][3] * wq[3]; }
            lg[j] = wave_sum(s); }
        float g0 = lg[0] + brg[0], g1 = lg[1] + brg[1], g2 = lg[2] + brg[2], g3 = lg[3] + brg[3];
        int gi = 0; float gm = g0; if (g1 > gm) { gm = g1; gi = 1; } if (g2 > gm) { gm = g2; gi = 2; } if (g3 > gm) { gm = g3; gi = 3; }
        const float pgrp = 1.0f / (expf(g0 - gm) + expf(g1 - gm) + expf(g2 - gm) + expf(g3 - gm));
        float le[8];
        {   const LAS float* We = Wt + (4 + 8 * gi) * RT_WST;
#pragma unroll
            for (int e = 0; e < 8; ++e) { float s = 0.f;
#pragma unroll
                for (int i = 0; i < 4; ++i) { const f32x4 wq = *(const LAS f32x4*)(We + e * RT_WST + i * 256 + 4 * F.lane); s += v[i][0] * wq[0] + v[i][1] * wq[1] + v[i][2] * wq[2] + v[i][3] * wq[3]; }
                le[e] = wave_sum(s) + bre[8 * gi + e]; } }
        int e0 = 0; float m0 = le[0];
#pragma unroll
        for (int e = 1; e < 8; ++e) if (le[e] > m0) { m0 = le[e]; e0 = e; }
        int e1 = -1; float m1 = -3.0e38f;
#pragma unroll
        for (int e = 0; e < 8; ++e) if (e != e0 && le[e] > m1) { m1 = le[e]; e1 = e; }
        const float x1 = expf(m1 - m0);
        const float w0 = pgrp / (1.0f + x1), w1 = pgrp * x1 / (1.0f + x1);
        if (F.lane == 0) { const int E0 = gi * 8 + e0, E1 = gi * 8 + e1; const int ri = row - rbeg;
            rec[ri] = (i32x4){E0, E1, __float_as_int(w0), __float_as_int(w1)};
            const int p0 = atomicAdd((int*)&lcnt[E0], 1), p1 = atomicAdd((int*)&lcnt[E1], 1); lp[ri] = (i32x2){p0, p1}; }
    }
    __syncthreads();
    if (F.tid < 32) lbase[F.tid] = (int)__hip_atomic_fetch_add(F.ctl + CW_CNT + l * 32 + F.tid, (unsigned)lcnt[F.tid], __ATOMIC_RELAXED, __HIP_MEMORY_SCOPE_AGENT);
    __syncthreads();
    int* tokof = (int*)(F.ws_() + WS_TOKOF); float* gateof = (float*)(F.ws_() + WS_GATEOF); i32x4* tokinf = (i32x4*)(F.ws_() + WS_TOKINF);
    for (int ri = F.tid; ri < 304; ri += NTHREADS) { const int row = rbeg + ri;
        if (row < rend) { const i32x4 rc = rec[ri]; const i32x2 q = lp[ri]; const int p0 = lbase[rc.x] + q.x, p1 = lbase[rc.y] + q.y;
            tokof[(size_t)rc.x * TT + p0] = row; gateof[(size_t)rc.x * TT + p0] = __int_as_float(rc.z);
            tokof[(size_t)rc.y * TT + p1] = row; gateof[(size_t)rc.y * TT + p1] = __int_as_float(rc.w);
            tokinf[row] = (i32x4){rc.x, p0, rc.y, p1}; } }
}


constexpr int RM_WST = 1032;
constexpr int RM_WHI = 0, RM_WLO = 36 * RM_WST * 2;
constexpr int RM_REC = 2 * 36 * RM_WST * 2;
constexpr int RM_LP = RM_REC + 304 * 16, RM_CNT = RM_LP + 304 * 8;
static_assert(RM_CNT + 256 <= LDS_BARW, "route LDS");
__device__ __forceinline__ float row_max16(float v) {
    v = fmaxf(v, __builtin_bit_cast(float, __builtin_amdgcn_update_dpp(0, __builtin_bit_cast(int, v), 0xB1, 0xF, 0xF, true)));
    v = fmaxf(v, __builtin_bit_cast(float, __builtin_amdgcn_update_dpp(0, __builtin_bit_cast(int, v), 0x4E, 0xF, 0xF, true)));
    v = fmaxf(v, __builtin_bit_cast(float, __builtin_amdgcn_update_dpp(0, __builtin_bit_cast(int, v), 0x141, 0xF, 0xF, true)));
    v = fmaxf(v, __builtin_bit_cast(float, __builtin_amdgcn_update_dpp(0, __builtin_bit_cast(int, v), 0x140, 0xF, 0xF, true)));
    return v;
}
__device__ __forceinline__ float row_sum16(float v) {
    v += __builtin_bit_cast(float, __builtin_amdgcn_update_dpp(0, __builtin_bit_cast(int, v), 0xB1, 0xF, 0xF, true));
    v += __builtin_bit_cast(float, __builtin_amdgcn_update_dpp(0, __builtin_bit_cast(int, v), 0x4E, 0xF, 0xF, true));
    v += __builtin_bit_cast(float, __builtin_amdgcn_update_dpp(0, __builtin_bit_cast(int, v), 0x141, 0xF, 0xF, true));
    v += __builtin_bit_cast(float, __builtin_amdgcn_update_dpp(0, __builtin_bit_cast(int, v), 0x140, 0xF, 0xF, true));
    return v;
}
__device__ __forceinline__ int row_first16(bool pred, int kq) {
    const unsigned long long m = __ballot(pred); const unsigned rb = (unsigned)(m >> (16 * kq)) & 0xffffu; return __ffs((int)rb) - 1;
}
__device__ __forceinline__ void ffn_route_mfma(const Frame& F, int l, int nrows) {
    LAS bf16_t* Whi = (LAS bf16_t*)(F.lds + RM_WHI); LAS bf16_t* Wlo = (LAS bf16_t*)(F.lds + RM_WLO);
    LAS i32x4* rec = (LAS i32x4*)(F.lds + RM_REC); LAS i32x2* lp = (LAS i32x2*)(F.lds + RM_LP); LAS int* lcnt = (LAS int*)(F.lds + RM_CNT); LAS int* lbase = lcnt + 32;
    const float* wrg = F.in(I_WRG) + (size_t)l * D * 4; const float* wre = F.in(I_WRE) + (size_t)l * D * 32;
    __syncthreads();
    {
        f32x4 wv[16], gv[2];
#pragma unroll
        for (int it = 0; it < 16; ++it) wv[it] = *(const f32x4*)(wre + 4 * (F.tid + NTHREADS * it));
#pragma unroll
        for (int it = 0; it < 2; ++it) gv[it] = *(const f32x4*)(wrg + 4 * (F.tid + NTHREADS * it));
        __builtin_amdgcn_sched_barrier(0);
#pragma unroll
        for (int it = 0; it < 16; ++it) { const int i = 4 * (F.tid + NTHREADS * it), k = i >> 5, j0 = i & 31;
#pragma unroll
            for (int e = 0; e < 4; ++e) { const float w = wv[it][e]; const unsigned h = pk_bf16(w, 0.f) & 0xffffu; const float r = w - __uint_as_float(h << 16);
                Whi[(j0 + e) * RM_WST + k] = (bf16_t)h; Wlo[(j0 + e) * RM_WST + k] = (bf16_t)(pk_bf16(r, 0.f) & 0xffffu); } }
#pragma unroll
        for (int it = 0; it < 2; ++it) { const int k = F.tid + NTHREADS * it;
#pragma unroll
            for (int e = 0; e < 4; ++e) { const float w = gv[it][e]; const unsigned h = pk_bf16(w, 0.f) & 0xffffu; const float r = w - __uint_as_float(h << 16);
                Whi[(32 + e) * RM_WST + k] = (bf16_t)h; Wlo[(32 + e) * RM_WST + k] = (bf16_t)(pk_bf16(r, 0.f) & 0xffffu); } }
    }
    if (F.tid < 32) lcnt[F.tid] = 0;
    __syncthreads();
    const int RPB = (nrows + F.G - 1) / F.G, rbeg = F.bid * RPB, rend = (rbeg + RPB < nrows) ? rbeg + RPB : nrows;
    const int lane = F.lane, tk = lane & 15, kq = lane >> 4;
    const bf16_t* XB = (const bf16_t*)(F.ws_() + WS_XB); bf16_t* H2 = (bf16_t*)(F.ws_() + WS_H);
    for (int g0 = rbeg + 16 * F.wave; g0 < rend; g0 += 128) {
        const int b = (g0 >= TL) ? 32 : (g0 >> 11);
        const float* GG = (const float*)(F.ws_() + WS_GG) + ((size_t)l * 33 + b) * D; const float* SH = (const float*)(F.ws_() + WS_MOD) + ((size_t)l * 33 + b) * (NMOD * D) + 3 * D;
        const float* RB = (const float*)(F.ws_() + WS_RB) + ((size_t)l * 33 + b) * 48;
        const int tok = (g0 + tk < rend) ? g0 + tk : rend - 1;
        const bf16_t* xp = XB + (size_t)tok * D + 8 * kq;
        f32x4 acc0 = (f32x4){0.f, 0.f, 0.f, 0.f}, acc1 = acc0, acc2 = acc0; float ss = 0.f;
        u32x4 xa[8], xn[8];
#pragma unroll
        for (int j = 0; j < 8; ++j) xa[j] = *(const u32x4*)(xp + 32 * j);
        int wob = tk * RM_WST + 8 * kq; asm volatile("" : "+v"(wob));
#pragma unroll 1
        for (int kc = 0; kc < 32; kc += 8) {
            f32x4 gaa[8], gbb[8];
#pragma unroll
            for (int j = 0; j < 8; ++j) { gaa[j] = *(const f32x4*)(GG + 32 * (kc + j) + 8 * kq); gbb[j] = *(const f32x4*)(GG + 32 * (kc + j) + 8 * kq + 4); }
            {   const int kn = (kc < 24) ? kc + 8 : 0;
#pragma unroll
                for (int j = 0; j < 8; ++j) xn[j] = *(const u32x4*)(xp + 32 * (kn + j)); }
            __builtin_amdgcn_sched_barrier(0);
#pragma unroll
            for (int jc = 0; jc < 8; ++jc) { const int ks = kc + jc;
            const u32x4 xv = xa[jc];
            const f32x4 ga = gaa[jc], gb = gbb[jc];
            const float x[8] = {bflo(xv.x), bfhi(xv.x), bflo(xv.y), bfhi(xv.y), bflo(xv.z), bfhi(xv.z), bflo(xv.w), bfhi(xv.w)};
            const float gg[8] = {ga[0], ga[1], ga[2], ga[3], gb[0], gb[1], gb[2], gb[3]};
            float y[8], yl[8]; unsigned hp[4];
#pragma unroll
            for (int j = 0; j < 8; ++j) { ss += x[j] * x[j]; y[j] = x[j] * gg[j]; }
#pragma unroll
            for (int j = 0; j < 4; ++j) { hp[j] = pk_bf16(y[2 * j], y[2 * j + 1]); yl[2 * j] = y[2 * j] - bflo(hp[j]); yl[2 * j + 1] = y[2 * j + 1] - bfhi(hp[j]); }
            const bf16x8 Ah = __builtin_bit_cast(bf16x8, (u32x4){hp[0], hp[1], hp[2], hp[3]}); const bf16x8 Al = pk8(yl);
            const int wo = wob + 32 * ks;
            const bf16x8 Bh0 = *(const LAS bf16x8*)(Whi + wo), Bl0 = *(const LAS bf16x8*)(Wlo + wo);
            const bf16x8 Bh1 = *(const LAS bf16x8*)(Whi + 16 * RM_WST + wo), Bl1 = *(const LAS bf16x8*)(Wlo + 16 * RM_WST + wo);
            const bf16x8 Bh2 = *(const LAS bf16x8*)(Whi + 32 * RM_WST + wo), Bl2 = *(const LAS bf16x8*)(Wlo + 32 * RM_WST + wo);
            acc0 = MFMA16(Ah, Bh0, acc0); acc0 = MFMA16(Ah, Bl0, acc0); acc0 = MFMA16(Al, Bh0, acc0);
            acc1 = MFMA16(Ah, Bh1, acc1); acc1 = MFMA16(Ah, Bl1, acc1); acc1 = MFMA16(Al, Bh1, acc1);
            acc2 = MFMA16(Ah, Bh2, acc2); acc2 = MFMA16(Ah, Bl2, acc2); acc2 = MFMA16(Al, Bh2, acc2);
            }
            __builtin_amdgcn_sched_barrier(0);
#pragma unroll
            for (int j = 0; j < 8; ++j) xa[j] = xn[j];
        }
        ss += __shfl_xor(ss, 16); ss += __shfl_xor(ss, 32);
        const float rstd = rsqrtf(ss * (1.0f / D) + EPS);
        const float rb0 = RB[tk], rb1 = RB[16 + tk], rb2 = RB[32 + tk];
#pragma unroll
        for (int r = 0; r < 4; ++r) {
            const float rs = __shfl(rstd, 4 * kq + r);
            const float gv = (tk < 4) ? rs * acc2[r] + rb2 : -3.0e38f;
            const float gmax = row_max16(gv); const int gi = row_first16(gv == gmax, kq);
            const float pg = __builtin_amdgcn_rcpf(row_sum16(tk < 4 ? __expf(gv - gmax) : 0.f));
            const float ev = (gi >> 1) ? rs * acc1[r] + rb1 : rs * acc0[r] + rb0; const bool valid = (tk >> 3) == (gi & 1);
            const float m0 = row_max16(valid ? ev : -3.0e38f); const int e0 = row_first16(valid && ev == m0, kq);
            const bool v2 = valid && tk != e0;
            const float m1 = row_max16(v2 ? ev : -3.0e38f); const int e1 = row_first16(v2 && ev == m1, kq);
            const float x1 = __expf(m1 - m0); const float w0 = pg / (1.0f + x1), w1 = pg * x1 / (1.0f + x1);
            const int row = g0 + 4 * kq + r;
            if (tk == 0 && row < rend) { const int E0 = 8 * gi + (e0 & 7), E1 = 8 * gi + (e1 & 7); const int ri = row - rbeg;
                rec[ri] = (i32x4){E0, E1, __float_as_int(w0), __float_as_int(w1)};
                const int p0 = atomicAdd((int*)&lcnt[E0], 1), p1 = atomicAdd((int*)&lcnt[E1], 1); lp[ri] = (i32x2){p0, p1}; }
        }
        if (g0 + tk < rend) { unsigned char* hp2 = (unsigned char*)H2 + (size_t)tok * D + 8 * kq;
            const float* GG2 = GG; asm volatile("" : "+s"(GG2)); const bf16_t* xp2 = xp; asm volatile("" : "+v"(xp2));
#pragma unroll 4
            for (int ks = 0; ks < 32; ++ks) {
                const u32x4 xv = *(const u32x4*)(xp2 + 32 * ks);
                const f32x4 ga = *(const f32x4*)(GG2 + 32 * ks + 8 * kq), gb = *(const f32x4*)(GG2 + 32 * ks + 8 * kq + 4), sa = *(const f32x4*)(SH + 32 * ks + 8 * kq), sb = *(const f32x4*)(SH + 32 * ks + 8 * kq + 4);
                u32x2 o; o.x = pk_fp8x4(bflo(xv.x) * rstd * ga[0] + sa[0], bfhi(xv.x) * rstd * ga[1] + sa[1], bflo(xv.y) * rstd * ga[2] + sa[2], bfhi(xv.y) * rstd * ga[3] + sa[3]);
                o.y = pk_fp8x4(bflo(xv.z) * rstd * gb[0] + sb[0], bfhi(xv.z) * rstd * gb[1] + sb[1], bflo(xv.w) * rstd * gb[2] + sb[2], bfhi(xv.w) * rstd * gb[3] + sb[3]);
                *(u32x2*)(hp2 + 32 * ks) = o; } }
    }
    __syncthreads();
    if (F.tid < 32) lbase[F.tid] = (int)__hip_atomic_fetch_add(F.ctl + CW_CNT + l * 32 + F.tid, (unsigned)lcnt[F.tid], __ATOMIC_RELAXED, __HIP_MEMORY_SCOPE_AGENT);
    __syncthreads();
    int* tokof = (int*)(F.ws_() + WS_TOKOF); float* gateof = (float*)(F.ws_() + WS_GATEOF); i32x4* tokinf = (i32x4*)(F.ws_() + WS_TOKINF);
    for (int ri = F.tid; ri < 304; ri += NTHREADS) { const int row = rbeg + ri;
        if (row < rend) { const i32x4 rc = rec[ri]; const i32x2 q = lp[ri]; const int p0 = lbase[rc.x] + q.x, p1 = lbase[rc.y] + q.y;
            tokof[(size_t)rc.x * TT + p0] = row; gateof[(size_t)rc.x * TT + p0] = __int_as_float(rc.z);
            tokof[(size_t)rc.y * TT + p1] = row; gateof[(size_t)rc.y * TT + p1] = __int_as_float(rc.w);
            tokinf[row] = (i32x4){rc.x, p0, rc.y, p1}; } }
}

constexpr int MO_TS = 131072;
constexpr int MO_TE = MO_TS + 256;
static_assert(MO_TE + 640 <= LDS_BARW, "moe LDS");
namespace pg8 {
struct MoeOrder {
    static constexpr bool PREFETCH = true;
    const LAS int* ts; const LAS unsigned char* te; const unsigned* cnt; const int* tokof; int G, c, nunits; bool gather;
    __device__ __forceinline__ bool next(int i, Unit& u) const {
        const long L = (long)i * G + c; if (L >= nunits) return false;
        u.pn = (int)(L & 3); u.pm = (int)(L >> 2); u.e = te[u.pm]; return true;
    }
    __device__ __forceinline__ unsigned arow(const Unit& u, int r) const {
        if (!gather) return (unsigned)(u.pm * BM + r);
        const int pos = (u.pm - ts[u.e]) * BM + r;
        return pos < (int)cnt[u.e] ? (unsigned)tokof[(size_t)u.e * TT + pos] : 0u;
    }
};
struct EpiSwiGLU {
    static constexpr bool PERM = true;
    bf16_t* H; const float* gateof; const unsigned* cnt; const LAS int* ts;
    __device__ __forceinline__ void operator()(const f32x4 (&acc)[2][2][4][2], const Unit& u, int wr, int wc, int fr, int fq) const {
        const int r0 = wr * 64 + fr, col0 = u.pn * 128 + wc * 32 + 8 * fq; const int pbase = (u.pm - ts[u.e]) * BM; const int ce = (int)cnt[u.e];
        float gt[2][4];
#pragma unroll
        for (int ai = 0; ai < 2; ++ai)
#pragma unroll
            for (int m = 0; m < 4; ++m) { const int pos = pbase + r0 + ai * HALF + m * 16; gt[ai][m] = pos < ce ? gateof[(size_t)u.e * TT + pos] : 0.f; }
#pragma unroll
        for (int ai = 0; ai < 2; ++ai)
#pragma unroll
            for (int m = 0; m < 4; ++m) { const f32x4 g0 = acc[ai][0][m][0], g1 = acc[ai][0][m][1], u0 = acc[ai][1][m][0], u1 = acc[ai][1][m][1]; const float q = gt[ai][m];
                const float q16 = q * 8.f;
                u32x2 w; w.x = pk_fp8x4(silu_f(g0[0]) * u0[0] * q16, silu_f(g0[1]) * u0[1] * q16, silu_f(g0[2]) * u0[2] * q16, silu_f(g0[3]) * u0[3] * q16);
                w.y = pk_fp8x4(silu_f(g1[0]) * u1[0] * q16, silu_f(g1[1]) * u1[1] * q16, silu_f(g1[2]) * u1[2] * q16, silu_f(g1[3]) * u1[3] * q16);
                *(u32x2*)((unsigned char*)H + (size_t)(u.pm * BM + r0 + ai * HALF + m * 16) * DEXP + col0) = w; }
    }
};
struct EpiMoeOut {
    static constexpr bool PERM = true;
    bf16_t* O; const float* gateof; const unsigned* cnt; const LAS int* ts;
    __device__ __forceinline__ void operator()(const f32x4 (&acc)[2][2][4][2], const Unit& u, int wr, int wc, int fr, int fq) const {
        const int r0 = wr * 64 + fr, col0 = u.pn * BM + wc * 32 + 8 * fq; const int pbase = (u.pm - ts[u.e]) * BM; const int ce = (int)cnt[u.e];
#pragma unroll
        for (int ai = 0; ai < 2; ++ai)
#pragma unroll
            for (int m = 0; m < 4; ++m) { const int r = r0 + ai * HALF + m * 16; const int pos = pbase + r;
                const float gt = pos < ce ? gateof[(size_t)u.e * TT + pos] : 0.f;
                bf16_t* rowp = O + (size_t)(u.pm * BM + r) * D + col0;
#pragma unroll
                for (int bj = 0; bj < 2; ++bj) { const f32x4 v0 = acc[ai][bj][m][0] * gt, v1 = acc[ai][bj][m][1] * gt;
                    u32x4 w; w.x = pk_bf16(v0[0], v0[1]); w.y = pk_bf16(v0[2], v0[3]); w.z = pk_bf16(v1[0], v1[1]); w.w = pk_bf16(v1[2], v1[3]);
                    *(u32x4*)(rowp + bj * HALF) = w; } }
    }
};
}
__device__ __forceinline__ int moe_tables(const Frame& F, int l) {
    LAS int* ts = (LAS int*)(F.lds + MO_TS); LAS unsigned char* te = (LAS unsigned char*)(F.lds + MO_TE);
    __syncthreads();
    if (F.tid == 0) { int acc = 0; for (int e = 0; e < 32; ++e) { ts[e] = acc; acc += ((int)F.ctl[CW_CNT + l * 32 + e] + 255) >> 8; } ts[32] = acc; }
    __syncthreads();
    if (F.tid < 32) { for (int t = ts[F.tid]; t < ts[F.tid + 1]; ++t) te[t] = (unsigned char)F.tid; }
    __syncthreads();
    return ts[32];
}

__global__ void __launch_bounds__(NTHREADS, 2) fwd_kernel(Params prm) {
    extern __shared__ __attribute__((aligned(16))) unsigned char lds_raw[];
    Frame F; F.P = (KParams)__builtin_amdgcn_kernarg_segment_ptr(); F.lds = (LAS unsigned char*)lds_raw; F.wsg = prm.ws; F.tid = threadIdx.x; F.lane = F.tid & 63; F.wave = __builtin_amdgcn_readfirstlane(F.tid >> 6);
    F.G = gridDim.x; F.bid = blockIdx.x; F.vcu = 0; F.ctl = (unsigned*)((unsigned char*)prm.ws + WS_CTL);
    if (F.tid < 4) ((LAS unsigned*)(F.lds + LDS_BARW))[F.tid] = 0u;
    __syncthreads();
    (void)xcd_barrier_post(F.ctl + CW_BAR, (volatile LAS unsigned*)(F.lds + LDS_BARW));
    int phase = 0; unsigned long long tacc = 0, tprev = TIME_MASK ? __builtin_amdgcn_s_memrealtime() : 0ull;
#define OPQ() do { asm volatile("" : "+s"(F.wsg)); asm volatile("" : "+s"(F.P)); asm volatile("" : "+s"(F.ctl)); asm volatile("" : "+s"(F.bid)); asm volatile("" : "+s"(F.G)); \
        F.vcu = (F.G % 8 == 0) ? (F.bid % 8) * (F.G / 8) + F.bid / 8 : F.bid; asm volatile("" : "+v"(F.tid)); F.lane = F.tid & 63; F.wave = __builtin_amdgcn_readfirstlane(F.tid >> 6); } while (0)
#define SEAM(sec) do { OPQ(); XcdBarrier b2_; b2_.bar = F.ctl + CW_BAR; b2_.x = xb_xcc_id(); b2_.st = (volatile LAS unsigned*)(F.lds + LDS_BARW); xcd_barrier(b2_); if (++phase > STOP_AFTER) return; \
        if (TIME_MASK) { const unsigned long long now_ = __builtin_amdgcn_s_memrealtime(); if ((TIME_MASK >> (sec)) & 1u) tacc += now_ - tprev; tprev = now_; } } while (0)

    OPQ(); if (PH(0)) {
        p0_rope(F);
        LAS int* qslot = (LAS int*)(F.lds + LDS_BARW - 16);
        for (;;) {
            __syncthreads();
            if (F.tid == 0) *qslot = (int)__hip_atomic_fetch_add(F.ctl + CW_Q, 1u, __ATOMIC_RELAXED, __HIP_MEMORY_SCOPE_AGENT);
            __syncthreads();
            const int it = *qslot;
            if (it >= 384 + 288 + 632 + 576) break;
            if (it < 384) p0_mods_item(F, it);
            else if (it < 672) p0_filter_item(F, it - 384);
            else if (it < 1304) p0_transposes_chunk(F, it - 672);
            else p0_xc_chunk(F, it - 1304);
        }
    }
    SEAM(9);
    OPQ(); if (PH(0)) { p0_gr(F); p0_rtab(F); }
    SEAM(10);
    for (int l = 0; l < DEPTH; ++l) {
        const bool last = (l == DEPTH - 1);
        OPQ(); if (PH(1)) row_norm_phase<0>(F, l, l - 1, l == 0);
        for (int rep_ = 0; rep_ < REPN(2); ++rep_) { OPQ(); if (PH(2)) moe_weight_cvt(F, l); }
        SEAM(0);
        for (int rep_ = 0; rep_ < REPN(3); ++rep_) { OPQ(); if (PH(3)) {
            {
                pg8::Gemm g{(const bf16_t*)(F.ws_() + WS_H8), (const bf16_t*)(F.ws_() + WS_WIN8 + (size_t)l * 1280 * 1024), D / 2, 0, 0x79797979, 0x7f7f7f7f};
                pg8::StaticOrder S; S.init(TT, 1280, F.G, F.bid);
                pg8::EpiFp8 E{F.ws_() + WS_P, DIN * 2, 1.f};
                pg8::gemm_phase<pg8::EpiFp8, pg8::StaticOrder, true, true, true>(F.lds, g, S, E, F.tid); }
            {
                pg8::Gemm g{(const bf16_t*)(F.ws_() + WS_H), (const bf16_t*)(F.ws_() + WS_WINT) + ((size_t)l * DIN + 1280) * D, D, 0, 0, 0};
                pg8::StaticOrder S; S.init(TT, 1280, F.G, F.G - 1 - F.bid);
                pg8::EpiBf16 E{(bf16_t*)(F.ws_() + WS_P) + 1280, DIN};
                pg8::gemm_phase<pg8::EpiBf16, pg8::StaticOrder>(F.lds, g, S, E, F.tid); }
            OPQ(); moe_weight_cvt_queue(F, l, 0); } }
        SEAM(1);
        for (int rep_ = 0; rep_ < REPN(4); ++rep_) { OPQ(); if (PH(4)) attn_pre(F, l); }
        for (int rep_ = 0; rep_ < REPN(5); ++rep_) { OPQ(); if (PH(5)) conf_phase(F, l, !last); }
        for (int rep_ = 0; rep_ < REPN(6); ++rep_) { OPQ(); if (PH(6)) hy_pre(F, l, !last); }
        for (int rep_ = 0; rep_ < REPN(7); ++rep_) { OPQ(); if (PH(7)) lru_seq(F, l, !last); }
        SEAM(2);
        for (int rep_ = 0; rep_ < REPN(8); ++rep_) { OPQ(); if (PH(8)) hy_conv<0>(F, l, !last); }
        for (int rep_ = 0; rep_ < REPN(9); ++rep_) { OPQ(); if (PH(9)) lru_comb(F, !last); }
        SEAM(3);
        for (int rep_ = 0; rep_ < REPN(10); ++rep_) { OPQ(); if (PH(10)) hy_conv<1>(F, l, !last); }
        for (int rep_ = 0; rep_ < REPN(11); ++rep_) { OPQ(); if (PH(11)) attn_phase(F, l, !last); }
        SEAM(4);
        OPQ(); if (PH(12)) {   pg8::Gemm g{(const bf16_t*)(F.ws_() + WS_Y), (const bf16_t*)(F.ws_() + WS_WOUTT) + (size_t)l * D * D, D, 0, 0, 0};
            pg8::StaticOrder S; S.init(last ? TL : TT, D, F.G, F.bid);
            pg8::EpiResid E{(bf16_t*)(F.ws_() + WS_XB), (const float*)(F.ws_() + WS_MOD) + (size_t)l * 33 * (NMOD * D) + 2 * D};
            pg8::gemm_phase<pg8::EpiResid, pg8::StaticOrder>(F.lds, g, S, E, F.tid);
            OPQ(); moe_weight_cvt_queue(F, l, 1); }
        SEAM(5);
        OPQ(); if (PH(13)) ffn_route_mfma(F, l, last ? TL : TT);
        SEAM(6);
        for (int rep_ = 0; rep_ < REPN(14); ++rep_) { OPQ(); if (PH(14)) {   const int ntile = moe_tables(F, l);
            pg8::MoeOrder S{(const LAS int*)(F.lds + MO_TS), (const LAS unsigned char*)(F.lds + MO_TE), F.ctl + CW_CNT + l * 32, (const int*)(F.ws_() + WS_TOKOF), F.G, (F.G % 8 == 0) ? (F.bid % 8) * (F.G / 8) + F.bid / 8 : F.bid, ntile * 4, true};
            pg8::Gemm g{(const bf16_t*)(F.ws_() + WS_H), (const bf16_t*)(F.ws_() + WS_MOEGU), D / 2, (size_t)1024 * 1024, 0x79797979, 0x7f7f7f7f};
            pg8::EpiSwiGLU E{(bf16_t*)(F.ws_() + WS_HID), (const float*)(F.ws_() + WS_GATEOF), F.ctl + CW_CNT + l * 32, (const LAS int*)(F.lds + MO_TS)};
            pg8::gemm_phase<pg8::EpiSwiGLU, pg8::MoeOrder, true, true, true>(F.lds, g, S, E, F.tid); } }
        SEAM(7);
        for (int rep_ = 0; rep_ < REPN(15); ++rep_) { OPQ(); if (PH(15)) {   const int ntile = moe_tables(F, l);
            pg8::MoeOrder S{(const LAS int*)(F.lds + MO_TS), (const LAS unsigned char*)(F.lds + MO_TE), F.ctl + CW_CNT + l * 32, (const int*)(F.ws_() + WS_TOKOF), F.G, (F.G % 8 == 0) ? (F.bid % 8) * (F.G / 8) + F.bid / 8 : F.bid, ntile * 4, false};
            pg8::Gemm g{(const bf16_t*)(F.ws_() + WS_HID), (const bf16_t*)(F.ws_() + WS_MOEDN), DEXP / 2, (size_t)1024 * 512, 0x79797979, 0x7c7c7c7c};
            pg8::EpiFp8 E{F.ws_() + WS_O, D, 16.f};
            pg8::gemm_phase<pg8::EpiFp8, pg8::MoeOrder, true, true, true>(F.lds, g, S, E, F.tid); } }
        SEAM(8);
    }
    OPQ(); if (PH(16)) row_norm_phase<2>(F, 0, DEPTH - 1, false);
    if (TIME_MASK) { __syncthreads(); const unsigned long long now_ = __builtin_amdgcn_s_memrealtime(); if ((TIME_MASK >> 11) & 1u) tacc += now_ - tprev;
        if (F.bid == 0) { const unsigned long long t0_ = __builtin_amdgcn_s_memrealtime(); while (__builtin_amdgcn_s_memrealtime() - t0_ < tacc) __builtin_amdgcn_s_sleep(8); } }
    if (xb_ld(F.ctl + CW_BAR + XB_TMO) != 0u) {
        __syncthreads();
        for (int row = F.bid * 8 + F.wave; row < TL; row += F.G * 8) { float* xr = F.out() + (size_t)row * D;
            for (int i = 0; i < 4; ++i) *(f32x4*)(xr + i * 256 + 4 * F.lane) = (f32x4){0.f, 0.f, 0.f, 0.f}; }
    }
}

extern "C" void kernel_launch(void* const* d_in, const int* in_sizes, int n_in, void* d_out, int out_size, void* d_ws, size_t ws_size, hipStream_t stream) {
    static int grid = 0;
    if (!grid) {
        int dev = 0, cus = 0, per_cu = 0;
        hipGetDevice(&dev);
        hipDeviceGetAttribute(&cus, hipDeviceAttributeMultiprocessorCount, dev);
        hipFuncSetAttribute((const void*)fwd_kernel, hipFuncAttributeMaxDynamicSharedMemorySize, LDS_BYTES);
        hipOccupancyMaxActiveBlocksPerMultiprocessor(&per_cu, (const void*)fwd_kernel, NTHREADS, LDS_BYTES);
        if (per_cu < 1) fprintf(stderr, "kernel_launch: occupancy query says %d\n", per_cu);
        grid = cus > 0 ? cus : 256;
        if (ws_size < WS_END) fprintf(stderr, "kernel_launch: workspace too small: %zu < %zu\n", ws_size, (size_t)WS_END);
        if (n_in != 46) fprintf(stderr, "kernel_launch: expected 46 inputs, got %d\n", n_in);
    }
    hipMemsetAsync((char*)d_ws + WS_CTL, 0, CTL_BYTES, stream);
    Params p; memset(&p, 0, sizeof(p));
    for (int i = 0; i < 46 && i < n_in; ++i) p.in[i] = (const GAS float*)d_in[i];
    p.out = (GAS float*)d_out; p.ws = (GAS unsigned char*)d_ws;
    hipLaunchKernelGGL(fwd_kernel, dim3(grid), dim3(NTHREADS), LDS_BYTES, stream, p);
}
```

```cpp
#include <hip/hip_runtime.h>
#include <cstdio>
#include <cstdint>
#include <cstring>

#ifndef PH_MASK
#define PH_MASK 0xffffffffu
#endif
#define PH(k) ((PH_MASK >> (k)) & 1u)
#ifndef REP_MASK
#define REP_MASK 0u
#endif
#define REPN(k) (1 + (int)((REP_MASK >> (k)) & 1u))
#ifndef TIME_MASK
#define TIME_MASK 0u
#endif
#ifndef STOP_AFTER
#define STOP_AFTER 9999
#endif

#define LAS __attribute__((address_space(3)))
#define GAS __attribute__((address_space(1)))
typedef unsigned short bf16_t;
typedef short bf16x8 __attribute__((ext_vector_type(8)));
typedef float f32x4 __attribute__((ext_vector_type(4)));
typedef float f32x16 __attribute__((ext_vector_type(16)));
typedef unsigned u32x4 __attribute__((ext_vector_type(4)));
typedef unsigned u32x2 __attribute__((ext_vector_type(2)));
typedef int i32x4 __attribute__((ext_vector_type(4)));
typedef int i32x2 __attribute__((ext_vector_type(2)));
typedef int i32x8v __attribute__((ext_vector_type(8)));

constexpr int D = 1024, NB = 32, SEQ = 2048, LC = 256, DEPTH = 4;
constexpr int TL = NB * SEQ, TC = NB * LC, TT = TL + TC;
constexpr int DIN = 2560, NMOD = 6;
constexpr int OFF_B = 0, OFF_C = 768, OFF_A = 1280, OFF_D = 1792;
constexpr int NEXP = 32, DEXP = 512;
constexpr int MAXSLOT = 155648;
constexpr float EPS = 1e-6f;
constexpr int NTHREADS = 512;
constexpr int LDS_BYTES = 163840;
constexpr int LDS_BARW = LDS_BYTES - 16;

constexpr size_t MBy = 1ull << 20;
constexpr size_t WS_CTL   = 0;
constexpr size_t CTL_BYTES = 65536;
constexpr size_t WS_MOD   = WS_CTL + CTL_BYTES;
constexpr size_t WS_GG    = WS_MOD + 3328 * 1024;
constexpr size_t WS_RB    = WS_GG + 576 * 1024;
constexpr size_t WS_ROPE  = WS_MOD + 4 * MBy;
constexpr size_t WS_WINT  = WS_ROPE + 1 * MBy;
constexpr size_t WS_WOUTT = WS_WINT + 20 * MBy;
constexpr size_t WS_CPW   = WS_WOUTT + 8 * MBy;
constexpr size_t WS_LRUW  = WS_CPW + 1 * MBy;
constexpr size_t WS_FRAW  = WS_LRUW + 1 * MBy;
constexpr size_t WS_FEN   = WS_FRAW + 36 * MBy;
constexpr size_t WS_GR    = WS_FEN + 1 * MBy;
constexpr size_t WS_GRC   = WS_GR + 16 * MBy;
constexpr size_t WS_XB    = WS_GRC + 2 * MBy;
constexpr size_t WS_H     = WS_XB + 144 * MBy;
constexpr size_t WS_Y     = WS_H + 144 * MBy;
constexpr size_t WS_MOEGU = WS_Y + 144 * MBy;
constexpr size_t WS_MOEDN = WS_MOEGU + 64 * MBy;
constexpr size_t WS_TOKOF = WS_MOEDN + 32 * MBy;
constexpr size_t WS_GATEOF= WS_TOKOF + 9 * MBy;
constexpr size_t WS_TOKINF= WS_GATEOF + 9 * MBy;
constexpr size_t WS_LRUS  = WS_TOKINF + 2 * MBy;
constexpr size_t WS_LRUC  = WS_LRUS + 3 * MBy;
constexpr size_t WS_BIG   = WS_LRUC + 2 * MBy;
constexpr size_t WS_P     = WS_BIG;
constexpr size_t WS_UF    = WS_P + 360 * MBy;
constexpr size_t WS_Z1F   = WS_UF + 108 * MBy;
constexpr size_t WS_HID   = WS_BIG;
constexpr size_t WS_O     = WS_HID + 152 * MBy;
constexpr size_t WS_WIN8  = WS_Z1F + 36 * MBy;
constexpr size_t WS_END   = WS_WIN8 + 8 * MBy;
constexpr size_t WS_H8    = WS_Y;
constexpr size_t WS_HT    = WS_H;
constexpr size_t WS_KIMG  = WS_H + 72 * MBy;
constexpr size_t WS_VIMG  = WS_H + 108 * MBy;
static_assert(WS_O + 304 * MBy <= WS_END, "overlay");
static_assert(WS_END <= 1200 * MBy, "workspace budget");

constexpr int CW_BAR = 0;
constexpr int CW_CNT = 4096;
constexpr int CW_Q   = 4096 + 256;
constexpr int CW_MQ  = CW_Q + 16;

struct Params {
    const GAS float* in[46];
    GAS float* out;
    GAS unsigned char* ws;
};

typedef float f32x2 __attribute__((ext_vector_type(2)));
typedef __bf16 bf16x2v __attribute__((ext_vector_type(2)));
__device__ __forceinline__ unsigned pk_bf16(float lo, float hi) { const f32x2 v = {lo, hi}; const bf16x2v r = __builtin_convertvector(v, bf16x2v); return __builtin_bit_cast(unsigned, r); }
__device__ __forceinline__ bf16x8 pk8(const float (&v)[8]) { u32x4 w; w.x = pk_bf16(v[0], v[1]); w.y = pk_bf16(v[2], v[3]); w.z = pk_bf16(v[4], v[5]); w.w = pk_bf16(v[6], v[7]); return __builtin_bit_cast(bf16x8, w); }
__device__ __forceinline__ unsigned pk_fp8x4(float a, float b, float c, float d) {
    a = __builtin_amdgcn_fmed3f(a, -448.f, 448.f); b = __builtin_amdgcn_fmed3f(b, -448.f, 448.f); c = __builtin_amdgcn_fmed3f(c, -448.f, 448.f); d = __builtin_amdgcn_fmed3f(d, -448.f, 448.f);
    int p = __builtin_amdgcn_cvt_pk_fp8_f32(a, b, 0, false); p = __builtin_amdgcn_cvt_pk_fp8_f32(c, d, p, true); return (unsigned)p; }
__device__ __forceinline__ void dec_fp8x8(const u32x2 w, float (&x)[8]) {
    x[0] = __builtin_amdgcn_cvt_f32_fp8((int)w.x, 0); x[1] = __builtin_amdgcn_cvt_f32_fp8((int)w.x, 1); x[2] = __builtin_amdgcn_cvt_f32_fp8((int)w.x, 2); x[3] = __builtin_amdgcn_cvt_f32_fp8((int)w.x, 3);
    x[4] = __builtin_amdgcn_cvt_f32_fp8((int)w.y, 0); x[5] = __builtin_amdgcn_cvt_f32_fp8((int)w.y, 1); x[6] = __builtin_amdgcn_cvt_f32_fp8((int)w.y, 2); x[7] = __builtin_amdgcn_cvt_f32_fp8((int)w.y, 3); }
#define MFMA32(a, b, c) __builtin_amdgcn_mfma_f32_32x32x16_bf16((a), (b), (c), 0, 0, 0)
#define MFMA16(a, b, c) __builtin_amdgcn_mfma_f32_16x16x32_bf16((a), (b), (c), 0, 0, 0)
__device__ __forceinline__ float bf2f(bf16_t v) { return __uint_as_float(((unsigned)v) << 16); }
__device__ __forceinline__ float bflo(unsigned w) { return __uint_as_float(w << 16); }
__device__ __forceinline__ float bfhi(unsigned w) { return __uint_as_float(w & 0xffff0000u); }
__device__ __forceinline__ float silu_f(float v) { return v * __builtin_amdgcn_rcpf(1.0f + __expf(-v)); }
__device__ __forceinline__ float sigmoid_f(float v) { return __builtin_amdgcn_rcpf(1.0f + __expf(-v)); }
__device__ __forceinline__ float gelu_tanh_f(float v) { const float u = 0.7978845608028654f * (v + 0.044715f * v * v * v); const float t = 1.0f - 2.0f * __builtin_amdgcn_rcpf(1.0f + __expf(2.0f * u)); return 0.5f * v * (1.0f + t); }
__device__ __forceinline__ float wave_sum(float v) {
    v += __builtin_bit_cast(float, __builtin_amdgcn_update_dpp(0, __builtin_bit_cast(int, v), 0xB1, 0xF, 0xF, true));
    v += __builtin_bit_cast(float, __builtin_amdgcn_update_dpp(0, __builtin_bit_cast(int, v), 0x4E, 0xF, 0xF, true));
    v += __builtin_bit_cast(float, __builtin_amdgcn_update_dpp(0, __builtin_bit_cast(int, v), 0x141, 0xF, 0xF, true));
    v += __builtin_bit_cast(float, __builtin_amdgcn_update_dpp(0, __builtin_bit_cast(int, v), 0x140, 0xF, 0xF, true));
    const int iv = __builtin_bit_cast(int, v);
    return (__builtin_bit_cast(float, __builtin_amdgcn_readlane(iv, 0)) + __builtin_bit_cast(float, __builtin_amdgcn_readlane(iv, 16)))
         + (__builtin_bit_cast(float, __builtin_amdgcn_readlane(iv, 32)) + __builtin_bit_cast(float, __builtin_amdgcn_readlane(iv, 48)));
}

#define XB_TMO      128
#define XB_XCNT(j)  (256  + 64 * (j))
#define XB_XSUB(j)  (1280 + 64 * (j))
#define XB_XGEN(j)  (2304 + 64 * (j))
#define XB_TOP      3328
#define XB_TOPGEN   3392
#define XCD_BAR_WORDS 3456
#define XB_SPIN_CAP (1u << 18)
__device__ __forceinline__ unsigned xb_ld(unsigned* p)              { return __hip_atomic_load(p, __ATOMIC_RELAXED, __HIP_MEMORY_SCOPE_AGENT); }
__device__ __forceinline__ unsigned xb_add(unsigned* p, unsigned v) { return __hip_atomic_fetch_add(p, v, __ATOMIC_RELAXED, __HIP_MEMORY_SCOPE_AGENT); }
__device__ __forceinline__ unsigned xb_xcc_id() { return (unsigned)__builtin_amdgcn_s_getreg((3 << 11) | 20) & 0xFu; }
#define XB_SPIN(cond, bar) do { unsigned _sp = 0; while (cond) { __builtin_amdgcn_s_sleep(1); \
    if ((++_sp & 255u) == 0u) { if (xb_ld(&(bar)[XB_TMO])) break; if (_sp > XB_SPIN_CAP) { atomicAdd(&(bar)[XB_TMO], 1u); break; } } } } while (0)
struct XcdBarrier { unsigned* bar; unsigned x; volatile LAS unsigned* st; };
__device__ __forceinline__ XcdBarrier xcd_barrier_post(unsigned* bar, volatile LAS unsigned* st) {
    XcdBarrier b; b.bar = bar; b.x = xb_xcc_id(); b.st = st;
    if (threadIdx.x == 0) (void)xb_add(&bar[XB_XCNT(b.x)], 1u);
    return b;
}
__device__ __forceinline__ void xcd_barrier_complete(unsigned* bar, unsigned x, unsigned& nloc, unsigned& nx) {
    const unsigned G = gridDim.x * gridDim.y * gridDim.z;
    unsigned sum, cnt, mine, sp = 0u;
    for (;;) {
        sum = 0u; cnt = 0u; mine = 0u;
#pragma unroll
        for (unsigned j = 0; j < 16; ++j) { const unsigned c = xb_ld(&bar[XB_XCNT(j)]); sum += c; cnt += (c > 0u) ? 1u : 0u; mine = (j == x) ? c : mine; }
        if (sum == G) break;
        __builtin_amdgcn_s_sleep(1);
        if ((++sp & 255u) == 0u) { if (xb_ld(&bar[XB_TMO])) break; if (sp > XB_SPIN_CAP) { atomicAdd(&bar[XB_TMO], 1u); break; } }
    }
    nloc = mine > 0u ? mine : 1u; nx = cnt > 0u ? cnt : 1u;
}
__device__ __forceinline__ void xcd_barrier(const XcdBarrier& b) {
    asm volatile("s_waitcnt vmcnt(0)" ::: "memory");
    __syncthreads();
    if (threadIdx.x == 0) {
        unsigned* bar = b.bar;
        __builtin_amdgcn_s_waitcnt(0);
        unsigned nloc = b.st[0], nx = b.st[1];
        if (nloc == 0u) { xcd_barrier_complete(bar, b.x, nloc, nx); b.st[0] = nloc; b.st[1] = nx; }
        const unsigned old = xb_add(&bar[XB_XSUB(b.x)], 1u);
        const unsigned gen = old / nloc;
        if (old + 1u == (gen + 1u) * nloc) {
            __builtin_amdgcn_fence(__ATOMIC_RELEASE, "agent");
            asm volatile("s_waitcnt vmcnt(0)" ::: "memory");
            const unsigned og = xb_add(&bar[XB_TOP], 1u);
            const unsigned tg = og / nx;
            if (og + 1u == (tg + 1u) * nx) xb_add(&bar[XB_TOPGEN], 1u);
            else XB_SPIN(xb_ld(&bar[XB_TOPGEN]) == tg, bar);
            __builtin_amdgcn_fence(__ATOMIC_ACQUIRE, "agent");
            xb_add(&bar[XB_XGEN(b.x)], 1u);
            asm volatile("s_waitcnt vmcnt(0)" ::: "memory");
        } else {
            XB_SPIN(xb_ld(&bar[XB_XGEN(b.x)]) == gen, bar);
            __builtin_amdgcn_fence(__ATOMIC_ACQUIRE, "agent");
            asm volatile("s_waitcnt vmcnt(0)" ::: "memory");
        }
    }
    __syncthreads();
}

namespace pg8 {
constexpr int BM = 256, BK = 64, HALF = 128, HTB = HALF * BK * 2, STAGE_BYTES = 8 * HTB, NXCD = 8, WGM = 8;
__host__ __device__ __forceinline__ int lds_byte(int r, int c) { const int st = (r >> 4) * 2 + (c >> 5), rr = r & 15, cc = c & 31, ob = rr * 64 + cc * 2; return st * 1024 + (ob ^ (((ob >> 9) & 1) << 5)); }
__host__ __device__ __forceinline__ void stage_rc(int b, int& R, int& C) { const int st = b / 1024, sb = b % 1024, swz = sb ^ (((sb >> 9) & 1) << 5); R = (st >> 1) * 16 + swz / 64; C = (st & 1) * 32 + (swz % 64) / 2; }
__host__ __device__ __forceinline__ int perm32(int rho) { const int n = rho >> 4, i = rho & 15; return 8 * (i >> 2) + 4 * n + (i & 3); }

struct Unit { int pm, pn, e; };
struct Gemm { const bf16_t* A; const bf16_t* Bt; int K; size_t bstride; int sc_w, sc_a; };

struct StaticOrder {
    static constexpr bool PREFETCH = false;
    int nM, nN, nwg, G, c;
    __device__ void init(int M, int N, int G_, int c_) { nM = M / BM; nN = N / BM; nwg = nM * nN; G = G_; c = c_; }
    __device__ __forceinline__ bool next(int i, Unit& u) const {
        const long L = (long)i * G + c; if (L >= nwg) return false;
        int wgid = (int)L; { const int q = nwg / NXCD, r = nwg % NXCD, xcd = wgid % NXCD, off = wgid / NXCD; wgid = (xcd < r ? xcd * (q + 1) : r * (q + 1) + (xcd - r) * q) + off; }
        const int nig = WGM * nN, gid = wgid / nig, fm = gid * WGM, gsz = (nM - fm) < WGM ? (nM - fm) : WGM;
        u.pm = fm + ((wgid % nig) % gsz); u.pn = (wgid % nig) / gsz; u.e = 0; return true;
    }
    __device__ __forceinline__ unsigned arow(const Unit& u, int r) const { return (unsigned)(u.pm * BM + r); }
};

template <class Epi, class Sched, bool ALIGN_EPI = true, bool SP2 = true, bool FP8 = false>
__device__ __forceinline__ void gemm_phase(LAS unsigned char* lds, const Gemm g, const Sched& S, const Epi& E, const int tid_in) {
    const int tid = tid_in, wid = __builtin_amdgcn_readfirstlane(tid >> 6), lane = tid & 63, wr = wid >> 2, wc = wid & 3, fr = lane & 15, fq = lane >> 4;
    const int K = g.K, nt = K / BK;
    unsigned voffB[2];
#pragma unroll
    for (int i = 0; i < 2; ++i) { int R, C; stage_rc(tid * 16 + i * 8192, R, C); const int Rb = Epi::PERM ? ((R & ~31) + perm32(R & 31)) : R;
        voffB[i] = (unsigned)(Rb * K + C) * 2u; }
    const size_t kstep = (size_t)(BK * 2);
    const size_t hstep = (size_t)HALF * K * 2;
    const size_t tstep = 2 * hstep;
    const unsigned rowb = (unsigned)K * 2u;
    const unsigned ldsw = (unsigned)wid * 1024u;
    const int aoff = lds_byte(wr * 64 + fr, fq * 8), boff = lds_byte(wc * 32 + fr, fq * 8);
#define PG8_SA(b, h) (((b) * 2 + (h)) * HTB)
#define PG8_SB(b, h) ((4 + (b) * 2 + (h)) * HTB)
#define PG8_STAGE(bufoff, gbase, voff) do { _Pragma("unroll") for (int _i = 0; _i < 2; ++_i) \
        __builtin_amdgcn_global_load_lds((const unsigned*)((const char*)(gbase) + (voff)[_i]), (LAS unsigned*)(lds + (bufoff) + ldsw + _i * 8192), 16, 0, 0); } while (0)
#define PG8_RD8(dst8, addr) do { const u32x4 x0_ = *(const LAS u32x4*)(addr), x1_ = *(const LAS u32x4*)((addr) + 1024); \
        dst8 = (i32x8v){(int)x0_.x, (int)x0_.y, (int)x0_.z, (int)x0_.w, (int)x1_.x, (int)x1_.y, (int)x1_.z, (int)x1_.w}; } while (0)
#define PG8_LDA(dst, b, h) do { if constexpr (FP8) { _Pragma("unroll") for (int m = 0; m < 4; ++m) PG8_RD8(dst##8[m], lds + PG8_SA(b, h) + aoff + m * 2048); } \
        else { _Pragma("unroll") for (int m = 0; m < 4; ++m) _Pragma("unroll") for (int k = 0; k < 2; ++k) dst[m][k] = *(const LAS bf16x8*)(lds + PG8_SA(b, h) + aoff + m * 2048 + k * 1024); } } while (0)
#define PG8_LDB(dst, b, h) do { if constexpr (FP8) { _Pragma("unroll") for (int n = 0; n < 2; ++n) PG8_RD8(dst##8[n], lds + PG8_SB(b, h) + boff + n * 2048); } \
        else { _Pragma("unroll") for (int n = 0; n < 2; ++n) _Pragma("unroll") for (int k = 0; k < 2; ++k) dst[n][k] = *(const LAS bf16x8*)(lds + PG8_SB(b, h) + boff + n * 2048 + k * 1024); } } while (0)
#define PG8_MMA(ai, bj, At, Bt) do { __builtin_amdgcn_s_setprio(1); \
        if constexpr (FP8) { _Pragma("unroll") for (int m = 0; m < 4; ++m) _Pragma("unroll") for (int n = 0; n < 2; ++n) \
            acc[ai][bj][m][n] = __builtin_amdgcn_mfma_scale_f32_16x16x128_f8f6f4(Bt##8[n], At##8[m], acc[ai][bj][m][n], 0, 0, 0, g.sc_w, 0, g.sc_a); } \
        else { _Pragma("unroll") for (int m = 0; m < 4; ++m) _Pragma("unroll") for (int n = 0; n < 2; ++n) _Pragma("unroll") for (int k = 0; k < 2; ++k) \
            acc[ai][bj][m][n] = __builtin_amdgcn_mfma_f32_16x16x32_bf16(Bt[n][k], At[m][k], acc[ai][bj][m][n], 0, 0, 0); } \
        __builtin_amdgcn_s_setprio(0); } while (0)
#define PG8_WAIT_V(n) asm volatile("s_waitcnt vmcnt(" #n ")" ::: "memory")
#define PG8_WAIT_L(n) asm volatile("s_waitcnt lgkmcnt(" #n ")" ::: "memory")
#define PG8_BAR __builtin_amdgcn_s_barrier()
#define PG8_SCHED __builtin_amdgcn_sched_barrier(0)
    Unit cur, nxt; int ui = 0;
    if (!S.next(0, cur)) return;
    f32x4 acc[2][2][4][2];
#pragma unroll
    for (int a = 0; a < 2; ++a)
#pragma unroll
        for (int b = 0; b < 2; ++b)
#pragma unroll
            for (int m = 0; m < 4; ++m)
#pragma unroll
                for (int n = 0; n < 2; ++n) acc[a][b][m][n] = (f32x4){0.f, 0.f, 0.f, 0.f};
    bf16x8 At[4][2], B0[2][2], B1[2][2]; i32x8v At8[4], B08[2], B18[2];
    unsigned ca0[2], ca1[2], na0[2], na1[2];
#define PG8_AROWS(u, o0, o1) do { int _tz = tid_in; asm volatile("" : "+v"(_tz)); _Pragma("unroll") for (int _i = 0; _i < 2; ++_i) { int _R, _C; stage_rc(_tz * 16 + _i * 8192, _R, _C); \
        o0[_i] = S.arow(u, _R) * rowb + (unsigned)_C * 2u; o1[_i] = S.arow(u, HALF + _R) * rowb + (unsigned)_C * 2u; } } while (0)
    PG8_AROWS(cur, ca0, ca1);
    const char* Ab = (const char*)g.A;
    const char* cB = (const char*)g.Bt + (size_t)cur.e * g.bstride + (size_t)cur.pn * tstep;
    if constexpr (SP2) {
        PG8_STAGE(PG8_SB(0, 0), cB, voffB); PG8_STAGE(PG8_SB(0, 1), cB + hstep, voffB); PG8_STAGE(PG8_SA(0, 0), Ab, ca0); PG8_STAGE(PG8_SA(0, 1), Ab, ca1);
        if (wr == 1) PG8_BAR;
        PG8_WAIT_V(2); PG8_BAR;
        PG8_STAGE(PG8_SB(1, 0), cB + kstep, voffB); PG8_STAGE(PG8_SA(1, 0), Ab + kstep, ca0); PG8_STAGE(PG8_SB(1, 1), cB + hstep + kstep, voffB);
        PG8_WAIT_V(6); PG8_BAR;
    } else {
        PG8_STAGE(PG8_SB(0, 0), cB, voffB); PG8_STAGE(PG8_SA(0, 0), Ab, ca0); PG8_STAGE(PG8_SB(0, 1), cB + hstep, voffB); PG8_STAGE(PG8_SA(0, 1), Ab, ca1);
        if (wr == 1) PG8_BAR;
        PG8_WAIT_V(4); PG8_BAR;
        PG8_STAGE(PG8_SB(1, 0), cB + kstep, voffB); PG8_STAGE(PG8_SA(1, 0), Ab + kstep, ca0); PG8_STAGE(PG8_SB(1, 1), cB + hstep + kstep, voffB);
        PG8_WAIT_V(6); PG8_BAR;
    }
    for (;;) {
        const bool has_next = S.next(ui + 1, nxt);
        const char* nB = has_next ? (const char*)g.Bt + (size_t)nxt.e * g.bstride + (size_t)nxt.pn * tstep : cB;
        if (Sched::PREFETCH && has_next) PG8_AROWS(nxt, na0, na1);
#pragma unroll 1
        for (int t = 0; t < nt; t += 2) {
            const bool last = (t == nt - 2);
            const char* a1 = Ab + (size_t)(t + 1) * kstep;
            const char* a2 = last ? Ab : Ab + (size_t)(t + 2) * kstep; const char* b2 = last ? nB : cB + (size_t)(t + 2) * kstep;
            const char* a3 = a2 + kstep; const char* b3 = b2 + kstep;
            if constexpr (SP2) {
            PG8_LDB(B0, 0, 0); PG8_LDB(B1, 0, 1); PG8_SCHED; PG8_LDA(At, 0, 0); PG8_STAGE(PG8_SA(1, 1), a1, ca1);
            if (last && has_next) { if (Sched::PREFETCH) { ca0[0] = na0[0]; ca0[1] = na0[1]; ca1[0] = na1[0]; ca1[1] = na1[1]; } else PG8_AROWS(nxt, ca0, ca1); }
            PG8_WAIT_V(8); PG8_WAIT_L(0); PG8_BAR; PG8_MMA(0, 0, At, B0); PG8_MMA(0, 1, At, B1); PG8_BAR; PG8_SCHED;
            PG8_LDA(At, 0, 1); PG8_STAGE(PG8_SB(0, 0), b2, voffB); PG8_STAGE(PG8_SB(0, 1), b2 + hstep, voffB); PG8_STAGE(PG8_SA(0, 0), a2, ca0);
            PG8_WAIT_V(8); PG8_WAIT_L(0); PG8_BAR; PG8_MMA(1, 0, At, B0); PG8_MMA(1, 1, At, B1); PG8_BAR; PG8_SCHED;
            PG8_LDB(B0, 1, 0); PG8_LDB(B1, 1, 1); PG8_SCHED; PG8_LDA(At, 1, 0); PG8_STAGE(PG8_SA(0, 1), a2, ca1);
            PG8_WAIT_V(8); PG8_WAIT_L(0); PG8_BAR; PG8_MMA(0, 0, At, B0); PG8_MMA(0, 1, At, B1); PG8_BAR; PG8_SCHED;
            PG8_LDA(At, 1, 1); PG8_STAGE(PG8_SB(1, 0), b3, voffB); PG8_STAGE(PG8_SB(1, 1), b3 + hstep, voffB); PG8_STAGE(PG8_SA(1, 0), a3, ca0);
            PG8_WAIT_V(8); PG8_WAIT_L(0); PG8_BAR; PG8_MMA(1, 0, At, B0); PG8_MMA(1, 1, At, B1); PG8_BAR; PG8_SCHED;
            } else {
            PG8_LDB(B0, 0, 0); PG8_SCHED; PG8_LDA(At, 0, 0); PG8_STAGE(PG8_SA(1, 1), a1, ca1);
            if (last && has_next) { if (Sched::PREFETCH) { ca0[0] = na0[0]; ca0[1] = na0[1]; ca1[0] = na1[0]; ca1[1] = na1[1]; } else PG8_AROWS(nxt, ca0, ca1); }
            PG8_WAIT_L(8); PG8_BAR; PG8_WAIT_L(0); PG8_MMA(0, 0, At, B0); PG8_BAR; PG8_SCHED;
            PG8_LDB(B1, 0, 1); PG8_STAGE(PG8_SB(0, 0), b2, voffB);
            PG8_BAR; PG8_WAIT_L(0); PG8_MMA(0, 1, At, B1); PG8_BAR;
            PG8_LDA(At, 0, 1); PG8_STAGE(PG8_SA(0, 0), a2, ca0);
            PG8_BAR; PG8_WAIT_L(0); PG8_MMA(1, 0, At, B0); PG8_BAR; PG8_SCHED;
            PG8_STAGE(PG8_SB(0, 1), b2 + hstep, voffB);
            PG8_WAIT_V(6); PG8_BAR; PG8_MMA(1, 1, At, B1); PG8_BAR;
            PG8_LDB(B0, 1, 0); PG8_SCHED; PG8_LDA(At, 1, 0); PG8_STAGE(PG8_SA(0, 1), a2, ca1);
            PG8_WAIT_L(8); PG8_BAR; PG8_WAIT_L(0); PG8_MMA(0, 0, At, B0); PG8_BAR; PG8_SCHED;
            PG8_LDB(B1, 1, 1); PG8_STAGE(PG8_SB(1, 0), b3, voffB);
            PG8_BAR; PG8_WAIT_L(0); PG8_MMA(0, 1, At, B1); PG8_BAR;
            PG8_LDA(At, 1, 1); PG8_STAGE(PG8_SA(1, 0), a3, ca0);
            PG8_BAR; PG8_WAIT_L(0); PG8_MMA(1, 0, At, B0); PG8_BAR; PG8_SCHED;
            PG8_STAGE(PG8_SB(1, 1), b3 + hstep, voffB);
            PG8_WAIT_V(6); PG8_BAR; PG8_MMA(1, 1, At, B1); PG8_BAR;
            }
        }
        if constexpr (ALIGN_EPI) { if (wr == 0) PG8_BAR; }
        E(acc, cur, wr, wc, fr, fq);
        if (!has_next) break;
#pragma unroll
        for (int a = 0; a < 2; ++a)
#pragma unroll
            for (int b = 0; b < 2; ++b)
#pragma unroll
                for (int m = 0; m < 4; ++m)
#pragma unroll
                    for (int n = 0; n < 2; ++n) acc[a][b][m][n] = (f32x4){0.f, 0.f, 0.f, 0.f};
        cur = nxt; cB = nB; ++ui;
        if constexpr (ALIGN_EPI) { if (wr == 1) PG8_BAR; }
    }
    PG8_WAIT_V(0);
    if constexpr (!ALIGN_EPI) { if (wr == 0) PG8_BAR; }
    PG8_BAR;
#undef PG8_AROWS
#undef PG8_SA
#undef PG8_SB
#undef PG8_STAGE
#undef PG8_LDA
#undef PG8_RD8
#undef PG8_LDB
#undef PG8_MMA
#undef PG8_WAIT_V
#undef PG8_WAIT_L
#undef PG8_BAR
#undef PG8_SCHED
}

struct EpiBf16 {
    static constexpr bool PERM = true;
    bf16_t* O; int ldc;
    __device__ __forceinline__ void operator()(const f32x4 (&acc)[2][2][4][2], const Unit& u, int wr, int wc, int fr, int fq) const {
        const int row0 = u.pm * BM + wr * 64 + fr, col0 = u.pn * BM + wc * 32 + 8 * fq;
#pragma unroll
        for (int ai = 0; ai < 2; ++ai)
#pragma unroll
            for (int m = 0; m < 4; ++m) { bf16_t* rowp = O + (size_t)(row0 + ai * HALF + m * 16) * ldc + col0;
#pragma unroll
                for (int bj = 0; bj < 2; ++bj) { const f32x4 v0 = acc[ai][bj][m][0], v1 = acc[ai][bj][m][1];
                    u32x4 w; w.x = pk_bf16(v0[0], v0[1]); w.y = pk_bf16(v0[2], v0[3]); w.z = pk_bf16(v1[0], v1[1]); w.w = pk_bf16(v1[2], v1[3]);
                    *(u32x4*)(rowp + bj * HALF) = w; } }
    }
};
struct EpiFp8 {
    static constexpr bool PERM = true;
    unsigned char* O; int ldc; float sc;
    __device__ __forceinline__ void operator()(const f32x4 (&acc)[2][2][4][2], const Unit& u, int wr, int wc, int fr, int fq) const {
        const int row0 = u.pm * BM + wr * 64 + fr, col0 = u.pn * BM + wc * 32 + 8 * fq;
#pragma unroll
        for (int ai = 0; ai < 2; ++ai)
#pragma unroll
            for (int m = 0; m < 4; ++m) { unsigned char* rowp = O + (size_t)(row0 + ai * HALF + m * 16) * ldc + col0;
#pragma unroll
                for (int bj = 0; bj < 2; ++bj) { const f32x4 v0 = acc[ai][bj][m][0] * sc, v1 = acc[ai][bj][m][1] * sc;
                    u32x2 w; w.x = pk_fp8x4(v0[0], v0[1], v0[2], v0[3]); w.y = pk_fp8x4(v1[0], v1[1], v1[2], v1[3]);
                    *(u32x2*)(rowp + bj * HALF) = w; } }
    }
};
struct EpiResid {
    static constexpr bool PERM = true;
    bf16_t* xb; const float* mod2;
    __device__ __forceinline__ void operator()(const f32x4 (&acc)[2][2][4][2], const Unit& u, int wr, int wc, int fr, int fq) const {
        const int rowt = u.pm * BM; const bool isc = rowt >= TL;
        const float* gv = mod2 + (size_t)(isc ? 32 : (rowt >> 11)) * (NMOD * D);
        const int r0 = rowt + wr * 64 + fr, col0 = u.pn * BM + wc * 32 + 8 * fq;
        f32x4 g4[2][2];
#pragma unroll
        for (int bj = 0; bj < 2; ++bj)
#pragma unroll
            for (int n = 0; n < 2; ++n) g4[bj][n] = *(const f32x4*)(gv + col0 + bj * HALF + 4 * n);
#pragma unroll
        for (int ai = 0; ai < 2; ++ai)
#pragma unroll
            for (int m = 0; m < 4; ++m) { bf16_t* rowp = xb + (size_t)(r0 + ai * HALF + m * 16) * D + col0;
#pragma unroll
                for (int bj = 0; bj < 2; ++bj) { const u32x4 xv = *(const u32x4*)(rowp + bj * HALF);
                    const f32x4 v0 = acc[ai][bj][m][0] * g4[bj][0], v1 = acc[ai][bj][m][1] * g4[bj][1];
                    u32x4 w; w.x = pk_bf16(bflo(xv.x) + v0[0], bfhi(xv.x) + v0[1]); w.y = pk_bf16(bflo(xv.y) + v0[2], bfhi(xv.y) + v0[3]);
                    w.z = pk_bf16(bflo(xv.z) + v1[0], bfhi(xv.z) + v1[1]); w.w = pk_bf16(bflo(xv.w) + v1[2], bfhi(xv.w) + v1[3]);
                    *(u32x4*)(rowp + bj * HALF) = w; } }
    }
};
}

typedef const Params __attribute__((address_space(4)))* KParams;
struct Frame {
    KParams P; LAS unsigned char* lds; GAS unsigned char* wsg; int vcu;
    __device__ __forceinline__ unsigned char* ws_() const { return (unsigned char*)wsg; }
    __device__ __forceinline__ const float* in(int k) const { return (const float*)P->in[k]; }
    __device__ __forceinline__ float* out() const { return (float*)P->out; } int tid, lane, wave, G, bid;
    unsigned* ctl;
};

struct TrDesc { const float* src; int ld, k0, n0; bf16_t* dst; int ldd, drow0; int f8; };
__device__ __forceinline__ void tr_load(const Frame& F, const TrDesc& d, f32x4 (&v)[2]) {
    const int r = F.tid >> 4, c4 = F.tid & 15;
#pragma unroll
    for (int i = 0; i < 2; ++i) v[i] = *(const f32x4*)(d.src + (size_t)(d.k0 + r + 32 * i) * d.ld + d.n0 + 4 * c4);
}
__device__ __forceinline__ void tr_put(const Frame& F, LAS float* tile, const f32x4 (&v)[2]) {
    const int r = F.tid >> 4, c4 = F.tid & 15;
#pragma unroll
    for (int i = 0; i < 2; ++i)
#pragma unroll
        for (int e = 0; e < 4; ++e) tile[(r + 32 * i) * 65 + 4 * c4 + e] = v[i][e];
}
__device__ __forceinline__ void tr_out(const Frame& F, const LAS float* tile, const TrDesc& d) {
    const int n = F.tid >> 3, kq = F.tid & 7;
    float v[8];
#pragma unroll
    for (int j = 0; j < 8; ++j) v[j] = tile[(8 * kq + j) * 65 + n];
    if (d.f8) { u32x2 w; w.x = pk_fp8x4(v[0] * 64.f, v[1] * 64.f, v[2] * 64.f, v[3] * 64.f); w.y = pk_fp8x4(v[4] * 64.f, v[5] * 64.f, v[6] * 64.f, v[7] * 64.f);
        *(u32x2*)((unsigned char*)d.dst + (size_t)(d.drow0 + n) * d.ldd + d.k0 + 8 * kq) = w; return; }
    u32x4 w; w.x = pk_bf16(v[0], v[1]); w.y = pk_bf16(v[2], v[3]); w.z = pk_bf16(v[4], v[5]); w.w = pk_bf16(v[6], v[7]);
    *(u32x4*)(d.dst + (size_t)(d.drow0 + n) * d.ldd + d.k0 + 8 * kq) = w;
}
#define TR_PIPELINE(F, first, stride, count, DESC) do { \
    LAS float* tb0_ = (LAS float*)(F).lds; LAS float* tb1_ = tb0_ + 64 * 65; \
    int it_ = (first); \
    if (it_ < (count)) { TrDesc dc_ = DESC(it_); f32x4 rv_[2]; tr_load(F, dc_, rv_); int par_ = 0; \
        __syncthreads(); \
        for (;;) { LAS float* tb_ = par_ ? tb1_ : tb0_; tr_put(F, tb_, rv_); \
            const int nx_ = it_ + (stride); const bool mo_ = nx_ < (count); TrDesc dn_ = dc_; \
            if (mo_) { dn_ = DESC(nx_); tr_load(F, dn_, rv_); } \
            __syncthreads(); tr_out(F, tb_, dc_); \
            if (!mo_) break; dc_ = dn_; it_ = nx_; par_ ^= 1; } \
        __syncthreads(); } } while (0)

enum { I_X = 0, I_C, I_CTX, I_CCTX, I_WADA, I_BADA, I_GMIX, I_GFFN, I_WIN, I_WOUT, I_ACW, I_ACB, I_AWR, I_ABR, I_AWI, I_ABI, I_ALAM,
       I_LQ1, I_LK1, I_LQ2, I_LK2, I_SUBG, I_CCW, I_CCB, I_CLG, I_CLB, I_CWPW, I_CBPW, I_DCW, I_DCB, I_DWF1, I_DBF1, I_DFREQ, I_DWF2, I_DBF2, I_DWF3,
       I_DDECAY, I_DBIAS, I_WRG, I_BRG, I_WRE, I_BRE, I_WGATE, I_WUP, I_WDOWN, I_GFINAL };

__device__ __forceinline__ void p0_mods_item(const Frame& F, const int it) {
    LAS float* sS = (LAS float*)F.lds;
    LAS float* red = sS + 33 * 512;
    static_assert((33 * 512 + 8 * 33 * 64) * 4 <= LDS_BARW, "p0_mods LDS");
    const float* c = F.in(I_C); const float* cc = F.in(I_CCTX);
    {
        const int l = it / 96, col0 = (it % 96) * 64;
        const float* W = F.in(I_WADA) + (size_t)l * D * (NMOD * D);
        const int cq = F.tid & 31, ks = F.tid >> 5;
        float acc[33][2];
#pragma unroll
        for (int b = 0; b < 33; ++b) { acc[b][0] = 0.f; acc[b][1] = 0.f; }
        for (int kh = 0; kh < 2; ++kh) {
            __syncthreads();
            {   float cv[33];
                const int k = kh * 512 + F.tid;
#pragma unroll
                for (int b = 0; b < 33; ++b) cv[b] = (b < 32) ? c[b * 1024 + k] : cc[k];
                __builtin_amdgcn_sched_barrier(0);
#pragma unroll
                for (int b = 0; b < 33; ++b) sS[b * 512 + F.tid] = silu_f(cv[b]); }
            __syncthreads();
#pragma unroll 1
            for (int kb = 0; kb < 32; kb += 8) {
                f32x2 wv[8];
#pragma unroll
                for (int u = 0; u < 8; ++u) wv[u] = *(const f32x2*)(W + (size_t)(kh * 512 + ks * 32 + kb + u) * (NMOD * D) + col0 + 2 * cq);
#pragma unroll
                for (int b = 0; b < 33; ++b) { const f32x4 s0 = *(const LAS f32x4*)(sS + b * 512 + ks * 32 + kb), s1 = *(const LAS f32x4*)(sS + b * 512 + ks * 32 + kb + 4);
                    const float sv[8] = {s0[0], s0[1], s0[2], s0[3], s1[0], s1[1], s1[2], s1[3]};
#pragma unroll
                    for (int u = 0; u < 8; ++u) { acc[b][0] += sv[u] * wv[u][0]; acc[b][1] += sv[u] * wv[u][1]; } }
            }
        }
#pragma unroll
        for (int b = 0; b < 33; ++b) { acc[b][0] += __shfl_xor(acc[b][0], 32); acc[b][1] += __shfl_xor(acc[b][1], 32); }
        if (F.lane < 32) {
#pragma unroll
            for (int b = 0; b < 33; ++b) { red[(F.wave * 33 + b) * 64 + 2 * cq] = acc[b][0]; red[(F.wave * 33 + b) * 64 + 2 * cq + 1] = acc[b][1]; }
        }
        __syncthreads();
        float* mod = (float*)(F.ws_() + WS_MOD) + (size_t)l * 33 * (NMOD * D);
        const float* bada = F.in(I_BADA) + (size_t)l * (NMOD * D);
        for (int o = F.tid; o < 33 * 64; o += NTHREADS) { const int b = o >> 6, cl = o & 63; float s = 0.f;
#pragma unroll
            for (int w = 0; w < 8; ++w) s += red[(w * 33 + b) * 64 + cl];
            mod[(size_t)b * (NMOD * D) + col0 + cl] = s + bada[col0 + cl]; }
        __syncthreads();
    }
}

__device__ __forceinline__ void p0_rope(const Frame& F) {
    float* ct = (float*)(F.ws_() + WS_ROPE); float* st = ct + 2048 * 16;
    for (int i = F.bid * NTHREADS + F.tid; i < 2048 * 16; i += F.G * NTHREADS) {
        const int t = i >> 4, f = i & 15; const float inv = powf(10000.0f, -(float)(f & 7) / 8.0f);
        const float pos = (f < 8) ? (float)(t >> 6) : (float)(t & 63); const float a = pos * inv;
        ct[i] = cosf(a); st[i] = sinf(a);
    }
}

__device__ __forceinline__ TrDesc p0_tr_desc(const Frame& F, int it) {
    constexpr int N1 = 2560, N2 = N1 + 1024, N3 = N2 + 64, N4 = N3 + 128;
    TrDesc d;
    if (it >= N4) { const int j = it - N4, l = j / 320, r = j % 320, kt = r / 20, nt = r % 20;
        d = TrDesc{F.in(I_WIN) + (size_t)l * D * DIN, DIN, kt * 64, 512 + nt * 64, (bf16_t*)(F.ws_() + WS_WIN8 + (size_t)l * 1280 * 1024), 1024, nt * 64, 1}; return d; }
    if (it < N1) { const int l = it / 640, r = it % 640, kt = r / 40, nt = r % 40;
        const int n0 = nt * 64, pr = n0 < 512 ? n0 + 1280 : (n0 < 1792 ? n0 - 512 : n0);
        d = TrDesc{F.in(I_WIN) + (size_t)l * D * DIN, DIN, kt * 64, n0, (bf16_t*)(F.ws_() + WS_WINT) + (size_t)l * DIN * D, D, pr, 0}; }
    else if (it < N2) { const int j = it - N1, l = j / 256, r = j % 256, kt = r / 16, nt = r % 16;
        d = TrDesc{F.in(I_WOUT) + (size_t)l * D * D, D, kt * 64, nt * 64, (bf16_t*)(F.ws_() + WS_WOUTT) + (size_t)l * D * D, D, nt * 64, 0}; }
    else if (it < N3) { const int j = it - N2, l = j / 16, r = j % 16, kt = r / 4, nt = r % 4;
        d = TrDesc{F.in(I_CWPW) + (size_t)l * 256 * 256, 256, kt * 64, nt * 64, (bf16_t*)(F.ws_() + WS_CPW) + (size_t)l * 256 * 256, 256, nt * 64, 0}; }
    else { const int j = it - N3, gate = j / 64, m = j % 64;
        const int l = m / 8, dir = (m / 4) & 1, hd = m & 3;
        d = TrDesc{F.in(gate ? I_AWI : I_AWR) + (size_t)m * 4096, 64, 0, 0, (bf16_t*)(F.ws_() + WS_LRUW) + ((size_t)((l * 2 + dir) * 2 + gate) * 4 + hd) * 4096, 64, 0, 0}; }
    return d;
}
__device__ __forceinline__ void p0_transposes_chunk(const Frame& F, const int ck) {
#define P0_DESC(i) p0_tr_desc(F, (i))
    TR_PIPELINE(F, ck * 8, 1, ck * 8 + 8, P0_DESC);
#undef P0_DESC
}

__device__ __forceinline__ void p0_filter_item(const Frame& F, const int it) {
    LAS float* feats = (LAS float*)F.lds;
    LAS float* f1 = feats + 32 * 33;
    LAS float* f2 = f1 + 32 * 64;
    LAS float* tun = f2 + 32 * 64;
    {
        const int l = it / 72, ch = it % 72; const bool isc = ch >= 64; const int Lf = isc ? LC : SEQ; const int t0 = isc ? (ch - 64) * 32 : ch * 32;
        const float* wf1 = F.in(I_DWF1) + (size_t)l * 33 * 64; const float* bf1 = F.in(I_DBF1) + l * 64; const float* frq = F.in(I_DFREQ) + l * 64;
        const float* wf2 = F.in(I_DWF2) + (size_t)l * 64 * 64; const float* bf2 = F.in(I_DBF2) + l * 64;
        const float* wf3 = F.in(I_DWF3) + (size_t)l * 64 * 1024; const float* dec = F.in(I_DDECAY) + l * 1024;
        __syncthreads();
        for (int i = F.tid; i < 32 * 33; i += NTHREADS) { const int p = i / 33, f = i % 33; const float t = (float)(t0 + p);
            float v;
            if (f == 0) v = t / (float)(Lf - 1);
            else { const int bi = (f - 1) & 15; const float band = 1e-4f + (float)bi * ((15.0f - 1e-4f) / 15.0f);
                   const float ang = (6.283185307179586f / (float)Lf) * t * band; v = (f <= 16) ? cosf(ang) : -sinf(ang); }
            feats[i] = v; if (f == 0) tun[p] = v; }
        __syncthreads();
        for (int i = F.tid; i < 32 * 64; i += NTHREADS) { const int p = i >> 6, j = i & 63; float s = bf1[j];
            for (int f = 0; f < 33; ++f) s += feats[p * 33 + f] * wf1[f * 64 + j];
            f1[i] = sinf(frq[j] * s); }
        __syncthreads();
        for (int i = F.tid; i < 32 * 64; i += NTHREADS) { const int p = i >> 6, j = i & 63; float s = bf2[j];
            for (int f = 0; f < 64; ++f) s += f1[p * 64 + f] * wf2[f * 64 + j];
            f2[i] = sinf(frq[j] * s); }
        __syncthreads();
        {   const int c4 = (F.tid & 255) * 4, pg = F.tid >> 8;
            const f32x4 dc = *(const f32x4*)(dec + c4);
            float acc[16][4];
#pragma unroll
            for (int p = 0; p < 16; ++p) { acc[p][0] = 0.f; acc[p][1] = 0.f; acc[p][2] = 0.f; acc[p][3] = 0.f; }
#pragma unroll 2
            for (int k = 0; k < 64; ++k) { const f32x4 w = *(const f32x4*)(wf3 + (size_t)k * 1024 + c4);
#pragma unroll
                for (int p = 0; p < 16; ++p) { const float a = f2[(pg * 16 + p) * 64 + k]; acc[p][0] += a * w[0]; acc[p][1] += a * w[1]; acc[p][2] += a * w[2]; acc[p][3] += a * w[3]; } }
#pragma unroll
            for (int p = 0; p < 16; ++p) { const float tu = tun[pg * 16 + p];
#pragma unroll
                for (int e = 0; e < 4; ++e) acc[p][e] *= expf(-tu * fabsf(dc[e])); }
            float* rawt = (float*)(F.ws_() + WS_FRAW) + (size_t)l * 2304 * 1024 + (isc ? (size_t)1024 * 2048 : 0);
#pragma unroll
            for (int e = 0; e < 4; ++e) { float* dst = rawt + (size_t)(c4 + e) * Lf + t0 + pg * 16;
#pragma unroll
                for (int q = 0; q < 4; ++q) *(f32x4*)(dst + 4 * q) = (f32x4){acc[4 * q][e], acc[4 * q + 1][e], acc[4 * q + 2][e], acc[4 * q + 3][e]}; }
        }
    }
}

__device__ __forceinline__ void p0_xc_chunk(const Frame& F, const int ck) {
    u32x4* d = (u32x4*)(F.ws_() + WS_XB);
    const size_t nl8 = (size_t)TL * D / 8, base = (size_t)ck * 128 * D / 8;
#pragma unroll 2
    for (int q0 = 0; q0 < 32; q0 += 4) {
        f32x4 a[4], c[4];
#pragma unroll
        for (int u = 0; u < 4; ++u) { const size_t i = base + (size_t)(q0 + u) * NTHREADS + F.tid; const f32x4* sp = (i < nl8) ? (const f32x4*)F.in(I_X) + 2 * i : (const f32x4*)F.in(I_CTX) + 2 * (i - nl8); a[u] = sp[0]; c[u] = sp[1]; }
#pragma unroll
        for (int u = 0; u < 4; ++u) { const size_t i = base + (size_t)(q0 + u) * NTHREADS + F.tid; d[i] = (u32x4){pk_bf16(a[u][0], a[u][1]), pk_bf16(a[u][2], a[u][3]), pk_bf16(c[u][0], c[u][1]), pk_bf16(c[u][2], c[u][3])}; }
    }
}

__device__ __forceinline__ void p0_gr(const Frame& F) {
    LAS float* red = (LAS float*)F.lds;
    for (int it = F.bid; it < 2048 + 256; it += F.G) {
        const bool isc = it >= 2048; const int Lf = isc ? LC : SEQ;
        const int row = isc ? (it - 2048) * 8 + F.wave : it;
        const int c = row & 255, o = (row >> 8) & 1, l = row >> 9;
        const float* rawt = (const float*)(F.ws_() + WS_FRAW) + (size_t)l * 2304 * 1024 + (isc ? (size_t)1024 * 2048 : 0);
        const float* fw = rawt + (size_t)((2 * o) * 256 + c) * Lf; const float* bw = rawt + (size_t)((2 * o + 1) * 256 + c) * Lf;
        const int x0 = 8 * (isc ? F.lane : F.tid);
        float v[8]; float es = 0.f;
#pragma unroll
        for (int j = 0; j < 8; ++j) { const int x = x0 + j; v[j] = (x == 0) ? 0.f : (x <= Lf ? fw[Lf - x] : bw[x - Lf]); es += v[j] * v[j]; }
        es = wave_sum(es);
        if (!isc) { __syncthreads(); if (F.lane == 0) red[F.wave] = es; __syncthreads(); es = ((red[0] + red[1]) + (red[2] + red[3])) + ((red[4] + red[5]) + (red[6] + red[7])); }
        const float sc = rsqrtf(es + EPS);
        const float bias = F.in(I_DBIAS)[(size_t)l * 512 + o * 256 + c];
#pragma unroll
        for (int j = 0; j < 8; ++j) { v[j] *= sc; if (x0 + j == Lf) v[j] += bias; }
        bf16_t* G = isc ? (bf16_t*)(F.ws_() + WS_GRC) + (size_t)row * 512 : (bf16_t*)(F.ws_() + WS_GR) + (size_t)row * 4096;
        *(bf16x8*)(G + x0) = pk8(v);
    }
}

__device__ __forceinline__ void p0_rtab(const Frame& F) {
    for (int it = F.bid; it < 4 * 33; it += F.G) {
        const int l = it / 33, b = it % 33;
        const float* mod = (const float*)(F.ws_() + WS_MOD) + ((size_t)l * 33 + b) * (NMOD * D);
        const float* sh = mod + 3 * D; const float* sc = mod + 4 * D; const float* gn = F.in(I_GFFN) + (size_t)l * D;
        float* GG = (float*)(F.ws_() + WS_GG) + ((size_t)l * 33 + b) * D; float* RB = (float*)(F.ws_() + WS_RB) + ((size_t)l * 33 + b) * 48;
        for (int k = F.tid; k < D; k += NTHREADS) GG[k] = gn[k] * (1.0f + sc[k]);
        const float* wrg = F.in(I_WRG) + (size_t)l * D * 4; const float* wre = F.in(I_WRE) + (size_t)l * D * 32;
        for (int j = F.wave; j < 48; j += 8) {
            float s = 0.f;
            if (j < 36) { for (int k = F.lane; k < D; k += 64) s += sh[k] * (j < 32 ? wre[(size_t)k * 32 + j] : wrg[(size_t)k * 4 + (j - 32)]); }
            s = wave_sum(s);
            if (F.lane == 0) RB[j] = (j < 32) ? s + F.in(I_BRE)[l * 32 + j] : (j < 36 ? s + F.in(I_BRG)[l * 4 + (j - 32)] : 0.f);
        }
    }
}

template <int MODE>
__device__ __forceinline__ void row_norm_phase(const Frame& F, int l, int lprev, bool from_input) {
    const bool addmoe = (lprev >= 0);
    const float* modp = (const float*)(F.ws_() + WS_MOD) + (size_t)l * 33 * (NMOD * D);
    const float* modm = (const float*)(F.ws_() + WS_MOD) + (size_t)(lprev >= 0 ? lprev : 0) * 33 * (NMOD * D) + 5 * D;
    const float* gn = (MODE == 2) ? F.in(I_GFINAL) : F.in(I_GMIX) + (size_t)l * D;
    LAS int* rb = (LAS int*)(F.lds + 131072);
    if (addmoe) {
        if (F.tid == 0) { const unsigned* cnt = F.ctl + CW_CNT + lprev * 32; int acc = 0; for (int e = 0; e < 32; ++e) { rb[e] = acc; acc += ((int)cnt[e] + 255) / 256 * 256; } }
        __syncthreads();
    }
    const int nrows = (MODE == 2) ? TL : TT;
    const int RPB = (nrows + F.G - 1) / F.G, rbeg = F.bid * RPB, rend = (rbeg + RPB < nrows) ? rbeg + RPB : nrows;
    const unsigned char* O = F.ws_() + WS_O;
    const i32x4* tokinf = (const i32x4*)(F.ws_() + WS_TOKINF);
    const int lo4 = 4 * F.lane;
    f32x4 gq[4];
#pragma unroll
    for (int i = 0; i < 4; ++i) gq[i] = *(const f32x4*)(gn + i * 256 + lo4);
    f32x4 gmq[4], shq[4], scq[4]; int curb = -1;
#pragma unroll
    for (int i = 0; i < 4; ++i) { gmq[i] = (f32x4){0.f, 0.f, 0.f, 0.f}; shq[i] = gmq[i]; scq[i] = gmq[i]; }
    u32x2 xa[4]; unsigned oa[4], oc[4]; i32x4 tin = (i32x4){0, 0, 0, 0};
    bf16_t* XB = (bf16_t*)(F.ws_() + WS_XB);
#define RN_LOADX(r) do { const bf16_t* xp_ = XB + (size_t)(r) * D; _Pragma("unroll") for (int i = 0; i < 4; ++i) xa[i] = *(const u32x2*)(xp_ + i * 256 + lo4); } while (0)
#define RN_LOADO(ti_) do { const size_t r0_ = (size_t)(rb[(ti_).x] + (ti_).y), r1_ = (size_t)(rb[(ti_).z] + (ti_).w); \
        _Pragma("unroll") for (int i = 0; i < 4; ++i) { oa[i] = *(const unsigned*)(O + r0_ * D + i * 256 + lo4); oc[i] = *(const unsigned*)(O + r1_ * D + i * 256 + lo4); } } while (0)
    int row = rbeg + F.wave;
    if (row < rend) { RN_LOADX(row); if (addmoe) { const i32x4 t0 = tokinf[row]; RN_LOADO(t0); if (row + 8 < rend) tin = tokinf[row + 8]; } }
    for (; row < rend; row += 8) {
        f32x4 v[4]; unsigned a[4], c[4];
#pragma unroll
        for (int i = 0; i < 4; ++i) { v[i] = (f32x4){bflo(xa[i].x), bfhi(xa[i].x), bflo(xa[i].y), bfhi(xa[i].y)}; a[i] = oa[i]; c[i] = oc[i]; }
        if (row + 8 < rend) { RN_LOADX(row + 8); if (addmoe) { const i32x4 t1 = tin; RN_LOADO(t1); if (row + 16 < rend) tin = tokinf[row + 16]; } }
        const bool isc = row >= TL; const int b = isc ? 32 : (row >> 11);
        if (b != curb) { curb = b;
            if (addmoe) { const float* gm = modm + (size_t)b * (NMOD * D);
#pragma unroll
                for (int i = 0; i < 4; ++i) gmq[i] = *(const f32x4*)(gm + i * 256 + lo4); }
            if (MODE != 2) { const float* sh = modp + (size_t)b * (NMOD * D);
#pragma unroll
                for (int i = 0; i < 4; ++i) { shq[i] = *(const f32x4*)(sh + i * 256 + lo4); scq[i] = *(const f32x4*)(sh + D + i * 256 + lo4); } }
        }
        if (addmoe) {
#pragma unroll
            for (int i = 0; i < 4; ++i) { const int ai_ = (int)a[i], ci_ = (int)c[i];
                v[i][0] += gmq[i][0] * 0.0625f * (__builtin_amdgcn_cvt_f32_fp8(ai_, 0) + __builtin_amdgcn_cvt_f32_fp8(ci_, 0)); v[i][1] += gmq[i][1] * 0.0625f * (__builtin_amdgcn_cvt_f32_fp8(ai_, 1) + __builtin_amdgcn_cvt_f32_fp8(ci_, 1));
                v[i][2] += gmq[i][2] * 0.0625f * (__builtin_amdgcn_cvt_f32_fp8(ai_, 2) + __builtin_amdgcn_cvt_f32_fp8(ci_, 2)); v[i][3] += gmq[i][3] * 0.0625f * (__builtin_amdgcn_cvt_f32_fp8(ai_, 3) + __builtin_amdgcn_cvt_f32_fp8(ci_, 3)); }
            if (MODE != 2) { bf16_t* xw = XB + (size_t)row * D;
#pragma unroll
                for (int i = 0; i < 4; ++i) { u32x2 w; w.x = pk_bf16(v[i][0], v[i][1]); w.y = pk_bf16(v[i][2], v[i][3]); *(u32x2*)(xw + i * 256 + lo4) = w; }
            }
        }
        float ss = 0.f;
#pragma unroll
        for (int i = 0; i < 4; ++i) ss += v[i][0] * v[i][0] + v[i][1] * v[i][1] + v[i][2] * v[i][2] + v[i][3] * v[i][3];
        ss = wave_sum(ss);
        const float rstd = rsqrtf(ss * (1.0f / D) + EPS);
        if (MODE == 2) { float* xr = F.out() + (size_t)row * D;
#pragma unroll
            for (int i = 0; i < 4; ++i) { f32x4 o;
#pragma unroll
                for (int e = 0; e < 4; ++e) o[e] = v[i][e] * rstd * gq[i][e];
                *(f32x4*)(xr + i * 256 + lo4) = o; }
        } else {
            bf16_t* hrow = (bf16_t*)(F.ws_() + WS_H) + (size_t)row * D; unsigned char* h8 = F.ws_() + WS_H8 + (size_t)row * D;
#pragma unroll
            for (int i = 0; i < 4; ++i) { float o[4];
#pragma unroll
                for (int e = 0; e < 4; ++e) o[e] = v[i][e] * rstd * gq[i][e] * (1.0f + scq[i][e]) + shq[i][e];
                u32x2 w; w.x = pk_bf16(o[0], o[1]); w.y = pk_bf16(o[2], o[3]); *(u32x2*)(hrow + i * 256 + lo4) = w;
                *(unsigned*)(h8 + i * 256 + lo4) = pk_fp8x4(o[0], o[1], o[2], o[3]); }
        }
    }
#undef RN_LOADX
#undef RN_LOADO
}

__device__ __forceinline__ TrDesc moe_tr_desc(const Frame& F, int l, int it) {
    TrDesc d;
    if (it < 8192) { const int up = it >= 4096, j = it & 4095, e = j >> 7, r = j & 127, kt = r >> 3, nt = r & 7;
        const int n0 = nt * 64, drow0 = (n0 >> 7) * 256 + (up ? 128 : 0) + (n0 & 127) - n0;
        d = TrDesc{F.in(up ? I_WUP : I_WGATE) + ((size_t)l * 32 + e) * D * DEXP, DEXP, kt * 64, n0, (bf16_t*)(F.ws_() + WS_MOEGU + (size_t)e * 1024 * 1024), 1024, drow0 + n0, 1}; }
    else { const int j = it - 8192, e = j >> 7, r = j & 127, kt = r >> 4, nt = r & 15;
        d = TrDesc{F.in(I_WDOWN) + ((size_t)l * 32 + e) * DEXP * D, D, kt * 64, nt * 64, (bf16_t*)(F.ws_() + WS_MOEDN + (size_t)e * 1024 * 512), 512, nt * 64, 1}; }
    return d;
}
constexpr int MOE_TILES_P1 = 2048, MOE_CH_Q0 = 640, MOE_CH_Q1 = 640;
static_assert(MOE_TILES_P1 % 8 == 0 && MOE_TILES_P1 + 8 * (MOE_CH_Q0 + MOE_CH_Q1) == 12288, "MoE weight tiles");
__device__ __forceinline__ void moe_weight_cvt(const Frame& F, int l) {
#define MOE_DESC(i) moe_tr_desc(F, l, (i))
    TR_PIPELINE(F, F.bid, F.G, MOE_TILES_P1, MOE_DESC);
#undef MOE_DESC
}
__device__ __forceinline__ void moe_weight_cvt_queue(const Frame& F, int l, int q) {
#define MOE_DESC(i) moe_tr_desc(F, l, (i))
    const int base = MOE_TILES_P1 / 8 + (q ? MOE_CH_Q0 : 0), n = q ? MOE_CH_Q1 : MOE_CH_Q0;
    LAS int* qslot = (LAS int*)(F.lds + LDS_BARW - 16);
    for (;;) {
        __syncthreads();
        if (F.tid == 0) *qslot = (int)__hip_atomic_fetch_add(F.ctl + CW_MQ + l * 2 + q, 1u, __ATOMIC_RELAXED, __HIP_MEMORY_SCOPE_AGENT);
        __syncthreads();
        const int ck = *qslot;
        if (ck >= n) break;
        TR_PIPELINE(F, (base + ck) * 8, 1, (base + ck) * 8 + 8, MOE_DESC);
    }
#undef MOE_DESC
}

__device__ __forceinline__ void hy_pre(const Frame& F, int l, bool do_ctx) {
    constexpr int BST = 1154;
    static_assert(32 * BST * 2 <= LDS_BARW, "hy_pre LDS");
    LAS bf16_t* raw = (LAS bf16_t*)F.lds;
    const bf16_t* P = (const bf16_t*)(F.ws_() + WS_P);
    const float* cw = F.in(I_DCW) + (size_t)l * 3 * 768; const float* cb = F.in(I_DCB) + (size_t)l * 768;
    const int nlat = 128 * 12, nitems = nlat + (do_ctx ? 16 * 12 : 0);
    __syncthreads();
    for (int it = F.bid; it < nitems; it += F.G) {
        const bool isc = it >= nlat; const int jj = isc ? it - nlat : it; const int sblk = jj / 12, cgp = jj % 12;
        const int Lseg = isc ? LC : SEQ; const size_t tokbase = isc ? TL : 0;
        {   u32x4 vv[9];
#pragma unroll
            for (int j = 0; j < 9; ++j) { const int pc = F.tid + j * NTHREADS; const int b = pc / 144, r = (pc % 144) >> 3, q = pc & 7; const int t = sblk * 16 + r - 1;
                const int tc = (t >= 0 && t < Lseg) ? t : 0;
                vv[j] = *(const u32x4*)(P + (tokbase + (size_t)b * Lseg + tc) * DIN + OFF_D + cgp * 64 + q * 8); }
            __builtin_amdgcn_sched_barrier(0);
#pragma unroll
            for (int j = 0; j < 9; ++j) { const int pc = F.tid + j * NTHREADS; const int b = pc / 144, r = (pc % 144) >> 3, q = pc & 7; const int t = sblk * 16 + r - 1;
                const bool ok = t >= 0 && t < Lseg; const u32x4 v = vv[j];
                LAS unsigned* dst = (LAS unsigned*)(raw + b * BST + r * 64 + q * 8);
                dst[0] = ok ? v.x : 0u; dst[1] = ok ? v.y : 0u; dst[2] = ok ? v.z : 0u; dst[3] = ok ? v.w : 0u; }
        }
        __syncthreads();
        const int b = F.tid & 31, cs = F.tid >> 5;
        bf16_t* UF = (bf16_t*)(F.ws_() + WS_UF) + (isc ? (size_t)768 * 65536 : 0);
        const size_t chs = isc ? 8192 : 65536;
#pragma unroll 1
        for (int i = 0; i < 4; ++i) {
            const int chl = cs * 4 + i, ch = cgp * 64 + chl;
            const float w0 = cw[ch], w1 = cw[768 + ch], w2 = cw[1536 + ch], bb = cb[ch];
#pragma unroll
            for (int hh = 0; hh < 2; ++hh) {
                float x[10];
#pragma unroll
                for (int q = 0; q < 10; ++q) x[q] = bf2f(raw[b * BST + (8 * hh + q) * 64 + chl]);
                float u[8];
#pragma unroll
                for (int j = 0; j < 8; ++j) u[j] = bb + w0 * x[j] + w1 * x[j + 1] + w2 * x[j + 2];
                u32x4 w; w.x = pk_bf16(u[0], u[1]); w.y = pk_bf16(u[2], u[3]); w.z = pk_bf16(u[4], u[5]); w.w = pk_bf16(u[6], u[7]);
                *(u32x4*)(UF + (size_t)ch * chs + (((size_t)sblk * 2 + hh) * 32 + b) * 8) = w;
            }
        }
        __syncthreads();
    }
}

template <int ORDER>
__device__ __forceinline__ void hy_conv(const Frame& F, int l, bool do_ctx) {
    LAS bf16_t* Gl = (LAS bf16_t*)F.lds + F.wave * 4096;
    LAS bf16_t* stg = (LAS bf16_t*)(F.lds + 65536 + 1024);
    const int lane = F.lane, i31 = lane & 31, hh = lane >> 5;
    const int nlat = 256, nitems = nlat + (do_ctx ? 32 : 0);
    const bf16_t* UF0 = (const bf16_t*)(F.ws_() + WS_UF); bf16_t* Z10 = (bf16_t*)(F.ws_() + WS_Z1F);
    for (int it = F.vcu; it < nitems; it += F.G) {
        const bool isc = it >= nlat; const int cg = isc ? it - nlat : (it >> 3), tg = isc ? 0 : (it & 7);
        const int Lf = isc ? LC : SEQ; const int c = cg * 8 + F.wave;
        const bf16_t* Gg = isc ? (const bf16_t*)(F.ws_() + WS_GRC) + ((size_t)(l * 2 + ORDER) * 256 + c) * 512
                               : (const bf16_t*)(F.ws_() + WS_GR) + ((size_t)(l * 2 + ORDER) * 256 + c) * 4096;
        {   u32x4 gq[8];
#pragma unroll
            for (int i = 0; i < 8; ++i) { const int q = isc ? lane : lane + 64 * i; gq[i] = *(const u32x4*)(Gg + q * 8); }
#pragma unroll
            for (int i = 0; i < 8; ++i) { const int q = isc ? lane : lane + 64 * i; *(LAS u32x4*)(Gl + q * 8) = gq[i]; } }
        const size_t chs = isc ? 8192 : 65536;
        const bf16_t* UFb = UF0 + (isc ? (size_t)768 * 65536 : 0); bf16_t* Z1b = Z10 + (isc ? (size_t)256 * 65536 : 0);
        const bf16_t* zsrc = (ORDER == 0) ? UFb + (size_t)c * chs : Z1b + (size_t)c * chs;
        const bf16_t* gsrc = UFb + (size_t)(256 * (ORDER + 1) + c) * chs;
        const int t0 = tg * 256;
        f32x16 acc[8];
#pragma unroll
        for (int a = 0; a < 8; ++a)
#pragma unroll
            for (int r = 0; r < 16; ++r) acc[a][r] = 0.f;
        bf16x8 FR[8][2];
#define HY_FRAG(dst, xb) do { const LAS bf16_t* _g = Gl + (xb); _Pragma("unroll") for (int _j = 0; _j < 8; ++_j) dst[_j] = (short)_g[_j]; } while (0)
        const int xb0 = Lf - t0 - i31 + 8 * hh;
#pragma unroll
        for (int a = 0; a < 8; ++a)
#pragma unroll
            for (int ks = 0; ks < 2; ++ks) HY_FRAG(FR[a][ks], xb0 - 32 * a + 16 * ks);
        const int nkp = Lf / 32;
        bf16x8 Bn[2];
        const char* zp = (const char*)zsrc + hh * 512 + i31 * 16;
#define HY_BLOAD(dst, sq) do { _Pragma("unroll") for (int ks = 0; ks < 2; ++ks) dst[ks] = *(const bf16x8*)(zp + (size_t)(sq) * 64 + ks * 1024); } while (0)
        constexpr bool DEEP = (ORDER == 0);
        bf16x8 Bm[2];
        HY_BLOAD(Bn, 0); if (DEEP) HY_BLOAD(Bm, 32);
        for (int nb = 0; nb < nkp; nb += 8) {
#pragma unroll
            for (int u = 0; u < 8; ++u) {
                const int s0 = (nb + u) * 32;
                bf16x8 Bf[2];
                if (DEEP) {
#pragma unroll
                    for (int ks = 0; ks < 2; ++ks) { Bf[ks] = Bn[ks]; Bn[ks] = Bm[ks]; }
                    HY_BLOAD(Bm, s0 + 64);
                } else {
#pragma unroll
                    for (int ks = 0; ks < 2; ++ks) Bf[ks] = Bn[ks];
                    HY_BLOAD(Bn, s0 + 32);
                }
                __builtin_amdgcn_sched_barrier(0);
#pragma unroll
                for (int a = 7; a >= 0; --a)
#pragma unroll
                    for (int ks = 0; ks < 2; ++ks) acc[a] = MFMA32(FR[(a - u) & 7][ks], Bf[ks], acc[a]);
#pragma unroll
                for (int ks = 0; ks < 2; ++ks) HY_FRAG(FR[(7 - u) & 7][ks], xb0 + s0 + 32 + 16 * ks);
            }
        }
#undef HY_FRAG
#undef HY_BLOAD
        if (ORDER == 0) {
#pragma unroll
            for (int a = 0; a < 8; ++a)
#pragma unroll
                for (int rg = 0; rg < 4; ++rg) {
                    const size_t off = ((size_t)(((t0 >> 4) + 2 * a + (rg >> 1)) * 2 + (rg & 1)) * 32 + i31) * 8 + 4 * hh;
                    const u32x2 g = *(const u32x2*)(gsrc + off);
                    u32x2 w; w.x = pk_bf16(bflo(g.x) * acc[a][4 * rg], bfhi(g.x) * acc[a][4 * rg + 1]); w.y = pk_bf16(bflo(g.y) * acc[a][4 * rg + 2], bfhi(g.y) * acc[a][4 * rg + 3]);
                    *(u32x2*)(Z1b + (size_t)c * chs + off) = w;
                }
        } else {
            bf16_t* Y = (bf16_t*)(F.ws_() + WS_Y);
            const size_t tokbase = isc ? TL : 0;
#pragma unroll
            for (int a = 0; a < 8; ++a) {
                __syncthreads();
#pragma unroll
                for (int rg = 0; rg < 4; ++rg) {
                    const size_t off = ((size_t)(((t0 >> 4) + 2 * a + (rg >> 1)) * 2 + (rg & 1)) * 32 + i31) * 8 + 4 * hh;
                    const u32x2 g = *(const u32x2*)(gsrc + off);
                    float gv[4] = {bflo(g.x), bfhi(g.x), bflo(g.y), bfhi(g.y)};
#pragma unroll
                    for (int e = 0; e < 4; ++e) { const int tl = 8 * rg + 4 * hh + e; stg[(tl * 32 + i31) * 8 + F.wave] = (bf16_t)(pk_bf16(gv[e] * acc[a][4 * rg + e], 0.f) & 0xffffu); }
                }
                __syncthreads();
#pragma unroll
                for (int q = 0; q < 2; ++q) { const int pr = F.tid + q * NTHREADS, tl = pr >> 5, b = pr & 31;
                    const u32x4 v = *(const LAS u32x4*)(stg + pr * 8);
                    *(u32x4*)(Y + (tokbase + (size_t)b * Lf + t0 + 32 * a + tl) * D + 768 + cg * 8) = v; }
            }
            __syncthreads();
        }
    }
}

constexpr int LR_XR = 0;
constexpr int LR_UB = 17408;
constexpr int LR_WT = LR_UB + 18432;
constexpr int LR_A  = LR_WT + 18432;
constexpr int LR_B  = LR_A + 32768;
constexpr int LR_WS = LR_B + 32768;
static_assert(LR_WS + 4096 <= LDS_BARW, "LRU LDS");

__device__ __forceinline__ void lru_chunk_ab(const Frame& F, int l, int b, int hd, int dir, bool isc, int t_lo) {
    LAS bf16_t* xr = (LAS bf16_t*)(F.lds + LR_XR); LAS bf16_t* ub = (LAS bf16_t*)(F.lds + LR_UB); LAS bf16_t* wt = (LAS bf16_t*)(F.lds + LR_WT);
    LAS float* a_s = (LAS float*)(F.lds + LR_A); LAS float* b_s = (LAS float*)(F.lds + LR_B);
    const bf16_t* P = (const bf16_t*)(F.ws_() + WS_P);
    const int Lseg = isc ? LC : SEQ; const size_t tokbase = (isc ? (size_t)TL : 0) + (size_t)b * Lseg;
    __syncthreads();
    for (int pc = F.tid; pc < 134 * 8; pc += NTHREADS) { const int r = pc >> 3, q = pc & 7; const int t = t_lo - 3 + r;
        u32x4 v = (u32x4){0u, 0u, 0u, 0u};
        if (t >= 0 && t < Lseg) v = *(const u32x4*)(P + (tokbase + t) * DIN + OFF_A + hd * 64 + q * 8);
        *(LAS u32x4*)(xr + r * 64 + q * 8) = v; }
    {   const bf16_t* W = (const bf16_t*)(F.ws_() + WS_LRUW) + (size_t)(l * 2 + dir) * 2 * 4 * 4096;
        for (int pc = F.tid; pc < 2 * 64 * 8; pc += NTHREADS) { const int g = pc >> 9, n = (pc >> 3) & 63, q = pc & 7;
            *(LAS u32x4*)(wt + (g * 64 + n) * 72 + q * 8) = *(const u32x4*)(W + ((size_t)(g * 4 + hd) * 64 + n) * 64 + q * 8); } }
    __syncthreads();
    {
        const int ch = F.tid & 63, tq = F.tid >> 6; const int chg = hd * 64 + ch;
        const float* cw = F.in(I_ACW) + ((size_t)(l * 2 + dir) * 4) * 256 + chg; const float cb = F.in(I_ACB)[(size_t)(l * 2 + dir) * 256 + chg];
        const float w0 = cw[0], w1 = cw[256], w2 = cw[512], w3 = cw[768];
        const int r0 = tq * 16 + (dir ? 3 : 0);
        float x[19];
#pragma unroll
        for (int q = 0; q < 19; ++q) x[q] = bf2f(xr[(r0 + q) * 64 + ch]);
#pragma unroll
        for (int k = 0; k < 16; ++k) { const float u = cb + w0 * x[k] + w1 * x[k + 1] + w2 * x[k + 2] + w3 * x[k + 3];
            ub[(tq * 16 + k) * 72 + ch] = (bf16_t)(pk_bf16(u, 0.f) & 0xffffu); }
    }
    __syncthreads();
    {
        const int w = F.wave, lane = F.lane, row = lane & 15, kq = lane >> 4;
        bf16x8 Af[2];
#pragma unroll
        for (int ks = 0; ks < 2; ++ks) Af[ks] = *(const LAS bf16x8*)(ub + (16 * w + row) * 72 + 32 * ks + 8 * kq);
        const float* br = F.in(I_ABR) + (size_t)(l * 2 + dir) * 256 + hd * 64; const float* bi = F.in(I_ABI) + (size_t)(l * 2 + dir) * 256 + hd * 64;
        const float* lam = F.in(I_ALAM) + (size_t)(l * 2 + dir) * 256 + hd * 64;
#pragma unroll
        for (int nt = 0; nt < 4; ++nt) {
            f32x4 cr = (f32x4){0.f, 0.f, 0.f, 0.f}, ci = cr;
#pragma unroll
            for (int ks = 0; ks < 2; ++ks) {
                const bf16x8 Br = *(const LAS bf16x8*)(wt + (0 * 64 + 16 * nt + row) * 72 + 32 * ks + 8 * kq);
                const bf16x8 Bi = *(const LAS bf16x8*)(wt + (1 * 64 + 16 * nt + row) * 72 + 32 * ks + 8 * kq);
                cr = MFMA16(Af[ks], Br, cr); ci = MFMA16(Af[ks], Bi, ci);
            }
            const int ch = 16 * nt + row;
            const float sp = log1pf(__expf(-lam[ch])), brc = br[ch], bic = bi[ch];
#pragma unroll
            for (int r = 0; r < 4; ++r) { const int tl = 16 * w + 4 * kq + r;
                const float rr = sigmoid_f(cr[r] + brc), ii = sigmoid_f(ci[r] + bic);
                const float a = __expf(-8.0f * rr * sp);
                const float uv = bf2f(ub[tl * 72 + ch]);
                a_s[tl * 64 + ch] = a; b_s[tl * 64 + ch] = sqrtf(fmaxf(1.0f - a * a, 0.f)) * (ii * uv); }
        }
    }
    __syncthreads();
}

__device__ __forceinline__ void lru_s1(const Frame& F, int l) {
    LAS float* a_s = (LAS float*)(F.lds + LR_A); LAS float* b_s = (LAS float*)(F.lds + LR_B); LAS float* wsum = (LAS float*)(F.lds + LR_WS);
    float* SUM = (float*)(F.ws_() + WS_LRUS);
    for (int it = F.bid; it < 32 * 4 * 2 * 18; it += F.G) {
        int r = it; const int n = r % 18; r /= 18; const int dir = r & 1; r >>= 1; const int hd = r & 3; const int b = r >> 2;
        const bool isc = n < 2; const int tc = isc ? (dir ? 1 - n : n) : (dir ? 15 - (n - 2) : n - 2);
        lru_chunk_ab(F, l, b, hd, dir, isc, tc * 128);
        const int w = F.wave, ch = F.lane;
        float A = 1.f, Bv = 0.f;
#pragma unroll
        for (int k = 0; k < 16; ++k) { const int tl = dir ? 127 - 16 * w - k : 16 * w + k; const float a = a_s[tl * 64 + ch], bb = b_s[tl * 64 + ch]; Bv = a * Bv + bb; A *= a; }
        wsum[(w * 2 + 0) * 64 + ch] = A; wsum[(w * 2 + 1) * 64 + ch] = Bv;
        __syncthreads();
        if (w == 0) { float At = 1.f, Bt = 0.f;
#pragma unroll
            for (int q = 0; q < 8; ++q) { const float Aq = wsum[(q * 2) * 64 + ch], Bq = wsum[(q * 2 + 1) * 64 + ch]; Bt = Aq * Bt + Bq; At *= Aq; }
            float* dst = SUM + ((size_t)((b * 2 + dir) * 4 + hd) * 18 + n) * 128;
            dst[ch] = At; dst[64 + ch] = Bt; }
    }
}
__device__ __forceinline__ void lru_s2(const Frame& F) {
    const float* SUM = (const float*)(F.ws_() + WS_LRUS); float* CAR = (float*)(F.ws_() + WS_LRUC);
    if (F.wave != 0) return;
    for (int it = F.bid; it < 32 * 2 * 4; it += F.G) {
        float As[18], Bs[18];
#pragma unroll
        for (int n = 0; n < 18; ++n) { const float* s = SUM + ((size_t)it * 18 + n) * 128; As[n] = s[F.lane]; Bs[n] = s[64 + F.lane]; }
        float carry = 0.f;
#pragma unroll
        for (int n = 0; n < 18; ++n) { CAR[((size_t)it * 18 + n) * 64 + F.lane] = carry; carry = As[n] * carry + Bs[n]; }
    }
}
__device__ __forceinline__ void lru_s3(const Frame& F, int l, bool do_ctx) {
    LAS float* a_s = (LAS float*)(F.lds + LR_A); LAS float* b_s = (LAS float*)(F.lds + LR_B); LAS float* wsum = (LAS float*)(F.lds + LR_WS);
    const float* CAR = (const float*)(F.ws_() + WS_LRUC);
    const bf16_t* P = (const bf16_t*)(F.ws_() + WS_P); bf16_t* Y = (bf16_t*)(F.ws_() + WS_Y);
    const int nlat = 32 * 4 * 16, nitems = nlat + (do_ctx ? 32 * 4 * 2 : 0);
    for (int it = F.bid; it < nitems; it += F.G) {
        const bool isc = it >= nlat; int r = isc ? it - nlat : it; const int ntc = isc ? 2 : 16; const int tc = r % ntc; r /= ntc; const int hd = r & 3; const int b = r >> 2;
        const int w = F.wave, ch = F.lane;
        float hs[16];
#pragma unroll
        for (int k = 0; k < 16; ++k) hs[k] = 0.f;
#pragma unroll
        for (int dir = 0; dir < 2; ++dir) {
            lru_chunk_ab(F, l, b, hd, dir, isc, tc * 128);
            const int n = isc ? (dir ? 1 - tc : tc) : 2 + (dir ? 15 - tc : tc);
            float hl[16], ca[16]; float A = 1.f, Bv = 0.f;
#pragma unroll
            for (int kk = 0; kk < 16; ++kk) { const int k = dir ? 15 - kk : kk; const int tl = 16 * w + k; const float a = a_s[tl * 64 + ch], bb = b_s[tl * 64 + ch]; Bv = a * Bv + bb; A *= a; hl[k] = Bv; ca[k] = A; }
            wsum[(w * 2 + 0) * 64 + ch] = A; wsum[(w * 2 + 1) * 64 + ch] = Bv;
            __syncthreads();
            float s = CAR[((size_t)((b * 2 + dir) * 4 + hd) * 18 + n) * 64 + ch];
            const int myord = dir ? 7 - w : w;
#pragma unroll
            for (int q = 0; q < 8; ++q) { const int wq = dir ? 7 - q : q; if (q < myord) s = wsum[(wq * 2) * 64 + ch] * s + wsum[(wq * 2 + 1) * 64 + ch]; }
#pragma unroll
            for (int k = 0; k < 16; ++k) hs[k] += hl[k] + ca[k] * s;
        }
        const int Lseg = isc ? LC : SEQ; const size_t tokbase = (isc ? (size_t)TL : 0) + (size_t)b * Lseg + tc * 128 + 16 * w;
#pragma unroll
        for (int k = 0; k < 16; ++k) { const float xg = bf2f(P[(tokbase + k) * DIN + OFF_A + 256 + hd * 64 + ch]);
            Y[(tokbase + k) * D + hd * 64 + ch] = (bf16_t)(pk_bf16(hs[k] * gelu_tanh_f(xg), 0.f) & 0xffffu); }
    }
}


__device__ __forceinline__ void lru_seq(const Frame& F, int l, bool ctx_out) {
    LAS bf16_t* xr = (LAS bf16_t*)(F.lds + LR_XR); LAS bf16_t* ub = (LAS bf16_t*)(F.lds + LR_UB); LAS bf16_t* wt = (LAS bf16_t*)(F.lds + LR_WT);
    LAS float* a_s = (LAS float*)(F.lds + LR_A); LAS float* b_s = (LAS float*)(F.lds + LR_B); LAS float* wsum = (LAS float*)(F.lds + LR_WS);
    const bf16_t* P = (const bf16_t*)(F.ws_() + WS_P); bf16_t* HT = (bf16_t*)(F.ws_() + WS_HT);
    const int w = F.wave, lane = F.lane, row = lane & 15, kq = lane >> 4;
    for (int it = F.bid; it < 32 * 4 * 2; it += F.G) {
        const int dir = it & 1, hd = (it >> 1) & 3, b = it >> 3;
        __syncthreads();
        {   const bf16_t* W = (const bf16_t*)(F.ws_() + WS_LRUW) + (size_t)(l * 2 + dir) * 2 * 4 * 4096;
            for (int pc = F.tid; pc < 2 * 64 * 8; pc += NTHREADS) { const int g = pc >> 9, n = (pc >> 3) & 63, q = pc & 7;
                *(LAS u32x4*)(wt + (g * 64 + n) * 72 + q * 8) = *(const u32x4*)(W + ((size_t)(g * 4 + hd) * 64 + n) * 64 + q * 8); } }
        const int cch = F.tid & 63, ctq = F.tid >> 6; const int chg = hd * 64 + cch;
        const float* cw = F.in(I_ACW) + ((size_t)(l * 2 + dir) * 4) * 256 + chg; const float cb = F.in(I_ACB)[(size_t)(l * 2 + dir) * 256 + chg];
        const float w0 = cw[0], w1 = cw[256], w2 = cw[512], w3 = cw[768];
        float spv[4], brv[4], biv[4];
#pragma unroll
        for (int nt = 0; nt < 4; ++nt) { const int ch = hd * 64 + 16 * nt + row; const size_t o = (size_t)(l * 2 + dir) * 256 + ch;
            spv[nt] = log1pf(__expf(-F.in(I_ALAM)[o])); brv[nt] = F.in(I_ABR)[o]; biv[nt] = F.in(I_ABI)[o]; }
        float carry = 0.f;
        u32x4 pf[3];
#define LRS_GEO(n, isc_, tlo_) const bool isc_ = (n) < 2; const int tlo_ = 128 * (isc_ ? (dir ? 1 - (n) : (n)) : (dir ? 15 - ((n) - 2) : (n) - 2))
#define LRS_PREFETCH(n) do { LRS_GEO(n, ic_, tl_); const int Ls_ = ic_ ? LC : SEQ; const size_t tb_ = (ic_ ? (size_t)TL : 0) + (size_t)b * Ls_; \
            _Pragma("unroll") for (int u_ = 0; u_ < 3; ++u_) { const int pc_ = F.tid + u_ * NTHREADS; const int r_ = pc_ >> 3, q_ = pc_ & 7; const int t_ = tl_ - 3 + r_; \
                pf[u_] = (u32x4){0u, 0u, 0u, 0u}; if (pc_ < 134 * 8 && t_ >= 0 && t_ < Ls_) pf[u_] = *(const u32x4*)(P + (tb_ + t_) * DIN + OFF_A + hd * 64 + q_ * 8); } } while (0)
        LRS_PREFETCH(0);
#pragma unroll 1
        for (int n = 0; n < 18; ++n) {
            LRS_GEO(n, isc, t_lo);
            const int Lseg = isc ? LC : SEQ; const size_t tokbase = (isc ? (size_t)TL : 0) + (size_t)b * Lseg + t_lo;
#pragma unroll
            for (int u = 0; u < 3; ++u) { const int pc = F.tid + u * NTHREADS; if (pc < 134 * 8) *(LAS u32x4*)(xr + (pc >> 3) * 64 + (pc & 7) * 8) = pf[u]; }
            __syncthreads();
            {   const int r0 = ctq * 16 + (dir ? 3 : 0);
                float x[19];
#pragma unroll
                for (int q = 0; q < 19; ++q) x[q] = bf2f(xr[(r0 + q) * 64 + cch]);
#pragma unroll
                for (int k = 0; k < 16; ++k) { const float u = cb + w0 * x[k] + w1 * x[k + 1] + w2 * x[k + 2] + w3 * x[k + 3];
                    ub[(ctq * 16 + k) * 72 + cch] = (bf16_t)(pk_bf16(u, 0.f) & 0xffffu); }
            }
            __syncthreads();
            if (n + 1 < 18) LRS_PREFETCH(n + 1);
            {   bf16x8 Af[2];
#pragma unroll
                for (int ks = 0; ks < 2; ++ks) Af[ks] = *(const LAS bf16x8*)(ub + (16 * w + row) * 72 + 32 * ks + 8 * kq);
#pragma unroll
                for (int nt = 0; nt < 4; ++nt) {
                    f32x4 cr = (f32x4){0.f, 0.f, 0.f, 0.f}, ci = cr;
#pragma unroll
                    for (int ks = 0; ks < 2; ++ks) {
                        const bf16x8 Br = *(const LAS bf16x8*)(wt + (0 * 64 + 16 * nt + row) * 72 + 32 * ks + 8 * kq);
                        const bf16x8 Bi = *(const LAS bf16x8*)(wt + (1 * 64 + 16 * nt + row) * 72 + 32 * ks + 8 * kq);
                        cr = MFMA16(Af[ks], Br, cr); ci = MFMA16(Af[ks], Bi, ci);
                    }
                    const int ch = 16 * nt + row;
#pragma unroll
                    for (int r = 0; r < 4; ++r) { const int tl = 16 * w + 4 * kq + r;
                        const float rr = sigmoid_f(cr[r] + brv[nt]), ii = sigmoid_f(ci[r] + biv[nt]);
                        const float a = __expf(-8.0f * rr * spv[nt]);
                        const float uv = bf2f(ub[tl * 72 + ch]);
                        a_s[tl * 64 + ch] = a; b_s[tl * 64 + ch] = sqrtf(fmaxf(1.0f - a * a, 0.f)) * (ii * uv); }
                }
            }
            __syncthreads();
            float hl[16], ca[16]; float A = 1.f, Bv = 0.f;
#pragma unroll
            for (int kk = 0; kk < 16; ++kk) { const int tl = 16 * w + (dir ? 15 - kk : kk); const float a = a_s[tl * 64 + lane], bb = b_s[tl * 64 + lane]; Bv = a * Bv + bb; A *= a; hl[kk] = Bv; ca[kk] = A; }
            wsum[(w * 2 + 0) * 64 + lane] = A; wsum[(w * 2 + 1) * 64 + lane] = Bv;
            __syncthreads();
            float s = carry; const int myord = dir ? 7 - w : w;
#pragma unroll
            for (int q = 0; q < 8; ++q) { const int wq = dir ? 7 - q : q; const float Aq = wsum[(wq * 2) * 64 + lane], Bq = wsum[(wq * 2 + 1) * 64 + lane];
                if (q < myord) s = Aq * s + Bq; carry = Aq * carry + Bq; }
            if (!isc || ctx_out) {
                bf16_t* dst = HT + ((size_t)dir * TT + tokbase + 16 * w) * 256 + hd * 64 + lane;
#pragma unroll
                for (int kk = 0; kk < 16; ++kk) { const int k = dir ? 15 - kk : kk; dst[(size_t)k * 256] = (bf16_t)(pk_bf16(hl[kk] + ca[kk] * s, 0.f) & 0xffffu); }
            }
        }
#undef LRS_GEO
#undef LRS_PREFETCH
    }
}
__device__ __forceinline__ void lru_comb(const Frame& F, bool ctx_out) {
    const bf16_t* P = (const bf16_t*)(F.ws_() + WS_P); const bf16_t* HT = (const bf16_t*)(F.ws_() + WS_HT); bf16_t* Y = (bf16_t*)(F.ws_() + WS_Y);
    const size_t n = (size_t)(ctx_out ? TT : TL) * 32;
    for (size_t i = (size_t)F.bid * NTHREADS + F.tid; i < n; i += (size_t)F.G * NTHREADS) { const size_t rowi = i >> 5; const int c8 = (int)(i & 31) * 8;
        const u32x4 hf = *(const u32x4*)(HT + rowi * 256 + c8), hb = *(const u32x4*)(HT + ((size_t)TT + rowi) * 256 + c8), xg = *(const u32x4*)(P + rowi * DIN + OFF_A + 256 + c8);
        const unsigned hfa[4] = {hf.x, hf.y, hf.z, hf.w}, hba[4] = {hb.x, hb.y, hb.z, hb.w}, xga[4] = {xg.x, xg.y, xg.z, xg.w}; unsigned o[4];
#pragma unroll
        for (int e = 0; e < 4; ++e) o[e] = pk_bf16((bflo(hfa[e]) + bflo(hba[e])) * gelu_tanh_f(bflo(xga[e])), (bfhi(hfa[e]) + bfhi(hba[e])) * gelu_tanh_f(bfhi(xga[e])));
        *(u32x4*)(Y + rowi * D + c8) = (u32x4){o[0], o[1], o[2], o[3]}; }
}

constexpr int CF_GLU = 0;
constexpr int CF_CV  = 48128;
constexpr int CF_ACT = CF_CV + 65536;
static_assert(CF_ACT + 64 * 264 * 2 <= LDS_BARW, "conformer LDS");
#ifndef CONF_STEPS
#define CONF_STEPS 4
#endif
__device__ __forceinline__ void conf_phase(const Frame& F, int l, bool do_ctx) {
    LAS bf16_t* glu = (LAS bf16_t*)(F.lds + CF_GLU); LAS float* cv = (LAS float*)(F.lds + CF_CV); LAS bf16_t* act = (LAS bf16_t*)(F.lds + CF_ACT);
    const bf16_t* P = (const bf16_t*)(F.ws_() + WS_P); bf16_t* Y = (bf16_t*)(F.ws_() + WS_Y);
    const int nlat = TL / 64, nitems = nlat + (do_ctx ? TC / 64 : 0);
    const float* ccw = F.in(I_CCW) + (size_t)l * 31 * 256; const float* ccb = F.in(I_CCB) + (size_t)l * 256;
    const float* lng = F.in(I_CLG) + (size_t)l * 256; const float* lnb = F.in(I_CLB) + (size_t)l * 256; const float* bpw = F.in(I_CBPW) + (size_t)l * 256;
    const bf16_t* Wt = (const bf16_t*)(F.ws_() + WS_CPW) + (size_t)l * 65536;
    bf16x8 Aw[2][8];
#pragma unroll
    for (int nt = 0; nt < 2; ++nt)
#pragma unroll
        for (int ks = 0; ks < 8; ++ks) Aw[nt][ks] = *(const bf16x8*)(Wt + (size_t)(32 * F.wave + 16 * nt + (F.lane & 15)) * 256 + 32 * ks + 8 * (F.lane >> 4));
    for (int it = F.bid; it < nitems; it += F.G) {
        const bool isc = it >= nlat; const int tile = isc ? it - nlat : it; const int Lseg = isc ? LC : SEQ; const int tps = Lseg / 64;
        const int b = tile / tps, t0 = (tile % tps) * 64; const size_t tokbase = (isc ? (size_t)TL : 0) + (size_t)b * Lseg;
        __syncthreads();
        {   u32x2 rv[6], rg[6];
#pragma unroll
            for (int j = 0; j < 6; ++j) { const int pc = F.tid + j * NTHREADS; const int r = (pc >> 5) < 94 ? (pc >> 5) : 93, q = pc & 31; const int t = t0 - 15 + r;
                const int tc = (t >= 0 && t < Lseg) ? t : 0; const unsigned char* src = (const unsigned char*)P + (tokbase + tc) * (DIN * 2) + OFF_C + q * 8;
                rv[j] = *(const u32x2*)src; rg[j] = *(const u32x2*)(src + 256); }
            __builtin_amdgcn_sched_barrier(0);
#pragma unroll
            for (int j = 0; j < 6; ++j) { const int pc = F.tid + j * NTHREADS; const int r = pc >> 5, q = pc & 31; const int t = t0 - 15 + r;
                if (pc < 94 * 32) {
                    u32x4 o = (u32x4){0u, 0u, 0u, 0u};
                    if (t >= 0 && t < Lseg) { float v[8], g[8];
                        dec_fp8x8(rv[j], v); dec_fp8x8(rg[j], g);
                        o.x = pk_bf16(v[0] * sigmoid_f(g[0]), v[1] * sigmoid_f(g[1])); o.y = pk_bf16(v[2] * sigmoid_f(g[2]), v[3] * sigmoid_f(g[3]));
                        o.z = pk_bf16(v[4] * sigmoid_f(g[4]), v[5] * sigmoid_f(g[5])); o.w = pk_bf16(v[6] * sigmoid_f(g[6]), v[7] * sigmoid_f(g[7])); }
                    *(LAS u32x4*)(glu + r * 256 + q * 8) = o; } }
        }
        __syncthreads();
        if (CONF_STEPS < 2) continue;
        {   const int ch = F.tid & 255, tg = F.tid >> 8;
            const float cbv = ccb[ch];
            float wv[31];
#pragma unroll
            for (int j = 0; j < 31; ++j) wv[j] = ccw[j * 256 + ch];
#pragma unroll 1
            for (int kg = 0; kg < 4; ++kg) {
                float xs[38];
#pragma unroll
                for (int q = 0; q < 38; ++q) xs[q] = bf2f(glu[(32 * tg + 8 * kg + q) * 256 + ch]);
#pragma unroll
                for (int kk = 0; kk < 8; ++kk) { float a = cbv;
#pragma unroll
                    for (int j = 0; j < 31; ++j) a += wv[j] * xs[kk + j];
                    cv[(32 * tg + 8 * kg + kk) * 256 + ch] = a; }
            }
        }
        __syncthreads();
        if (CONF_STEPS < 3) continue;
        {
            const f32x4 g4 = *(const f32x4*)(lng + 4 * F.lane), b4 = *(const f32x4*)(lnb + 4 * F.lane);
#pragma unroll 1
            for (int q = 0; q < 8; ++q) { const int tk = 8 * F.wave + q; const f32x4 v = *(const LAS f32x4*)(cv + tk * 256 + 4 * F.lane);
                const float mu = wave_sum(v[0] + v[1] + v[2] + v[3]) * (1.0f / 256.0f);
                const float d0 = v[0] - mu, d1 = v[1] - mu, d2 = v[2] - mu, d3 = v[3] - mu;
                const float var = wave_sum(d0 * d0 + d1 * d1 + d2 * d2 + d3 * d3) * (1.0f / 256.0f);
                const float rs = rsqrtf(var + 1e-5f);
                const float y0 = silu_f(d0 * rs * g4[0] + b4[0]), y1 = silu_f(d1 * rs * g4[1] + b4[1]), y2 = silu_f(d2 * rs * g4[2] + b4[2]), y3 = silu_f(d3 * rs * g4[3] + b4[3]);
                u32x2 o; o.x = pk_bf16(y0, y1); o.y = pk_bf16(y2, y3); *(LAS u32x2*)(act + tk * 264 + 4 * F.lane) = o; }
        }
        __syncthreads();
        if (CONF_STEPS < 4) continue;
        {
            const int lane = F.lane, row = lane & 15, kq = lane >> 4;
            f32x4 acc[2][4];
#pragma unroll
            for (int nt = 0; nt < 2; ++nt)
#pragma unroll
                for (int tt = 0; tt < 4; ++tt) acc[nt][tt] = (f32x4){0.f, 0.f, 0.f, 0.f};
#pragma unroll
            for (int ks = 0; ks < 8; ++ks) {
                bf16x8 Bt[4];
#pragma unroll
                for (int tt = 0; tt < 4; ++tt) Bt[tt] = *(const LAS bf16x8*)(act + (16 * tt + row) * 264 + 32 * ks + 8 * kq);
#pragma unroll
                for (int nt = 0; nt < 2; ++nt)
#pragma unroll
                    for (int tt = 0; tt < 4; ++tt) acc[nt][tt] = MFMA16(Aw[nt][ks], Bt[tt], acc[nt][tt]);
            }
#pragma unroll
            for (int nt = 0; nt < 2; ++nt) { const int n0 = 32 * F.wave + 16 * nt + 4 * kq; const f32x4 bb = *(const f32x4*)(bpw + n0);
#pragma unroll
                for (int tt = 0; tt < 4; ++tt) { const f32x4 v = acc[nt][tt] + bb; u32x2 o; o.x = pk_bf16(v[0], v[1]); o.y = pk_bf16(v[2], v[3]);
                    *(u32x2*)(Y + (tokbase + t0 + 16 * tt + row) * D + 512 + n0) = o; } }
        }
    }
}

constexpr int AP_VT = 0;
__device__ __forceinline__ void attn_pre(const Frame& F, int l) {
    const bf16_t* P = (const bf16_t*)(F.ws_() + WS_P);
    const float* ropec = (const float*)(F.ws_() + WS_ROPE); const float* ropes = ropec + 2048 * 16;
    LAS bf16_t* vt = (LAS bf16_t*)(F.lds + AP_VT);
    const int skey = F.tid >> 2, scomp = (F.tid >> 1) & 1, shf = F.tid & 1;
    const int vkp = F.tid & 63, vg = F.tid >> 6;
    for (int it = F.bid; it < 32 * 4 * 18; it += F.G) {
        const int kt = it % 18, hd = (it / 18) & 3, b = it / 72;
        const bool kc = kt >= 16; const size_t kb = kc ? (size_t)TL + (size_t)b * LC + (kt - 16) * 128 : (size_t)b * SEQ + kt * 128;
        unsigned char* kimg = F.ws_() + WS_KIMG + (size_t)it * 16384; unsigned char* vimg = F.ws_() + WS_VIMG + (size_t)it * 8192;
        {   const unsigned char* kp = (const unsigned char*)P + (kb + skey) * (DIN * 2) + OFF_B + 256 + hd * 64 + scomp * 32 + 8 * shf;
            float x1[8], x2[8]; dec_fp8x8(*(const u32x2*)kp, x1); dec_fp8x8(*(const u32x2*)(kp + 16), x2);
            float o1[8], o2[8];
            if (!kc) { const int tpos = kt * 128 + skey; const float* cp = ropec + tpos * 16 + 8 * shf; const float* sp = ropes + tpos * 16 + 8 * shf;
#pragma unroll
                for (int j = 0; j < 8; ++j) { const float cs = cp[j], sn = sp[j]; o1[j] = x1[j] * cs - x2[j] * sn; o2[j] = x1[j] * sn + x2[j] * cs; } }
            else {
#pragma unroll
                for (int j = 0; j < 8; ++j) { o1[j] = x1[j]; o2[j] = x2[j]; } }
            const int sw = (skey >> 1) & 7, p0 = scomp * 4 + shf, p1 = p0 + 2;
            *(bf16x8*)(kimg + skey * 128 + ((p0 ^ sw) << 4)) = pk8(o1); *(bf16x8*)(kimg + skey * 128 + ((p1 ^ sw) << 4)) = pk8(o2); }
        {   const unsigned char* vp = (const unsigned char*)P + (kb + 2 * vkp) * (DIN * 2) + OFF_B + 512 + hd * 64 + 8 * vg;
            float va[8], vb[8]; dec_fp8x8(*(const u32x2*)vp, va); dec_fp8x8(*(const u32x2*)(vp + DIN * 2), vb);
            __syncthreads();
            LAS bf16_t* vd = vt + (8 * vg) * 136 + 2 * vkp;
#pragma unroll
            for (int e = 0; e < 8; ++e) *(LAS unsigned*)(vd + e * 136) = (__float_as_uint(va[e]) >> 16) | (__float_as_uint(vb[e]) & 0xffff0000u);
            __syncthreads();
#pragma unroll
            for (int u = 0; u < 2; ++u) { const int pc = F.tid + u * NTHREADS, dv = pc >> 4, pi = pc & 15, G = pi >> 1, h = pi & 1;
                const u32x2 lo = *(const LAS u32x2*)(vt + dv * 136 + 16 * G + 4 * h), hi = *(const LAS u32x2*)(vt + dv * 136 + 16 * G + 8 + 4 * h);
                int w0 = __builtin_amdgcn_cvt_pk_fp8_f32(bflo(lo.x), bfhi(lo.x), 0, false); w0 = __builtin_amdgcn_cvt_pk_fp8_f32(bflo(lo.y), bfhi(lo.y), w0, true);
                int w1 = __builtin_amdgcn_cvt_pk_fp8_f32(bflo(hi.x), bfhi(hi.x), 0, false); w1 = __builtin_amdgcn_cvt_pk_fp8_f32(bflo(hi.y), bfhi(hi.y), w1, true);
                *(u32x2*)(vimg + dv * 128 + ((pi ^ ((dv >> 1) & 15)) << 3)) = (u32x2){(unsigned)w0, (unsigned)w1}; }
        }
    }
}
constexpr int AT_K0 = 0, AT_V0 = 65536, AT_X = 0;
static_assert(AT_V0 + 65536 <= LDS_BARW, "attention LDS");
__device__ __forceinline__ void attn_phase(const Frame& F, int l, bool do_ctx) {
    const bf16_t* P = (const bf16_t*)(F.ws_() + WS_P); bf16_t* Y = (bf16_t*)(F.ws_() + WS_Y);
    const float* ropec = (const float*)(F.ws_() + WS_ROPE); const float* ropes = ropec + 2048 * 16;
    const int lane = F.lane, w = F.wave, i31 = lane & 31, hh = lane >> 5, qs = w >> 1, comp = w & 1;
    const float lam_init = (l == 0) ? 0.2f : (l == 1) ? 0.35550906759f : (l == 2) ? 0.47071301834f : 0.55605820419f;
    float lam;
    {   const float* q1 = F.in(I_LQ1) + l * 32; const float* k1 = F.in(I_LK1) + l * 32; const float* q2 = F.in(I_LQ2) + l * 32; const float* k2 = F.in(I_LK2) + l * 32;
        const float s1 = wave_sum(lane < 32 ? q1[i31] * k1[i31] : 0.f), s2 = wave_sum(lane < 32 ? q2[i31] * k2[i31] : 0.f);
        lam = expf(s1) - expf(s2) + lam_init; }
    const float* subg = F.in(I_SUBG) + l * 64;
    const int nlat = 32 * 4 * 16, nitems = nlat + (do_ctx ? 32 * 4 * 2 : 0);
    const float qscale = 0.17677669529663687f * 1.4426950408889634f;
    const int ksw = (i31 >> 1) & 7;
    const int koff0 = i31 * 128 + (((comp * 4 + hh) ^ ksw) << 4), koff1 = i31 * 128 + (((comp * 4 + 2 + hh) ^ ksw) << 4);
    for (int it = F.vcu; it < nitems; it += F.G) {
        const bool isc = it >= nlat; int r_ = isc ? it - nlat : it; const int nqb = isc ? 2 : 16; const int qb = r_ % nqb; r_ /= nqb; const int hd = r_ & 3; const int b = r_ >> 2;
        const int ntiles = isc ? 1 : 9, kt0 = isc ? 16 : 0;
        const size_t qtok = isc ? (size_t)TL + (size_t)b * LC + qb * 128 + qs * 32 + i31 : (size_t)b * SEQ + qb * 128 + qs * 32 + i31;
        const unsigned char* kimg = F.ws_() + WS_KIMG + ((size_t)(b * 4 + hd) * 18 + kt0) * 16384; const unsigned char* vimg = F.ws_() + WS_VIMG + ((size_t)(b * 4 + hd) * 18 + kt0) * 8192;
        bf16x8 Bq[2];
        {   const unsigned char* qp = (const unsigned char*)P + qtok * (DIN * 2) + OFF_B + hd * 64 + comp * 32 + 8 * hh;
            float x1[8], x2[8]; dec_fp8x8(*(const u32x2*)qp, x1); dec_fp8x8(*(const u32x2*)(qp + 16), x2);
            float o1[8], o2[8];
            if (!isc) { const int tpos = qb * 128 + qs * 32 + i31; const float* cp = ropec + tpos * 16 + 8 * hh; const float* sp = ropes + tpos * 16 + 8 * hh;
#pragma unroll
                for (int j = 0; j < 8; ++j) { const float cs = cp[j], sn = sp[j]; o1[j] = (x1[j] * cs - x2[j] * sn) * qscale; o2[j] = (x1[j] * sn + x2[j] * cs) * qscale; } }
            else {
#pragma unroll
                for (int j = 0; j < 8; ++j) { o1[j] = x1[j] * qscale; o2[j] = x2[j] * qscale; } }
            Bq[0] = pk8(o1); Bq[1] = pk8(o2); }
#define AT_DMA(kt, buf) do { _Pragma("unroll") for (int u_ = 0; u_ < 4; ++u_) { const int ch_ = (u_ * 8 + w) * 1024; \
            __builtin_amdgcn_global_load_lds((const unsigned*)(kimg + (size_t)(kt) * 32768 + ch_ + lane * 16), (LAS unsigned*)(F.lds + AT_K0 + (buf) * 32768 + ch_), 16, 0, 0); \
            if (u_ < 2) __builtin_amdgcn_global_load_lds((const unsigned*)(vimg + (size_t)(kt) * 16384 + ch_ + lane * 16), (LAS unsigned*)(F.lds + AT_V0 + (buf) * 16384 + ch_), 16, 0, 0); } } while (0)
        __syncthreads();
        AT_DMA(0, 0);
        asm volatile("s_waitcnt vmcnt(0)" ::: "memory");
        __syncthreads();
        f32x16 O0, O1, negm;
#pragma unroll
        for (int r = 0; r < 16; ++r) { O0[r] = 0.f; O1[r] = 0.f; negm[r] = 0.f; }
        f32x2 lsum2 = {0.f, 0.f}; bool first = true;
        f32x16 S;
        {   const LAS unsigned char* K0 = F.lds + AT_K0; const bf16x8 Ak0 = *(const LAS bf16x8*)(K0 + koff0), Ak1 = *(const LAS bf16x8*)(K0 + koff1);
            S = MFMA32(Ak0, Bq[0], negm); S = MFMA32(Ak1, Bq[1], S); }
        for (int kt = 0; kt < ntiles; ++kt) {
            const int buf = kt & 1; const bool more = kt + 1 < ntiles;
            const LAS unsigned char* Kl = F.lds + AT_K0 + buf * 32768; const LAS unsigned char* Vl = F.lds + AT_V0 + buf * 16384;
            const LAS unsigned char* Kn = F.lds + AT_K0 + (buf ^ 1) * 32768;
#pragma unroll
            for (int st = 0; st < 8; ++st) {
                if (st == 1) { __syncthreads(); if (more) AT_DMA(kt + 1, buf ^ 1); }
                if (st == 7) { asm volatile("s_waitcnt vmcnt(0)" ::: "memory"); __syncthreads(); }
                f32x16 Sn;
                if (st < 7) { const bf16x8 Ak0 = *(const LAS bf16x8*)(Kl + (st + 1) * 4096 + koff0), Ak1 = *(const LAS bf16x8*)(Kl + (st + 1) * 4096 + koff1);
                    Sn = MFMA32(Ak0, Bq[0], negm); Sn = MFMA32(Ak1, Bq[1], Sn); }
                else if (more) { const bf16x8 Ak0 = *(const LAS bf16x8*)(Kn + koff0), Ak1 = *(const LAS bf16x8*)(Kn + koff1);
                    Sn = MFMA32(Ak0, Bq[0], negm); Sn = MFMA32(Ak1, Bq[1], Sn); }
                else Sn = negm;
                float p[16]; f32x2 ps2;
#define AT_EXPS() do { _Pragma("unroll") for (int r = 0; r < 16; ++r) p[r] = __builtin_amdgcn_exp2f(S[r]); \
                    const f32x2 q0_ = {p[0], p[1]}, q1_ = {p[2], p[3]}, q2_ = {p[4], p[5]}, q3_ = {p[6], p[7]}, q4_ = {p[8], p[9]}, q5_ = {p[10], p[11]}, q6_ = {p[12], p[13]}, q7_ = {p[14], p[15]}; \
                    asm("s_nop 0\n\tv_pk_add_f32 %0, %1, %2\n\tv_pk_add_f32 %0, %0, %3\n\tv_pk_add_f32 %0, %0, %4\n\tv_pk_add_f32 %0, %0, %5\n\tv_pk_add_f32 %0, %0, %6\n\tv_pk_add_f32 %0, %0, %7\n\tv_pk_add_f32 %0, %0, %8" \
                        : "=&v"(ps2) : "v"(q0_), "v"(q1_), "v"(q2_), "v"(q3_), "v"(q4_), "v"(q5_), "v"(q6_), "v"(q7_)); } while (0)
                AT_EXPS();
                if (first || __any(!(ps2[0] + ps2[1] <= 256.0f))) {
                    float mx = fmaxf(fmaxf(S[0], S[1]), S[2]);
                    mx = fmaxf(fmaxf(mx, S[3]), S[4]); mx = fmaxf(fmaxf(mx, S[5]), S[6]); mx = fmaxf(fmaxf(mx, S[7]), S[8]); mx = fmaxf(fmaxf(mx, S[9]), S[10]);
                    mx = fmaxf(fmaxf(mx, S[11]), S[12]); mx = fmaxf(fmaxf(mx, S[13]), S[14]); mx = fmaxf(mx, S[15]);
                    const u32x2 sw = __builtin_amdgcn_permlane32_swap(__float_as_uint(mx), __float_as_uint(mx), false, false);
                    const float mp = fmaxf(__uint_as_float(sw.x), __uint_as_float(sw.y));
                    const float d = first ? mp - 3.0f : fmaxf(mp - 3.0f, 0.f);
                    const float alpha = __builtin_amdgcn_exp2f(-d);
#pragma unroll
                    for (int r = 0; r < 16; ++r) { S[r] -= d; O0[r] *= alpha; O1[r] *= alpha; negm[r] -= d; Sn[r] -= d; }
                    lsum2 *= (f32x2){alpha, alpha}; first = false;
                    AT_EXPS();
                }
                asm("v_pk_add_f32 %0, %1, %0" : "+v"(lsum2) : "v"(ps2));
#pragma unroll
                for (int s = 0; s < 2; ++s) {
                    float pp[8];
#pragma unroll
                    for (int j = 0; j < 8; ++j) pp[j] = p[8 * s + j];
                    int b0_ = __builtin_amdgcn_cvt_pk_fp8_f32(pp[0], pp[1], 0, false); b0_ = __builtin_amdgcn_cvt_pk_fp8_f32(pp[2], pp[3], b0_, true);
                    int b1_ = __builtin_amdgcn_cvt_pk_fp8_f32(pp[4], pp[5], 0, false); b1_ = __builtin_amdgcn_cvt_pk_fp8_f32(pp[6], pp[7], b1_, true);
                    const long Bp = (long)(((unsigned long long)(unsigned)b1_ << 32) | (unsigned long long)(unsigned)b0_);
                    const int pi = 2 * (2 * (st & 3) + s) + hh;
#pragma unroll
                    for (int mt = 0; mt < 2; ++mt) { const long av = *(const LAS long*)(Vl + (st >> 2) * 8192 + (32 * mt + i31) * 128 + ((pi ^ ((i31 >> 1) & 15)) << 3));
                        if (mt == 0) O0 = __builtin_amdgcn_mfma_f32_32x32x16_fp8_fp8(av, Bp, O0, 0, 0, 0); else O1 = __builtin_amdgcn_mfma_f32_32x32x16_fp8_fp8(av, Bp, O1, 0, 0, 0); }
                }
                S = Sn;
            }
        }
        __syncthreads();
#undef AT_DMA
#undef AT_EXPS
        const float lsum = lsum2[0] + lsum2[1]; const float ltot = lsum + __shfl_xor(lsum, 32); const float inv = __builtin_amdgcn_rcpf(ltot);
        LAS float* xch = (LAS float*)(F.lds + AT_X) + qs * 2048;
        if (comp == 1) {
#pragma unroll
            for (int r = 0; r < 16; ++r) { const int dv = (r & 3) + 8 * (r >> 2) + 4 * hh; xch[dv * 32 + i31] = O0[r] * inv; xch[(32 + dv) * 32 + i31] = O1[r] * inv; }
        }
        __syncthreads();
        if (comp == 0) {
            float d0[16], d1[16]; float ss = 0.f;
#pragma unroll
            for (int r = 0; r < 16; ++r) { const int dv = (r & 3) + 8 * (r >> 2) + 4 * hh;
                d0[r] = O0[r] * inv - lam * xch[dv * 32 + i31]; d1[r] = O1[r] * inv - lam * xch[(32 + dv) * 32 + i31]; ss += d0[r] * d0[r] + d1[r] * d1[r]; }
            ss += __shfl_xor(ss, 32);
            const float rs = rsqrtf(ss * (1.0f / 64.0f) + EPS) * (1.0f - lam_init);
            bf16_t* yp = Y + qtok * D + 256 + hd * 64;
#pragma unroll
            for (int rg = 0; rg < 4; ++rg) { const int dv = 8 * rg + 4 * hh; const f32x4 g0 = *(const f32x4*)(subg + dv), g1 = *(const f32x4*)(subg + 32 + dv);
                u32x2 o0, o1; o0.x = pk_bf16(d0[4 * rg] * rs * g0[0], d0[4 * rg + 1] * rs * g0[1]); o0.y = pk_bf16(d0[4 * rg + 2] * rs * g0[2], d0[4 * rg + 3] * rs * g0[3]);
                o1.x = pk_bf16(d1[4 * rg] * rs * g1[0], d1[4 * rg + 1] * rs * g1[1]); o1.y = pk_bf16(d1[4 * rg + 2] * rs * g1[2], d1[4 * rg + 3] * rs * g1[3]);
                *(u32x2*)(yp + dv) = o0; *(u32x2*)(yp + 32 + dv) = o1; }
        }
    }
}

constexpr int RT_W = 0;
constexpr int RT_WST = 1028;
constexpr int RT_REC = 36 * RT_WST * 4;
constexpr int RT_LP = RT_REC + 304 * 16;
constexpr int RT_CNT = RT_LP + 304 * 8;
static_assert(RT_CNT + 256 <= LDS_BARW, "route LDS");
__device__ __forceinline__ void ffn_route(const Frame& F, int l, int nrows) {
    LAS float* Wt = (LAS float*)(F.lds + RT_W); LAS i32x4* rec = (LAS i32x4*)(F.lds + RT_REC); LAS i32x2* lp = (LAS i32x2*)(F.lds + RT_LP);
    LAS int* lcnt = (LAS int*)(F.lds + RT_CNT); LAS int* lbase = lcnt + 32;
    const float* wrg = F.in(I_WRG) + (size_t)l * D * 4; const float* wre = F.in(I_WRE) + (size_t)l * D * 32;
    const float* brg = F.in(I_BRG) + l * 4; const float* bre = F.in(I_BRE) + l * 32;
    __syncthreads();
    for (int i = F.tid; i < 1024 * 4; i += NTHREADS) { const int k = i >> 2, j = i & 3; Wt[j * RT_WST + k] = wrg[i]; }
    for (int i = F.tid; i < 1024 * 32; i += NTHREADS) { const int k = i >> 5, j = i & 31; Wt[(4 + j) * RT_WST + k] = wre[i]; }
    if (F.tid < 32) lcnt[F.tid] = 0;
    __syncthreads();
    const float* modp = (const float*)(F.ws_() + WS_MOD) + (size_t)l * 33 * (NMOD * D) + 3 * D;
    const float* gn = F.in(I_GFFN) + (size_t)l * D;
    const int RPB = (nrows + F.G - 1) / F.G, rbeg = F.bid * RPB, rend = (rbeg + RPB < nrows) ? rbeg + RPB : nrows;
    const int lo4 = 4 * F.lane;
    f32x4 gq[4], shq[4], scq[4]; u32x2 xa[4]; int curb = -1;
    const bf16_t* XB = (const bf16_t*)(F.ws_() + WS_XB);
#pragma unroll
    for (int i = 0; i < 4; ++i) { gq[i] = *(const f32x4*)(gn + i * 256 + lo4); shq[i] = (f32x4){0.f, 0.f, 0.f, 0.f}; scq[i] = shq[i]; }
#define RT_LOADX(r) do { const bf16_t* xp_ = XB + (size_t)(r) * D; _Pragma("unroll") for (int i = 0; i < 4; ++i) xa[i] = *(const u32x2*)(xp_ + i * 256 + lo4); } while (0)
    int row = rbeg + F.wave;
    if (row < rend) RT_LOADX(row);
    for (; row < rend; row += 8) {
        const bool isc = row >= TL; const int b = isc ? 32 : (row >> 11);
        f32x4 v[4];
#pragma unroll
        for (int i = 0; i < 4; ++i) v[i] = (f32x4){bflo(xa[i].x), bfhi(xa[i].x), bflo(xa[i].y), bfhi(xa[i].y)};
        if (row + 8 < rend) RT_LOADX(row + 8);
        if (b != curb) { curb = b; const float* sh = modp + (size_t)b * (NMOD * D);
#pragma unroll
            for (int i = 0; i < 4; ++i) { shq[i] = *(const f32x4*)(sh + i * 256 + lo4); scq[i] = *(const f32x4*)(sh + D + i * 256 + lo4); } }
        float ss = 0.f;
#pragma unroll
        for (int i = 0; i < 4; ++i) ss += v[i][0] * v[i][0] + v[i][1] * v[i][1] + v[i][2] * v[i][2] + v[i][3] * v[i][3];
        ss = wave_sum(ss);
        const float rstd = rsqrtf(ss * (1.0f / D) + EPS);
        bf16_t* hrow = (bf16_t*)(F.ws_() + WS_H) + (size_t)row * D;
#pragma unroll
        for (int i = 0; i < 4; ++i) {
#pragma unroll
            for (int e = 0; e < 4; ++e) v[i][e] = v[i][e] * rstd * gq[i][e] * (1.0f + scq[i][e]) + shq[i][e];
            u32x2 wv; wv.x = pk_bf16(v[i][0], v[i][1]); wv.y = pk_bf16(v[i][2], v[i][3]); *(u32x2*)(hrow + i * 256 + lo4) = wv; }
        float lg[4];
#pragma unroll
        for (int j = 0; j < 4; ++j) { float s = 0.f;
#pragma unroll
            for (int i = 0; i < 4; ++i) { const f32x4 wq = *(const LAS f32x4*)(Wt + j * RT_WST + i * 256 + 4 * F.lane); s += v[i][0] * wq[0] + v[i][1] * wq[1] + v[i][2] * wq[2] + v[i][3] * wq[3]; }
            lg[j] = wave_sum(s); }
        float g0 = lg[0] + brg[0], g1 = lg[1] + brg[1], g2 = lg[2] + brg[2], g3 = lg[3] + brg[3];
        int gi = 0; float gm = g0; if (g1 > gm) { gm = g1; gi = 1; } if (g2 > gm) { gm = g2; gi = 2; } if (g3 > gm) { gm = g3; gi = 3; }
        const float pgrp = 1.0f / (expf(g0 - gm) + expf(g1 - gm) + expf(g2 - gm) + expf(g3 - gm));
        float le[8];
        {   const LAS float* We = Wt + (4 + 8 * gi) * RT_WST;
#pragma unroll
            for (int e = 0; e < 8; ++e) { float s = 0.f;
#pragma unroll
                for (int i = 0; i < 4; ++i) { const f32x4 wq = *(const LAS f32x4*)(We + e * RT_WST + i * 256 + 4 * F.lane); s += v[i][0] * wq[0] + v[i][1] * wq[1] + v[i][2] * wq[2] + v[i][3] * wq[3]; }
                le[e] = wave_sum(s) + bre[8 * gi + e]; } }
        int e0 = 0; float m0 = le[0];
#pragma unroll
        for (int e = 1; e < 8; ++e) if (le[e] > m0) { m0 = le[e]; e0 = e; }
        int e1 = -1; float m1 = -3.0e38f;
#pragma unroll
        for (int e = 0; e < 8; ++e) if (e != e0 && le[e] > m1) { m1 = le[e]; e1 = e; }
        const float x1 = expf(m1 - m0);
        const float w0 = pgrp / (1.0f + x1), w1 = pgrp * x1 / (1.0f + x1);
        if (F.lane == 0) { const int E0 = gi * 8 + e0, E1 = gi * 8 + e1; const int ri = row - rbeg;
            rec[ri] = (i32x4){E0, E1, __float_as_int(w0), __float_as_int(w1)};
            const int p0 = atomicAdd((int*)&lcnt[E0], 1), p1 = atomicAdd((int*)&lcnt[E1], 1); lp[ri] = (i32x2){p0, p1}; }
    }
    __syncthreads();
    if (F.tid < 32) lbase[F.tid] = (int)__hip_atomic_fetch_add(F.ctl + CW_CNT + l * 32 + F.tid, (unsigned)lcnt[F.tid], __ATOMIC_RELAXED, __HIP_MEMORY_SCOPE_AGENT);
    __syncthreads();
    int* tokof = (int*)(F.ws_() + WS_TOKOF); float* gateof = (float*)(F.ws_() + WS_GATEOF); i32x4* tokinf = (i32x4*)(F.ws_() + WS_TOKINF);
    for (int ri = F.tid; ri < 304; ri += NTHREADS) { const int row = rbeg + ri;
        if (row < rend) { const i32x4 rc = rec[ri]; const i32x2 q = lp[ri]; const int p0 = lbase[rc.x] + q.x, p1 = lbase[rc.y] + q.y;
            tokof[(size_t)rc.x * TT + p0] = row; gateof[(size_t)rc.x * TT + p0] = __int_as_float(rc.z);
            tokof[(size_t)rc.y * TT + p1] = row; gateof[(size_t)rc.y * TT + p1] = __int_as_float(rc.w);
            tokinf[row] = (i32x4){rc.x, p0, rc.y, p1}; } }
}


constexpr int RM_WST = 1032;
constexpr int RM_WHI = 0, RM_WLO = 36 * RM_WST * 2;
constexpr int RM_REC = 2 * 36 * RM_WST * 2;
constexpr int RM_LP = RM_REC + 304 * 16, RM_CNT = RM_LP + 304 * 8;
static_assert(RM_CNT + 256 <= LDS_BARW, "route LDS");
__device__ __forceinline__ float row_max16(float v) {
    v = fmaxf(v, __builtin_bit_cast(float, __builtin_amdgcn_update_dpp(0, __builtin_bit_cast(int, v), 0xB1, 0xF, 0xF, true)));
    v = fmaxf(v, __builtin_bit_cast(float, __builtin_amdgcn_update_dpp(0, __builtin_bit_cast(int, v), 0x4E, 0xF, 0xF, true)));
    v = fmaxf(v, __builtin_bit_cast(float, __builtin_amdgcn_update_dpp(0, __builtin_bit_cast(int, v), 0x141, 0xF, 0xF, true)));
    v = fmaxf(v, __builtin_bit_cast(float, __builtin_amdgcn_update_dpp(0, __builtin_bit_cast(int, v), 0x140, 0xF, 0xF, true)));
    return v;
}
__device__ __forceinline__ float row_sum16(float v) {
    v += __builtin_bit_cast(float, __builtin_amdgcn_update_dpp(0, __builtin_bit_cast(int, v), 0xB1, 0xF, 0xF, true));
    v += __builtin_bit_cast(float, __builtin_amdgcn_update_dpp(0, __builtin_bit_cast(int, v), 0x4E, 0xF, 0xF, true));
    v += __builtin_bit_cast(float, __builtin_amdgcn_update_dpp(0, __builtin_bit_cast(int, v), 0x141, 0xF, 0xF, true));
    v += __builtin_bit_cast(float, __builtin_amdgcn_update_dpp(0, __builtin_bit_cast(int, v), 0x140, 0xF, 0xF, true));
    return v;
}
__device__ __forceinline__ int row_first16(bool pred, int kq) {
    const unsigned long long m = __ballot(pred); const unsigned rb = (unsigned)(m >> (16 * kq)) & 0xffffu; return __ffs((int)rb) - 1;
}
__device__ __forceinline__ void ffn_route_mfma(const Frame& F, int l, int nrows) {
    LAS bf16_t* Whi = (LAS bf16_t*)(F.lds + RM_WHI); LAS bf16_t* Wlo = (LAS bf16_t*)(F.lds + RM_WLO);
    LAS i32x4* rec = (LAS i32x4*)(F.lds + RM_REC); LAS i32x2* lp = (LAS i32x2*)(F.lds + RM_LP); LAS int* lcnt = (LAS int*)(F.lds + RM_CNT); LAS int* lbase = lcnt + 32;
    const float* wrg = F.in(I_WRG) + (size_t)l * D * 4; const float* wre = F.in(I_WRE) + (size_t)l * D * 32;
    __syncthreads();
    {
        f32x4 wv[16], gv[2];
#pragma unroll
        for (int it = 0; it < 16; ++it) wv[it] = *(const f32x4*)(wre + 4 * (F.tid + NTHREADS * it));
#pragma unroll
        for (int it = 0; it < 2; ++it) gv[it] = *(const f32x4*)(wrg + 4 * (F.tid + NTHREADS * it));
        __builtin_amdgcn_sched_barrier(0);
#pragma unroll
        for (int it = 0; it < 16; ++it) { const int i = 4 * (F.tid + NTHREADS * it), k = i >> 5, j0 = i & 31;
#pragma unroll
            for (int e = 0; e < 4; ++e) { const float w = wv[it][e]; const unsigned h = pk_bf16(w, 0.f) & 0xffffu; const float r = w - __uint_as_float(h << 16);
                Whi[(j0 + e) * RM_WST + k] = (bf16_t)h; Wlo[(j0 + e) * RM_WST + k] = (bf16_t)(pk_bf16(r, 0.f) & 0xffffu); } }
#pragma unroll
        for (int it = 0; it < 2; ++it) { const int k = F.tid + NTHREADS * it;
#pragma unroll
            for (int e = 0; e < 4; ++e) { const float w = gv[it][e]; const unsigned h = pk_bf16(w, 0.f) & 0xffffu; const float r = w - __uint_as_float(h << 16);
                Whi[(32 + e) * RM_WST + k] = (bf16_t)h; Wlo[(32 + e) * RM_WST + k] = (bf16_t)(pk_bf16(r, 0.f) & 0xffffu); } }
    }
    if (F.tid < 32) lcnt[F.tid] = 0;
    __syncthreads();
    const int RPB = (nrows + F.G - 1) / F.G, rbeg = F.bid * RPB, rend = (rbeg + RPB < nrows) ? rbeg + RPB : nrows;
    const int lane = F.lane, tk = lane & 15, kq = lane >> 4;
    const bf16_t* XB = (const bf16_t*)(F.ws_() + WS_XB); bf16_t* H2 = (bf16_t*)(F.ws_() + WS_H);
    for (int g0 = rbeg + 16 * F.wave; g0 < rend; g0 += 128) {
        const int b = (g0 >= TL) ? 32 : (g0 >> 11);
        const float* GG = (const float*)(F.ws_() + WS_GG) + ((size_t)l * 33 + b) * D; const float* SH = (const float*)(F.ws_() + WS_MOD) + ((size_t)l * 33 + b) * (NMOD * D) + 3 * D;
        const float* RB = (const float*)(F.ws_() + WS_RB) + ((size_t)l * 33 + b) * 48;
        const int tok = (g0 + tk < rend) ? g0 + tk : rend - 1;
        const bf16_t* xp = XB + (size_t)tok * D + 8 * kq;
        f32x4 acc0 = (f32x4){0.f, 0.f, 0.f, 0.f}, acc1 = acc0, acc2 = acc0; float ss = 0.f;
        u32x4 xa[8], xn[8];
#pragma unroll
        for (int j = 0; j < 8; ++j) xa[j] = *(const u32x4*)(xp + 32 * j);
        int wob = tk * RM_WST + 8 * kq; asm volatile("" : "+v"(wob));
#pragma unroll 1
        for (int kc = 0; kc < 32; kc += 8) {
            f32x4 gaa[8], gbb[8];
#pragma unroll
            for (int j = 0; j < 8; ++j) { gaa[j] = *(const f32x4*)(GG + 32 * (kc + j) + 8 * kq); gbb[j] = *(const f32x4*)(GG + 32 * (kc + j) + 8 * kq + 4); }
            {   const int kn = (kc < 24) ? kc + 8 : 0;
#pragma unroll
                for (int j = 0; j < 8; ++j) xn[j] = *(const u32x4*)(xp + 32 * (kn + j)); }
            __builtin_amdgcn_sched_barrier(0);
#pragma unroll
            for (int jc = 0; jc < 8; ++jc) { const int ks = kc + jc;
            const u32x4 xv = xa[jc];
            const f32x4 ga = gaa[jc], gb = gbb[jc];
            const float x[8] = {bflo(xv.x), bfhi(xv.x), bflo(xv.y), bfhi(xv.y), bflo(xv.z), bfhi(xv.z), bflo(xv.w), bfhi(xv.w)};
            const float gg[8] = {ga[0], ga[1], ga[2], ga[3], gb[0], gb[1], gb[2], gb[3]};
            float y[8], yl[8]; unsigned hp[4];
#pragma unroll
            for (int j = 0; j < 8; ++j) { ss += x[j] * x[j]; y[j] = x[j] * gg[j]; }
#pragma unroll
            for (int j = 0; j < 4; ++j) { hp[j] = pk_bf16(y[2 * j], y[2 * j + 1]); yl[2 * j] = y[2 * j] - bflo(hp[j]); yl[2 * j + 1] = y[2 * j + 1] - bfhi(hp[j]); }
            const bf16x8 Ah = __builtin_bit_cast(bf16x8, (u32x4){hp[0], hp[1], hp[2], hp[3]}); const bf16x8 Al = pk8(yl);
            const int wo = wob + 32 * ks;
            const bf16x8 Bh0 = *(const LAS bf16x8*)(Whi + wo), Bl0 = *(const LAS bf16x8*)(Wlo + wo);
            const bf16x8 Bh1 = *(const LAS bf16x8*)(Whi + 16 * RM_WST + wo), Bl1 = *(const LAS bf16x8*)(Wlo + 16 * RM_WST + wo);
            const bf16x8 Bh2 = *(const LAS bf16x8*)(Whi + 32 * RM_WST + wo), Bl2 = *(const LAS bf16x8*)(Wlo + 32 * RM_WST + wo);
            acc0 = MFMA16(Ah, Bh0, acc0); acc0 = MFMA16(Ah, Bl0, acc0); acc0 = MFMA16(Al, Bh0, acc0);
            acc1 = MFMA16(Ah, Bh1, acc1); acc1 = MFMA16(Ah, Bl1, acc1); acc1 = MFMA16(Al, Bh1, acc1);
            acc2 = MFMA16(Ah, Bh2, acc2); acc2 = MFMA16(Ah, Bl2, acc2); acc2 = MFMA16(Al, Bh2, acc2);
            }
            __builtin_amdgcn_sched_barrier(0);
#pragma unroll
            for (int j = 0; j < 8; ++j) xa[j] = xn[j];
        }
        ss += __shfl_xor(ss, 16); ss += __shfl_xor(ss, 32);
        const float rstd = rsqrtf(ss * (1.0f / D) + EPS);
        const float rb0 = RB[tk], rb1 = RB[16 + tk], rb2 = RB[32 + tk];
#pragma unroll
        for (int r = 0; r < 4; ++r) {
            const float rs = __shfl(rstd, 4 * kq + r);
            const float gv = (tk < 4) ? rs * acc2[r] + rb2 : -3.0e38f;
            const float gmax = row_max16(gv); const int gi = row_first16(gv == gmax, kq);
            const float pg = __builtin_amdgcn_rcpf(row_sum16(tk < 4 ? __expf(gv - gmax) : 0.f));
            const float ev = (gi >> 1) ? rs * acc1[r] + rb1 : rs * acc0[r] + rb0; const bool valid = (tk >> 3) == (gi & 1);
            const float m0 = row_max16(valid ? ev : -3.0e38f); const int e0 = row_first16(valid && ev == m0, kq);
            const bool v2 = valid && tk != e0;
            const float m1 = row_max16(v2 ? ev : -3.0e38f); const int e1 = row_first16(v2 && ev == m1, kq);
            const float x1 = __expf(m1 - m0); const float w0 = pg / (1.0f + x1), w1 = pg * x1 / (1.0f + x1);
            const int row = g0 + 4 * kq + r;
            if (tk == 0 && row < rend) { const int E0 = 8 * gi + (e0 & 7), E1 = 8 * gi + (e1 & 7); const int ri = row - rbeg;
                rec[ri] = (i32x4){E0, E1, __float_as_int(w0), __float_as_int(w1)};
                const int p0 = atomicAdd((int*)&lcnt[E0], 1), p1 = atomicAdd((int*)&lcnt[E1], 1); lp[ri] = (i32x2){p0, p1}; }
        }
        if (g0 + tk < rend) { unsigned char* hp2 = (unsigned char*)H2 + (size_t)tok * D + 8 * kq;
            const float* GG2 = GG; asm volatile("" : "+s"(GG2)); const bf16_t* xp2 = xp; asm volatile("" : "+v"(xp2));
#pragma unroll 4
            for (int ks = 0; ks < 32; ++ks) {
                const u32x4 xv = *(const u32x4*)(xp2 + 32 * ks);
                const f32x4 ga = *(const f32x4*)(GG2 + 32 * ks + 8 * kq), gb = *(const f32x4*)(GG2 + 32 * ks + 8 * kq + 4), sa = *(const f32x4*)(SH + 32 * ks + 8 * kq), sb = *(const f32x4*)(SH + 32 * ks + 8 * kq + 4);
                u32x2 o; o.x = pk_fp8x4(bflo(xv.x) * rstd * ga[0] + sa[0], bfhi(xv.x) * rstd * ga[1] + sa[1], bflo(xv.y) * rstd * ga[2] + sa[2], bfhi(xv.y) * rstd * ga[3] + sa[3]);
                o.y = pk_fp8x4(bflo(xv.z) * rstd * gb[0] + sb[0], bfhi(xv.z) * rstd * gb[1] + sb[1], bflo(xv.w) * rstd * gb[2] + sb[2], bfhi(xv.w) * rstd * gb[3] + sb[3]);
                *(u32x2*)(hp2 + 32 * ks) = o; } }
    }
    __syncthreads();
    if (F.tid < 32) lbase[F.tid] = (int)__hip_atomic_fetch_add(F.ctl + CW_CNT + l * 32 + F.tid, (unsigned)lcnt[F.tid], __ATOMIC_RELAXED, __HIP_MEMORY_SCOPE_AGENT);
    __syncthreads();
    int* tokof = (int*)(F.ws_() + WS_TOKOF); float* gateof = (float*)(F.ws_() + WS_GATEOF); i32x4* tokinf = (i32x4*)(F.ws_() + WS_TOKINF);
    for (int ri = F.tid; ri < 304; ri += NTHREADS) { const int row = rbeg + ri;
        if (row < rend) { const i32x4 rc = rec[ri]; const i32x2 q = lp[ri]; const int p0 = lbase[rc.x] + q.x, p1 = lbase[rc.y] + q.y;
            tokof[(size_t)rc.x * TT + p0] = row; gateof[(size_t)rc.x * TT + p0] = __int_as_float(rc.z);
            tokof[(size_t)rc.y * TT + p1] = row; gateof[(size_t)rc.y * TT + p1] = __int_as_float(rc.w);
            tokinf[row] = (i32x4){rc.x, p0, rc.y, p1}; } }
}

constexpr int MO_TS = 131072;
constexpr int MO_TE = MO_TS + 256;
static_assert(MO_TE + 640 <= LDS_BARW, "moe LDS");
namespace pg8 {
struct MoeOrder {
    static constexpr bool PREFETCH = true;
    const LAS int* ts; const LAS unsigned char* te; const unsigned* cnt; const int* tokof; int G, c, nunits; bool gather;
    __device__ __forceinline__ bool next(int i, Unit& u) const {
        const long L = (long)i * G + c; if (L >= nunits) return false;
        u.pn = (int)(L & 3); u.pm = (int)(L >> 2); u.e = te[u.pm]; return true;
    }
    __device__ __forceinline__ unsigned arow(const Unit& u, int r) const {
        if (!gather) return (unsigned)(u.pm * BM + r);
        const int pos = (u.pm - ts[u.e]) * BM + r;
        return pos < (int)cnt[u.e] ? (unsigned)tokof[(size_t)u.e * TT + pos] : 0u;
    }
};
struct EpiSwiGLU {
    static constexpr bool PERM = true;
    bf16_t* H; const float* gateof; const unsigned* cnt; const LAS int* ts;
    __device__ __forceinline__ void operator()(const f32x4 (&acc)[2][2][4][2], const Unit& u, int wr, int wc, int fr, int fq) const {
        const int r0 = wr * 64 + fr, col0 = u.pn * 128 + wc * 32 + 8 * fq; const int pbase = (u.pm - ts[u.e]) * BM; const int ce = (int)cnt[u.e];
        float gt[2][4];
#pragma unroll
        for (int ai = 0; ai < 2; ++ai)
#pragma unroll
            for (int m = 0; m < 4; ++m) { const int pos = pbase + r0 + ai * HALF + m * 16; gt[ai][m] = pos < ce ? gateof[(size_t)u.e * TT + pos] : 0.f; }
#pragma unroll
        for (int ai = 0; ai < 2; ++ai)
#pragma unroll
            for (int m = 0; m < 4; ++m) { const f32x4 g0 = acc[ai][0][m][0], g1 = acc[ai][0][m][1], u0 = acc[ai][1][m][0], u1 = acc[ai][1][m][1]; const float q = gt[ai][m];
                const float q16 = q * 8.f;
                u32x2 w; w.x = pk_fp8x4(silu_f(g0[0]) * u0[0] * q16, silu_f(g0[1]) * u0[1] * q16, silu_f(g0[2]) * u0[2] * q16, silu_f(g0[3]) * u0[3] * q16);
                w.y = pk_fp8x4(silu_f(g1[0]) * u1[0] * q16, silu_f(g1[1]) * u1[1] * q16, silu_f(g1[2]) * u1[2] * q16, silu_f(g1[3]) * u1[3] * q16);
                *(u32x2*)((unsigned char*)H + (size_t)(u.pm * BM + r0 + ai * HALF + m * 16) * DEXP + col0) = w; }
    }
};
struct EpiMoeOut {
    static constexpr bool PERM = true;
    bf16_t* O; const float* gateof; const unsigned* cnt; const LAS int* ts;
    __device__ __forceinline__ void operator()(const f32x4 (&acc)[2][2][4][2], const Unit& u, int wr, int wc, int fr, int fq) const {
        const int r0 = wr * 64 + fr, col0 = u.pn * BM + wc * 32 + 8 * fq; const int pbase = (u.pm - ts[u.e]) * BM; const int ce = (int)cnt[u.e];
#pragma unroll
        for (int ai = 0; ai < 2; ++ai)
#pragma unroll
            for (int m = 0; m < 4; ++m) { const int r = r0 + ai * HALF + m * 16; const int pos = pbase + r;
                const float gt = pos < ce ? gateof[(size_t)u.e * TT + pos] : 0.f;
                bf16_t* rowp = O + (size_t)(u.pm * BM + r) * D + col0;
#pragma unroll
                for (int bj = 0; bj < 2; ++bj) { const f32x4 v0 = acc[ai][bj][m][0] * gt, v1 = acc[ai][bj][m][1] * gt;
                    u32x4 w; w.x = pk_bf16(v0[0], v0[1]); w.y = pk_bf16(v0[2], v0[3]); w.z = pk_bf16(v1[0], v1[1]); w.w = pk_bf16(v1[2], v1[3]);
                    *(u32x4*)(rowp + bj * HALF) = w; } }
    }
};
}
__device__ __forceinline__ int moe_tables(const Frame& F, int l) {
    LAS int* ts = (LAS int*)(F.lds + MO_TS); LAS unsigned char* te = (LAS unsigned char*)(F.lds + MO_TE);
    __syncthreads();
    if (F.tid == 0) { int acc = 0; for (int e = 0; e < 32; ++e) { ts[e] = acc; acc += ((int)F.ctl[CW_CNT + l * 32 + e] + 255) >> 8; } ts[32] = acc; }
    __syncthreads();
    if (F.tid < 32) { for (int t = ts[F.tid]; t < ts[F.tid + 1]; ++t) te[t] = (unsigned char)F.tid; }
    __syncthreads();
    return ts[32];
}

__global__ void __launch_bounds__(NTHREADS, 2) fwd_kernel(Params prm) {
    extern __shared__ __attribute__((aligned(16))) unsigned char lds_raw[];
    Frame F; F.P = (KParams)__builtin_amdgcn_kernarg_segment_ptr(); F.lds = (LAS unsigned char*)lds_raw; F.wsg = prm.ws; F.tid = threadIdx.x; F.lane = F.tid & 63; F.wave = __builtin_amdgcn_readfirstlane(F.tid >> 6);
    F.G = gridDim.x; F.bid = blockIdx.x; F.vcu = 0; F.ctl = (unsigned*)((unsigned char*)prm.ws + WS_CTL);
    if (F.tid < 4) ((LAS unsigned*)(F.lds + LDS_BARW))[F.tid] = 0u;
    __syncthreads();
    (void)xcd_barrier_post(F.ctl + CW_BAR, (volatile LAS unsigned*)(F.lds + LDS_BARW));
    int phase = 0; unsigned long long tacc = 0, tprev = TIME_MASK ? __builtin_amdgcn_s_memrealtime() : 0ull;
#define OPQ() do { asm volatile("" : "+s"(F.wsg)); asm volatile("" : "+s"(F.P)); asm volatile("" : "+s"(F.ctl)); asm volatile("" : "+s"(F.bid)); asm volatile("" : "+s"(F.G)); \
        F.vcu = (F.G % 8 == 0) ? (F.bid % 8) * (F.G / 8) + F.bid / 8 : F.bid; asm volatile("" : "+v"(F.tid)); F.lane = F.tid & 63; F.wave = __builtin_amdgcn_readfirstlane(F.tid >> 6); } while (0)
#define SEAM(sec) do { OPQ(); XcdBarrier b2_; b2_.bar = F.ctl + CW_BAR; b2_.x = xb_xcc_id(); b2_.st = (volatile LAS unsigned*)(F.lds + LDS_BARW); xcd_barrier(b2_); if (++phase > STOP_AFTER) return; \
        if (TIME_MASK) { const unsigned long long now_ = __builtin_amdgcn_s_memrealtime(); if ((TIME_MASK >> (sec)) & 1u) tacc += now_ - tprev; tprev = now_; } } while (0)

    OPQ(); if (PH(0)) {
        p0_rope(F);
        LAS int* qslot = (LAS int*)(F.lds + LDS_BARW - 16);
        for (;;) {
            __syncthreads();
            if (F.tid == 0) *qslot = (int)__hip_atomic_fetch_add(F.ctl + CW_Q, 1u, __ATOMIC_RELAXED, __HIP_MEMORY_SCOPE_AGENT);
            __syncthreads();
            const int it = *qslot;
            if (it >= 384 + 288 + 632 + 576) break;
            if (it < 384) p0_mods_item(F, it);
            else if (it < 672) p0_filter_item(F, it - 384);
            else if (it < 1304) p0_transposes_chunk(F, it - 672);
            else p0_xc_chunk(F, it - 1304);
        }
    }
    SEAM(9);
    OPQ(); if (PH(0)) { p0_gr(F); p0_rtab(F); }
    SEAM(10);
    for (int l = 0; l < DEPTH; ++l) {
        const bool last = (l == DEPTH - 1);
        OPQ(); if (PH(1)) row_norm_phase<0>(F, l, l - 1, l == 0);
        for (int rep_ = 0; rep_ < REPN(2); ++rep_) { OPQ(); if (PH(2)) moe_weight_cvt(F, l); }
        SEAM(0);
        for (int rep_ = 0; rep_ < REPN(3); ++rep_) { OPQ(); if (PH(3)) {
            {
                pg8::Gemm g{(const bf16_t*)(F.ws_() + WS_H8), (const bf16_t*)(F.ws_() + WS_WIN8 + (size_t)l * 1280 * 1024), D / 2, 0, 0x79797979, 0x7f7f7f7f};
                pg8::StaticOrder S; S.init(TT, 1280, F.G, F.bid);
                pg8::EpiFp8 E{F.ws_() + WS_P, DIN * 2, 1.f};
                pg8::gemm_phase<pg8::EpiFp8, pg8::StaticOrder, true, true, true>(F.lds, g, S, E, F.tid); }
            {
                pg8::Gemm g{(const bf16_t*)(F.ws_() + WS_H), (const bf16_t*)(F.ws_() + WS_WINT) + ((size_t)l * DIN + 1280) * D, D, 0, 0, 0};
                pg8::StaticOrder S; S.init(TT, 1280, F.G, F.G - 1 - F.bid);
                pg8::EpiBf16 E{(bf16_t*)(F.ws_() + WS_P) + 1280, DIN};
                pg8::gemm_phase<pg8::EpiBf16, pg8::StaticOrder>(F.lds, g, S, E, F.tid); }
            OPQ(); moe_weight_cvt_queue(F, l, 0); } }
        SEAM(1);
        for (int rep_ = 0; rep_ < REPN(4); ++rep_) { OPQ(); if (PH(4)) attn_pre(F, l); }
        for (int rep_ = 0; rep_ < REPN(5); ++rep_) { OPQ(); if (PH(5)) conf_phase(F, l, !last); }
        for (int rep_ = 0; rep_ < REPN(6); ++rep_) { OPQ(); if (PH(6)) hy_pre(F, l, !last); }
        for (int rep_ = 0; rep_ < REPN(7); ++rep_) { OPQ(); if (PH(7)) lru_seq(F, l, !last); }
        SEAM(2);
        for (int rep_ = 0; rep_ < REPN(8); ++rep_) { OPQ(); if (PH(8)) hy_conv<0>(F, l, !last); }
        for (int rep_ = 0; rep_ < REPN(9); ++rep_) { OPQ(); if (PH(9)) lru_comb(F, !last); }
        SEAM(3);
        for (int rep_ = 0; rep_ < REPN(10); ++rep_) { OPQ(); if (PH(10)) hy_conv<1>(F, l, !last); }
        for (int rep_ = 0; rep_ < REPN(11); ++rep_) { OPQ(); if (PH(11)) attn_phase(F, l, !last); }
        SEAM(4);
        OPQ(); if (PH(12)) {   pg8::Gemm g{(const bf16_t*)(F.ws_() + WS_Y), (const bf16_t*)(F.ws_() + WS_WOUTT) + (size_t)l * D * D, D, 0, 0, 0};
            pg8::StaticOrder S; S.init(last ? TL : TT, D, F.G, F.bid);
            pg8::EpiResid E{(bf16_t*)(F.ws_() + WS_XB), (const float*)(F.ws_() + WS_MOD) + (size_t)l * 33 * (NMOD * D) + 2 * D};
            pg8::gemm_phase<pg8::EpiResid, pg8::StaticOrder>(F.lds, g, S, E, F.tid);
            OPQ(); moe_weight_cvt_queue(F, l, 1); }
        SEAM(5);
        OPQ(); if (PH(13)) ffn_route_mfma(F, l, last ? TL : TT);
        SEAM(6);
        for (int rep_ = 0; rep_ < REPN(14); ++rep_) { OPQ(); if (PH(14)) {   const int ntile = moe_tables(F, l);
            pg8::MoeOrder S{(const LAS int*)(F.lds + MO_TS), (const LAS unsigned char*)(F.lds + MO_TE), F.ctl + CW_CNT + l * 32, (const int*)(F.ws_() + WS_TOKOF), F.G, (F.G % 8 == 0) ? (F.bid % 8) * (F.G / 8) + F.bid / 8 : F.bid, ntile * 4, true};
            pg8::Gemm g{(const bf16_t*)(F.ws_() + WS_H), (const bf16_t*)(F.ws_() + WS_MOEGU), D / 2, (size_t)1024 * 1024, 0x79797979, 0x7f7f7f7f};
            pg8::EpiSwiGLU E{(bf16_t*)(F.ws_() + WS_HID), (const float*)(F.ws_() + WS_GATEOF), F.ctl + CW_CNT + l * 32, (const LAS int*)(F.lds + MO_TS)};
            pg8::gemm_phase<pg8::EpiSwiGLU, pg8::MoeOrder, true, true, true>(F.lds, g, S, E, F.tid); } }
        SEAM(7);
        for (int rep_ = 0; rep_ < REPN(15); ++rep_) { OPQ(); if (PH(15)) {   const int ntile = moe_tables(F, l);
            pg8::MoeOrder S{(const LAS int*)(F.lds + MO_TS), (const LAS unsigned char*)(F.lds + MO_TE), F.ctl + CW_CNT + l * 32, (const int*)(F.ws_() + WS_TOKOF), F.G, (F.G % 8 == 0) ? (F.bid % 8) * (F.G / 8) + F.bid / 8 : F.bid, ntile * 4, false};
            pg8::Gemm g{(const bf16_t*)(F.ws_() + WS_HID), (const bf16_t*)(F.ws_() + WS_MOEDN), DEXP / 2, (size_t)1024 * 512, 0x79797979, 0x7c7c7c7c};
            pg8::EpiFp8 E{F.ws_() + WS_O, D, 16.f};
            pg8::gemm_phase<pg8::EpiFp8, pg8::MoeOrder, true, true, true>(F.lds, g, S, E, F.tid); } }
        SEAM(8);
    }
    OPQ(); if (PH(16)) row_norm_phase<2>(F, 0, DEPTH - 1, false);
    if (TIME_MASK) { __syncthreads(); const unsigned long long now_ = __builtin_amdgcn_s_memrealtime(); if ((TIME_MASK >> 11) & 1u) tacc += now_ - tprev;
        if (F.bid == 0) { const unsigned long long t0_ = __builtin_amdgcn_s_memrealtime(); while (__builtin_amdgcn_s_memrealtime() - t0_ < tacc) __builtin_amdgcn_s_sleep(8); } }
    if (xb_ld(F.ctl + CW_BAR + XB_TMO) != 0u) {
        __syncthreads();
        for (int row = F.bid * 8 + F.wave; row < TL; row += F.G * 8) { float* xr = F.out() + (size_t)row * D;
            for (int i = 0; i < 4; ++i) *(f32x4*)(xr + i * 256 + 4 * F.lane) = (f32x4){0.f, 0.f, 0.f, 0.f}; }
    }
}

extern "C" void kernel_launch(void* const* d_in, const int* in_sizes, int n_in, void* d_out, int out_size, void* d_ws, size_t ws_size, hipStream_t stream) {
    static int grid = 0;
    if (!grid) {
        int dev = 0, cus = 0, per_cu = 0;
        hipGetDevice(&dev);
        hipDeviceGetAttribute(&cus, hipDeviceAttributeMultiprocessorCount, dev);
        hipFuncSetAttribute((const void*)fwd_kernel, hipFuncAttributeMaxDynamicSharedMemorySize, LDS_BYTES);
        hipOccupancyMaxActiveBlocksPerMultiprocessor(&per_cu, (const void*)fwd_kernel, NTHREADS, LDS_BYTES);
        if (per_cu < 1) fprintf(stderr, "kernel_launch: occupancy query says %d\n", per_cu);
        grid = cus > 0 ? cus : 256;
        if (ws_size < WS_END) fprintf(stderr, "kernel_launch: workspace too small: %zu < %zu\n", ws_size, (size_t)WS_END);
        if (n_in != 46) fprintf(stderr, "kernel_launch: expected 46 inputs, got %d\n", n_in);
    }
    hipMemsetAsync((char*)d_ws + WS_CTL, 0, CTL_BYTES, stream);
    Params p; memset(&p, 0, sizeof(p));
    for (int i = 0; i < 46 && i < n_in; ++i) p.in[i] = (const GAS float*)d_in[i];
    p.out = (GAS float*)d_out; p.ws = (GAS unsigned char*)d_ws;
    hipLaunchKernelGGL(fwd_kernel, dim3(grid), dim3(NTHREADS), LDS_BYTES, stream, p);
}
```

```cpp
#include <hip/hip_runtime.h>
#include <cstdio>
#include <cstdint>
#include <cstring>

#ifndef PH_MASK
#define PH_MASK 0xffffffffu
#endif
#define PH(k) ((PH_MASK >> (k)) & 1u)
#ifndef REP_MASK
#define REP_MASK 0u
#endif
#define REPN(k) (1 + (int)((REP_MASK >> (k)) & 1u))
#ifndef TIME_MASK
#define TIME_MASK 0u
#endif
#ifndef STOP_AFTER
#define STOP_AFTER 9999
#endif

#define LAS __attribute__((address_space(3)))
#define GAS __attribute__((address_space(1)))
typedef unsigned short bf16_t;
typedef short bf16x8 __attribute__((ext_vector_type(8)));
typedef float f32x4 __attribute__((ext_vector_type(4)));
typedef float f32x16 __attribute__((ext_vector_type(16)));
typedef unsigned u32x4 __attribute__((ext_vector_type(4)));
typedef unsigned u32x2 __attribute__((ext_vector_type(2)));
typedef int i32x4 __attribute__((ext_vector_type(4)));
typedef int i32x2 __attribute__((ext_vector_type(2)));
typedef int i32x8v __attribute__((ext_vector_type(8)));

constexpr int D = 1024, NB = 32, SEQ = 2048, LC = 256, DEPTH = 4;
constexpr int TL = NB * SEQ, TC = NB * LC, TT = TL + TC;
constexpr int DIN = 2560, NMOD = 6;
constexpr int OFF_B = 0, OFF_C = 768, OFF_A = 1280, OFF_D = 1792;
constexpr int NEXP = 32, DEXP = 512;
constexpr int MAXSLOT = 155648;
constexpr float EPS = 1e-6f;
constexpr int NTHREADS = 512;
constexpr int LDS_BYTES = 163840;
constexpr int LDS_BARW = LDS_BYTES - 16;

constexpr size_t MBy = 1ull << 20;
constexpr size_t WS_CTL   = 0;
constexpr size_t CTL_BYTES = 65536;
constexpr size_t WS_MOD   = WS_CTL + CTL_BYTES;
constexpr size_t WS_GG    = WS_MOD + 3328 * 1024;
constexpr size_t WS_RB    = WS_GG + 576 * 1024;
constexpr size_t WS_ROPE  = WS_MOD + 4 * MBy;
constexpr size_t WS_WINT  = WS_ROPE + 1 * MBy;
constexpr size_t WS_WOUTT = WS_WINT + 20 * MBy;
constexpr size_t WS_CPW   = WS_WOUTT + 8 * MBy;
constexpr size_t WS_LRUW  = WS_CPW + 1 * MBy;
constexpr size_t WS_FRAW  = WS_LRUW + 1 * MBy;
constexpr size_t WS_FEN   = WS_FRAW + 36 * MBy;
constexpr size_t WS_GR    = WS_FEN + 1 * MBy;
constexpr size_t WS_GRC   = WS_GR + 16 * MBy;
constexpr size_t WS_XB    = WS_GRC + 2 * MBy;
constexpr size_t WS_H     = WS_XB + 144 * MBy;
constexpr size_t WS_Y     = WS_H + 144 * MBy;
constexpr size_t WS_MOEGU = WS_Y + 144 * MBy;
constexpr size_t WS_MOEDN = WS_MOEGU + 64 * MBy;
constexpr size_t WS_TOKOF = WS_MOEDN + 32 * MBy;
constexpr size_t WS_GATEOF= WS_TOKOF + 9 * MBy;
constexpr size_t WS_TOKINF= WS_GATEOF + 9 * MBy;
constexpr size_t WS_LRUS  = WS_TOKINF + 2 * MBy;
constexpr size_t WS_LRUC  = WS_LRUS + 3 * MBy;
constexpr size_t WS_BIG   = WS_LRUC + 2 * MBy;
constexpr size_t WS_P     = WS_BIG;
constexpr size_t WS_UF    = WS_P + 360 * MBy;
constexpr size_t WS_Z1F   = WS_UF + 108 * MBy;
constexpr size_t WS_HID   = WS_BIG;
constexpr size_t WS_O     = WS_HID + 152 * MBy;
constexpr size_t WS_WIN8  = WS_Z1F + 36 * MBy;
constexpr size_t WS_END   = WS_WIN8 + 8 * MBy;
constexpr size_t WS_H8    = WS_Y;
constexpr size_t WS_HT    = WS_H;
constexpr size_t WS_KIMG  = WS_H + 72 * MBy;
constexpr size_t WS_VIMG  = WS_H + 108 * MBy;
static_assert(WS_O + 304 * MBy <= WS_END, "overlay");
static_assert(WS_END <= 1200 * MBy, "workspace budget");

constexpr int CW_BAR = 0;
constexpr int CW_CNT = 4096;
constexpr int CW_Q   = 4096 + 256;
constexpr int CW_MQ  = CW_Q + 16;

struct Params {
    const GAS float* in[46];
    GAS float* out;
    GAS unsigned char* ws;
};

typedef float f32x2 __attribute__((ext_vector_type(2)));
typedef __bf16 bf16x2v __attribute__((ext_vector_type(2)));
__device__ __forceinline__ unsigned pk_bf16(float lo, float hi) { const f32x2 v = {lo, hi}; const bf16x2v r = __builtin_convertvector(v, bf16x2v); return __builtin_bit_cast(unsigned, r); }
__device__ __forceinline__ bf16x8 pk8(const float (&v)[8]) { u32x4 w; w.x = pk_bf16(v[0], v[1]); w.y = pk_bf16(v[2], v[3]); w.z = pk_bf16(v[4], v[5]); w.w = pk_bf16(v[6], v[7]); return __builtin_bit_cast(bf16x8, w); }
__device__ __forceinline__ unsigned pk_fp8x4(float a, float b, float c, float d) {
    a = __builtin_amdgcn_fmed3f(a, -448.f, 448.f); b = __builtin_amdgcn_fmed3f(b, -448.f, 448.f); c = __builtin_amdgcn_fmed3f(c, -448.f, 448.f); d = __builtin_amdgcn_fmed3f(d, -448.f, 448.f);
    int p = __builtin_amdgcn_cvt_pk_fp8_f32(a, b, 0, false); p = __builtin_amdgcn_cvt_pk_fp8_f32(c, d, p, true); return (unsigned)p; }
__device__ __forceinline__ void dec_fp8x8(const u32x2 w, float (&x)[8]) {
    x[0] = __builtin_amdgcn_cvt_f32_fp8((int)w.x, 0); x[1] = __builtin_amdgcn_cvt_f32_fp8((int)w.x, 1); x[2] = __builtin_amdgcn_cvt_f32_fp8((int)w.x, 2); x[3] = __builtin_amdgcn_cvt_f32_fp8((int)w.x, 3);
    x[4] = __builtin_amdgcn_cvt_f32_fp8((int)w.y, 0); x[5] = __builtin_amdgcn_cvt_f32_fp8((int)w.y, 1); x[6] = __builtin_amdgcn_cvt_f32_fp8((int)w.y, 2); x[7] = __builtin_amdgcn_cvt_f32_fp8((int)w.y, 3); }
#define MFMA32(a, b, c) __builtin_amdgcn_mfma_f32_32x32x16_bf16((a), (b), (c), 0, 0, 0)
#define MFMA16(a, b, c) __builtin_amdgcn_mfma_f32_16x16x32_bf16((a), (b), (c), 0, 0, 0)
__device__ __forceinline__ float bf2f(bf16_t v) { return __uint_as_float(((unsigned)v) << 16); }
__device__ __forceinline__ float bflo(unsigned w) { return __uint_as_float(w << 16); }
__device__ __forceinline__ float bfhi(unsigned w) { return __uint_as_float(w & 0xffff0000u); }
__device__ __forceinline__ float silu_f(float v) { return v * __builtin_amdgcn_rcpf(1.0f + __expf(-v)); }
__device__ __forceinline__ float sigmoid_f(float v) { return __builtin_amdgcn_rcpf(1.0f + __expf(-v)); }
__device__ __forceinline__ float gelu_tanh_f(float v) { const float u = 0.7978845608028654f * (v + 0.044715f * v * v * v); const float t = 1.0f - 2.0f * __builtin_amdgcn_rcpf(1.0f + __expf(2.0f * u)); return 0.5f * v * (1.0f + t); }
__device__ __forceinline__ float wave_sum(float v) {
    v += __builtin_bit_cast(float, __builtin_amdgcn_update_dpp(0, __builtin_bit_cast(int, v), 0xB1, 0xF, 0xF, true));
    v += __builtin_bit_cast(float, __builtin_amdgcn_update_dpp(0, __builtin_bit_cast(int, v), 0x4E, 0xF, 0xF, true));
    v += __builtin_bit_cast(float, __builtin_amdgcn_update_dpp(0, __builtin_bit_cast(int, v), 0x141, 0xF, 0xF, true));
    v += __builtin_bit_cast(float, __builtin_amdgcn_update_dpp(0, __builtin_bit_cast(int, v), 0x140, 0xF, 0xF, true));
    const int iv = __builtin_bit_cast(int, v);
    return (__builtin_bit_cast(float, __builtin_amdgcn_readlane(iv, 0)) + __builtin_bit_cast(float, __builtin_amdgcn_readlane(iv, 16)))
         + (__builtin_bit_cast(float, __builtin_amdgcn_readlane(iv, 32)) + __builtin_bit_cast(float, __builtin_amdgcn_readlane(iv, 48)));
}

#define XB_TMO      128
#define XB_XCNT(j)  (256  + 64 * (j))
#define XB_XSUB(j)  (1280 + 64 * (j))
#define XB_XGEN(j)  (2304 + 64 * (j))
#define XB_TOP      3328
#define XB_TOPGEN   3392
#define XCD_BAR_WORDS 3456
#define XB_SPIN_CAP (1u << 18)
__device__ __forceinline__ unsigned xb_ld(unsigned* p)              { return __hip_atomic_load(p, __ATOMIC_RELAXED, __HIP_MEMORY_SCOPE_AGENT); }
__device__ __forceinline__ unsigned xb_add(unsigned* p, unsigned v) { return __hip_atomic_fetch_add(p, v, __ATOMIC_RELAXED, __HIP_MEMORY_SCOPE_AGENT); }
__device__ __forceinline__ unsigned xb_xcc_id() { return (unsigned)__builtin_amdgcn_s_getreg((3 << 11) | 20) & 0xFu; }
#define XB_SPIN(cond, bar) do { unsigned _sp = 0; while (cond) { __builtin_amdgcn_s_sleep(1); \
    if ((++_sp & 255u) == 0u) { if (xb_ld(&(bar)[XB_TMO])) break; if (_sp > XB_SPIN_CAP) { atomicAdd(&(bar)[XB_TMO], 1u); break; } } } } while (0)
struct XcdBarrier { unsigned* bar; unsigned x; volatile LAS unsigned* st; };
__device__ __forceinline__ XcdBarrier xcd_barrier_post(unsigned* bar, volatile LAS unsigned* st) {
    XcdBarrier b; b.bar = bar; b.x = xb_xcc_id(); b.st = st;
    if (threadIdx.x == 0) (void)xb_add(&bar[XB_XCNT(b.x)], 1u);
    return b;
}
__device__ __forceinline__ void xcd_barrier_complete(unsigned* bar, unsigned x, unsigned& nloc, unsigned& nx) {
    const unsigned G = gridDim.x * gridDim.y * gridDim.z;
    unsigned sum, cnt, mine, sp = 0u;
    for (;;) {
        sum = 0u; cnt = 0u; mine = 0u;
#pragma unroll
        for (unsigned j = 0; j < 16; ++j) { const unsigned c = xb_ld(&bar[XB_XCNT(j)]); sum += c; cnt += (c > 0u) ? 1u : 0u; mine = (j == x) ? c : mine; }
        if (sum == G) break;
        __builtin_amdgcn_s_sleep(1);
        if ((++sp & 255u) == 0u) { if (xb_ld(&bar[XB_TMO])) break; if (sp > XB_SPIN_CAP) { atomicAdd(&bar[XB_TMO], 1u); break; } }
    }
    nloc = mine > 0u ? mine : 1u; nx = cnt > 0u ? cnt : 1u;
}
__device__ __forceinline__ void xcd_barrier(const XcdBarrier& b) {
    asm volatile("s_waitcnt vmcnt(0)" ::: "memory");
    __syncthreads();
    if (threadIdx.x == 0) {
        unsigned* bar = b.bar;
        __builtin_amdgcn_s_waitcnt(0);
        unsigned nloc = b.st[0], nx = b.st[1];
        if (nloc == 0u) { xcd_barrier_complete(bar, b.x, nloc, nx); b.st[0] = nloc; b.st[1] = nx; }
        const unsigned old = xb_add(&bar[XB_XSUB(b.x)], 1u);
        const unsigned gen = old / nloc;
        if (old + 1u == (gen + 1u) * nloc) {
            __builtin_amdgcn_fence(__ATOMIC_RELEASE, "agent");
            asm volatile("s_waitcnt vmcnt(0)" ::: "memory");
            const unsigned og = xb_add(&bar[XB_TOP], 1u);
            const unsigned tg = og / nx;
            if (og + 1u == (tg + 1u) * nx) xb_add(&bar[XB_TOPGEN], 1u);
            else XB_SPIN(xb_ld(&bar[XB_TOPGEN]) == tg, bar);
            __builtin_amdgcn_fence(__ATOMIC_ACQUIRE, "agent");
            xb_add(&bar[XB_XGEN(b.x)], 1u);
            asm volatile("s_waitcnt vmcnt(0)" ::: "memory");
        } else {
            XB_SPIN(xb_ld(&bar[XB_XGEN(b.x)]) == gen, bar);
            __builtin_amdgcn_fence(__ATOMIC_ACQUIRE, "agent");
            asm volatile("s_waitcnt vmcnt(0)" ::: "memory");
        }
    }
    __syncthreads();
}

namespace pg8 {
constexpr int BM = 256, BK = 64, HALF = 128, HTB = HALF * BK * 2, STAGE_BYTES = 8 * HTB, NXCD = 8, WGM = 8;
__host__ __device__ __forceinline__ int lds_byte(int r, int c) { const int st = (r >> 4) * 2 + (c >> 5), rr = r & 15, cc = c & 31, ob = rr * 64 + cc * 2; return st * 1024 + (ob ^ (((ob >> 9) & 1) << 5)); }
__host__ __device__ __forceinline__ void stage_rc(int b, int& R, int& C) { const int st = b / 1024, sb = b % 1024, swz = sb ^ (((sb >> 9) & 1) << 5); R = (st >> 1) * 16 + swz / 64; C = (st & 1) * 32 + (swz % 64) / 2; }
__host__ __device__ __forceinline__ int perm32(int rho) { const int n = rho >> 4, i = rho & 15; return 8 * (i >> 2) + 4 * n + (i & 3); }

struct Unit { int pm, pn, e; };
struct Gemm { const bf16_t* A; const bf16_t* Bt; int K; size_t bstride; int sc_w, sc_a; };

struct StaticOrder {
    static constexpr bool PREFETCH = false;
    int nM, nN, nwg, G, c;
    __device__ void init(int M, int N, int G_, int c_) { nM = M / BM; nN = N / BM; nwg = nM * nN; G = G_; c = c_; }
    __device__ __forceinline__ bool next(int i, Unit& u) const {
        const long L = (long)i * G + c; if (L >= nwg) return false;
        int wgid = (int)L; { const int q = nwg / NXCD, r = nwg % NXCD, xcd = wgid % NXCD, off = wgid / NXCD; wgid = (xcd < r ? xcd * (q + 1) : r * (q + 1) + (xcd - r) * q) + off; }
        const int nig = WGM * nN, gid = wgid / nig, fm = gid * WGM, gsz = (nM - fm) < WGM ? (nM - fm) : WGM;
        u.pm = fm + ((wgid % nig) % gsz); u.pn = (wgid % nig) / gsz; u.e = 0; return true;
    }
    __device__ __forceinline__ unsigned arow(const Unit& u, int r) const { return (unsigned)(u.pm * BM + r); }
};

template <class Epi, class Sched, bool ALIGN_EPI = true, bool SP2 = true, bool FP8 = false>
__device__ __forceinline__ void gemm_phase(LAS unsigned char* lds, const Gemm g, const Sched& S, const Epi& E, const int tid_in) {
    const int tid = tid_in, wid = __builtin_amdgcn_readfirstlane(tid >> 6), lane = tid & 63, wr = wid >> 2, wc = wid & 3, fr = lane & 15, fq = lane >> 4;
    const int K = g.K, nt = K / BK;
    unsigned voffB[2];
#pragma unroll
    for (int i = 0; i < 2; ++i) { int R, C; stage_rc(tid * 16 + i * 8192, R, C); const int Rb = Epi::PERM ? ((R & ~31) + perm32(R & 31)) : R;
        voffB[i] = (unsigned)(Rb * K + C) * 2u; }
    const size_t kstep = (size_t)(BK * 2);
    const size_t hstep = (size_t)HALF * K * 2;
    const size_t tstep = 2 * hstep;
    const unsigned rowb = (unsigned)K * 2u;
    const unsigned ldsw = (unsigned)wid * 1024u;
    const int aoff = lds_byte(wr * 64 + fr, fq * 8), boff = lds_byte(wc * 32 + fr, fq * 8);
#define PG8_SA(b, h) (((b) * 2 + (h)) * HTB)
#define PG8_SB(b, h) ((4 + (b) * 2 + (h)) * HTB)
#define PG8_STAGE(bufoff, gbase, voff) do { _Pragma("unroll") for (int _i = 0; _i < 2; ++_i) \
        __builtin_amdgcn_global_load_lds((const unsigned*)((const char*)(gbase) + (voff)[_i]), (LAS unsigned*)(lds + (bufoff) + ldsw + _i * 8192), 16, 0, 0); } while (0)
#define PG8_RD8(dst8, addr) do { const u32x4 x0_ = *(const LAS u32x4*)(addr), x1_ = *(const LAS u32x4*)((addr) + 1024); \
        dst8 = (i32x8v){(int)x0_.x, (int)x0_.y, (int)x0_.z, (int)x0_.w, (int)x1_.x, (int)x1_.y, (int)x1_.z, (int)x1_.w}; } while (0)
#define PG8_LDA(dst, b, h) do { if constexpr (FP8) { _Pragma("unroll") for (int m = 0; m < 4; ++m) PG8_RD8(dst##8[m], lds + PG8_SA(b, h) + aoff + m * 2048); } \
        else { _Pragma("unroll") for (int m = 0; m < 4; ++m) _Pragma("unroll") for (int k = 0; k < 2; ++k) dst[m][k] = *(const LAS bf16x8*)(lds + PG8_SA(b, h) + aoff + m * 2048 + k * 1024); } } while (0)
#define PG8_LDB(dst, b, h) do { if constexpr (FP8) { _Pragma("unroll") for (int n = 0; n < 2; ++n) PG8_RD8(dst##8[n], lds + PG8_SB(b, h) + boff + n * 2048); } \
        else { _Pragma("unroll") for (int n = 0; n < 2; ++n) _Pragma("unroll") for (int k = 0; k < 2; ++k) dst[n][k] = *(const LAS bf16x8*)(lds + PG8_SB(b, h) + boff + n * 2048 + k * 1024); } } while (0)
#define PG8_MMA(ai, bj, At, Bt) do { __builtin_amdgcn_s_setprio(1); \
        if constexpr (FP8) { _Pragma("unroll") for (int m = 0; m < 4; ++m) _Pragma("unroll") for (int n = 0; n < 2; ++n) \
            acc[ai][bj][m][n] = __builtin_amdgcn_mfma_scale_f32_16x16x128_f8f6f4(Bt##8[n], At##8[m], acc[ai][bj][m][n], 0, 0, 0, g.sc_w, 0, g.sc_a); } \
        else { _Pragma("unroll") for (int m = 0; m < 4; ++m) _Pragma("unroll") for (int n = 0; n < 2; ++n) _Pragma("unroll") for (int k = 0; k < 2; ++k) \
            acc[ai][bj][m][n] = __builtin_amdgcn_mfma_f32_16x16x32_bf16(Bt[n][k], At[m][k], acc[ai][bj][m][n], 0, 0, 0); } \
        __builtin_amdgcn_s_setprio(0); } while (0)
#define PG8_WAIT_V(n) asm volatile("s_waitcnt vmcnt(" #n ")" ::: "memory")
#define PG8_WAIT_L(n) asm volatile("s_waitcnt lgkmcnt(" #n ")" ::: "memory")
#define PG8_BAR __builtin_amdgcn_s_barrier()
#define PG8_SCHED __builtin_amdgcn_sched_barrier(0)
    Unit cur, nxt; int ui = 0;
    if (!S.next(0, cur)) return;
    f32x4 acc[2][2][4][2];
#pragma unroll
    for (int a = 0; a < 2; ++a)
#pragma unroll
        for (int b = 0; b < 2; ++b)
#pragma unroll
            for (int m = 0; m < 4; ++m)
#pragma unroll
                for (int n = 0; n < 2; ++n) acc[a][b][m][n] = (f32x4){0.f, 0.f, 0.f, 0.f};
    bf16x8 At[4][2], B0[2][2], B1[2][2]; i32x8v At8[4], B08[2], B18[2];
    unsigned ca0[2], ca1[2], na0[2], na1[2];
#define PG8_AROWS(u, o0, o1) do { int _tz = tid_in; asm volatile("" : "+v"(_tz)); _Pragma("unroll") for (int _i = 0; _i < 2; ++_i) { int _R, _C; stage_rc(_tz * 16 + _i * 8192, _R, _C); \
        o0[_i] = S.arow(u, _R) * rowb + (unsigned)_C * 2u; o1[_i] = S.arow(u, HALF + _R) * rowb + (unsigned)_C * 2u; } } while (0)
    PG8_AROWS(cur, ca0, ca1);
    const char* Ab = (const char*)g.A;
    const char* cB = (const char*)g.Bt + (size_t)cur.e * g.bstride + (size_t)cur.pn * tstep;
    if constexpr (SP2) {
        PG8_STAGE(PG8_SB(0, 0), cB, voffB); PG8_STAGE(PG8_SB(0, 1), cB + hstep, voffB); PG8_STAGE(PG8_SA(0, 0), Ab, ca0); PG8_STAGE(PG8_SA(0, 1), Ab, ca1);
        if (wr == 1) PG8_BAR;
        PG8_WAIT_V(2); PG8_BAR;
        PG8_STAGE(PG8_SB(1, 0), cB + kstep, voffB); PG8_STAGE(PG8_SA(1, 0), Ab + kstep, ca0); PG8_STAGE(PG8_SB(1, 1), cB + hstep + kstep, voffB);
        PG8_WAIT_V(6); PG8_BAR;
    } else {
        PG8_STAGE(PG8_SB(0, 0), cB, voffB); PG8_STAGE(PG8_SA(0, 0), Ab, ca0); PG8_STAGE(PG8_SB(0, 1), cB + hstep, voffB); PG8_STAGE(PG8_SA(0, 1), Ab, ca1);
        if (wr == 1) PG8_BAR;
        PG8_WAIT_V(4); PG8_BAR;
        PG8_STAGE(PG8_SB(1, 0), cB + kstep, voffB); PG8_STAGE(PG8_SA(1, 0), Ab + kstep, ca0); PG8_STAGE(PG8_SB(1, 1), cB + hstep + kstep, voffB);
        PG8_WAIT_V(6); PG8_BAR;
    }
    for (;;) {
        const bool has_next = S.next(ui + 1, nxt);
        const char* nB = has_next ? (const char*)g.Bt + (size_t)nxt.e * g.bstride + (size_t)nxt.pn * tstep : cB;
        if (Sched::PREFETCH && has_next) PG8_AROWS(nxt, na0, na1);
#pragma unroll 1
        for (int t = 0; t < nt; t += 2) {
            const bool last = (t == nt - 2);
            const char* a1 = Ab + (size_t)(t + 1) * kstep;
            const char* a2 = last ? Ab : Ab + (size_t)(t + 2) * kstep; const char* b2 = last ? nB : cB + (size_t)(t + 2) * kstep;
            const char* a3 = a2 + kstep; const char* b3 = b2 + kstep;
            if constexpr (SP2) {
            PG8_LDB(B0, 0, 0); PG8_LDB(B1, 0, 1); PG8_SCHED; PG8_LDA(At, 0, 0); PG8_STAGE(PG8_SA(1, 1), a1, ca1);
            if (last && has_next) { if (Sched::PREFETCH) { ca0[0] = na0[0]; ca0[1] = na0[1]; ca1[0] = na1[0]; ca1[1] = na1[1]; } else PG8_AROWS(nxt, ca0, ca1); }
            PG8_WAIT_V(8); PG8_WAIT_L(0); PG8_BAR; PG8_MMA(0, 0, At, B0); PG8_MMA(0, 1, At, B1); PG8_BAR; PG8_SCHED;
            PG8_LDA(At, 0, 1); PG8_STAGE(PG8_SB(0, 0), b2, voffB); PG8_STAGE(PG8_SB(0, 1), b2 + hstep, voffB); PG8_STAGE(PG8_SA(0, 0), a2, ca0);
            PG8_WAIT_V(8); PG8_WAIT_L(0); PG8_BAR; PG8_MMA(1, 0, At, B0); PG8_MMA(1, 1, At, B1); PG8_BAR; PG8_SCHED;
            PG8_LDB(B0, 1, 0); PG8_LDB(B1, 1, 1); PG8_SCHED; PG8_LDA(At, 1, 0); PG8_STAGE(PG8_SA(0, 1), a2, ca1);
            PG8_WAIT_V(8); PG8_WAIT_L(0); PG8_BAR; PG8_MMA(0, 0, At, B0); PG8_MMA(0, 1, At, B1); PG8_BAR; PG8_SCHED;
            PG8_LDA(At, 1, 1); PG8_STAGE(PG8_SB(1, 0), b3, voffB); PG8_STAGE(PG8_SB(1, 1), b3 + hstep, voffB); PG8_STAGE(PG8_SA(1, 0), a3, ca0);
            PG8_WAIT_V(8); PG8_WAIT_L(0); PG8_BAR; PG8_MMA(1, 0, At, B0); PG8_MMA(1, 1, At, B1); PG8_BAR; PG8_SCHED;
            } else {
            PG8_LDB(B0, 0, 0); PG8_SCHED; PG8_LDA(At, 0, 0); PG8_STAGE(PG8_SA(1, 1), a1, ca1);
            if (last && has_next) { if (Sched::PREFETCH) { ca0[0] = na0[0]; ca0[1] = na0[1]; ca1[0] = na1[0]; ca1[1] = na1[1]; } else PG8_AROWS(nxt, ca0, ca1); }
            PG8_WAIT_L(8); PG8_BAR; PG8_WAIT_L(0); PG8_MMA(0, 0, At, B0); PG8_BAR; PG8_SCHED;
            PG8_LDB(B1, 0, 1); PG8_STAGE(PG8_SB(0, 0), b2, voffB);
            PG8_BAR; PG8_WAIT_L(0); PG8_MMA(0, 1, At, B1); PG8_BAR;
            PG8_LDA(At, 0, 1); PG8_STAGE(PG8_SA(0, 0), a2, ca0);
            PG8_BAR; PG8_WAIT_L(0); PG8_MMA(1, 0, At, B0); PG8_BAR; PG8_SCHED;
            PG8_STAGE(PG8_SB(0, 1), b2 + hstep, voffB);
            PG8_WAIT_V(6); PG8_BAR; PG8_MMA(1, 1, At, B1); PG8_BAR;
            PG8_LDB(B0, 1, 0); PG8_SCHED; PG8_LDA(At, 1, 0); PG8_STAGE(PG8_SA(0, 1), a2, ca1);
            PG8_WAIT_L(8); PG8_BAR; PG8_WAIT_L(0); PG8_MMA(0, 0, At, B0); PG8_BAR; PG8_SCHED;
            PG8_LDB(B1, 1, 1); PG8_STAGE(PG8_SB(1, 0), b3, voffB);
            PG8_BAR; PG8_WAIT_L(0); PG8_MMA(0, 1, At, B1); PG8_BAR;
            PG8_LDA(At, 1, 1); PG8_STAGE(PG8_SA(1, 0), a3, ca0);
            PG8_BAR; PG8_WAIT_L(0); PG8_MMA(1, 0, At, B0); PG8_BAR; PG8_SCHED;
            PG8_STAGE(PG8_SB(1, 1), b3 + hstep, voffB);
            PG8_WAIT_V(6); PG8_BAR; PG8_MMA(1, 1, At, B1); PG8_BAR;
            }
        }
        if constexpr (ALIGN_EPI) { if (wr == 0) PG8_BAR; }
        E(acc, cur, wr, wc, fr, fq);
        if (!has_next) break;
#pragma unroll
        for (int a = 0; a < 2; ++a)
#pragma unroll
            for (int b = 0; b < 2; ++b)
#pragma unroll
                for (int m = 0; m < 4; ++m)
#pragma unroll
                    for (int n = 0; n < 2; ++n) acc[a][b][m][n] = (f32x4){0.f, 0.f, 0.f, 0.f};
        cur = nxt; cB = nB; ++ui;
        if constexpr (ALIGN_EPI) { if (wr == 1) PG8_BAR; }
    }
    PG8_WAIT_V(0);
    if constexpr (!ALIGN_EPI) { if (wr == 0) PG8_BAR; }
    PG8_BAR;
#undef PG8_AROWS
#undef PG8_SA
#undef PG8_SB
#undef PG8_STAGE
#undef PG8_LDA
#undef PG8_RD8
#undef PG8_LDB
#undef PG8_MMA
#undef PG8_WAIT_V
#undef PG8_WAIT_L
#undef PG8_BAR
#undef PG8_SCHED
}

struct EpiBf16 {
    static constexpr bool PERM = true;
    bf16_t* O; int ldc;
    __device__ __forceinline__ void operator()(const f32x4 (&acc)[2][2][4][2], const Unit& u, int wr, int wc, int fr, int fq) const {
        const int row0 = u.pm * BM + wr * 64 + fr, col0 = u.pn * BM + wc * 32 + 8 * fq;
#pragma unroll
        for (int ai = 0; ai < 2; ++ai)
#pragma unroll
            for (int m = 0; m < 4; ++m) { bf16_t* rowp = O + (size_t)(row0 + ai * HALF + m * 16) * ldc + col0;
#pragma unroll
                for (int bj = 0; bj < 2; ++bj) { const f32x4 v0 = acc[ai][bj][m][0], v1 = acc[ai][bj][m][1];
                    u32x4 w; w.x = pk_bf16(v0[0], v0[1]); w.y = pk_bf16(v0[2], v0[3]); w.z = pk_bf16(v1[0], v1[1]); w.w = pk_bf16(v1[2], v1[3]);
                    *(u32x4*)(rowp + bj * HALF) = w; } }
    }
};
struct EpiFp8 {
    static constexpr bool PERM = true;
    unsigned char* O; int ldc; float sc;
    __device__ __forceinline__ void operator()(const f32x4 (&acc)[2][2][4][2], const Unit& u, int wr, int wc, int fr, int fq) const {
        const int row0 = u.pm * BM + wr * 64 + fr, col0 = u.pn * BM + wc * 32 + 8 * fq;
#pragma unroll
        for (int ai = 0; ai < 2; ++ai)
#pragma unroll
            for (int m = 0; m < 4; ++m) { unsigned char* rowp = O + (size_t)(row0 + ai * HALF + m * 16) * ldc + col0;
#pragma unroll
                for (int bj = 0; bj < 2; ++bj) { const f32x4 v0 = acc[ai][bj][m][0] * sc, v1 = acc[ai][bj][m][1] * sc;
                    u32x2 w; w.x = pk_fp8x4(v0[0], v0[1], v0[2], v0[3]); w.y = pk_fp8x4(v1[0], v1[1], v1[2], v1[3]);
                    *(u32x2*)(rowp + bj * HALF) = w; } }
    }
};
struct EpiResid {
    static constexpr bool PERM = true;
    bf16_t* xb; const float* mod2;
    __device__ __forceinline__ void operator()(const f32x4 (&acc)[2][2][4][2], const Unit& u, int wr, int wc, int fr, int fq) const {
        const int rowt = u.pm * BM; const bool isc = rowt >= TL;
        const float* gv = mod2 + (size_t)(isc ? 32 : (rowt >> 11)) * (NMOD * D);
        const int r0 = rowt + wr * 64 + fr, col0 = u.pn * BM + wc * 32 + 8 * fq;
        f32x4 g4[2][2];
#pragma unroll
        for (int bj = 0; bj < 2; ++bj)
#pragma unroll
            for (int n = 0; n < 2; ++n) g4[bj][n] = *(const f32x4*)(gv + col0 + bj * HALF + 4 * n);
#pragma unroll
        for (int ai = 0; ai < 2; ++ai)
#pragma unroll
            for (int m = 0; m < 4; ++m) { bf16_t* rowp = xb + (size_t)(r0 + ai * HALF + m * 16) * D + col0;
#pragma unroll
                for (int bj = 0; bj < 2; ++bj) { const u32x4 xv = *(const u32x4*)(rowp + bj * HALF);
                    const f32x4 v0 = acc[ai][bj][m][0] * g4[bj][0], v1 = acc[ai][bj][m][1] * g4[bj][1];
                    u32x4 w; w.x = pk_bf16(bflo(xv.x) + v0[0], bfhi(xv.x) + v0[1]); w.y = pk_bf16(bflo(xv.y) + v0[2], bfhi(xv.y) + v0[3]);
                    w.z = pk_bf16(bflo(xv.z) + v1[0], bfhi(xv.z) + v1[1]); w.w = pk_bf16(bflo(xv.w) + v1[2], bfhi(xv.w) + v1[3]);
                    *(u32x4*)(rowp + bj * HALF) = w; } }
    }
};
}

typedef const Params __attribute__((address_space(4)))* KParams;
struct Frame {
    KParams P; LAS unsigned char* lds; GAS unsigned char* wsg; int vcu;
    __device__ __forceinline__ unsigned char* ws_() const { return (unsigned char*)wsg; }
    __device__ __forceinline__ const float* in(int k) const { return (const float*)P->in[k]; }
    __device__ __forceinline__ float* out() const { return (float*)P->out; } int tid, lane, wave, G, bid;
    unsigned* ctl;
};

struct TrDesc { const float* src; int ld, k0, n0; bf16_t* dst; int ldd, drow0; int f8; };
__device__ __forceinline__ void tr_load(const Frame& F, const TrDesc& d, f32x4 (&v)[2]) {
    const int r = F.tid >> 4, c4 = F.tid & 15;
#pragma unroll
    for (int i = 0; i < 2; ++i) v[i] = __builtin_nontemporal_load((const f32x4*)(d.src + (size_t)(d.k0 + r + 32 * i) * d.ld + d.n0 + 4 * c4));
}
__device__ __forceinline__ void tr_put(const Frame& F, LAS float* tile, const f32x4 (&v)[2]) {
    const int r = F.tid >> 4, c4 = F.tid & 15;
#pragma unroll
    for (int i = 0; i < 2; ++i)
#pragma unroll
        for (int e = 0; e < 4; ++e) tile[(r + 32 * i) * 65 + 4 * c4 + e] = v[i][e];
}
__device__ __forceinline__ void tr_out(const Frame& F, const LAS float* tile, const TrDesc& d) {
    const int n = F.tid >> 3, kq = F.tid & 7;
    float v[8];
#pragma unroll
    for (int j = 0; j < 8; ++j) v[j] = tile[(8 * kq + j) * 65 + n];
    if (d.f8) { u32x2 w; w.x = pk_fp8x4(v[0] * 64.f, v[1] * 64.f, v[2] * 64.f, v[3] * 64.f); w.y = pk_fp8x4(v[4] * 64.f, v[5] * 64.f, v[6] * 64.f, v[7] * 64.f);
        *(u32x2*)((unsigned char*)d.dst + (size_t)(d.drow0 + n) * d.ldd + d.k0 + 8 * kq) = w; return; }
    u32x4 w; w.x = pk_bf16(v[0], v[1]); w.y = pk_bf16(v[2], v[3]); w.z = pk_bf16(v[4], v[5]); w.w = pk_bf16(v[6], v[7]);
    *(u32x4*)(d.dst + (size_t)(d.drow0 + n) * d.ldd + d.k0 + 8 * kq) = w;
}
#define TR_PIPELINE(F, first, stride, count, DESC) do { \
    LAS float* tb0_ = (LAS float*)(F).lds; LAS float* tb1_ = tb0_ + 64 * 65; \
    int it_ = (first); \
    if (it_ < (count)) { TrDesc dc_ = DESC(it_); f32x4 rv_[2]; tr_load(F, dc_, rv_); int par_ = 0; \
        __syncthreads(); \
        for (;;) { LAS float* tb_ = par_ ? tb1_ : tb0_; tr_put(F, tb_, rv_); \
            const int nx_ = it_ + (stride); const bool mo_ = nx_ < (count); TrDesc dn_ = dc_; \
            if (mo_) { dn_ = DESC(nx_); tr_load(F, dn_, rv_); } \
            __syncthreads(); tr_out(F, tb_, dc_); \
            if (!mo_) break; dc_ = dn_; it_ = nx_; par_ ^= 1; } \
        __syncthreads(); } } while (0)

enum { I_X = 0, I_C, I_CTX, I_CCTX, I_WADA, I_BADA, I_GMIX, I_GFFN, I_WIN, I_WOUT, I_ACW, I_ACB, I_AWR, I_ABR, I_AWI, I_ABI, I_ALAM,
       I_LQ1, I_LK1, I_LQ2, I_LK2, I_SUBG, I_CCW, I_CCB, I_CLG, I_CLB, I_CWPW, I_CBPW, I_DCW, I_DCB, I_DWF1, I_DBF1, I_DFREQ, I_DWF2, I_DBF2, I_DWF3,
       I_DDECAY, I_DBIAS, I_WRG, I_BRG, I_WRE, I_BRE, I_WGATE, I_WUP, I_WDOWN, I_GFINAL };

__device__ __forceinline__ void p0_mods_item(const Frame& F, const int it) {
    LAS float* sS = (LAS float*)F.lds;
    LAS float* red = sS + 33 * 512;
    static_assert((33 * 512 + 8 * 33 * 64) * 4 <= LDS_BARW, "p0_mods LDS");
    const float* c = F.in(I_C); const float* cc = F.in(I_CCTX);
    {
        const int l = it / 96, col0 = (it % 96) * 64;
        const float* W = F.in(I_WADA) + (size_t)l * D * (NMOD * D);
        const int cq = F.tid & 31, ks = F.tid >> 5;
        float acc[33][2];
#pragma unroll
        for (int b = 0; b < 33; ++b) { acc[b][0] = 0.f; acc[b][1] = 0.f; }
        for (int kh = 0; kh < 2; ++kh) {
            __syncthreads();
            {   float cv[33];
                const int k = kh * 512 + F.tid;
#pragma unroll
                for (int b = 0; b < 33; ++b) cv[b] = (b < 32) ? c[b * 1024 + k] : cc[k];
                __builtin_amdgcn_sched_barrier(0);
#pragma unroll
                for (int b = 0; b < 33; ++b) sS[b * 512 + F.tid] = silu_f(cv[b]); }
            __syncthreads();
#pragma unroll 1
            for (int kb = 0; kb < 32; kb += 8) {
                f32x2 wv[8];
#pragma unroll
                for (int u = 0; u < 8; ++u) wv[u] = *(const f32x2*)(W + (size_t)(kh * 512 + ks * 32 + kb + u) * (NMOD * D) + col0 + 2 * cq);
#pragma unroll
                for (int b = 0; b < 33; ++b) { const f32x4 s0 = *(const LAS f32x4*)(sS + b * 512 + ks * 32 + kb), s1 = *(const LAS f32x4*)(sS + b * 512 + ks * 32 + kb + 4);
                    const float sv[8] = {s0[0], s0[1], s0[2], s0[3], s1[0], s1[1], s1[2], s1[3]};
#pragma unroll
                    for (int u = 0; u < 8; ++u) { acc[b][0] += sv[u] * wv[u][0]; acc[b][1] += sv[u] * wv[u][1]; } }
            }
        }
#pragma unroll
        for (int b = 0; b < 33; ++b) { acc[b][0] += __shfl_xor(acc[b][0], 32); acc[b][1] += __shfl_xor(acc[b][1], 32); }
        if (F.lane < 32) {
#pragma unroll
            for (int b = 0; b < 33; ++b) { red[(F.wave * 33 + b) * 64 + 2 * cq] = acc[b][0]; red[(F.wave * 33 + b) * 64 + 2 * cq + 1] = acc[b][1]; }
        }
        __syncthreads();
        float* mod = (float*)(F.ws_() + WS_MOD) + (size_t)l * 33 * (NMOD * D);
        const float* bada = F.in(I_BADA) + (size_t)l * (NMOD * D);
        for (int o = F.tid; o < 33 * 64; o += NTHREADS) { const int b = o >> 6, cl = o & 63; float s = 0.f;
#pragma unroll
            for (int w = 0; w < 8; ++w) s += red[(w * 33 + b) * 64 + cl];
            mod[(size_t)b * (NMOD * D) + col0 + cl] = s + bada[col0 + cl]; }
        __syncthreads();
    }
}

__device__ __forceinline__ void p0_rope(const Frame& F) {
    float* ct = (float*)(F.ws_() + WS_ROPE); float* st = ct + 2048 * 16;
    for (int i = F.bid * NTHREADS + F.tid; i < 2048 * 16; i += F.G * NTHREADS) {
        const int t = i >> 4, f = i & 15; const float inv = powf(10000.0f, -(float)(f & 7) / 8.0f);
        const float pos = (f < 8) ? (float)(t >> 6) : (float)(t & 63); const float a = pos * inv;
        ct[i] = cosf(a); st[i] = sinf(a);
    }
}

__device__ __forceinline__ TrDesc p0_tr_desc(const Frame& F, int it) {
    constexpr int N1 = 2560, N2 = N1 + 1024, N3 = N2 + 64, N4 = N3 + 128;
    TrDesc d;
    if (it >= N4) { const int j = it - N4, l = j / 320, r = j % 320, kt = r / 20, nt = r % 20;
        d = TrDesc{F.in(I_WIN) + (size_t)l * D * DIN, DIN, kt * 64, 512 + nt * 64, (bf16_t*)(F.ws_() + WS_WIN8 + (size_t)l * 1280 * 1024), 1024, nt * 64, 1}; return d; }
    if (it < N1) { const int l = it / 640, r = it % 640, kt = r / 40, nt = r % 40;
        const int n0 = nt * 64, pr = n0 < 512 ? n0 + 1280 : (n0 < 1792 ? n0 - 512 : n0);
        d = TrDesc{F.in(I_WIN) + (size_t)l * D * DIN, DIN, kt * 64, n0, (bf16_t*)(F.ws_() + WS_WINT) + (size_t)l * DIN * D, D, pr, 0}; }
    else if (it < N2) { const int j = it - N1, l = j / 256, r = j % 256, kt = r / 16, nt = r % 16;
        d = TrDesc{F.in(I_WOUT) + (size_t)l * D * D, D, kt * 64, nt * 64, (bf16_t*)(F.ws_() + WS_WOUTT) + (size_t)l * D * D, D, nt * 64, 0}; }
    else if (it < N3) { const int j = it - N2, l = j / 16, r = j % 16, kt = r / 4, nt = r % 4;
        d = TrDesc{F.in(I_CWPW) + (size_t)l * 256 * 256, 256, kt * 64, nt * 64, (bf16_t*)(F.ws_() + WS_CPW) + (size_t)l * 256 * 256, 256, nt * 64, 0}; }
    else { const int j = it - N3, gate = j / 64, m = j % 64;
        const int l = m / 8, dir = (m / 4) & 1, hd = m & 3;
        d = TrDesc{F.in(gate ? I_AWI : I_AWR) + (size_t)m * 4096, 64, 0, 0, (bf16_t*)(F.ws_() + WS_LRUW) + ((size_t)((l * 2 + dir) * 2 + gate) * 4 + hd) * 4096, 64, 0, 0}; }
    return d;
}
__device__ __forceinline__ void p0_transposes_chunk(const Frame& F, const int ck) {
#define P0_DESC(i) p0_tr_desc(F, (i))
    TR_PIPELINE(F, ck * 8, 1, ck * 8 + 8, P0_DESC);
#undef P0_DESC
}

__device__ __forceinline__ void p0_filter_item(const Frame& F, const int it) {
    LAS float* feats = (LAS float*)F.lds;
    LAS float* f1 = feats + 32 * 33;
    LAS float* f2 = f1 + 32 * 64;
    LAS float* tun = f2 + 32 * 64;
    {
        const int l = it / 72, ch = it % 72; const bool isc = ch >= 64; const int Lf = isc ? LC : SEQ; const int t0 = isc ? (ch - 64) * 32 : ch * 32;
        const float* wf1 = F.in(I_DWF1) + (size_t)l * 33 * 64; const float* bf1 = F.in(I_DBF1) + l * 64; const float* frq = F.in(I_DFREQ) + l * 64;
        const float* wf2 = F.in(I_DWF2) + (size_t)l * 64 * 64; const float* bf2 = F.in(I_DBF2) + l * 64;
        const float* wf3 = F.in(I_DWF3) + (size_t)l * 64 * 1024; const float* dec = F.in(I_DDECAY) + l * 1024;
        __syncthreads();
        for (int i = F.tid; i < 32 * 33; i += NTHREADS) { const int p = i / 33, f = i % 33; const float t = (float)(t0 + p);
            float v;
            if (f == 0) v = t / (float)(Lf - 1);
            else { const int bi = (f - 1) & 15; const float band = 1e-4f + (float)bi * ((15.0f - 1e-4f) / 15.0f);
                   const float ang = (6.283185307179586f / (float)Lf) * t * band; v = (f <= 16) ? cosf(ang) : -sinf(ang); }
            feats[i] = v; if (f == 0) tun[p] = v; }
        __syncthreads();
        for (int i = F.tid; i < 32 * 64; i += NTHREADS) { const int p = i >> 6, j = i & 63; float s = bf1[j];
            for (int f = 0; f < 33; ++f) s += feats[p * 33 + f] * wf1[f * 64 + j];
            f1[i] = sinf(frq[j] * s); }
        __syncthreads();
        for (int i = F.tid; i < 32 * 64; i += NTHREADS) { const int p = i >> 6, j = i & 63; float s = bf2[j];
            for (int f = 0; f < 64; ++f) s += f1[p * 64 + f] * wf2[f * 64 + j];
            f2[i] = sinf(frq[j] * s); }
        __syncthreads();
        {   const int c4 = (F.tid & 255) * 4, pg = F.tid >> 8;
            const f32x4 dc = *(const f32x4*)(dec + c4);
            float acc[16][4];
#pragma unroll
            for (int p = 0; p < 16; ++p) { acc[p][0] = 0.f; acc[p][1] = 0.f; acc[p][2] = 0.f; acc[p][3] = 0.f; }
#pragma unroll 2
            for (int k = 0; k < 64; ++k) { const f32x4 w = *(const f32x4*)(wf3 + (size_t)k * 1024 + c4);
#pragma unroll
                for (int p = 0; p < 16; ++p) { const float a = f2[(pg * 16 + p) * 64 + k]; acc[p][0] += a * w[0]; acc[p][1] += a * w[1]; acc[p][2] += a * w[2]; acc[p][3] += a * w[3]; } }
#pragma unroll
            for (int p = 0; p < 16; ++p) { const float tu = tun[pg * 16 + p];
#pragma unroll
                for (int e = 0; e < 4; ++e) acc[p][e] *= expf(-tu * fabsf(dc[e])); }
            float* rawt = (float*)(F.ws_() + WS_FRAW) + (size_t)l * 2304 * 1024 + (isc ? (size_t)1024 * 2048 : 0);
#pragma unroll
            for (int e = 0; e < 4; ++e) { float* dst = rawt + (size_t)(c4 + e) * Lf + t0 + pg * 16;
#pragma unroll
                for (int q = 0; q < 4; ++q) *(f32x4*)(dst + 4 * q) = (f32x4){acc[4 * q][e], acc[4 * q + 1][e], acc[4 * q + 2][e], acc[4 * q + 3][e]}; }
        }
    }
}

__device__ __forceinline__ void p0_xc_chunk(const Frame& F, const int ck) {
    u32x4* d = (u32x4*)(F.ws_() + WS_XB);
    const size_t nl8 = (size_t)TL * D / 8, base = (size_t)ck * 128 * D / 8;
#pragma unroll 2
    for (int q0 = 0; q0 < 32; q0 += 4) {
        f32x4 a[4], c[4];
#pragma unroll
        for (int u = 0; u < 4; ++u) { const size_t i = base + (size_t)(q0 + u) * NTHREADS + F.tid; const f32x4* sp = (i < nl8) ? (const f32x4*)F.in(I_X) + 2 * i : (const f32x4*)F.in(I_CTX) + 2 * (i - nl8); a[u] = __builtin_nontemporal_load(sp); c[u] = __builtin_nontemporal_load(sp + 1); }
#pragma unroll
        for (int u = 0; u < 4; ++u) { const size_t i = base + (size_t)(q0 + u) * NTHREADS + F.tid; d[i] = (u32x4){pk_bf16(a[u][0], a[u][1]), pk_bf16(a[u][2], a[u][3]), pk_bf16(c[u][0], c[u][1]), pk_bf16(c[u][2], c[u][3])}; }
    }
}

__device__ __forceinline__ void p0_gr(const Frame& F) {
    LAS float* red = (LAS float*)F.lds;
    for (int it = F.bid; it < 2048 + 256; it += F.G) {
        const bool isc = it >= 2048; const int Lf = isc ? LC : SEQ;
        const int row = isc ? (it - 2048) * 8 + F.wave : it;
        const int c = row & 255, o = (row >> 8) & 1, l = row >> 9;
        const float* rawt = (const float*)(F.ws_() + WS_FRAW) + (size_t)l * 2304 * 1024 + (isc ? (size_t)1024 * 2048 : 0);
        const float* fw = rawt + (size_t)((2 * o) * 256 + c) * Lf; const float* bw = rawt + (size_t)((2 * o + 1) * 256 + c) * Lf;
        const int x0 = 8 * (isc ? F.lane : F.tid);
        float v[8]; float es = 0.f;
#pragma unroll
        for (int j = 0; j < 8; ++j) { const int x = x0 + j; v[j] = (x == 0) ? 0.f : (x <= Lf ? fw[Lf - x] : bw[x - Lf]); es += v[j] * v[j]; }
        es = wave_sum(es);
        if (!isc) { __syncthreads(); if (F.lane == 0) red[F.wave] = es; __syncthreads(); es = ((red[0] + red[1]) + (red[2] + red[3])) + ((red[4] + red[5]) + (red[6] + red[7])); }
        const float sc = rsqrtf(es + EPS);
        const float bias = F.in(I_DBIAS)[(size_t)l * 512 + o * 256 + c];
#pragma unroll
        for (int j = 0; j < 8; ++j) { v[j] *= sc; if (x0 + j == Lf) v[j] += bias; }
        bf16_t* G = isc ? (bf16_t*)(F.ws_() + WS_GRC) + (size_t)row * 512 : (bf16_t*)(F.ws_() + WS_GR) + (size_t)row * 4096;
        *(bf16x8*)(G + x0) = pk8(v);
    }
}

__device__ __forceinline__ void p0_rtab(const Frame& F) {
    for (int it = F.bid; it < 4 * 33; it += F.G) {
        const int l = it / 33, b = it % 33;
        const float* mod = (const float*)(F.ws_() + WS_MOD) + ((size_t)l * 33 + b) * (NMOD * D);
        const float* sh = mod + 3 * D; const float* sc = mod + 4 * D; const float* gn = F.in(I_GFFN) + (size_t)l * D;
        float* GG = (float*)(F.ws_() + WS_GG) + ((size_t)l * 33 + b) * D; float* RB = (float*)(F.ws_() + WS_RB) + ((size_t)l * 33 + b) * 48;
        for (int k = F.tid; k < D; k += NTHREADS) GG[k] = gn[k] * (1.0f + sc[k]);
        const float* wrg = F.in(I_WRG) + (size_t)l * D * 4; const float* wre = F.in(I_WRE) + (size_t)l * D * 32;
        for (int j = F.wave; j < 48; j += 8) {
            float s = 0.f;
            if (j < 36) { for (int k = F.lane; k < D; k += 64) s += sh[k] * (j < 32 ? wre[(size_t)k * 32 + j] : wrg[(size_t)k * 4 + (j - 32)]); }
            s = wave_sum(s);
            if (F.lane == 0) RB[j] = (j < 32) ? s + F.in(I_BRE)[l * 32 + j] : (j < 36 ? s + F.in(I_BRG)[l * 4 + (j - 32)] : 0.f);
        }
    }
}

template <int MODE>
__device__ __forceinline__ void row_norm_phase(const Frame& F, int l, int lprev, bool from_input) {
    const bool addmoe = (lprev >= 0);
    const float* modp = (const float*)(F.ws_() + WS_MOD) + (size_t)l * 33 * (NMOD * D);
    const float* modm = (const float*)(F.ws_() + WS_MOD) + (size_t)(lprev >= 0 ? lprev : 0) * 33 * (NMOD * D) + 5 * D;
    const float* gn = (MODE == 2) ? F.in(I_GFINAL) : F.in(I_GMIX) + (size_t)l * D;
    LAS int* rb = (LAS int*)(F.lds + 131072);
    if (addmoe) {
        if (F.tid == 0) { const unsigned* cnt = F.ctl + CW_CNT + lprev * 32; int acc = 0; for (int e = 0; e < 32; ++e) { rb[e] = acc; acc += ((int)cnt[e] + 255) / 256 * 256; } }
        __syncthreads();
    }
    const int nrows = (MODE == 2) ? TL : TT;
    const int RPB = (nrows + F.G - 1) / F.G, rbeg = F.bid * RPB, rend = (rbeg + RPB < nrows) ? rbeg + RPB : nrows;
    const unsigned char* O = F.ws_() + WS_O;
    const i32x4* tokinf = (const i32x4*)(F.ws_() + WS_TOKINF);
    const int lo4 = 4 * F.lane;
    f32x4 gq[4];
#pragma unroll
    for (int i = 0; i < 4; ++i) gq[i] = *(const f32x4*)(gn + i * 256 + lo4);
    f32x4 gmq[4], shq[4], scq[4]; int curb = -1;
#pragma unroll
    for (int i = 0; i < 4; ++i) { gmq[i] = (f32x4){0.f, 0.f, 0.f, 0.f}; shq[i] = gmq[i]; scq[i] = gmq[i]; }
    u32x2 xa[4]; unsigned oa[4], oc[4]; i32x4 tin = (i32x4){0, 0, 0, 0};
    bf16_t* XB = (bf16_t*)(F.ws_() + WS_XB);
#define RN_LOADX(r) do { const bf16_t* xp_ = XB + (size_t)(r) * D; _Pragma("unroll") for (int i = 0; i < 4; ++i) xa[i] = *(const u32x2*)(xp_ + i * 256 + lo4); } while (0)
#define RN_LOADO(ti_) do { const size_t r0_ = (size_t)(rb[(ti_).x] + (ti_).y), r1_ = (size_t)(rb[(ti_).z] + (ti_).w); \
        _Pragma("unroll") for (int i = 0; i < 4; ++i) { oa[i] = __builtin_nontemporal_load((const unsigned*)(O + r0_ * D + i * 256 + lo4)); oc[i] = __builtin_nontemporal_load((const unsigned*)(O + r1_ * D + i * 256 + lo4)); } } while (0)
    int row = rbeg + F.wave;
    if (row < rend) { RN_LOADX(row); if (addmoe) { const i32x4 t0 = tokinf[row]; RN_LOADO(t0); if (row + 8 < rend) tin = tokinf[row + 8]; } }
    for (; row < rend; row += 8) {
        f32x4 v[4]; unsigned a[4], c[4];
#pragma unroll
        for (int i = 0; i < 4; ++i) { v[i] = (f32x4){bflo(xa[i].x), bfhi(xa[i].x), bflo(xa[i].y), bfhi(xa[i].y)}; a[i] = oa[i]; c[i] = oc[i]; }
        if (row + 8 < rend) { RN_LOADX(row + 8); if (addmoe) { const i32x4 t1 = tin; RN_LOADO(t1); if (row + 16 < rend) tin = tokinf[row + 16]; } }
        const bool isc = row >= TL; const int b = isc ? 32 : (row >> 11);
        if (b != curb) { curb = b;
            if (addmoe) { const float* gm = modm + (size_t)b * (NMOD * D);
#pragma unroll
                for (int i = 0; i < 4; ++i) gmq[i] = *(const f32x4*)(gm + i * 256 + lo4); }
            if (MODE != 2) { const float* sh = modp + (size_t)b * (NMOD * D);
#pragma unroll
                for (int i = 0; i < 4; ++i) { shq[i] = *(const f32x4*)(sh + i * 256 + lo4); scq[i] = *(const f32x4*)(sh + D + i * 256 + lo4); } }
        }
        if (addmoe) {
#pragma unroll
            for (int i = 0; i < 4; ++i) { const int ai_ = (int)a[i], ci_ = (int)c[i];
                v[i][0] += gmq[i][0] * 0.0625f * (__builtin_amdgcn_cvt_f32_fp8(ai_, 0) + __builtin_amdgcn_cvt_f32_fp8(ci_, 0)); v[i][1] += gmq[i][1] * 0.0625f * (__builtin_amdgcn_cvt_f32_fp8(ai_, 1) + __builtin_amdgcn_cvt_f32_fp8(ci_, 1));
                v[i][2] += gmq[i][2] * 0.0625f * (__builtin_amdgcn_cvt_f32_fp8(ai_, 2) + __builtin_amdgcn_cvt_f32_fp8(ci_, 2)); v[i][3] += gmq[i][3] * 0.0625f * (__builtin_amdgcn_cvt_f32_fp8(ai_, 3) + __builtin_amdgcn_cvt_f32_fp8(ci_, 3)); }
            if (MODE != 2) { bf16_t* xw = XB + (size_t)row * D;
#pragma unroll
                for (int i = 0; i < 4; ++i) { u32x2 w; w.x = pk_bf16(v[i][0], v[i][1]); w.y = pk_bf16(v[i][2], v[i][3]); *(u32x2*)(xw + i * 256 + lo4) = w; }
            }
        }
        float ss = 0.f;
#pragma unroll
        for (int i = 0; i < 4; ++i) ss += v[i][0] * v[i][0] + v[i][1] * v[i][1] + v[i][2] * v[i][2] + v[i][3] * v[i][3];
        ss = wave_sum(ss);
        const float rstd = rsqrtf(ss * (1.0f / D) + EPS);
        if (MODE == 2) { float* xr = F.out() + (size_t)row * D;
#pragma unroll
            for (int i = 0; i < 4; ++i) { f32x4 o;
#pragma unroll
                for (int e = 0; e < 4; ++e) o[e] = v[i][e] * rstd * gq[i][e];
                *(f32x4*)(xr + i * 256 + lo4) = o; }
        } else {
            bf16_t* hrow = (bf16_t*)(F.ws_() + WS_H) + (size_t)row * D; unsigned char* h8 = F.ws_() + WS_H8 + (size_t)row * D;
#pragma unroll
            for (int i = 0; i < 4; ++i) { float o[4];
#pragma unroll
                for (int e = 0; e < 4; ++e) o[e] = v[i][e] * rstd * gq[i][e] * (1.0f + scq[i][e]) + shq[i][e];
                u32x2 w; w.x = pk_bf16(o[0], o[1]); w.y = pk_bf16(o[2], o[3]); *(u32x2*)(hrow + i * 256 + lo4) = w;
                *(unsigned*)(h8 + i * 256 + lo4) = pk_fp8x4(o[0], o[1], o[2], o[3]); }
        }
    }
#undef RN_LOADX
#undef RN_LOADO
}

__device__ __forceinline__ TrDesc moe_tr_desc(const Frame& F, int l, int it) {
    TrDesc d;
    if (it < 8192) { const int up = it >= 4096, j = it & 4095, e = j >> 7, r = j & 127, kt = r >> 3, nt = r & 7;
        const int n0 = nt * 64, drow0 = (n0 >> 7) * 256 + (up ? 128 : 0) + (n0 & 127) - n0;
        d = TrDesc{F.in(up ? I_WUP : I_WGATE) + ((size_t)l * 32 + e) * D * DEXP, DEXP, kt * 64, n0, (bf16_t*)(F.ws_() + WS_MOEGU + (size_t)e * 1024 * 1024), 1024, drow0 + n0, 1}; }
    else { const int j = it - 8192, e = j >> 7, r = j & 127, kt = r >> 4, nt = r & 15;
        d = TrDesc{F.in(I_WDOWN) + ((size_t)l * 32 + e) * DEXP * D, D, kt * 64, nt * 64, (bf16_t*)(F.ws_() + WS_MOEDN + (size_t)e * 1024 * 512), 512, nt * 64, 1}; }
    return d;
}
constexpr int MOE_TILES_P1 = 2048, MOE_CH_Q0 = 640, MOE_CH_Q1 = 640;
static_assert(MOE_TILES_P1 % 8 == 0 && MOE_TILES_P1 + 8 * (MOE_CH_Q0 + MOE_CH_Q1) == 12288, "MoE weight tiles");
__device__ __forceinline__ void moe_weight_cvt(const Frame& F, int l) {
#define MOE_DESC(i) moe_tr_desc(F, l, (i))
    TR_PIPELINE(F, F.bid, F.G, MOE_TILES_P1, MOE_DESC);
#undef MOE_DESC
}
__device__ __forceinline__ void moe_weight_cvt_queue(const Frame& F, int l, int q) {
#define MOE_DESC(i) moe_tr_desc(F, l, (i))
    const int base = MOE_TILES_P1 / 8 + (q ? MOE_CH_Q0 : 0), n = q ? MOE_CH_Q1 : MOE_CH_Q0;
    LAS int* qslot = (LAS int*)(F.lds + LDS_BARW - 16);
    for (;;) {
        __syncthreads();
        if (F.tid == 0) *qslot = (int)__hip_atomic_fetch_add(F.ctl + CW_MQ + l * 2 + q, 1u, __ATOMIC_RELAXED, __HIP_MEMORY_SCOPE_AGENT);
        __syncthreads();
        const int ck = *qslot;
        if (ck >= n) break;
        TR_PIPELINE(F, (base + ck) * 8, 1, (base + ck) * 8 + 8, MOE_DESC);
    }
#undef MOE_DESC
}

__device__ __forceinline__ void hy_pre(const Frame& F, int l, bool do_ctx) {
    constexpr int BST = 1154;
    static_assert(32 * BST * 2 <= LDS_BARW, "hy_pre LDS");
    LAS bf16_t* raw = (LAS bf16_t*)F.lds;
    const bf16_t* P = (const bf16_t*)(F.ws_() + WS_P);
    const float* cw = F.in(I_DCW) + (size_t)l * 3 * 768; const float* cb = F.in(I_DCB) + (size_t)l * 768;
    const int nlat = 128 * 12, nitems = nlat + (do_ctx ? 16 * 12 : 0);
    __syncthreads();
    for (int it = F.bid; it < nitems; it += F.G) {
        const bool isc = it >= nlat; const int jj = isc ? it - nlat : it; const int sblk = jj / 12, cgp = jj % 12;
        const int Lseg = isc ? LC : SEQ; const size_t tokbase = isc ? TL : 0;
        {   u32x4 vv[9];
#pragma unroll
            for (int j = 0; j < 9; ++j) { const int pc = F.tid + j * NTHREADS; const int b = pc / 144, r = (pc % 144) >> 3, q = pc & 7; const int t = sblk * 16 + r - 1;
                const int tc = (t >= 0 && t < Lseg) ? t : 0;
                vv[j] = __builtin_nontemporal_load((const u32x4*)(P + (tokbase + (size_t)b * Lseg + tc) * DIN + OFF_D + cgp * 64 + q * 8)); }
            __builtin_amdgcn_sched_barrier(0);
#pragma unroll
            for (int j = 0; j < 9; ++j) { const int pc = F.tid + j * NTHREADS; const int b = pc / 144, r = (pc % 144) >> 3, q = pc & 7; const int t = sblk * 16 + r - 1;
                const bool ok = t >= 0 && t < Lseg; const u32x4 v = vv[j];
                LAS unsigned* dst = (LAS unsigned*)(raw + b * BST + r * 64 + q * 8);
                dst[0] = ok ? v.x : 0u; dst[1] = ok ? v.y : 0u; dst[2] = ok ? v.z : 0u; dst[3] = ok ? v.w : 0u; }
        }
        __syncthreads();
        const int b = F.tid & 31, cs = F.tid >> 5;
        bf16_t* UF = (bf16_t*)(F.ws_() + WS_UF) + (isc ? (size_t)768 * 65536 : 0);
        const size_t chs = isc ? 8192 : 65536;
#pragma unroll 1
        for (int i = 0; i < 4; ++i) {
            const int chl = cs * 4 + i, ch = cgp * 64 + chl;
            const float w0 = cw[ch], w1 = cw[768 + ch], w2 = cw[1536 + ch], bb = cb[ch];
#pragma unroll
            for (int hh = 0; hh < 2; ++hh) {
                float x[10];
#pragma unroll
                for (int q = 0; q < 10; ++q) x[q] = bf2f(raw[b * BST + (8 * hh + q) * 64 + chl]);
                float u[8];
#pragma unroll
                for (int j = 0; j < 8; ++j) u[j] = bb + w0 * x[j] + w1 * x[j + 1] + w2 * x[j + 2];
                u32x4 w; w.x = pk_bf16(u[0], u[1]); w.y = pk_bf16(u[2], u[3]); w.z = pk_bf16(u[4], u[5]); w.w = pk_bf16(u[6], u[7]);
                *(u32x4*)(UF + (size_t)ch * chs + (((size_t)sblk * 2 + hh) * 32 + b) * 8) = w;
            }
        }
        __syncthreads();
    }
}

template <int ORDER>
__device__ __forceinline__ void hy_conv(const Frame& F, int l, bool do_ctx) {
    LAS bf16_t* Gl = (LAS bf16_t*)F.lds + F.wave * 4096;
    LAS bf16_t* stg = (LAS bf16_t*)(F.lds + 65536 + 1024);
    const int lane = F.lane, i31 = lane & 31, hh = lane >> 5;
    const int nlat = 256, nitems = nlat + (do_ctx ? 32 : 0);
    const bf16_t* UF0 = (const bf16_t*)(F.ws_() + WS_UF); bf16_t* Z10 = (bf16_t*)(F.ws_() + WS_Z1F);
    for (int it = F.vcu; it < nitems; it += F.G) {
        const bool isc = it >= nlat; const int cg = isc ? it - nlat : (it >> 3), tg = isc ? 0 : (it & 7);
        const int Lf = isc ? LC : SEQ; const int c = cg * 8 + F.wave;
        const bf16_t* Gg = isc ? (const bf16_t*)(F.ws_() + WS_GRC) + ((size_t)(l * 2 + ORDER) * 256 + c) * 512
                               : (const bf16_t*)(F.ws_() + WS_GR) + ((size_t)(l * 2 + ORDER) * 256 + c) * 4096;
        {   u32x4 gq[8];
#pragma unroll
            for (int i = 0; i < 8; ++i) { const int q = isc ? lane : lane + 64 * i; gq[i] = *(const u32x4*)(Gg + q * 8); }
#pragma unroll
            for (int i = 0; i < 8; ++i) { const int q = isc ? lane : lane + 64 * i; *(LAS u32x4*)(Gl + q * 8) = gq[i]; } }
        const size_t chs = isc ? 8192 : 65536;
        const bf16_t* UFb = UF0 + (isc ? (size_t)768 * 65536 : 0); bf16_t* Z1b = Z10 + (isc ? (size_t)256 * 65536 : 0);
        const bf16_t* zsrc = (ORDER == 0) ? UFb + (size_t)c * chs : Z1b + (size_t)c * chs;
        const bf16_t* gsrc = UFb + (size_t)(256 * (ORDER + 1) + c) * chs;
        const int t0 = tg * 256;
        f32x16 acc[8];
#pragma unroll
        for (int a = 0; a < 8; ++a)
#pragma unroll
            for (int r = 0; r < 16; ++r) acc[a][r] = 0.f;
        bf16x8 FR[8][2];
#define HY_FRAG(dst, xb) do { const LAS bf16_t* _g = Gl + (xb); _Pragma("unroll") for (int _j = 0; _j < 8; ++_j) dst[_j] = (short)_g[_j]; } while (0)
        const int xb0 = Lf - t0 - i31 + 8 * hh;
#pragma unroll
        for (int a = 0; a < 8; ++a)
#pragma unroll
            for (int ks = 0; ks < 2; ++ks) HY_FRAG(FR[a][ks], xb0 - 32 * a + 16 * ks);
        const int nkp = Lf / 32;
        bf16x8 Bn[2];
        const char* zp = (const char*)zsrc + hh * 512 + i31 * 16;
#define HY_BLOAD(dst, sq) do { _Pragma("unroll") for (int ks = 0; ks < 2; ++ks) dst[ks] = *(const bf16x8*)(zp + (size_t)(sq) * 64 + ks * 1024); } while (0)
        constexpr bool DEEP = (ORDER == 0);
        bf16x8 Bm[2];
        HY_BLOAD(Bn, 0); if (DEEP) HY_BLOAD(Bm, 32);
        for (int nb = 0; nb < nkp; nb += 8) {
#pragma unroll
            for (int u = 0; u < 8; ++u) {
                const int s0 = (nb + u) * 32;
                bf16x8 Bf[2];
                if (DEEP) {
#pragma unroll
                    for (int ks = 0; ks < 2; ++ks) { Bf[ks] = Bn[ks]; Bn[ks] = Bm[ks]; }
                    HY_BLOAD(Bm, s0 + 64);
                } else {
#pragma unroll
                    for (int ks = 0; ks < 2; ++ks) Bf[ks] = Bn[ks];
                    HY_BLOAD(Bn, s0 + 32);
                }
                __builtin_amdgcn_sched_barrier(0);
#pragma unroll
                for (int a = 7; a >= 0; --a)
#pragma unroll
                    for (int ks = 0; ks < 2; ++ks) acc[a] = MFMA32(FR[(a - u) & 7][ks], Bf[ks], acc[a]);
#pragma unroll
                for (int ks = 0; ks < 2; ++ks) HY_FRAG(FR[(7 - u) & 7][ks], xb0 + s0 + 32 + 16 * ks);
            }
        }
#undef HY_FRAG
#undef HY_BLOAD
        if (ORDER == 0) {
#pragma unroll
            for (int a = 0; a < 8; ++a)
#pragma unroll
                for (int rg = 0; rg < 4; ++rg) {
                    const size_t off = ((size_t)(((t0 >> 4) + 2 * a + (rg >> 1)) * 2 + (rg & 1)) * 32 + i31) * 8 + 4 * hh;
                    const u32x2 g = *(const u32x2*)(gsrc + off);
                    u32x2 w; w.x = pk_bf16(bflo(g.x) * acc[a][4 * rg], bfhi(g.x) * acc[a][4 * rg + 1]); w.y = pk_bf16(bflo(g.y) * acc[a][4 * rg + 2], bfhi(g.y) * acc[a][4 * rg + 3]);
                    *(u32x2*)(Z1b + (size_t)c * chs + off) = w;
                }
        } else {
            bf16_t* Y = (bf16_t*)(F.ws_() + WS_Y);
            const size_t tokbase = isc ? TL : 0;
#pragma unroll
            for (int a = 0; a < 8; ++a) {
                __syncthreads();
#pragma unroll
                for (int rg = 0; rg < 4; ++rg) {
                    const size_t off = ((size_t)(((t0 >> 4) + 2 * a + (rg >> 1)) * 2 + (rg & 1)) * 32 + i31) * 8 + 4 * hh;
                    const u32x2 g = *(const u32x2*)(gsrc + off);
                    float gv[4] = {bflo(g.x), bfhi(g.x), bflo(g.y), bfhi(g.y)};
#pragma unroll
                    for (int e = 0; e < 4; ++e) { const int tl = 8 * rg + 4 * hh + e; stg[(tl * 32 + i31) * 8 + F.wave] = (bf16_t)(pk_bf16(gv[e] * acc[a][4 * rg + e], 0.f) & 0xffffu); }
                }
                __syncthreads();
#pragma unroll
                for (int q = 0; q < 2; ++q) { const int pr = F.tid + q * NTHREADS, tl = pr >> 5, b = pr & 31;
                    const u32x4 v = *(const LAS u32x4*)(stg + pr * 8);
                    *(u32x4*)(Y + (tokbase + (size_t)b * Lf + t0 + 32 * a + tl) * D + 768 + cg * 8) = v; }
            }
            __syncthreads();
        }
    }
}

constexpr int LR_XR = 0;
constexpr int LR_UB = 17408;
constexpr int LR_WT = LR_UB + 18432;
constexpr int LR_A  = LR_WT + 18432;
constexpr int LR_B  = LR_A + 32768;
constexpr int LR_WS = LR_B + 32768;
static_assert(LR_WS + 4096 <= LDS_BARW, "LRU LDS");

__device__ __forceinline__ void lru_chunk_ab(const Frame& F, int l, int b, int hd, int dir, bool isc, int t_lo) {
    LAS bf16_t* xr = (LAS bf16_t*)(F.lds + LR_XR); LAS bf16_t* ub = (LAS bf16_t*)(F.lds + LR_UB); LAS bf16_t* wt = (LAS bf16_t*)(F.lds + LR_WT);
    LAS float* a_s = (LAS float*)(F.lds + LR_A); LAS float* b_s = (LAS float*)(F.lds + LR_B);
    const bf16_t* P = (const bf16_t*)(F.ws_() + WS_P);
    const int Lseg = isc ? LC : SEQ; const size_t tokbase = (isc ? (size_t)TL : 0) + (size_t)b * Lseg;
    __syncthreads();
    for (int pc = F.tid; pc < 134 * 8; pc += NTHREADS) { const int r = pc >> 3, q = pc & 7; const int t = t_lo - 3 + r;
        u32x4 v = (u32x4){0u, 0u, 0u, 0u};
        if (t >= 0 && t < Lseg) v = *(const u32x4*)(P + (tokbase + t) * DIN + OFF_A + hd * 64 + q * 8);
        *(LAS u32x4*)(xr + r * 64 + q * 8) = v; }
    {   const bf16_t* W = (const bf16_t*)(F.ws_() + WS_LRUW) + (size_t)(l * 2 + dir) * 2 * 4 * 4096;
        for (int pc = F.tid; pc < 2 * 64 * 8; pc += NTHREADS) { const int g = pc >> 9, n = (pc >> 3) & 63, q = pc & 7;
            *(LAS u32x4*)(wt + (g * 64 + n) * 72 + q * 8) = *(const u32x4*)(W + ((size_t)(g * 4 + hd) * 64 + n) * 64 + q * 8); } }
    __syncthreads();
    {
        const int ch = F.tid & 63, tq = F.tid >> 6; const int chg = hd * 64 + ch;
        const float* cw = F.in(I_ACW) + ((size_t)(l * 2 + dir) * 4) * 256 + chg; const float cb = F.in(I_ACB)[(size_t)(l * 2 + dir) * 256 + chg];
        const float w0 = cw[0], w1 = cw[256], w2 = cw[512], w3 = cw[768];
        const int r0 = tq * 16 + (dir ? 3 : 0);
        float x[19];
#pragma unroll
        for (int q = 0; q < 19; ++q) x[q] = bf2f(xr[(r0 + q) * 64 + ch]);
#pragma unroll
        for (int k = 0; k < 16; ++k) { const float u = cb + w0 * x[k] + w1 * x[k + 1] + w2 * x[k + 2] + w3 * x[k + 3];
            ub[(tq * 16 + k) * 72 + ch] = (bf16_t)(pk_bf16(u, 0.f) & 0xffffu); }
    }
    __syncthreads();
    {
        const int w = F.wave, lane = F.lane, row = lane & 15, kq = lane >> 4;
        bf16x8 Af[2];
#pragma unroll
        for (int ks = 0; ks < 2; ++ks) Af[ks] = *(const LAS bf16x8*)(ub + (16 * w + row) * 72 + 32 * ks + 8 * kq);
        const float* br = F.in(I_ABR) + (size_t)(l * 2 + dir) * 256 + hd * 64; const float* bi = F.in(I_ABI) + (size_t)(l * 2 + dir) * 256 + hd * 64;
        const float* lam = F.in(I_ALAM) + (size_t)(l * 2 + dir) * 256 + hd * 64;
#pragma unroll
        for (int nt = 0; nt < 4; ++nt) {
            f32x4 cr = (f32x4){0.f, 0.f, 0.f, 0.f}, ci = cr;
#pragma unroll
            for (int ks = 0; ks < 2; ++ks) {
                const bf16x8 Br = *(const LAS bf16x8*)(wt + (0 * 64 + 16 * nt + row) * 72 + 32 * ks + 8 * kq);
                const bf16x8 Bi = *(const LAS bf16x8*)(wt + (1 * 64 + 16 * nt + row) * 72 + 32 * ks + 8 * kq);
                cr = MFMA16(Af[ks], Br, cr); ci = MFMA16(Af[ks], Bi, ci);
            }
            const int ch = 16 * nt + row;
            const float sp = log1pf(__expf(-lam[ch])), brc = br[ch], bic = bi[ch];
#pragma unroll
            for (int r = 0; r < 4; ++r) { const int tl = 16 * w + 4 * kq + r;
                const float rr = sigmoid_f(cr[r] + brc), ii = sigmoid_f(ci[r] + bic);
                const float a = __expf(-8.0f * rr * sp);
                const float uv = bf2f(ub[tl * 72 + ch]);
                a_s[tl * 64 + ch] = a; b_s[tl * 64 + ch] = sqrtf(fmaxf(1.0f - a * a, 0.f)) * (ii * uv); }
        }
    }
    __syncthreads();
}

__device__ __forceinline__ void lru_s1(const Frame& F, int l) {
    LAS float* a_s = (LAS float*)(F.lds + LR_A); LAS float* b_s = (LAS float*)(F.lds + LR_B); LAS float* wsum = (LAS float*)(F.lds + LR_WS);
    float* SUM = (float*)(F.ws_() + WS_LRUS);
    for (int it = F.bid; it < 32 * 4 * 2 * 18; it += F.G) {
        int r = it; const int n = r % 18; r /= 18; const int dir = r & 1; r >>= 1; const int hd = r & 3; const int b = r >> 2;
        const bool isc = n < 2; const int tc = isc ? (dir ? 1 - n : n) : (dir ? 15 - (n - 2) : n - 2);
        lru_chunk_ab(F, l, b, hd, dir, isc, tc * 128);
        const int w = F.wave, ch = F.lane;
        float A = 1.f, Bv = 0.f;
#pragma unroll
        for (int k = 0; k < 16; ++k) { const int tl = dir ? 127 - 16 * w - k : 16 * w + k; const float a = a_s[tl * 64 + ch], bb = b_s[tl * 64 + ch]; Bv = a * Bv + bb; A *= a; }
        wsum[(w * 2 + 0) * 64 + ch] = A; wsum[(w * 2 + 1) * 64 + ch] = Bv;
        __syncthreads();
        if (w == 0) { float At = 1.f, Bt = 0.f;
#pragma unroll
            for (int q = 0; q < 8; ++q) { const float Aq = wsum[(q * 2) * 64 + ch], Bq = wsum[(q * 2 + 1) * 64 + ch]; Bt = Aq * Bt + Bq; At *= Aq; }
            float* dst = SUM + ((size_t)((b * 2 + dir) * 4 + hd) * 18 + n) * 128;
            dst[ch] = At; dst[64 + ch] = Bt; }
    }
}
__device__ __forceinline__ void lru_s2(const Frame& F) {
    const float* SUM = (const float*)(F.ws_() + WS_LRUS); float* CAR = (float*)(F.ws_() + WS_LRUC);
    if (F.wave != 0) return;
    for (int it = F.bid; it < 32 * 2 * 4; it += F.G) {
        float As[18], Bs[18];
#pragma unroll
        for (int n = 0; n < 18; ++n) { const float* s = SUM + ((size_t)it * 18 + n) * 128; As[n] = s[F.lane]; Bs[n] = s[64 + F.lane]; }
        float carry = 0.f;
#pragma unroll
        for (int n = 0; n < 18; ++n) { CAR[((size_t)it * 18 + n) * 64 + F.lane] = carry; carry = As[n] * carry + Bs[n]; }
    }
}
__device__ __forceinline__ void lru_s3(const Frame& F, int l, bool do_ctx) {
    LAS float* a_s = (LAS float*)(F.lds + LR_A); LAS float* b_s = (LAS float*)(F.lds + LR_B); LAS float* wsum = (LAS float*)(F.lds + LR_WS);
    const float* CAR = (const float*)(F.ws_() + WS_LRUC);
    const bf16_t* P = (const bf16_t*)(F.ws_() + WS_P); bf16_t* Y = (bf16_t*)(F.ws_() + WS_Y);
    const int nlat = 32 * 4 * 16, nitems = nlat + (do_ctx ? 32 * 4 * 2 : 0);
    for (int it = F.bid; it < nitems; it += F.G) {
        const bool isc = it >= nlat; int r = isc ? it - nlat : it; const int ntc = isc ? 2 : 16; const int tc = r % ntc; r /= ntc; const int hd = r & 3; const int b = r >> 2;
        const int w = F.wave, ch = F.lane;
        float hs[16];
#pragma unroll
        for (int k = 0; k < 16; ++k) hs[k] = 0.f;
#pragma unroll
        for (int dir = 0; dir < 2; ++dir) {
            lru_chunk_ab(F, l, b, hd, dir, isc, tc * 128);
            const int n = isc ? (dir ? 1 - tc : tc) : 2 + (dir ? 15 - tc : tc);
            float hl[16], ca[16]; float A = 1.f, Bv = 0.f;
#pragma unroll
            for (int kk = 0; kk < 16; ++kk) { const int k = dir ? 15 - kk : kk; const int tl = 16 * w + k; const float a = a_s[tl * 64 + ch], bb = b_s[tl * 64 + ch]; Bv = a * Bv + bb; A *= a; hl[k] = Bv; ca[k] = A; }
            wsum[(w * 2 + 0) * 64 + ch] = A; wsum[(w * 2 + 1) * 64 + ch] = Bv;
            __syncthreads();
            float s = CAR[((size_t)((b * 2 + dir) * 4 + hd) * 18 + n) * 64 + ch];
            const int myord = dir ? 7 - w : w;
#pragma unroll
            for (int q = 0; q < 8; ++q) { const int wq = dir ? 7 - q : q; if (q < myord) s = wsum[(wq * 2) * 64 + ch] * s + wsum[(wq * 2 + 1) * 64 + ch]; }
#pragma unroll
            for (int k = 0; k < 16; ++k) hs[k] += hl[k] + ca[k] * s;
        }
        const int Lseg = isc ? LC : SEQ; const size_t tokbase = (isc ? (size_t)TL : 0) + (size_t)b * Lseg + tc * 128 + 16 * w;
#pragma unroll
        for (int k = 0; k < 16; ++k) { const float xg = bf2f(P[(tokbase + k) * DIN + OFF_A + 256 + hd * 64 + ch]);
            Y[(tokbase + k) * D + hd * 64 + ch] = (bf16_t)(pk_bf16(hs[k] * gelu_tanh_f(xg), 0.f) & 0xffffu); }
    }
}


__device__ __forceinline__ void lru_seq(const Frame& F, int l, bool ctx_out) {
    LAS bf16_t* xr = (LAS bf16_t*)(F.lds + LR_XR); LAS bf16_t* ub = (LAS bf16_t*)(F.lds + LR_UB); LAS bf16_t* wt = (LAS bf16_t*)(F.lds + LR_WT);
    LAS float* a_s = (LAS float*)(F.lds + LR_A); LAS float* b_s = (LAS float*)(F.lds + LR_B); LAS float* wsum = (LAS float*)(F.lds + LR_WS);
    const bf16_t* P = (const bf16_t*)(F.ws_() + WS_P); bf16_t* HT = (bf16_t*)(F.ws_() + WS_HT);
    const int w = F.wave, lane = F.lane, row = lane & 15, kq = lane >> 4;
    for (int it = F.bid; it < 32 * 4 * 2; it += F.G) {
        const int dir = it & 1, hd = (it >> 1) & 3, b = it >> 3;
        __syncthreads();
        {   const bf16_t* W = (const bf16_t*)(F.ws_() + WS_LRUW) + (size_t)(l * 2 + dir) * 2 * 4 * 4096;
            for (int pc = F.tid; pc < 2 * 64 * 8; pc += NTHREADS) { const int g = pc >> 9, n = (pc >> 3) & 63, q = pc & 7;
                *(LAS u32x4*)(wt + (g * 64 + n) * 72 + q * 8) = *(const u32x4*)(W + ((size_t)(g * 4 + hd) * 64 + n) * 64 + q * 8); } }
        const int cch = F.tid & 63, ctq = F.tid >> 6; const int chg = hd * 64 + cch;
        const float* cw = F.in(I_ACW) + ((size_t)(l * 2 + dir) * 4) * 256 + chg; const float cb = F.in(I_ACB)[(size_t)(l * 2 + dir) * 256 + chg];
        const float w0 = cw[0], w1 = cw[256], w2 = cw[512], w3 = cw[768];
        float spv[4], brv[4], biv[4];
#pragma unroll
        for (int nt = 0; nt < 4; ++nt) { const int ch = hd * 64 + 16 * nt + row; const size_t o = (size_t)(l * 2 + dir) * 256 + ch;
            spv[nt] = log1pf(__expf(-F.in(I_ALAM)[o])); brv[nt] = F.in(I_ABR)[o]; biv[nt] = F.in(I_ABI)[o]; }
        float carry = 0.f;
        u32x4 pf[3];
#define LRS_GEO(n, isc_, tlo_) const bool isc_ = (n) < 2; const int tlo_ = 128 * (isc_ ? (dir ? 1 - (n) : (n)) : (dir ? 15 - ((n) - 2) : (n) - 2))
#define LRS_PREFETCH(n) do { LRS_GEO(n, ic_, tl_); const int Ls_ = ic_ ? LC : SEQ; const size_t tb_ = (ic_ ? (size_t)TL : 0) + (size_t)b * Ls_; \
            _Pragma("unroll") for (int u_ = 0; u_ < 3; ++u_) { const int pc_ = F.tid + u_ * NTHREADS; const int r_ = pc_ >> 3, q_ = pc_ & 7; const int t_ = tl_ - 3 + r_; \
                pf[u_] = (u32x4){0u, 0u, 0u, 0u}; if (pc_ < 134 * 8 && t_ >= 0 && t_ < Ls_) pf[u_] = *(const u32x4*)(P + (tb_ + t_) * DIN + OFF_A + hd * 64 + q_ * 8); } } while (0)
        LRS_PREFETCH(0);
#pragma unroll 1
        for (int n = 0; n < 18; ++n) {
            LRS_GEO(n, isc, t_lo);
            const int Lseg = isc ? LC : SEQ; const size_t tokbase = (isc ? (size_t)TL : 0) + (size_t)b * Lseg + t_lo;
#pragma unroll
            for (int u = 0; u < 3; ++u) { const int pc = F.tid + u * NTHREADS; if (pc < 134 * 8) *(LAS u32x4*)(xr + (pc >> 3) * 64 + (pc & 7) * 8) = pf[u]; }
            __syncthreads();
            {   const int r0 = ctq * 16 + (dir ? 3 : 0);
                float x[19];
#pragma unroll
                for (int q = 0; q < 19; ++q) x[q] = bf2f(xr[(r0 + q) * 64 + cch]);
#pragma unroll
                for (int k = 0; k < 16; ++k) { const float u = cb + w0 * x[k] + w1 * x[k + 1] + w2 * x[k + 2] + w3 * x[k + 3];
                    ub[(ctq * 16 + k) * 72 + cch] = (bf16_t)(pk_bf16(u, 0.f) & 0xffffu); }
            }
            __syncthreads();
            if (n + 1 < 18) LRS_PREFETCH(n + 1);
            {   bf16x8 Af[2];
#pragma unroll
                for (int ks = 0; ks < 2; ++ks) Af[ks] = *(const LAS bf16x8*)(ub + (16 * w + row) * 72 + 32 * ks + 8 * kq);
#pragma unroll
                for (int nt = 0; nt < 4; ++nt) {
                    f32x4 cr = (f32x4){0.f, 0.f, 0.f, 0.f}, ci = cr;
#pragma unroll
                    for (int ks = 0; ks < 2; ++ks) {
                        const bf16x8 Br = *(const LAS bf16x8*)(wt + (0 * 64 + 16 * nt + row) * 72 + 32 * ks + 8 * kq);
                        const bf16x8 Bi = *(const LAS bf16x8*)(wt + (1 * 64 + 16 * nt + row) * 72 + 32 * ks + 8 * kq);
                        cr = MFMA16(Af[ks], Br, cr); ci = MFMA16(Af[ks], Bi, ci);
                    }
                    const int ch = 16 * nt + row;
#pragma unroll
                    for (int r = 0; r < 4; ++r) { const int tl = 16 * w + 4 * kq + r;
                        const float rr = sigmoid_f(cr[r] + brv[nt]), ii = sigmoid_f(ci[r] + biv[nt]);
                        const float a = __expf(-8.0f * rr * spv[nt]);
                        const float uv = bf2f(ub[tl * 72 + ch]);
                        a_s[tl * 64 + ch] = a; b_s[tl * 64 + ch] = sqrtf(fmaxf(1.0f - a * a, 0.f)) * (ii * uv); }
                }
            }
            __syncthreads();
            float hl[16], ca[16]; float A = 1.f, Bv = 0.f;
#pragma unroll
            for (int kk = 0; kk < 16; ++kk) { const int tl = 16 * w + (dir ? 15 - kk : kk); const float a = a_s[tl * 64 + lane], bb = b_s[tl * 64 + lane]; Bv = a * Bv + bb; A *= a; hl[kk] = Bv; ca[kk] = A; }
            wsum[(w * 2 + 0) * 64 + lane] = A; wsum[(w * 2 + 1) * 64 + lane] = Bv;
            __syncthreads();
            float s = carry; const int myord = dir ? 7 - w : w;
#pragma unroll
            for (int q = 0; q < 8; ++q) { const int wq = dir ? 7 - q : q; const float Aq = wsum[(wq * 2) * 64 + lane], Bq = wsum[(wq * 2 + 1) * 64 + lane];
                if (q < myord) s = Aq * s + Bq; carry = Aq * carry + Bq; }
            if (!isc || ctx_out) {
                bf16_t* dst = HT + ((size_t)dir * TT + tokbase + 16 * w) * 256 + hd * 64 + lane;
#pragma unroll
                for (int kk = 0; kk < 16; ++kk) { const int k = dir ? 15 - kk : kk; dst[(size_t)k * 256] = (bf16_t)(pk_bf16(hl[kk] + ca[kk] * s, 0.f) & 0xffffu); }
            }
        }
#undef LRS_GEO
#undef LRS_PREFETCH
    }
}
__device__ __forceinline__ void lru_comb(const Frame& F, bool ctx_out) {
    const bf16_t* P = (const bf16_t*)(F.ws_() + WS_P); const bf16_t* HT = (const bf16_t*)(F.ws_() + WS_HT); bf16_t* Y = (bf16_t*)(F.ws_() + WS_Y);
    const size_t n = (size_t)(ctx_out ? TT : TL) * 32;
    for (size_t i = (size_t)F.bid * NTHREADS + F.tid; i < n; i += (size_t)F.G * NTHREADS) { const size_t rowi = i >> 5; const int c8 = (int)(i & 31) * 8;
        const u32x4 hf = __builtin_nontemporal_load((const u32x4*)(HT + rowi * 256 + c8)), hb = __builtin_nontemporal_load((const u32x4*)(HT + ((size_t)TT + rowi) * 256 + c8)), xg = __builtin_nontemporal_load((const u32x4*)(P + rowi * DIN + OFF_A + 256 + c8));
        const unsigned hfa[4] = {hf.x, hf.y, hf.z, hf.w}, hba[4] = {hb.x, hb.y, hb.z, hb.w}, xga[4] = {xg.x, xg.y, xg.z, xg.w}; unsigned o[4];
#pragma unroll
        for (int e = 0; e < 4; ++e) o[e] = pk_bf16((bflo(hfa[e]) + bflo(hba[e])) * gelu_tanh_f(bflo(xga[e])), (bfhi(hfa[e]) + bfhi(hba[e])) * gelu_tanh_f(bfhi(xga[e])));
        *(u32x4*)(Y + rowi * D + c8) = (u32x4){o[0], o[1], o[2], o[3]}; }
}

constexpr int CF_GLU = 0;
constexpr int CF_CV  = 48128;
constexpr int CF_ACT = CF_CV + 65536;
static_assert(CF_ACT + 64 * 264 * 2 <= LDS_BARW, "conformer LDS");
#ifndef CONF_STEPS
#define CONF_STEPS 4
#endif
__device__ __forceinline__ void conf_phase(const Frame& F, int l, bool do_ctx) {
    LAS bf16_t* glu = (LAS bf16_t*)(F.lds + CF_GLU); LAS float* cv = (LAS float*)(F.lds + CF_CV); LAS bf16_t* act = (LAS bf16_t*)(F.lds + CF_ACT);
    const bf16_t* P = (const bf16_t*)(F.ws_() + WS_P); bf16_t* Y = (bf16_t*)(F.ws_() + WS_Y);
    const int nlat = TL / 64, nitems = nlat + (do_ctx ? TC / 64 : 0);
    const float* ccw = F.in(I_CCW) + (size_t)l * 31 * 256; const float* ccb = F.in(I_CCB) + (size_t)l * 256;
    const float* lng = F.in(I_CLG) + (size_t)l * 256; const float* lnb = F.in(I_CLB) + (size_t)l * 256; const float* bpw = F.in(I_CBPW) + (size_t)l * 256;
    const bf16_t* Wt = (const bf16_t*)(F.ws_() + WS_CPW) + (size_t)l * 65536;
    bf16x8 Aw[2][8];
#pragma unroll
    for (int nt = 0; nt < 2; ++nt)
#pragma unroll
        for (int ks = 0; ks < 8; ++ks) Aw[nt][ks] = *(const bf16x8*)(Wt + (size_t)(32 * F.wave + 16 * nt + (F.lane & 15)) * 256 + 32 * ks + 8 * (F.lane >> 4));
    for (int it = F.bid; it < nitems; it += F.G) {
        const bool isc = it >= nlat; const int tile = isc ? it - nlat : it; const int Lseg = isc ? LC : SEQ; const int tps = Lseg / 64;
        const int b = tile / tps, t0 = (tile % tps) * 64; const size_t tokbase = (isc ? (size_t)TL : 0) + (size_t)b * Lseg;
        __syncthreads();
        {   u32x2 rv[6], rg[6];
#pragma unroll
            for (int j = 0; j < 6; ++j) { const int pc = F.tid + j * NTHREADS; const int r = (pc >> 5) < 94 ? (pc >> 5) : 93, q = pc & 31; const int t = t0 - 15 + r;
                const int tc = (t >= 0 && t < Lseg) ? t : 0; const unsigned char* src = (const unsigned char*)P + (tokbase + tc) * (DIN * 2) + OFF_C + q * 8;
                rv[j] = *(const u32x2*)src; rg[j] = *(const u32x2*)(src + 256); }
            __builtin_amdgcn_sched_barrier(0);
#pragma unroll
            for (int j = 0; j < 6; ++j) { const int pc = F.tid + j * NTHREADS; const int r = pc >> 5, q = pc & 31; const int t = t0 - 15 + r;
                if (pc < 94 * 32) {
                    u32x4 o = (u32x4){0u, 0u, 0u, 0u};
                    if (t >= 0 && t < Lseg) { float v[8], g[8];
                        dec_fp8x8(rv[j], v); dec_fp8x8(rg[j], g);
                        o.x = pk_bf16(v[0] * sigmoid_f(g[0]), v[1] * sigmoid_f(g[1])); o.y = pk_bf16(v[2] * sigmoid_f(g[2]), v[3] * sigmoid_f(g[3]));
                        o.z = pk_bf16(v[4] * sigmoid_f(g[4]), v[5] * sigmoid_f(g[5])); o.w = pk_bf16(v[6] * sigmoid_f(g[6]), v[7] * sigmoid_f(g[7])); }
                    *(LAS u32x4*)(glu + r * 256 + q * 8) = o; } }
        }
        __syncthreads();
        if (CONF_STEPS < 2) continue;
        {   const int ch = F.tid & 255, tg = F.tid >> 8;
            const float cbv = ccb[ch];
            float wv[31];
#pragma unroll
            for (int j = 0; j < 31; ++j) wv[j] = ccw[j * 256 + ch];
#pragma unroll 1
            for (int kg = 0; kg < 4; ++kg) {
                float xs[38];
#pragma unroll
                for (int q = 0; q < 38; ++q) xs[q] = bf2f(glu[(32 * tg + 8 * kg + q) * 256 + ch]);
#pragma unroll
                for (int kk = 0; kk < 8; ++kk) { float a = cbv;
#pragma unroll
                    for (int j = 0; j < 31; ++j) a += wv[j] * xs[kk + j];
                    cv[(32 * tg + 8 * kg + kk) * 256 + ch] = a; }
            }
        }
        __syncthreads();
        if (CONF_STEPS < 3) continue;
        {
            const f32x4 g4 = *(const f32x4*)(lng + 4 * F.lane), b4 = *(const f32x4*)(lnb + 4 * F.lane);
#pragma unroll 1
            for (int q = 0; q < 8; ++q) { const int tk = 8 * F.wave + q; const f32x4 v = *(const LAS f32x4*)(cv + tk * 256 + 4 * F.lane);
                const float mu = wave_sum(v[0] + v[1] + v[2] + v[3]) * (1.0f / 256.0f);
                const float d0 = v[0] - mu, d1 = v[1] - mu, d2 = v[2] - mu, d3 = v[3] - mu;
                const float var = wave_sum(d0 * d0 + d1 * d1 + d2 * d2 + d3 * d3) * (1.0f / 256.0f);
                const float rs = rsqrtf(var + 1e-5f);
                const float y0 = silu_f(d0 * rs * g4[0] + b4[0]), y1 = silu_f(d1 * rs * g4[1] + b4[1]), y2 = silu_f(d2 * rs * g4[2] + b4[2]), y3 = silu_f(d3 * rs * g4[3] + b4[3]);
                u32x2 o; o.x = pk_bf16(y0, y1); o.y = pk_bf16(y2, y3); *(LAS u32x2*)(act + tk * 264 + 4 * F.lane) = o; }
        }
        __syncthreads();
        if (CONF_STEPS < 4) continue;
        {
            const int lane = F.lane, row = lane & 15, kq = lane >> 4;
            f32x4 acc[2][4];
#pragma unroll
            for (int nt = 0; nt < 2; ++nt)
#pragma unroll
                for (int tt = 0; tt < 4; ++tt) acc[nt][tt] = (f32x4){0.f, 0.f, 0.f, 0.f};
#pragma unroll
            for (int ks = 0; ks < 8; ++ks) {
                bf16x8 Bt[4];
#pragma unroll
                for (int tt = 0; tt < 4; ++tt) Bt[tt] = *(const LAS bf16x8*)(act + (16 * tt + row) * 264 + 32 * ks + 8 * kq);
#pragma unroll
                for (int nt = 0; nt < 2; ++nt)
#pragma unroll
                    for (int tt = 0; tt < 4; ++tt) acc[nt][tt] = MFMA16(Aw[nt][ks], Bt[tt], acc[nt][tt]);
            }
#pragma unroll
            for (int nt = 0; nt < 2; ++nt) { const int n0 = 32 * F.wave + 16 * nt + 4 * kq; const f32x4 bb = *(const f32x4*)(bpw + n0);
#pragma unroll
                for (int tt = 0; tt < 4; ++tt) { const f32x4 v = acc[nt][tt] + bb; u32x2 o; o.x = pk_bf16(v[0], v[1]); o.y = pk_bf16(v[2], v[3]);
                    *(u32x2*)(Y + (tokbase + t0 + 16 * tt + row) * D + 512 + n0) = o; } }
        }
    }
}

constexpr int AP_VT = 0;
__device__ __forceinline__ void attn_pre(const Frame& F, int l) {
    const bf16_t* P = (const bf16_t*)(F.ws_() + WS_P);
    const float* ropec = (const float*)(F.ws_() + WS_ROPE); const float* ropes = ropec + 2048 * 16;
    LAS bf16_t* vt = (LAS bf16_t*)(F.lds + AP_VT);
    const int skey = F.tid >> 2, scomp = (F.tid >> 1) & 1, shf = F.tid & 1;
    const int vkp = F.tid & 63, vg = F.tid >> 6;
    for (int it = F.bid; it < 32 * 4 * 18; it += F.G) {
        const int kt = it % 18, hd = (it / 18) & 3, b = it / 72;
        const bool kc = kt >= 16; const size_t kb = kc ? (size_t)TL + (size_t)b * LC + (kt - 16) * 128 : (size_t)b * SEQ + kt * 128;
        unsigned char* kimg = F.ws_() + WS_KIMG + (size_t)it * 16384; unsigned char* vimg = F.ws_() + WS_VIMG + (size_t)it * 8192;
        {   const unsigned char* kp = (const unsigned char*)P + (kb + skey) * (DIN * 2) + OFF_B + 256 + hd * 64 + scomp * 32 + 8 * shf;
            float x1[8], x2[8]; dec_fp8x8(*(const u32x2*)kp, x1); dec_fp8x8(*(const u32x2*)(kp + 16), x2);
            float o1[8], o2[8];
            if (!kc) { const int tpos = kt * 128 + skey; const float* cp = ropec + tpos * 16 + 8 * shf; const float* sp = ropes + tpos * 16 + 8 * shf;
#pragma unroll
                for (int j = 0; j < 8; ++j) { const float cs = cp[j], sn = sp[j]; o1[j] = x1[j] * cs - x2[j] * sn; o2[j] = x1[j] * sn + x2[j] * cs; } }
            else {
#pragma unroll
                for (int j = 0; j < 8; ++j) { o1[j] = x1[j]; o2[j] = x2[j]; } }
            const int sw = (skey >> 1) & 7, p0 = scomp * 4 + shf, p1 = p0 + 2;
            *(bf16x8*)(kimg + skey * 128 + ((p0 ^ sw) << 4)) = pk8(o1); *(bf16x8*)(kimg + skey * 128 + ((p1 ^ sw) << 4)) = pk8(o2); }
        {   const unsigned char* vp = (const unsigned char*)P + (kb + 2 * vkp) * (DIN * 2) + OFF_B + 512 + hd * 64 + 8 * vg;
            float va[8], vb[8]; dec_fp8x8(*(const u32x2*)vp, va); dec_fp8x8(*(const u32x2*)(vp + DIN * 2), vb);
            __syncthreads();
            LAS bf16_t* vd = vt + (8 * vg) * 136 + 2 * vkp;
#pragma unroll
            for (int e = 0; e < 8; ++e) *(LAS unsigned*)(vd + e * 136) = (__float_as_uint(va[e]) >> 16) | (__float_as_uint(vb[e]) & 0xffff0000u);
            __syncthreads();
            {
                const int dv = F.tid >> 3, uu = F.tid & 7, blk = uu >> 2, h = (uu >> 1) & 1, sub = uu & 1;
                unsigned wq[4];
#pragma unroll
                for (int g = 0; g < 4; ++g) { const u32x2 q4 = *(const LAS u32x2*)(vt + dv * 136 + 64 * blk + 32 * sub + 8 * g + 4 * h);
                    int w_ = __builtin_amdgcn_cvt_pk_fp8_f32(bflo(q4.x), bfhi(q4.x), 0, false); w_ = __builtin_amdgcn_cvt_pk_fp8_f32(bflo(q4.y), bfhi(q4.y), w_, true); wq[g] = (unsigned)w_; }
                *(u32x4*)(vimg + dv * 128 + ((uu ^ ((dv >> 1) & 7)) << 4)) = (u32x4){wq[0], wq[1], wq[2], wq[3]}; }
        }
    }
}
constexpr int AT_K0 = 0, AT_V0 = 65536, AT_X = 0;
static_assert(AT_V0 + 65536 <= LDS_BARW, "attention LDS");
__device__ __forceinline__ void attn_phase(const Frame& F, int l, bool do_ctx) {
    const bf16_t* P = (const bf16_t*)(F.ws_() + WS_P); bf16_t* Y = (bf16_t*)(F.ws_() + WS_Y);
    const float* ropec = (const float*)(F.ws_() + WS_ROPE); const float* ropes = ropec + 2048 * 16;
    const int lane = F.lane, w = F.wave, i31 = lane & 31, hh = lane >> 5, qs = w >> 1, comp = w & 1;
    const float lam_init = (l == 0) ? 0.2f : (l == 1) ? 0.35550906759f : (l == 2) ? 0.47071301834f : 0.55605820419f;
    float lam;
    {   const float* q1 = F.in(I_LQ1) + l * 32; const float* k1 = F.in(I_LK1) + l * 32; const float* q2 = F.in(I_LQ2) + l * 32; const float* k2 = F.in(I_LK2) + l * 32;
        const float s1 = wave_sum(lane < 32 ? q1[i31] * k1[i31] : 0.f), s2 = wave_sum(lane < 32 ? q2[i31] * k2[i31] : 0.f);
        lam = expf(s1) - expf(s2) + lam_init; }
    const float* subg = F.in(I_SUBG) + l * 64;
    const int nlat = 32 * 4 * 16, nitems = nlat + (do_ctx ? 32 * 4 * 2 : 0);
    const float qscale = 0.17677669529663687f * 1.4426950408889634f;
    const int ksw = (i31 >> 1) & 7;
    const int koff0 = i31 * 128 + (((comp * 4 + hh) ^ ksw) << 4), koff1 = i31 * 128 + (((comp * 4 + 2 + hh) ^ ksw) << 4);
    if (w >= 4) __builtin_amdgcn_s_setprio(1);
    for (int it = F.vcu; it < nitems; it += F.G) {
        const bool isc = it >= nlat; int r_ = isc ? it - nlat : it; const int nqb = isc ? 2 : 16; const int qb = r_ % nqb; r_ /= nqb; const int hd = r_ & 3; const int b = r_ >> 2;
        const int ntiles = isc ? 1 : 9, kt0 = isc ? 16 : 0;
        const size_t qtok = isc ? (size_t)TL + (size_t)b * LC + qb * 128 + qs * 32 + i31 : (size_t)b * SEQ + qb * 128 + qs * 32 + i31;
        const unsigned char* kimg = F.ws_() + WS_KIMG + ((size_t)(b * 4 + hd) * 18 + kt0) * 16384; const unsigned char* vimg = F.ws_() + WS_VIMG + ((size_t)(b * 4 + hd) * 18 + kt0) * 8192;
        bf16x8 Bq[2];
        {   const unsigned char* qp = (const unsigned char*)P + qtok * (DIN * 2) + OFF_B + hd * 64 + comp * 32 + 8 * hh;
            float x1[8], x2[8]; dec_fp8x8(*(const u32x2*)qp, x1); dec_fp8x8(*(const u32x2*)(qp + 16), x2);
            float o1[8], o2[8];
            if (!isc) { const int tpos = qb * 128 + qs * 32 + i31; const float* cp = ropec + tpos * 16 + 8 * hh; const float* sp = ropes + tpos * 16 + 8 * hh;
#pragma unroll
                for (int j = 0; j < 8; ++j) { const float cs = cp[j], sn = sp[j]; o1[j] = (x1[j] * cs - x2[j] * sn) * qscale; o2[j] = (x1[j] * sn + x2[j] * cs) * qscale; } }
            else {
#pragma unroll
                for (int j = 0; j < 8; ++j) { o1[j] = x1[j] * qscale; o2[j] = x2[j] * qscale; } }
            Bq[0] = pk8(o1); Bq[1] = pk8(o2); }
#define AT_DMA(kt, buf) do { _Pragma("unroll") for (int u_ = 0; u_ < 4; ++u_) { const int ch_ = (u_ * 8 + w) * 1024; \
            __builtin_amdgcn_global_load_lds((const unsigned*)(kimg + (size_t)(kt) * 32768 + ch_ + lane * 16), (LAS unsigned*)(F.lds + AT_K0 + (buf) * 32768 + ch_), 16, 0, 0); \
            if (u_ < 2) __builtin_amdgcn_global_load_lds((const unsigned*)(vimg + (size_t)(kt) * 16384 + ch_ + lane * 16), (LAS unsigned*)(F.lds + AT_V0 + (buf) * 16384 + ch_), 16, 0, 0); } } while (0)
        __syncthreads();
        AT_DMA(0, 0);
        asm volatile("s_waitcnt vmcnt(0)" ::: "memory");
        __syncthreads();
        f32x16 O0, O1, negm;
#pragma unroll
        for (int r = 0; r < 16; ++r) { O0[r] = 0.f; O1[r] = 0.f; negm[r] = 0.f; }
        f32x2 lsum2 = {0.f, 0.f}; bool first = true;
        unsigned pe0 = 0u, pe1 = 0u, pe2 = 0u, pe3 = 0u;
        f32x16 S;
        {   const LAS unsigned char* K0 = F.lds + AT_K0; const bf16x8 Ak0 = *(const LAS bf16x8*)(K0 + koff0), Ak1 = *(const LAS bf16x8*)(K0 + koff1);
            S = MFMA32(Ak0, Bq[0], negm); S = MFMA32(Ak1, Bq[1], S); }
        for (int kt = 0; kt < ntiles; ++kt) {
            const int buf = kt & 1; const bool more = kt + 1 < ntiles;
            const LAS unsigned char* Kl = F.lds + AT_K0 + buf * 32768; const LAS unsigned char* Vl = F.lds + AT_V0 + buf * 16384;
            const LAS unsigned char* Kn = F.lds + AT_K0 + (buf ^ 1) * 32768;
#pragma unroll
            for (int st = 0; st < 8; ++st) {
                if (st == 0) { __syncthreads(); if (more) AT_DMA(kt + 1, buf ^ 1); }
                if (st == 7) { asm volatile("s_waitcnt vmcnt(0)" ::: "memory"); __syncthreads(); }
                f32x16 Sn;
                if (st < 7) { const bf16x8 Ak0 = *(const LAS bf16x8*)(Kl + (st + 1) * 4096 + koff0), Ak1 = *(const LAS bf16x8*)(Kl + (st + 1) * 4096 + koff1);
                    Sn = MFMA32(Ak0, Bq[0], negm); Sn = MFMA32(Ak1, Bq[1], Sn); }
                else if (more) { const bf16x8 Ak0 = *(const LAS bf16x8*)(Kn + koff0), Ak1 = *(const LAS bf16x8*)(Kn + koff1);
                    Sn = MFMA32(Ak0, Bq[0], negm); Sn = MFMA32(Ak1, Bq[1], Sn); }
                else Sn = negm;
                float p[16]; f32x2 ps2;
#define AT_EXPS() do { _Pragma("unroll") for (int r = 0; r < 16; ++r) p[r] = __builtin_amdgcn_exp2f(S[r]); \
                    const f32x2 q0_ = {p[0], p[1]}, q1_ = {p[2], p[3]}, q2_ = {p[4], p[5]}, q3_ = {p[6], p[7]}, q4_ = {p[8], p[9]}, q5_ = {p[10], p[11]}, q6_ = {p[12], p[13]}, q7_ = {p[14], p[15]}; \
                    asm("s_nop 0\n\tv_pk_add_f32 %0, %1, %2\n\tv_pk_add_f32 %0, %0, %3\n\tv_pk_add_f32 %0, %0, %4\n\tv_pk_add_f32 %0, %0, %5\n\tv_pk_add_f32 %0, %0, %6\n\tv_pk_add_f32 %0, %0, %7\n\tv_pk_add_f32 %0, %0, %8" \
                        : "=&v"(ps2) : "v"(q0_), "v"(q1_), "v"(q2_), "v"(q3_), "v"(q4_), "v"(q5_), "v"(q6_), "v"(q7_)); } while (0)
                AT_EXPS();
                if (first || __any(!(ps2[0] + ps2[1] <= 256.0f))) {
                    float mx = fmaxf(fmaxf(S[0], S[1]), S[2]);
                    mx = fmaxf(fmaxf(mx, S[3]), S[4]); mx = fmaxf(fmaxf(mx, S[5]), S[6]); mx = fmaxf(fmaxf(mx, S[7]), S[8]); mx = fmaxf(fmaxf(mx, S[9]), S[10]);
                    mx = fmaxf(fmaxf(mx, S[11]), S[12]); mx = fmaxf(fmaxf(mx, S[13]), S[14]); mx = fmaxf(mx, S[15]);
                    const u32x2 sw = __builtin_amdgcn_permlane32_swap(__float_as_uint(mx), __float_as_uint(mx), false, false);
                    const float mp = fmaxf(__uint_as_float(sw.x), __uint_as_float(sw.y));
                    const float d = first ? mp - 3.0f : fmaxf(mp - 3.0f, 0.f);
                    const float alpha = __builtin_amdgcn_exp2f(-d);
#pragma unroll
                    for (int r = 0; r < 16; ++r) { S[r] -= d; O0[r] *= alpha; O1[r] *= alpha; negm[r] -= d; Sn[r] -= d; }
                    lsum2 *= (f32x2){alpha, alpha}; first = false;
                    if (st & 1) {
#define AT_RS8(w) do { const int w_ = (int)(w); int r_ = __builtin_amdgcn_cvt_pk_fp8_f32(__builtin_amdgcn_cvt_f32_fp8(w_, 0) * alpha, __builtin_amdgcn_cvt_f32_fp8(w_, 1) * alpha, 0, false); \
                        r_ = __builtin_amdgcn_cvt_pk_fp8_f32(__builtin_amdgcn_cvt_f32_fp8(w_, 2) * alpha, __builtin_amdgcn_cvt_f32_fp8(w_, 3) * alpha, r_, true); (w) = (unsigned)r_; } while (0)
                        AT_RS8(pe0); AT_RS8(pe1); AT_RS8(pe2); AT_RS8(pe3);
#undef AT_RS8
                    }
                    AT_EXPS();
                }
                asm("v_pk_add_f32 %0, %1, %0" : "+v"(lsum2) : "v"(ps2));
                {
                    unsigned pq[4];
#pragma unroll
                    for (int g = 0; g < 4; ++g) { int w_ = __builtin_amdgcn_cvt_pk_fp8_f32(p[4 * g], p[4 * g + 1], 0, false); w_ = __builtin_amdgcn_cvt_pk_fp8_f32(p[4 * g + 2], p[4 * g + 3], w_, true); pq[g] = (unsigned)w_; }
                    if ((st & 1) == 0) { pe0 = pq[0]; pe1 = pq[1]; pe2 = pq[2]; pe3 = pq[3]; }
                    else {
                        const i32x8v Bp8 = (i32x8v){(int)pe0, (int)pe1, (int)pe2, (int)pe3, (int)pq[0], (int)pq[1], (int)pq[2], (int)pq[3]};
                        const int ub = ((st >> 1) & 1) * 4 + hh * 2;
                        const int sw_ = (i31 >> 1) & 7;
#pragma unroll
                        for (int mt = 0; mt < 2; ++mt) { const LAS unsigned char* vr = Vl + (st >> 2) * 8192 + (32 * mt + i31) * 128;
                            const u32x4 a0 = *(const LAS u32x4*)(vr + ((ub ^ sw_) << 4)), a1 = *(const LAS u32x4*)(vr + (((ub + 1) ^ sw_) << 4));
                            const i32x8v Av8 = (i32x8v){(int)a0.x, (int)a0.y, (int)a0.z, (int)a0.w, (int)a1.x, (int)a1.y, (int)a1.z, (int)a1.w};
                            if (mt == 0) O0 = __builtin_amdgcn_mfma_scale_f32_32x32x64_f8f6f4(Av8, Bp8, O0, 0, 0, 0, 0x7f7f7f7f, 0, 0x7f7f7f7f);
                            else O1 = __builtin_amdgcn_mfma_scale_f32_32x32x64_f8f6f4(Av8, Bp8, O1, 0, 0, 0, 0x7f7f7f7f, 0, 0x7f7f7f7f); }
                    }
                }
                S = Sn;
            }
        }
        __syncthreads();
#undef AT_DMA
#undef AT_EXPS
        const float lsum = lsum2[0] + lsum2[1]; const float ltot = lsum + __shfl_xor(lsum, 32); const float inv = __builtin_amdgcn_rcpf(ltot);
        LAS float* xch = (LAS float*)(F.lds + AT_X) + qs * 2048;
        if (comp == 1) {
#pragma unroll
            for (int r = 0; r < 16; ++r) { const int dv = (r & 3) + 8 * (r >> 2) + 4 * hh; xch[dv * 32 + i31] = O0[r] * inv; xch[(32 + dv) * 32 + i31] = O1[r] * inv; }
        }
        __syncthreads();
        if (comp == 0) {
            float d0[16], d1[16]; float ss = 0.f;
#pragma unroll
            for (int r = 0; r < 16; ++r) { const int dv = (r & 3) + 8 * (r >> 2) + 4 * hh;
                d0[r] = O0[r] * inv - lam * xch[dv * 32 + i31]; d1[r] = O1[r] * inv - lam * xch[(32 + dv) * 32 + i31]; ss += d0[r] * d0[r] + d1[r] * d1[r]; }
            ss += __shfl_xor(ss, 32);
            const float rs = rsqrtf(ss * (1.0f / 64.0f) + EPS) * (1.0f - lam_init);
            bf16_t* yp = Y + qtok * D + 256 + hd * 64;
#pragma unroll
            for (int rg = 0; rg < 4; ++rg) { const int dv = 8 * rg + 4 * hh; const f32x4 g0 = *(const f32x4*)(subg + dv), g1 = *(const f32x4*)(subg + 32 + dv);
                u32x2 o0, o1; o0.x = pk_bf16(d0[4 * rg] * rs * g0[0], d0[4 * rg + 1] * rs * g0[1]); o0.y = pk_bf16(d0[4 * rg + 2] * rs * g0[2], d0[4 * rg + 3] * rs * g0[3]);
                o1.x = pk_bf16(d1[4 * rg] * rs * g1[0], d1[4 * rg + 1] * rs * g1[1]); o1.y = pk_bf16(d1[4 * rg + 2] * rs * g1[2], d1[4 * rg + 3] * rs * g1[3]);
                *(u32x2*)(yp + dv) = o0; *(u32x2*)(yp + 32 + dv) = o1; }
        }
    }
    __builtin_amdgcn_s_setprio(0);
}

constexpr int RT_W = 0;
constexpr int RT_WST = 1028;
constexpr int RT_REC = 36 * RT_WST * 4;
constexpr int RT_LP = RT_REC + 304 * 16;
constexpr int RT_CNT = RT_LP + 304 * 8;
static_assert(RT_CNT + 256 <= LDS_BARW, "route LDS");
__device__ __forceinline__ void ffn_route(const Frame& F, int l, int nrows) {
    LAS float* Wt = (LAS float*)(F.lds + RT_W); LAS i32x4* rec = (LAS i32x4*)(F.lds + RT_REC); LAS i32x2* lp = (LAS i32x2*)(F.lds + RT_LP);
    LAS int* lcnt = (LAS int*)(F.lds + RT_CNT); LAS int* lbase = lcnt + 32;
    const float* wrg = F.in(I_WRG) + (size_t)l * D * 4; const float* wre = F.in(I_WRE) + (size_t)l * D * 32;
    const float* brg = F.in(I_BRG) + l * 4; const float* bre = F.in(I_BRE) + l * 32;
    __syncthreads();
    for (int i = F.tid; i < 1024 * 4; i += NTHREADS) { const int k = i >> 2, j = i & 3; Wt[j * RT_WST + k] = wrg[i]; }
    for (int i = F.tid; i < 1024 * 32; i += NTHREADS) { const int k = i >> 5, j = i & 31; Wt[(4 + j) * RT_WST + k] = wre[i]; }
    if (F.tid < 32) lcnt[F.tid] = 0;
    __syncthreads();
    const float* modp = (const float*)(F.ws_() + WS_MOD) + (size_t)l * 33 * (NMOD * D) + 3 * D;
    const float* gn = F.in(I_GFFN) + (size_t)l * D;
    const int RPB = (nrows + F.G - 1) / F.G, rbeg = F.bid * RPB, rend = (rbeg + RPB < nrows) ? rbeg + RPB : nrows;
    const int lo4 = 4 * F.lane;
    f32x4 gq[4], shq[4], scq[4]; u32x2 xa[4]; int curb = -1;
    const bf16_t* XB = (const bf16_t*)(F.ws_() + WS_XB);
#pragma unroll
    for (int i = 0; i < 4; ++i) { gq[i] = *(const f32x4*)(gn + i * 256 + lo4); shq[i] = (f32x4){0.f, 0.f, 0.f, 0.f}; scq[i] = shq[i]; }
#define RT_LOADX(r) do { const bf16_t* xp_ = XB + (size_t)(r) * D; _Pragma("unroll") for (int i = 0; i < 4; ++i) xa[i] = *(const u32x2*)(xp_ + i * 256 + lo4); } while (0)
    int row = rbeg + F.wave;
    if (row < rend) RT_LOADX(row);
    for (; row < rend; row += 8) {
        const bool isc = row >= TL; const int b = isc ? 32 : (row >> 11);
        f32x4 v[4];
#pragma unroll
        for (int i = 0; i < 4; ++i) v[i] = (f32x4){bflo(xa[i].x), bfhi(xa[i].x), bflo(xa[i].y), bfhi(xa[i].y)};
        if (row + 8 < rend) RT_LOADX(row + 8);
        if (b != curb) { curb = b; const float* sh = modp + (size_t)b * (NMOD * D);
#pragma unroll
            for (int i = 0; i < 4; ++i) { shq[i] = *(const f32x4*)(sh + i * 256 + lo4); scq[i] = *(const f32x4*)(sh + D + i * 256 + lo4); } }
        float ss = 0.f;
#pragma unroll
        for (int i = 0; i < 4; ++i) ss += v[i][0] * v[i][0] + v[i][1] * v[i][1] + v[i][2] * v[i][2] + v[i][3] * v[i][3];
        ss = wave_sum(ss);
        const float rstd = rsqrtf(ss * (1.0f / D) + EPS);
        bf16_t* hrow = (bf16_t*)(F.ws_() + WS_H) + (size_t)row * D;
#pragma unroll
        for (int i = 0; i < 4; ++i) {
#pragma unroll
            for (int e = 0; e < 4; ++e) v[i][e] = v[i][e] * rstd * gq[i][e] * (1.0f + scq[i][e]) + shq[i][e];
            u32x2 wv; wv.x = pk_bf16(v[i][0], v[i][1]); wv.y = pk_bf16(v[i][2], v[i][3]); *(u32x2*)(hrow + i * 256 + lo4) = wv; }
        float lg[4];
#pragma unroll
        for (int j = 0; j < 4; ++j) { float s = 0.f;
#pragma unroll
            for (int i = 0; i < 4; ++i) { const f32x4 wq = *(const LAS f32x4*)(Wt + j * RT_WST + i * 256 + 4 * F.lane); s += v[i][0] * wq[0] + v[i][1] * wq[1] + v[i][2] * wq[2] + v[i][3] * wq[3]; }
            lg[j] = wave_sum(s); }
        float g0 = lg[0] + brg[0], g1 = lg[1] + brg[1], g2 = lg[2] + brg[2], g3 = lg[3] + brg[3];
        int gi = 0; float gm = g0; if (g1 > gm) { gm = g1; gi = 1; } if (g2 > gm) { gm = g2; gi = 2; } if (g3 > gm) { gm = g3; gi = 3; }
        const float pgrp = 1.0f / (expf(g0 - gm) + expf(g1 - gm) + expf(g2 - gm) + expf(g3 - gm));
        float le[8];
        {   const LAS float* We = Wt + (4 + 8 * gi) * RT_WST;
#pragma unroll
            for (int e = 0; e < 8; ++e) { float s = 0.f;
#pragma unroll
                for (int i = 0; i < 4; ++i) { const f32x4 wq = *(const LAS f32x4*)(We + e * RT_WST + i * 256 + 4 * F.lane); s += v[i][0] * wq[0] + v[i][1] * wq[1] + v[i][2] * wq[2] + v[i][3] * wq[3]; }
                le[e] = wave_sum(s) + bre[8 * gi + e]; } }
        int e0 = 0; float m0 = le[0];
#pragma unroll
        for (int e = 1; e < 8; ++e) if (le[e] > m0) { m0 = le[e]; e0 = e; }
        int e1 = -1; float m1 = -3.0e38f;
#pragma unroll
        for (int e = 0; e < 8; ++e) if (e != e0 && le[e] > m1) { m1 = le[e]; e1 = e; }
        const float x1 = expf(m1 - m0);
        const float w0 = pgrp / (1.0f + x1), w1 = pgrp * x1 / (1.0f + x1);
        if (F.lane == 0) { const int E0 = gi * 8 + e0, E1 = gi * 8 + e1; const int ri = row - rbeg;
            rec[ri] = (i32x4){E0, E1, __float_as_int(w0), __float_as_int(w1)};
            const int p0 = atomicAdd((int*)&lcnt[E0], 1), p1 = atomicAdd((int*)&lcnt[E1], 1); lp[ri] = (i32x2){p0, p1}; }
    }
    __syncthreads();
    if (F.tid < 32) lbase[F.tid] = (int)__hip_atomic_fetch_add(F.ctl + CW_CNT + l * 32 + F.tid, (unsigned)lcnt[F.tid], __ATOMIC_RELAXED, __HIP_MEMORY_SCOPE_AGENT);
    __syncthreads();
    int* tokof = (int*)(F.ws_() + WS_TOKOF); float* gateof = (float*)(F.ws_() + WS_GATEOF); i32x4* tokinf = (i32x4*)(F.ws_() + WS_TOKINF);
    for (int ri = F.tid; ri < 304; ri += NTHREADS) { const int row = rbeg + ri;
        if (row < rend) { const i32x4 rc = rec[ri]; const i32x2 q = lp[ri]; const int p0 = lbase[rc.x] + q.x, p1 = lbase[rc.y] + q.y;
            tokof[(size_t)rc.x * TT + p0] = row; gateof[(size_t)rc.x * TT + p0] = __int_as_float(rc.z);
            tokof[(size_t)rc.y * TT + p1] = row; gateof[(size_t)rc.y * TT + p1] = __int_as_float(rc.w);
            tokinf[row] = (i32x4){rc.x, p0, rc.y, p1}; } }
}


constexpr int RM_WST = 1032;
constexpr int RM_WHI = 0, RM_WLO = 36 * RM_WST * 2;
constexpr int RM_REC = 2 * 36 * RM_WST * 2;
constexpr int RM_LP = RM_REC + 304 * 16, RM_CNT = RM_LP + 304 * 8;
static_assert(RM_CNT + 256 <= LDS_BARW, "route LDS");
__device__ __forceinline__ float row_max16(float v) {
    v = fmaxf(v, __builtin_bit_cast(float, __builtin_amdgcn_update_dpp(0, __builtin_bit_cast(int, v), 0xB1, 0xF, 0xF, true)));
    v = fmaxf(v, __builtin_bit_cast(float, __builtin_amdgcn_update_dpp(0, __builtin_bit_cast(int, v), 0x4E, 0xF, 0xF, true)));
    v = fmaxf(v, __builtin_bit_cast(float, __builtin_amdgcn_update_dpp(0, __builtin_bit_cast(int, v), 0x141, 0xF, 0xF, true)));
    v = fmaxf(v, __builtin_bit_cast(float, __builtin_amdgcn_update_dpp(0, __builtin_bit_cast(int, v), 0x140, 0xF, 0xF, true)));
    return v;
}
__device__ __forceinline__ float row_sum16(float v) {
    v += __builtin_bit_cast(float, __builtin_amdgcn_update_dpp(0, __builtin_bit_cast(int, v), 0xB1, 0xF, 0xF, true));
    v += __builtin_bit_cast(float, __builtin_amdgcn_update_dpp(0, __builtin_bit_cast(int, v), 0x4E, 0xF, 0xF, true));
    v += __builtin_bit_cast(float, __builtin_amdgcn_update_dpp(0, __builtin_bit_cast(int, v), 0x141, 0xF, 0xF, true));
    v += __builtin_bit_cast(float, __builtin_amdgcn_update_dpp(0, __builtin_bit_cast(int, v), 0x140, 0xF, 0xF, true));
    return v;
}
__device__ __forceinline__ int row_first16(bool pred, int kq) {
    const unsigned long long m = __ballot(pred); const unsigned rb = (unsigned)(m >> (16 * kq)) & 0xffffu; return __ffs((int)rb) - 1;
}
__device__ __forceinline__ void ffn_route_mfma(const Frame& F, int l, int nrows) {
    LAS bf16_t* Whi = (LAS bf16_t*)(F.lds + RM_WHI); LAS bf16_t* Wlo = (LAS bf16_t*)(F.lds + RM_WLO);
    LAS i32x4* rec = (LAS i32x4*)(F.lds + RM_REC); LAS i32x2* lp = (LAS i32x2*)(F.lds + RM_LP); LAS int* lcnt = (LAS int*)(F.lds + RM_CNT); LAS int* lbase = lcnt + 32;
    const float* wrg = F.in(I_WRG) + (size_t)l * D * 4; const float* wre = F.in(I_WRE) + (size_t)l * D * 32;
    __syncthreads();
    {
        f32x4 wv[16], gv[2];
#pragma unroll
        for (int it = 0; it < 16; ++it) wv[it] = *(const f32x4*)(wre + 4 * (F.tid + NTHREADS * it));
#pragma unroll
        for (int it = 0; it < 2; ++it) gv[it] = *(const f32x4*)(wrg + 4 * (F.tid + NTHREADS * it));
        __builtin_amdgcn_sched_barrier(0);
#pragma unroll
        for (int it = 0; it < 16; ++it) { const int i = 4 * (F.tid + NTHREADS * it), k = i >> 5, j0 = i & 31;
#pragma unroll
            for (int e = 0; e < 4; ++e) { const float w = wv[it][e]; const unsigned h = pk_bf16(w, 0.f) & 0xffffu; const float r = w - __uint_as_float(h << 16);
                Whi[(j0 + e) * RM_WST + k] = (bf16_t)h; Wlo[(j0 + e) * RM_WST + k] = (bf16_t)(pk_bf16(r, 0.f) & 0xffffu); } }
#pragma unroll
        for (int it = 0; it < 2; ++it) { const int k = F.tid + NTHREADS * it;
#pragma unroll
            for (int e = 0; e < 4; ++e) { const float w = gv[it][e]; const unsigned h = pk_bf16(w, 0.f) & 0xffffu; const float r = w - __uint_as_float(h << 16);
                Whi[(32 + e) * RM_WST + k] = (bf16_t)h; Wlo[(32 + e) * RM_WST + k] = (bf16_t)(pk_bf16(r, 0.f) & 0xffffu); } }
    }
    if (F.tid < 32) lcnt[F.tid] = 0;
    __syncthreads();
    const int RPB = (nrows + F.G - 1) / F.G, rbeg = F.bid * RPB, rend = (rbeg + RPB < nrows) ? rbeg + RPB : nrows;
    const int lane = F.lane, tk = lane & 15, kq = lane >> 4;
    const bf16_t* XB = (const bf16_t*)(F.ws_() + WS_XB); bf16_t* H2 = (bf16_t*)(F.ws_() + WS_H);
    for (int g0 = rbeg + 16 * F.wave; g0 < rend; g0 += 128) {
        const int b = (g0 >= TL) ? 32 : (g0 >> 11);
        const float* GG = (const float*)(F.ws_() + WS_GG) + ((size_t)l * 33 + b) * D; const float* SH = (const float*)(F.ws_() + WS_MOD) + ((size_t)l * 33 + b) * (NMOD * D) + 3 * D;
        const float* RB = (const float*)(F.ws_() + WS_RB) + ((size_t)l * 33 + b) * 48;
        const int tok = (g0 + tk < rend) ? g0 + tk : rend - 1;
        const bf16_t* xp = XB + (size_t)tok * D + 8 * kq;
        f32x4 acc0 = (f32x4){0.f, 0.f, 0.f, 0.f}, acc1 = acc0, acc2 = acc0; float ss = 0.f;
        u32x4 xa[8], xn[8];
#pragma unroll
        for (int j = 0; j < 8; ++j) xa[j] = *(const u32x4*)(xp + 32 * j);
        int wob = tk * RM_WST + 8 * kq; asm volatile("" : "+v"(wob));
#pragma unroll 1
        for (int kc = 0; kc < 32; kc += 8) {
            f32x4 gaa[8], gbb[8];
#pragma unroll
            for (int j = 0; j < 8; ++j) { gaa[j] = *(const f32x4*)(GG + 32 * (kc + j) + 8 * kq); gbb[j] = *(const f32x4*)(GG + 32 * (kc + j) + 8 * kq + 4); }
            {   const int kn = (kc < 24) ? kc + 8 : 0;
#pragma unroll
                for (int j = 0; j < 8; ++j) xn[j] = *(const u32x4*)(xp + 32 * (kn + j)); }
            __builtin_amdgcn_sched_barrier(0);
#pragma unroll
            for (int jc = 0; jc < 8; ++jc) { const int ks = kc + jc;
            const u32x4 xv = xa[jc];
            const f32x4 ga = gaa[jc], gb = gbb[jc];
            const float x[8] = {bflo(xv.x), bfhi(xv.x), bflo(xv.y), bfhi(xv.y), bflo(xv.z), bfhi(xv.z), bflo(xv.w), bfhi(xv.w)};
            const float gg[8] = {ga[0], ga[1], ga[2], ga[3], gb[0], gb[1], gb[2], gb[3]};
            float y[8], yl[8]; unsigned hp[4];
#pragma unroll
            for (int j = 0; j < 8; ++j) { ss += x[j] * x[j]; y[j] = x[j] * gg[j]; }
#pragma unroll
            for (int j = 0; j < 4; ++j) { hp[j] = pk_bf16(y[2 * j], y[2 * j + 1]); yl[2 * j] = y[2 * j] - bflo(hp[j]); yl[2 * j + 1] = y[2 * j + 1] - bfhi(hp[j]); }
            const bf16x8 Ah = __builtin_bit_cast(bf16x8, (u32x4){hp[0], hp[1], hp[2], hp[3]}); const bf16x8 Al = pk8(yl);
            const int wo = wob + 32 * ks;
            const bf16x8 Bh0 = *(const LAS bf16x8*)(Whi + wo), Bl0 = *(const LAS bf16x8*)(Wlo + wo);
            const bf16x8 Bh1 = *(const LAS bf16x8*)(Whi + 16 * RM_WST + wo), Bl1 = *(const LAS bf16x8*)(Wlo + 16 * RM_WST + wo);
            const bf16x8 Bh2 = *(const LAS bf16x8*)(Whi + 32 * RM_WST + wo), Bl2 = *(const LAS bf16x8*)(Wlo + 32 * RM_WST + wo);
            acc0 = MFMA16(Ah, Bh0, acc0); acc0 = MFMA16(Ah, Bl0, acc0); acc0 = MFMA16(Al, Bh0, acc0);
            acc1 = MFMA16(Ah, Bh1, acc1); acc1 = MFMA16(Ah, Bl1, acc1); acc1 = MFMA16(Al, Bh1, acc1);
            acc2 = MFMA16(Ah, Bh2, acc2); acc2 = MFMA16(Ah, Bl2, acc2); acc2 = MFMA16(Al, Bh2, acc2);
            }
            __builtin_amdgcn_sched_barrier(0);
#pragma unroll
            for (int j = 0; j < 8; ++j) xa[j] = xn[j];
        }
        ss += __shfl_xor(ss, 16); ss += __shfl_xor(ss, 32);
        const float rstd = rsqrtf(ss * (1.0f / D) + EPS);
        const float rb0 = RB[tk], rb1 = RB[16 + tk], rb2 = RB[32 + tk];
#pragma unroll
        for (int r = 0; r < 4; ++r) {
            const float rs = __shfl(rstd, 4 * kq + r);
            const float gv = (tk < 4) ? rs * acc2[r] + rb2 : -3.0e38f;
            const float gmax = row_max16(gv); const int gi = row_first16(gv == gmax, kq);
            const float pg = __builtin_amdgcn_rcpf(row_sum16(tk < 4 ? __expf(gv - gmax) : 0.f));
            const float ev = (gi >> 1) ? rs * acc1[r] + rb1 : rs * acc0[r] + rb0; const bool valid = (tk >> 3) == (gi & 1);
            const float m0 = row_max16(valid ? ev : -3.0e38f); const int e0 = row_first16(valid && ev == m0, kq);
            const bool v2 = valid && tk != e0;
            const float m1 = row_max16(v2 ? ev : -3.0e38f); const int e1 = row_first16(v2 && ev == m1, kq);
            const float x1 = __expf(m1 - m0); const float w0 = pg / (1.0f + x1), w1 = pg * x1 / (1.0f + x1);
            const int row = g0 + 4 * kq + r;
            if (tk == 0 && row < rend) { const int E0 = 8 * gi + (e0 & 7), E1 = 8 * gi + (e1 & 7); const int ri = row - rbeg;
                rec[ri] = (i32x4){E0, E1, __float_as_int(w0), __float_as_int(w1)};
                const int p0 = atomicAdd((int*)&lcnt[E0], 1), p1 = atomicAdd((int*)&lcnt[E1], 1); lp[ri] = (i32x2){p0, p1}; }
        }
        if (g0 + tk < rend) { unsigned char* hp2 = (unsigned char*)H2 + (size_t)tok * D + 8 * kq;
            const float* GG2 = GG; asm volatile("" : "+s"(GG2)); const bf16_t* xp2 = xp; asm volatile("" : "+v"(xp2));
#pragma unroll 4
            for (int ks = 0; ks < 32; ++ks) {
                const u32x4 xv = *(const u32x4*)(xp2 + 32 * ks);
                const f32x4 ga = *(const f32x4*)(GG2 + 32 * ks + 8 * kq), gb = *(const f32x4*)(GG2 + 32 * ks + 8 * kq + 4), sa = *(const f32x4*)(SH + 32 * ks + 8 * kq), sb = *(const f32x4*)(SH + 32 * ks + 8 * kq + 4);
                u32x2 o; o.x = pk_fp8x4(bflo(xv.x) * rstd * ga[0] + sa[0], bfhi(xv.x) * rstd * ga[1] + sa[1], bflo(xv.y) * rstd * ga[2] + sa[2], bfhi(xv.y) * rstd * ga[3] + sa[3]);
                o.y = pk_fp8x4(bflo(xv.z) * rstd * gb[0] + sb[0], bfhi(xv.z) * rstd * gb[1] + sb[1], bflo(xv.w) * rstd * gb[2] + sb[2], bfhi(xv.w) * rstd * gb[3] + sb[3]);
                *(u32x2*)(hp2 + 32 * ks) = o; } }
    }
    __syncthreads();
    if (F.tid < 32) lbase[F.tid] = (int)__hip_atomic_fetch_add(F.ctl + CW_CNT + l * 32 + F.tid, (unsigned)lcnt[F.tid], __ATOMIC_RELAXED, __HIP_MEMORY_SCOPE_AGENT);
    __syncthreads();
    int* tokof = (int*)(F.ws_() + WS_TOKOF); float* gateof = (float*)(F.ws_() + WS_GATEOF); i32x4* tokinf = (i32x4*)(F.ws_() + WS_TOKINF);
    for (int ri = F.tid; ri < 304; ri += NTHREADS) { const int row = rbeg + ri;
        if (row < rend) { const i32x4 rc = rec[ri]; const i32x2 q = lp[ri]; const int p0 = lbase[rc.x] + q.x, p1 = lbase[rc.y] + q.y;
            tokof[(size_t)rc.x * TT + p0] = row; gateof[(size_t)rc.x * TT + p0] = __int_as_float(rc.z);
            tokof[(size_t)rc.y * TT + p1] = row; gateof[(size_t)rc.y * TT + p1] = __int_as_float(rc.w);
            tokinf[row] = (i32x4){rc.x, p0, rc.y, p1}; } }
}

constexpr int MO_TS = 131072;
constexpr int MO_TE = MO_TS + 256;
static_assert(MO_TE + 640 <= LDS_BARW, "moe LDS");
namespace pg8 {
struct MoeOrder {
    static constexpr bool PREFETCH = true;
    const LAS int* ts; const LAS unsigned char* te; const unsigned* cnt; const int* tokof; int G, c, nunits; bool gather;
    __device__ __forceinline__ bool next(int i, Unit& u) const {
        const long L = (long)i * G + c; if (L >= nunits) return false;
        u.pn = (int)(L & 3); u.pm = (int)(L >> 2); u.e = te[u.pm]; return true;
    }
    __device__ __forceinline__ unsigned arow(const Unit& u, int r) const {
        if (!gather) return (unsigned)(u.pm * BM + r);
        const int pos = (u.pm - ts[u.e]) * BM + r;
        return pos < (int)cnt[u.e] ? (unsigned)tokof[(size_t)u.e * TT + pos] : 0u;
    }
};
struct EpiSwiGLU {
    static constexpr bool PERM = true;
    bf16_t* H; const float* gateof; const unsigned* cnt; const LAS int* ts;
    __device__ __forceinline__ void operator()(const f32x4 (&acc)[2][2][4][2], const Unit& u, int wr, int wc, int fr, int fq) const {
        const int r0 = wr * 64 + fr, col0 = u.pn * 128 + wc * 32 + 8 * fq; const int pbase = (u.pm - ts[u.e]) * BM; const int ce = (int)cnt[u.e];
        float gt[2][4];
#pragma unroll
        for (int ai = 0; ai < 2; ++ai)
#pragma unroll
            for (int m = 0; m < 4; ++m) { const int pos = pbase + r0 + ai * HALF + m * 16; gt[ai][m] = pos < ce ? gateof[(size_t)u.e * TT + pos] : 0.f; }
#pragma unroll
        for (int ai = 0; ai < 2; ++ai)
#pragma unroll
            for (int m = 0; m < 4; ++m) { const f32x4 g0 = acc[ai][0][m][0], g1 = acc[ai][0][m][1], u0 = acc[ai][1][m][0], u1 = acc[ai][1][m][1]; const float q = gt[ai][m];
                const float q16 = q * 8.f;
                u32x2 w; w.x = pk_fp8x4(silu_f(g0[0]) * u0[0] * q16, silu_f(g0[1]) * u0[1] * q16, silu_f(g0[2]) * u0[2] * q16, silu_f(g0[3]) * u0[3] * q16);
                w.y = pk_fp8x4(silu_f(g1[0]) * u1[0] * q16, silu_f(g1[1]) * u1[1] * q16, silu_f(g1[2]) * u1[2] * q16, silu_f(g1[3]) * u1[3] * q16);
                *(u32x2*)((unsigned char*)H + (size_t)(u.pm * BM + r0 + ai * HALF + m * 16) * DEXP + col0) = w; }
    }
};
struct EpiMoeOut {
    static constexpr bool PERM = true;
    bf16_t* O; const float* gateof; const unsigned* cnt; const LAS int* ts;
    __device__ __forceinline__ void operator()(const f32x4 (&acc)[2][2][4][2], const Unit& u, int wr, int wc, int fr, int fq) const {
        const int r0 = wr * 64 + fr, col0 = u.pn * BM + wc * 32 + 8 * fq; const int pbase = (u.pm - ts[u.e]) * BM; const int ce = (int)cnt[u.e];
#pragma unroll
        for (int ai = 0; ai < 2; ++ai)
#pragma unroll
            for (int m = 0; m < 4; ++m) { const int r = r0 + ai * HALF + m * 16; const int pos = pbase + r;
                const float gt = pos < ce ? gateof[(size_t)u.e * TT + pos] : 0.f;
                bf16_t* rowp = O + (size_t)(u.pm * BM + r) * D + col0;
#pragma unroll
                for (int bj = 0; bj < 2; ++bj) { const f32x4 v0 = acc[ai][bj][m][0] * gt, v1 = acc[ai][bj][m][1] * gt;
                    u32x4 w; w.x = pk_bf16(v0[0], v0[1]); w.y = pk_bf16(v0[2], v0[3]); w.z = pk_bf16(v1[0], v1[1]); w.w = pk_bf16(v1[2], v1[3]);
                    *(u32x4*)(rowp + bj * HALF) = w; } }
    }
};
}
__device__ __forceinline__ int moe_tables(const Frame& F, int l) {
    LAS int* ts = (LAS int*)(F.lds + MO_TS); LAS unsigned char* te = (LAS unsigned char*)(F.lds + MO_TE);
    __syncthreads();
    if (F.tid == 0) { int acc = 0; for (int e = 0; e < 32; ++e) { ts[e] = acc; acc += ((int)F.ctl[CW_CNT + l * 32 + e] + 255) >> 8; } ts[32] = acc; }
    __syncthreads();
    if (F.tid < 32) { for (int t = ts[F.tid]; t < ts[F.tid + 1]; ++t) te[t] = (unsigned char)F.tid; }
    __syncthreads();
    return ts[32];
}

__global__ void __launch_bounds__(NTHREADS, 2) fwd_kernel(Params prm) {
    extern __shared__ __attribute__((aligned(16))) unsigned char lds_raw[];
    Frame F; F.P = (KParams)__builtin_amdgcn_kernarg_segment_ptr(); F.lds = (LAS unsigned char*)lds_raw; F.wsg = prm.ws; F.tid = threadIdx.x; F.lane = F.tid & 63; F.wave = __builtin_amdgcn_readfirstlane(F.tid >> 6);
    F.G = gridDim.x; F.bid = blockIdx.x; F.vcu = 0; F.ctl = (unsigned*)((unsigned char*)prm.ws + WS_CTL);
    if (F.tid < 4) ((LAS unsigned*)(F.lds + LDS_BARW))[F.tid] = 0u;
    __syncthreads();
    (void)xcd_barrier_post(F.ctl + CW_BAR, (volatile LAS unsigned*)(F.lds + LDS_BARW));
    int phase = 0; unsigned long long tacc = 0, tprev = TIME_MASK ? __builtin_amdgcn_s_memrealtime() : 0ull;
#define OPQ() do { asm volatile("" : "+s"(F.wsg)); asm volatile("" : "+s"(F.P)); asm volatile("" : "+s"(F.ctl)); asm volatile("" : "+s"(F.bid)); asm volatile("" : "+s"(F.G)); \
        F.vcu = (F.G % 8 == 0) ? (F.bid % 8) * (F.G / 8) + F.bid / 8 : F.bid; asm volatile("" : "+v"(F.tid)); F.lane = F.tid & 63; F.wave = __builtin_amdgcn_readfirstlane(F.tid >> 6); } while (0)
#define SEAM(sec) do { OPQ(); XcdBarrier b2_; b2_.bar = F.ctl + CW_BAR; b2_.x = xb_xcc_id(); b2_.st = (volatile LAS unsigned*)(F.lds + LDS_BARW); xcd_barrier(b2_); if (++phase > STOP_AFTER) return; \
        if (TIME_MASK) { const unsigned long long now_ = __builtin_amdgcn_s_memrealtime(); if ((TIME_MASK >> (sec)) & 1u) tacc += now_ - tprev; tprev = now_; } } while (0)

    OPQ(); if (PH(0)) {
        p0_rope(F);
        LAS int* qslot = (LAS int*)(F.lds + LDS_BARW - 16);
        for (;;) {
            __syncthreads();
            if (F.tid == 0) *qslot = (int)__hip_atomic_fetch_add(F.ctl + CW_Q, 1u, __ATOMIC_RELAXED, __HIP_MEMORY_SCOPE_AGENT);
            __syncthreads();
            const int it = *qslot;
            if (it >= 384 + 288 + 632 + 576) break;
            if (it < 384) p0_mods_item(F, it);
            else if (it < 672) p0_filter_item(F, it - 384);
            else if (it < 1304) p0_transposes_chunk(F, it - 672);
            else p0_xc_chunk(F, it - 1304);
        }
    }
    SEAM(9);
    OPQ(); if (PH(0)) { p0_gr(F); p0_rtab(F); }
    for (int l = 0; l < DEPTH; ++l) {
        const bool last = (l == DEPTH - 1);
        OPQ(); if (PH(1)) row_norm_phase<0>(F, l, l - 1, l == 0);
        for (int rep_ = 0; rep_ < REPN(2); ++rep_) { OPQ(); if (PH(2)) moe_weight_cvt(F, l); }
        SEAM(0);
        for (int rep_ = 0; rep_ < REPN(3); ++rep_) { OPQ(); if (PH(3)) {
            {
                pg8::Gemm g{(const bf16_t*)(F.ws_() + WS_H8), (const bf16_t*)(F.ws_() + WS_WIN8 + (size_t)l * 1280 * 1024), D / 2, 0, 0x79797979, 0x7f7f7f7f};
                pg8::StaticOrder S; S.init(TT, 1280, F.G, F.bid);
                pg8::EpiFp8 E{F.ws_() + WS_P, DIN * 2, 1.f};
                pg8::gemm_phase<pg8::EpiFp8, pg8::StaticOrder, true, true, true>(F.lds, g, S, E, F.tid); }
            {
                pg8::Gemm g{(const bf16_t*)(F.ws_() + WS_H), (const bf16_t*)(F.ws_() + WS_WINT) + ((size_t)l * DIN + 1280) * D, D, 0, 0, 0};
                pg8::StaticOrder S; S.init(TT, 1280, F.G, F.G - 1 - F.bid);
                pg8::EpiBf16 E{(bf16_t*)(F.ws_() + WS_P) + 1280, DIN};
                pg8::gemm_phase<pg8::EpiBf16, pg8::StaticOrder>(F.lds, g, S, E, F.tid); }
            OPQ(); moe_weight_cvt_queue(F, l, 0); } }
        SEAM(1);
        for (int rep_ = 0; rep_ < REPN(4); ++rep_) { OPQ(); if (PH(4)) attn_pre(F, l); }
        for (int rep_ = 0; rep_ < REPN(5); ++rep_) { OPQ(); if (PH(5)) conf_phase(F, l, !last); }
        for (int rep_ = 0; rep_ < REPN(6); ++rep_) { OPQ(); if (PH(6)) hy_pre(F, l, !last); }
        for (int rep_ = 0; rep_ < REPN(7); ++rep_) { OPQ(); if (PH(7)) lru_seq(F, l, !last); }
        SEAM(2);
        for (int rep_ = 0; rep_ < REPN(8); ++rep_) { OPQ(); if (PH(8)) hy_conv<0>(F, l, !last); }
        for (int rep_ = 0; rep_ < REPN(9); ++rep_) { OPQ(); if (PH(9)) lru_comb(F, !last); }
        SEAM(3);
        for (int rep_ = 0; rep_ < REPN(10); ++rep_) { OPQ(); if (PH(10)) hy_conv<1>(F, l, !last); }
        for (int rep_ = 0; rep_ < REPN(11); ++rep_) { OPQ(); if (PH(11)) attn_phase(F, l, !last); }
        SEAM(4);
        OPQ(); if (PH(12)) {   pg8::Gemm g{(const bf16_t*)(F.ws_() + WS_Y), (const bf16_t*)(F.ws_() + WS_WOUTT) + (size_t)l * D * D, D, 0, 0, 0};
            pg8::StaticOrder S; S.init(last ? TL : TT, D, F.G, F.bid);
            pg8::EpiResid E{(bf16_t*)(F.ws_() + WS_XB), (const float*)(F.ws_() + WS_MOD) + (size_t)l * 33 * (NMOD * D) + 2 * D};
            pg8::gemm_phase<pg8::EpiResid, pg8::StaticOrder>(F.lds, g, S, E, F.tid);
            OPQ(); moe_weight_cvt_queue(F, l, 1); }
        SEAM(5);
        OPQ(); if (PH(13)) ffn_route_mfma(F, l, last ? TL : TT);
        SEAM(6);
        for (int rep_ = 0; rep_ < REPN(14); ++rep_) { OPQ(); if (PH(14)) {   const int ntile = moe_tables(F, l);
            pg8::MoeOrder S{(const LAS int*)(F.lds + MO_TS), (const LAS unsigned char*)(F.lds + MO_TE), F.ctl + CW_CNT + l * 32, (const int*)(F.ws_() + WS_TOKOF), F.G, (F.G % 8 == 0) ? (F.bid % 8) * (F.G / 8) + F.bid / 8 : F.bid, ntile * 4, true};
            pg8::Gemm g{(const bf16_t*)(F.ws_() + WS_H), (const bf16_t*)(F.ws_() + WS_MOEGU), D / 2, (size_t)1024 * 1024, 0x79797979, 0x7f7f7f7f};
            pg8::EpiSwiGLU E{(bf16_t*)(F.ws_() + WS_HID), (const float*)(F.ws_() + WS_GATEOF), F.ctl + CW_CNT + l * 32, (const LAS int*)(F.lds + MO_TS)};
            pg8::gemm_phase<pg8::EpiSwiGLU, pg8::MoeOrder, true, true, true>(F.lds, g, S, E, F.tid); } }
        SEAM(7);
        for (int rep_ = 0; rep_ < REPN(15); ++rep_) { OPQ(); if (PH(15)) {   const int ntile = moe_tables(F, l);
            pg8::MoeOrder S{(const LAS int*)(F.lds + MO_TS), (const LAS unsigned char*)(F.lds + MO_TE), F.ctl + CW_CNT + l * 32, (const int*)(F.ws_() + WS_TOKOF), F.G, (F.G % 8 == 0) ? (F.bid % 8) * (F.G / 8) + F.bid / 8 : F.bid, ntile * 4, false};
            pg8::Gemm g{(const bf16_t*)(F.ws_() + WS_HID), (const bf16_t*)(F.ws_() + WS_MOEDN), DEXP / 2, (size_t)1024 * 512, 0x79797979, 0x7c7c7c7c};
            pg8::EpiFp8 E{F.ws_() + WS_O, D, 16.f};
            pg8::gemm_phase<pg8::EpiFp8, pg8::MoeOrder, true, true, true>(F.lds, g, S, E, F.tid); } }
        SEAM(8);
    }
    OPQ(); if (PH(16)) row_norm_phase<2>(F, 0, DEPTH - 1, false);
    if (TIME_MASK) { __syncthreads(); const unsigned long long now_ = __builtin_amdgcn_s_memrealtime(); if ((TIME_MASK >> 11) & 1u) tacc += now_ - tprev;
        if (F.bid == 0) { const unsigned long long t0_ = __builtin_amdgcn_s_memrealtime(); while (__builtin_amdgcn_s_memrealtime() - t0_ < tacc) __builtin_amdgcn_s_sleep(8); } }
    if (xb_ld(F.ctl + CW_BAR + XB_TMO) != 0u) {
        __syncthreads();
        for (int row = F.bid * 8 + F.wave; row < TL; row += F.G * 8) { float* xr = F.out() + (size_t)row * D;
            for (int i = 0; i < 4; ++i) *(f32x4*)(xr + i * 256 + 4 * F.lane) = (f32x4){0.f, 0.f, 0.f, 0.f}; }
    }
}

extern "C" void kernel_launch(void* const* d_in, const int* in_sizes, int n_in, void* d_out, int out_size, void* d_ws, size_t ws_size, hipStream_t stream) {
    static int grid = 0;
    if (!grid) {
        int dev = 0, cus = 0, per_cu = 0;
        hipGetDevice(&dev);
        hipDeviceGetAttribute(&cus, hipDeviceAttributeMultiprocessorCount, dev);
        hipFuncSetAttribute((const void*)fwd_kernel, hipFuncAttributeMaxDynamicSharedMemorySize, LDS_BYTES);
        hipOccupancyMaxActiveBlocksPerMultiprocessor(&per_cu, (const void*)fwd_kernel, NTHREADS, LDS_BYTES);
        if (per_cu < 1) fprintf(stderr, "kernel_launch: occupancy query says %d\n", per_cu);
        grid = cus > 0 ? cus : 256;
        if (ws_size < WS_END) fprintf(stderr, "kernel_launch: workspace too small: %zu < %zu\n", ws_size, (size_t)WS_END);
        if (n_in != 46) fprintf(stderr, "kernel_launch: expected 46 inputs, got %d\n", n_in);
    }
    hipMemsetAsync((char*)d_ws + WS_CTL, 0, CTL_BYTES, stream);
    Params p; memset(&p, 0, sizeof(p));
    for (int i = 0; i < 46 && i < n_in; ++i) p.in[i] = (const GAS float*)d_in[i];
    p.out = (GAS float*)d_out; p.ws = (GAS unsigned char*)d_ws;
    hipLaunchKernelGGL(fwd_kernel, dim3(grid), dim3(NTHREADS), LDS_BYTES, stream, p);
}
```
